# Optimizing an MI355X kernel written in HIP

```python
import jax, jax.numpy as jnp
from jax import lax
import numpy as np

D_MODEL = 2048
BATCH = 1
SEQ = 8192
DEPTH = 1

D_MIX = D_MODEL
RET_HEADS = 4
RET_HEAD_DIM = 256
RET_WIDTH = RET_HEADS * RET_HEAD_DIM
SSM_WIDTH = D_MIX - RET_WIDTH
SSM_HEAD_DIM = 64
SSM_HEADS = SSM_WIDTH // SSM_HEAD_DIM
SSM_GROUPS = 2
SSM_STATE = 128
CONV_WIDTH = 4
XBC_WIDTH = SSM_WIDTH + 2 * SSM_GROUPS * SSM_STATE
D_IN_PROJ = 4 * RET_WIDTH + SSM_WIDTH + XBC_WIDTH + SSM_HEADS
CHUNK = 128
ROPE_BASE = 10000.0
N_EXPERTS = 32
TOP_K = 4
D_FF = D_MODEL
SWIGLU_LIMIT = 7.0
SWIGLU_ALPHA = 1.702
MOE_BLOCK = 128
EPS = 1e-6

kernel_name = "hybrid_retention_ssd_moe_layer"

F32 = jnp.float32


def rmsnorm(x, w):
    xf = x.astype(F32)
    y = xf * lax.rsqrt(jnp.mean(xf * xf, axis=-1, keepdims=True) + EPS)
    return (y * w.astype(F32)).astype(x.dtype)


def apply_rope(t, positions):
    half = t.shape[-1] // 2
    inv_freq = ROPE_BASE ** (-jnp.arange(half, dtype=F32) / half)
    ang = positions.astype(F32)[..., None] * inv_freq
    cos = jnp.cos(ang)[:, :, None, :]
    sin = jnp.sin(ang)[:, :, None, :]
    t1, t2 = t[..., :half], t[..., half:]
    return jnp.concatenate([t1 * cos - t2 * sin, t2 * cos + t1 * sin], axis=-1)


def retention_chunkwise(q, k, v):
    b, L, h, dk = q.shape
    dv = v.shape[-1]
    c = L // CHUNK
    log_gamma = jnp.log1p(-jnp.exp2(-5.0 - jnp.arange(h, dtype=F32)))
    idx = jnp.arange(CHUNK, dtype=F32)
    rel = idx[:, None] - idx[None, :]
    causal = rel >= 0
    intra = jnp.where(causal, jnp.exp(log_gamma[:, None, None] * jnp.where(causal, rel, 0.0)), 0.0)
    q_decay = jnp.exp(log_gamma[:, None] * (idx + 1.0))
    k_decay = jnp.exp(log_gamma[:, None] * (CHUNK - 1.0 - idx))
    chunk_decay = jnp.exp(log_gamma * CHUNK)
    qc = q.reshape(b, c, CHUNK, h, dk)
    kc = k.reshape(b, c, CHUNK, h, dk)
    vc = v.reshape(b, c, CHUNK, h, dv)
    scores = jnp.einsum('bclhd,bcshd->bchls', qc, kc) * intra
    inner = jnp.einsum('bchls,bcshv->bclhv', scores, vc)
    kv = jnp.einsum('bclhd,bclhv,hl->bchdv', kc, vc, k_decay)

    def step(state, kv_c):
        return chunk_decay[None, :, None, None] * state + kv_c, state

    _, prev = lax.scan(step, jnp.zeros((b, h, dk, dv), F32), jnp.moveaxis(kv, 1, 0))
    prev = jnp.moveaxis(prev, 0, 1)
    cross = jnp.einsum('bclhd,bchdv,hl->bclhv', qc, prev, q_decay)
    return (inner + cross).reshape(b, L, h, dv)


def ssd_chunked(x, dt, A, Bm, Cm):
    b, L, H, P = x.shape
    G, N = Bm.shape[2], Bm.shape[3]
    E = H // G
    c = L // CHUNK
    x = x.reshape(b, c, CHUNK, G, E, P)
    dt = dt.reshape(b, c, CHUNK, G, E)
    Bm = Bm.reshape(b, c, CHUNK, G, N)
    Cm = Cm.reshape(b, c, CHUNK, G, N)
    a_cum = jnp.cumsum(dt * A.reshape(G, E), axis=2)
    a_t = jnp.moveaxis(a_cum, 2, -1)
    seg = a_t[..., :, None] - a_t[..., None, :]
    tril = jnp.tril(jnp.ones((CHUNK, CHUNK), dtype=bool))
    decay_ls = jnp.exp(jnp.where(tril, seg, -jnp.inf))
    xdt = x * dt[..., None]
    cb = jnp.einsum('bclgn,bcsgn->bcgls', Cm, Bm)
    y_diag = jnp.einsum('bcgels,bcsgep->bclgep', cb[:, :, :, None] * decay_ls, xdt)
    decay_states = jnp.exp(a_cum[:, :, -1:] - a_cum)
    states = jnp.einsum('bclgn,bclge,bclgep->bcgepn', Bm, decay_states, xdt)
    chunk_decay = jnp.exp(a_cum[:, :, -1])

    def step(state, inp):
        s_c, d_c = inp
        return d_c[..., None, None] * state + s_c, state

    _, prev = lax.scan(step, jnp.zeros((b, G, E, P, N), F32),
                       (jnp.moveaxis(states, 1, 0), jnp.moveaxis(chunk_decay, 1, 0)))
    prev = jnp.moveaxis(prev, 0, 1)
    y_off = jnp.einsum('bclgn,bcgepn,bclge->bclgep', Cm, prev, jnp.exp(a_cum))
    return (y_diag + y_off).reshape(b, L, H, P)


def causal_depthwise_conv(u, w, bias):
    K, ch = w.shape
    out = lax.conv_general_dilated(u, w[:, None, :], window_strides=(1,), padding=[(K - 1, 0)],
                                   dimension_numbers=('NWC', 'WIO', 'NWC'), feature_group_count=ch)
    return out + bias


def hybrid_mixer(u, positions, w_in, conv_w, conv_b, dt_bias, a_log, d_skip, ssm_norm_w, w_out):
    b, L, _ = u.shape
    proj = u @ w_in
    cuts = np.cumsum([RET_WIDTH, RET_WIDTH, RET_WIDTH, RET_WIDTH, SSM_WIDTH, XBC_WIDTH]).tolist()
    q, k, v, g, z, xbc, dt_raw = jnp.split(proj, cuts, axis=-1)

    q = apply_rope(q.astype(F32).reshape(b, L, RET_HEADS, RET_HEAD_DIM), positions)
    k = apply_rope(k.astype(F32).reshape(b, L, RET_HEADS, RET_HEAD_DIM), positions) * (RET_HEAD_DIM ** -0.5)
    v = v.astype(F32).reshape(b, L, RET_HEADS, RET_HEAD_DIM)
    o = retention_chunkwise(q, k, v)
    o = o * lax.rsqrt(jnp.mean(o * o, axis=-1, keepdims=True) + EPS)
    ret_out = o.reshape(b, L, RET_WIDTH) * jax.nn.silu(g.astype(F32))

    xbc = jax.nn.silu(causal_depthwise_conv(xbc, conv_w, conv_b)).astype(F32)
    xs, Bm, Cm = jnp.split(xbc, [SSM_WIDTH, SSM_WIDTH + SSM_GROUPS * SSM_STATE], axis=-1)
    xs = xs.reshape(b, L, SSM_HEADS, SSM_HEAD_DIM)
    Bm = Bm.reshape(b, L, SSM_GROUPS, SSM_STATE)
    Cm = Cm.reshape(b, L, SSM_GROUPS, SSM_STATE)
    dt = jax.nn.softplus(dt_raw.astype(F32) + dt_bias.astype(F32))
    A = -jnp.exp(a_log.astype(F32))
    y = ssd_chunked(xs, dt, A, Bm, Cm) + d_skip.astype(F32)[:, None] * xs
    y = y.reshape(b, L, SSM_WIDTH) * jax.nn.silu(z.astype(F32))
    yg = y.reshape(b, L, SSM_GROUPS, SSM_WIDTH // SSM_GROUPS)
    yg = yg * lax.rsqrt(jnp.mean(yg * yg, axis=-1, keepdims=True) + EPS)
    ssm_out = yg.reshape(b, L, SSM_WIDTH) * ssm_norm_w.astype(F32)

    mixed = jnp.concatenate([ret_out, ssm_out], axis=-1).astype(u.dtype)
    return mixed @ w_out


def moe_ffn(h, w_router, b_router, w_gate_up, b_gate_up, w_down, b_down):
    b, L, Dm = h.shape
    T = b * L
    xt = h.reshape(T, Dm)
    logits = (xt @ w_router + b_router).astype(F32)
    top_logits, top_idx = lax.top_k(logits, TOP_K)
    top_w = jax.nn.softmax(top_logits, axis=-1).astype(h.dtype)

    n_assign = T * TOP_K
    n_blocks = -(-(n_assign + N_EXPERTS * (MOE_BLOCK - 1)) // MOE_BLOCK)
    n_rows = n_blocks * MOE_BLOCK
    expert_flat = top_idx.reshape(-1).astype(jnp.int32)
    token_flat = jnp.arange(n_assign, dtype=jnp.int32) // TOP_K
    weight_flat = top_w.reshape(-1)
    order = jnp.argsort(expert_flat, stable=True)
    sorted_expert = expert_flat[order]
    counts = jnp.bincount(expert_flat, length=N_EXPERTS).astype(jnp.int32)
    padded = (counts + MOE_BLOCK - 1) // MOE_BLOCK * MOE_BLOCK
    padded_end = jnp.cumsum(padded)
    padded_start = padded_end - padded
    start = jnp.cumsum(counts) - counts
    rank = jnp.arange(n_assign, dtype=jnp.int32) - start[sorted_expert]
    dest = padded_start[sorted_expert] + rank
    row_token = jnp.full((n_rows,), T, jnp.int32).at[dest].set(token_flat[order])
    row_weight = jnp.zeros((n_rows,), h.dtype).at[dest].set(weight_flat[order])
    block_expert = jnp.minimum(
        jnp.searchsorted(padded_end, jnp.arange(n_blocks, dtype=jnp.int32) * MOE_BLOCK, side='right'),
        N_EXPERTS - 1).astype(jnp.int32)
    x_rows = jnp.concatenate([xt, jnp.zeros((1, Dm), xt.dtype)], axis=0)[row_token]
    x_rows = x_rows.reshape(n_blocks, MOE_BLOCK, Dm)

    def expert_block(args):
        xb, e = args
        gu = xb @ w_gate_up[e] + b_gate_up[e]
        gate = jnp.minimum(gu[..., ::2], SWIGLU_LIMIT)
        up = jnp.clip(gu[..., 1::2], -SWIGLU_LIMIT, SWIGLU_LIMIT)
        act = (up + 1.0) * (gate * jax.nn.sigmoid(gate * SWIGLU_ALPHA))
        return act @ w_down[e] + b_down[e]

    y_rows = lax.map(expert_block, (x_rows, block_expert)).reshape(n_rows, Dm)
    y = jnp.zeros((T + 1, Dm), h.dtype).at[row_token].add(y_rows * row_weight[:, None])
    return y[:T].reshape(b, L, Dm)


def setup_inputs(seed: int = 0) -> dict:
    key = jax.random.key(seed)
    ks = jax.random.split(key, 20)
    nrm = jax.random.normal
    x = nrm(ks[0], (BATCH, SEQ, D_MODEL), F32)
    positions = jnp.broadcast_to(jnp.arange(SEQ, dtype=jnp.int32), (BATCH, SEQ))
    ln_mix_w = 1.0 + 0.02 * nrm(ks[1], (DEPTH, D_MODEL), F32)
    w_in = nrm(ks[2], (DEPTH, D_MODEL, D_IN_PROJ), F32) * D_MODEL ** -0.5
    conv_w = nrm(ks[3], (DEPTH, CONV_WIDTH, XBC_WIDTH), F32) * CONV_WIDTH ** -0.5
    conv_b = 0.01 * nrm(ks[4], (DEPTH, XBC_WIDTH), F32)
    dt0 = jnp.exp(jax.random.uniform(ks[5], (DEPTH, SSM_HEADS), F32, np.log(1e-3), np.log(1e-1)))
    dt_bias = dt0 + jnp.log(-jnp.expm1(-dt0))
    a_log = jnp.log(jax.random.uniform(ks[6], (DEPTH, SSM_HEADS), F32, 1.0, 16.0))
    d_skip = 1.0 + 0.02 * nrm(ks[7], (DEPTH, SSM_HEADS), F32)
    ssm_norm_w = 1.0 + 0.02 * nrm(ks[8], (DEPTH, SSM_WIDTH), F32)
    w_out = nrm(ks[9], (DEPTH, D_MIX, D_MODEL), F32) * D_MIX ** -0.5
    ln_ffn_w = 1.0 + 0.02 * nrm(ks[10], (DEPTH, D_MODEL), F32)
    w_router = nrm(ks[11], (DEPTH, D_MODEL, N_EXPERTS), F32) * D_MODEL ** -0.5
    b_router = 0.01 * nrm(ks[12], (DEPTH, N_EXPERTS), F32)
    w_gate_up = nrm(ks[13], (DEPTH, N_EXPERTS, D_MODEL, 2 * D_FF), F32) * D_MODEL ** -0.5
    b_gate_up = 0.01 * nrm(ks[14], (DEPTH, N_EXPERTS, 2 * D_FF), F32)
    w_down = nrm(ks[15], (DEPTH, N_EXPERTS, D_FF, D_MODEL), F32) * D_FF ** -0.5
    b_down = 0.01 * nrm(ks[16], (DEPTH, N_EXPERTS, D_MODEL), F32)
    ln_final_w = 1.0 + 0.02 * nrm(ks[17], (D_MODEL,), F32)
    return {"x": x, "positions": positions, "ln_mix_w": ln_mix_w, "w_in": w_in, "conv_w": conv_w,
            "conv_b": conv_b, "dt_bias": dt_bias, "a_log": a_log, "d_skip": d_skip,
            "ssm_norm_w": ssm_norm_w, "w_out": w_out, "ln_ffn_w": ln_ffn_w, "w_router": w_router,
            "b_router": b_router, "w_gate_up": w_gate_up, "b_gate_up": b_gate_up, "w_down": w_down,
            "b_down": b_down, "ln_final_w": ln_final_w}


def reference(x, positions, ln_mix_w, w_in, conv_w, conv_b, dt_bias, a_log, d_skip, ssm_norm_w, w_out,
              ln_ffn_w, w_router, b_router, w_gate_up, b_gate_up, w_down, b_down, ln_final_w):
    h = x
    for layer in range(DEPTH):
        u = rmsnorm(h, ln_mix_w[layer])
        h = h + hybrid_mixer(u, positions, w_in[layer], conv_w[layer], conv_b[layer], dt_bias[layer],
                             a_log[layer], d_skip[layer], ssm_norm_w[layer], w_out[layer])
        u = rmsnorm(h, ln_ffn_w[layer])
        h = h + moe_ffn(u, w_router[layer], b_router[layer], w_gate_up[layer], b_gate_up[layer],
                        w_down[layer], b_down[layer])
    return rmsnorm(h, ln_final_w)
```

```cpp
#include <hip/hip_runtime.h>
#include <cstdio>
#include <cstdint>

#ifndef MK_N_LAUNCHES
#define MK_N_LAUNCHES 1
#endif

#define LAS __attribute__((address_space(3)))
typedef unsigned short bf16;
typedef short bf16x8 __attribute__((ext_vector_type(8)));
typedef short s16x4 __attribute__((ext_vector_type(4)));
typedef float f32x4 __attribute__((ext_vector_type(4)));
typedef float f32x2 __attribute__((ext_vector_type(2)));
typedef unsigned u32x4 __attribute__((ext_vector_type(4)));
typedef unsigned u32x2 __attribute__((ext_vector_type(2)));
typedef unsigned char uchar;

constexpr int T = 8192, D = 2048, NPROJ = 6672, LDP = 6912;
constexpr int C_Q = 0, C_K = 1024, C_V = 2048, C_G = 3072, C_Z = 4096, C_X = 5120, C_DT = 6656;
constexpr int XBCW = 1536, NCHUNK = 64, CH = 128;
constexpr int NE = 32, DFF = 2048, MAXBLK = 160;
constexpr float EPS = 1e-6f;
constexpr int NPHASE = 10;
constexpr int NWAVES = 8, NTHR = 512;

constexpr size_t MiB = 1ull << 20;
constexpr size_t WS_CTL = 0, CTL_ZERO_BYTES = 1 * MiB;
constexpr size_t WS_WINT = 2 * MiB, WS_WOUTT = 30 * MiB, WS_COS = 38 * MiB, WS_SIN = 42 * MiB;
constexpr size_t WS_TOPI = 46 * MiB, WS_TOPR = 46 * MiB + 128 * 1024, WS_TOPW = 46 * MiB + 256 * 1024, WS_LIST = 47 * MiB, WS_ADEC = 48 * MiB;
constexpr size_t WS_U = 64 * MiB, WS_U2 = 96 * MiB, WS_MIX = 128 * MiB, WS_XBC = 160 * MiB, WS_KV = 192 * MiB, WS_SST = 224 * MiB;
constexpr size_t WS_H = 256 * MiB, WS_PROJ = 320 * MiB, WS_ACT = 448 * MiB, WS_YR = 608 * MiB, WS_WGUT = 768 * MiB, WS_WDT = 1280 * MiB, WS_END = 1536 * MiB;
constexpr int CW_TMO = 0, CW_BAR = 4096, CW_CNT = 16384;

constexpr int RING_BYTES = 131072;
constexpr int LDS_PHASE_END = 139264;
constexpr int LDS_TAB = LDS_PHASE_END;
constexpr int LDS_MISC = LDS_PHASE_END + 4096;
constexpr int LDS_BYTES = 147456;

__device__ __forceinline__ unsigned pk_bf16(float lo, float hi) { unsigned r; asm("v_cvt_pk_bf16_f32 %0, %1, %2" : "=v"(r) : "v"(lo), "v"(hi)); return r; }
__device__ __forceinline__ float bf_lo(unsigned u) { return __uint_as_float(u << 16); }
__device__ __forceinline__ float bf_hi(unsigned u) { return __uint_as_float(u & 0xffff0000u); }
__device__ __forceinline__ float bf2f(bf16 b) { return __uint_as_float(((unsigned)b) << 16); }
__device__ __forceinline__ float wave_sum(float v) {
#pragma unroll
    for (int o = 1; o < 64; o <<= 1) v += __shfl_xor(v, o);
    return v;
}
__device__ __forceinline__ float silu_f(float x) { return x / (1.0f + __expf(-x)); }
__device__ __forceinline__ float softplus_f(float x) { return x > 20.f ? x : log1pf(__expf(x)); }

__constant__ double INV_FREQ[128] = {1,0.93057204092969903,0.86596432336006535,0.80584218776148187,0.74989420933245587,0.69783058485986638,0.64938163157621132,0.60429639023813286,0.56234132519034907,0.5232991146814947,0.48696752516586311,0.45315836376008178,0.42169650342858223,0.39241897584845359,0.36517412725483772,0.33982083289425596,0.31622776601683794,0.29427271762092816,0.27384196342643613,0.25482967479793467,0.23713737056616552,0.22067340690845899,0.20535250264571461,0.19109529749704404,0.17782794100389229,0.16548170999431813,0.15399265260594919,0.14330125702369628,0.1333521432163324,0.12409377607517195,0.11547819846894582,0.10746078283213174,0.10000000000000001,0.0930572040929699,0.086596432336006529,0.080584218776148187,0.074989420933245579,0.069783058485986635,0.064938163157621132,0.060429639023813285,0.056234132519034911,0.05232991146814947,0.048696752516586311,0.045315836376008181,0.042169650342858224,0.039241897584845357,0.036517412725483769,0.033982083289425591,0.031622776601683791,0.029427271762092817,0.027384196342643614,0.025482967479793464,0.023713737056616554,0.022067340690845899,0.02053525026457146,0.019109529749704406,0.017782794100389229,0.016548170999431813,0.015399265260594919,0.014330125702369627,0.013335214321633241,0.012409377607517195,0.011547819846894581,0.010746078283213174,0.01,0.0093057204092969904,0.0086596432336006543,0.008058421877614819,0.0074989420933245579,0.0069783058485986633,0.006493816315762113,0.0060429639023813278,0.005623413251903491,0.0052329911468149467,0.004869675251658631,0.0045315836376008181,0.0042169650342858229,0.0039241897584845363,0.0036517412725483771,0.0033982083289425592,0.0031622776601683794,0.002942727176209282,0.0027384196342643613,0.0025482967479793467,0.0023713737056616554,0.0022067340690845897,0.002053525026457146,0.0019109529749704406,0.0017782794100389228,0.0016548170999431814,0.001539926526059492,0.0014330125702369627,0.0013335214321633241,0.0012409377607517195,0.0011547819846894581,0.0010746078283213176,0.001,0.00093057204092969893,0.00086596432336006539,0.00080584218776148179,0.00074989420933245586,0.00069783058485986635,0.00064938163157621134,0.00060429639023813287,0.0005623413251903491,0.00052329911468149473,0.0004869675251658631,0.00045315836376008179,0.00042169650342858224,0.00039241897584845359,0.0003651741272548377,0.00033982083289425596,0.00031622776601683794,0.00029427271762092817,0.00027384196342643611,0.00025482967479793463,0.00023713737056616554,0.00022067340690845897,0.00020535250264571461,0.00019109529749704405,0.00017782794100389227,0.00016548170999431815,0.00015399265260594919,0.00014330125702369627,0.0001333521432163324,0.00012409377607517196,0.00011547819846894582,0.00010746078283213175};
__constant__ float LG2_GAMMA[4] = {-0.045803689613124789f, -0.022720076500083529f, -0.011315313227834146f, -0.0056465631411420627f};
__constant__ float GAMMA_CHUNK[4] = {0.017183023570817902f, 0.13321516287964841f, 0.36643771592203728f, 0.60593708822908032f};

namespace pg8 {
constexpr int BM = 256, BK = 64, HALF = 128, HTB = HALF * BK * 2, STAGE_BYTES = 8 * HTB, NXCD = 8, WGM = 8;
__host__ __device__ __forceinline__ int lds_byte(int r, int c) { const int st = (r >> 4) * 2 + (c >> 5), rr = r & 15, cc = c & 31, ob = rr * 64 + cc * 2; return st * 1024 + (ob ^ (((ob >> 9) & 1) << 5)); }
__host__ __device__ __forceinline__ void stage_rc(int b, int& R, int& C) { const int st = b / 1024, sb = b % 1024, swz = sb ^ (((sb >> 9) & 1) << 5); R = (st >> 1) * 16 + swz / 64; C = (st & 1) * 32 + (swz % 64) / 2; }
__host__ __device__ __forceinline__ int perm32(int rho) { const int n = rho >> 4, i = rho & 15; return 8 * (i >> 2) + 4 * n + (i & 3); }

struct Unit { const char* pa; const char* pb; int row0, col0, aux, blk; };

template <class Epi, class Sched, bool GATHER>
__device__ __forceinline__ void gemm_phase(LAS uchar* lds, const int K, const Sched& S, const Epi& E) {
    const int tid = threadIdx.x, wid = __builtin_amdgcn_readfirstlane(tid >> 6), lane = tid & 63, wr = wid >> 2, wc = wid & 3, fr = lane & 15, fq = lane >> 4;
    const int nt = K / BK;
    unsigned voA[2][2], voffB[2];
#pragma unroll
    for (int i = 0; i < 2; ++i) { int R, C; stage_rc(tid * 16 + i * 8192, R, C); const int Rb = Epi::PERM ? ((R & ~31) + perm32(R & 31)) : R;
        voA[0][i] = (unsigned)(R * K + C) * 2u; voA[1][i] = voA[0][i] + (unsigned)(HALF * K * 2); voffB[i] = (unsigned)(Rb * K + C) * 2u; }
    const size_t kstep = (size_t)(BK * 2);
    const size_t hstep = (size_t)HALF * K * 2;
    const unsigned ldsw = (unsigned)wid * 1024u;
    const int aoff = lds_byte(wr * 64 + fr, fq * 8), boff = lds_byte(wc * 32 + fr, fq * 8);
#define PG8_SA(b, h) (((b) * 2 + (h)) * HTB)
#define PG8_SB(b, h) ((4 + (b) * 2 + (h)) * HTB)
#define PG8_STAGE(bufoff, gbase, voff) do { _Pragma("unroll") for (int _i = 0; _i < 2; ++_i) \
        __builtin_amdgcn_global_load_lds((const unsigned*)((const char*)(gbase) + (voff)[_i]), (LAS unsigned*)(lds + (bufoff) + ldsw + _i * 8192), 16, 0, 0); } while (0)
#define PG8_LDA(dst, b, h) do { _Pragma("unroll") for (int m = 0; m < 4; ++m) _Pragma("unroll") for (int k = 0; k < 2; ++k) dst[m][k] = *(const LAS bf16x8*)(lds + PG8_SA(b, h) + aoff + m * 2048 + k * 1024); } while (0)
#define PG8_LDB(dst, b, h) do { _Pragma("unroll") for (int n = 0; n < 2; ++n) _Pragma("unroll") for (int k = 0; k < 2; ++k) dst[n][k] = *(const LAS bf16x8*)(lds + PG8_SB(b, h) + boff + n * 2048 + k * 1024); } while (0)
#define PG8_MMA(ai, bj, At, Bt) do { __builtin_amdgcn_s_setprio(1); _Pragma("unroll") for (int m = 0; m < 4; ++m) _Pragma("unroll") for (int n = 0; n < 2; ++n) _Pragma("unroll") for (int k = 0; k < 2; ++k) \
        acc[ai][bj][m][n] = __builtin_amdgcn_mfma_f32_16x16x32_bf16(Bt[n][k], At[m][k], acc[ai][bj][m][n], 0, 0, 0); __builtin_amdgcn_s_setprio(0); } while (0)
#define PG8_WAIT_V(n) asm volatile("s_waitcnt vmcnt(" #n ")" ::: "memory")
#define PG8_WAIT_L(n) asm volatile("s_waitcnt lgkmcnt(" #n ")" ::: "memory")
#define PG8_BAR __builtin_amdgcn_s_barrier()
#define PG8_SCHED __builtin_amdgcn_sched_barrier(0)
    Unit cur, nxt; int ui = 0;
    if (!S.next(0, cur)) return;
    f32x4 acc[2][2][4][2];
#pragma unroll
    for (int a = 0; a < 2; ++a)
#pragma unroll
        for (int b = 0; b < 2; ++b)
#pragma unroll
            for (int m = 0; m < 4; ++m)
#pragma unroll
                for (int n = 0; n < 2; ++n) acc[a][b][m][n] = (f32x4){0.f, 0.f, 0.f, 0.f};
    bf16x8 At[4][2], B0[2][2], B1[2][2];
    const char* cA = cur.pa; const char* cB = cur.pb;
    if constexpr (GATHER) S.gather(cur, voA);
    PG8_STAGE(PG8_SB(0, 0), cB, voffB); PG8_STAGE(PG8_SB(0, 1), cB + hstep, voffB); PG8_STAGE(PG8_SA(0, 0), cA, voA[0]); PG8_STAGE(PG8_SA(0, 1), cA, voA[1]);
    if (wr == 1) PG8_BAR;
    PG8_WAIT_V(2); PG8_BAR;
    PG8_STAGE(PG8_SB(1, 0), cB + kstep, voffB); PG8_STAGE(PG8_SA(1, 0), cA + kstep, voA[0]); PG8_STAGE(PG8_SB(1, 1), cB + hstep + kstep, voffB);
    PG8_WAIT_V(6); PG8_BAR;
    for (;;) {
        const bool has_next = S.next(ui + 1, nxt);
        const char* nA = has_next ? nxt.pa : cA; const char* nB = has_next ? nxt.pb : cB;
        for (int t = 0; t < nt; t += 2) {
            const bool last = (t == nt - 2);
            const char* a1 = cA + (size_t)(t + 1) * kstep;
            const char* a2 = last ? nA : cA + (size_t)(t + 2) * kstep; const char* b2 = last ? nB : cB + (size_t)(t + 2) * kstep;
            const char* a3 = a2 + kstep; const char* b3 = b2 + kstep;
            PG8_LDB(B0, 0, 0); PG8_LDB(B1, 0, 1); PG8_SCHED; PG8_LDA(At, 0, 0); PG8_STAGE(PG8_SA(1, 1), a1, voA[1]);
            if constexpr (GATHER) { if (last && has_next) S.gather(nxt, voA); }
            PG8_WAIT_V(8); PG8_WAIT_L(0); PG8_BAR; PG8_MMA(0, 0, At, B0); PG8_MMA(0, 1, At, B1); PG8_BAR; PG8_SCHED;
            PG8_LDA(At, 0, 1); PG8_STAGE(PG8_SB(0, 0), b2, voffB); PG8_STAGE(PG8_SB(0, 1), b2 + hstep, voffB); PG8_STAGE(PG8_SA(0, 0), a2, voA[0]);
            PG8_WAIT_V(8); PG8_WAIT_L(0); PG8_BAR; PG8_MMA(1, 0, At, B0); PG8_MMA(1, 1, At, B1); PG8_BAR; PG8_SCHED;
            PG8_LDB(B0, 1, 0); PG8_LDB(B1, 1, 1); PG8_SCHED; PG8_LDA(At, 1, 0); PG8_STAGE(PG8_SA(0, 1), a2, voA[1]);
            PG8_WAIT_V(8); PG8_WAIT_L(0); PG8_BAR; PG8_MMA(0, 0, At, B0); PG8_MMA(0, 1, At, B1); PG8_BAR; PG8_SCHED;
            PG8_LDA(At, 1, 1); PG8_STAGE(PG8_SB(1, 0), b3, voffB); PG8_STAGE(PG8_SB(1, 1), b3 + hstep, voffB); PG8_STAGE(PG8_SA(1, 0), a3, voA[0]);
            PG8_WAIT_V(8); PG8_WAIT_L(0); PG8_BAR; PG8_MMA(1, 0, At, B0); PG8_MMA(1, 1, At, B1); PG8_BAR; PG8_SCHED;
        }
        if (wr == 0) PG8_BAR;
        E(acc, cur, wr, wc, fr, fq);
        if (!has_next) break;
#pragma unroll
        for (int a = 0; a < 2; ++a)
#pragma unroll
            for (int b = 0; b < 2; ++b)
#pragma unroll
                for (int m = 0; m < 4; ++m)
#pragma unroll
                    for (int n = 0; n < 2; ++n) acc[a][b][m][n] = (f32x4){0.f, 0.f, 0.f, 0.f};
        cur = nxt; cA = nA; cB = nB; ++ui;
        if (wr == 1) PG8_BAR;
    }
    PG8_WAIT_V(0);
    PG8_BAR;
#undef PG8_SA
#undef PG8_SB
#undef PG8_STAGE
#undef PG8_LDA
#undef PG8_LDB
#undef PG8_MMA
#undef PG8_WAIT_V
#undef PG8_WAIT_L
#undef PG8_BAR
#undef PG8_SCHED
}
}

struct DenseSched {
    const char* A; const char* B; int K, nM, nN, nwg, G, c;
    __device__ __forceinline__ bool next(int i, pg8::Unit& u) const {
        const long L = (long)i * G + c; if (L >= nwg) return false;
        int wgid = (int)L; { const int q = nwg / pg8::NXCD, r = nwg % pg8::NXCD, xcd = wgid % pg8::NXCD, off = wgid / pg8::NXCD; wgid = (xcd < r ? xcd * (q + 1) : r * (q + 1) + (xcd - r) * q) + off; }
        const int nig = pg8::WGM * nN, gid = wgid / nig, fm = gid * pg8::WGM, gsz = (nM - fm) < pg8::WGM ? (nM - fm) : pg8::WGM;
        const int pm = fm + ((wgid % nig) % gsz), pn = (wgid % nig) / gsz;
        u.pa = A + (size_t)pm * 256 * K * 2; u.pb = B + (size_t)pn * 256 * K * 2; u.row0 = pm * 256; u.col0 = pn * 256; u.aux = 0; u.blk = 0; return true;
    }
    __device__ __forceinline__ void gather(const pg8::Unit&, unsigned (&)[2][2]) const {}
};
struct MoeSched {
    const LAS int* tab; const char* A; const char* B; size_t bexp; const int* list; int K, nN, G, c;
    __device__ __forceinline__ bool next(int i, pg8::Unit& u) const {
        const int NB = tab[0]; const long L = (long)i * G + c; if (L >= (long)NB * nN) return false;
        const int b = (int)(L / nN), pn = (int)(L % nN), e = tab[64 + b];
        u.pa = A; u.pb = B + (size_t)e * bexp + (size_t)pn * 256 * K * 2; u.row0 = b * 256; u.col0 = pn * 256; u.aux = e; u.blk = b; return true;
    }
    __device__ __forceinline__ void gather(const pg8::Unit& u, unsigned (&vo)[2][2]) const {
        const int e = u.aux, lb = (u.blk - tab[8 + e]) * 256, cnt = tab[256 + u.blk];
#pragma unroll
        for (int i = 0; i < 2; ++i) { int R, C; pg8::stage_rc((int)threadIdx.x * 16 + i * 8192, R, C);
#pragma unroll
            for (int h = 0; h < 2; ++h) { const int r = h * 128 + R; const int tok = (r < cnt) ? list[e * T + lb + r] : 0; vo[h][i] = ((unsigned)tok * (unsigned)K + (unsigned)C) * 2u; } }
    }
};
struct MoeSchedDirect {
    const LAS int* tab; const char* A; const char* B; size_t bexp; int K, nN, G, c;
    __device__ __forceinline__ bool next(int i, pg8::Unit& u) const {
        const int NB = tab[0]; const long L = (long)i * G + c; if (L >= (long)NB * nN) return false;
        const int b = (int)(L / nN), pn = (int)(L % nN), e = tab[64 + b];
        u.pa = A + (size_t)b * 256 * K * 2; u.pb = B + (size_t)e * bexp + (size_t)pn * 256 * K * 2; u.row0 = b * 256; u.col0 = pn * 256; u.aux = e; u.blk = b; return true;
    }
    __device__ __forceinline__ void gather(const pg8::Unit&, unsigned (&)[2][2]) const {}
};

struct EpiProj {
    static constexpr bool PERM = true;
    bf16* O; int ldc;
    __device__ __forceinline__ void operator()(const f32x4 (&acc)[2][2][4][2], const pg8::Unit& u, int wr, int wc, int fr, int fq) const {
        const int row0 = u.row0 + wr * 64 + fr, col0 = u.col0 + wc * 32 + 8 * fq;
#pragma unroll
        for (int ai = 0; ai < 2; ++ai)
#pragma unroll
            for (int m = 0; m < 4; ++m) { bf16* rowp = O + (size_t)(row0 + ai * 128 + m * 16) * ldc + col0;
#pragma unroll
                for (int bj = 0; bj < 2; ++bj) { const f32x4 v0 = acc[ai][bj][m][0], v1 = acc[ai][bj][m][1];
                    u32x4 w; w.x = pk_bf16(v0[0], v0[1]); w.y = pk_bf16(v0[2], v0[3]); w.z = pk_bf16(v1[0], v1[1]); w.w = pk_bf16(v1[2], v1[3]);
                    *(u32x4*)(rowp + bj * 128) = w; } }
    }
};
struct EpiOut {
    static constexpr bool PERM = false;
    const float* X; float* Hh;
    __device__ __forceinline__ void operator()(const f32x4 (&acc)[2][2][4][2], const pg8::Unit& u, int wr, int wc, int fr, int fq) const {
        const int row0 = u.row0 + wr * 64 + fr, col0 = u.col0 + wc * 32 + 4 * fq;
#pragma unroll
        for (int ai = 0; ai < 2; ++ai)
#pragma unroll
            for (int m = 0; m < 4; ++m) { const size_t off = (size_t)(row0 + ai * 128 + m * 16) * D + col0;
#pragma unroll
                for (int bj = 0; bj < 2; ++bj)
#pragma unroll
                    for (int n = 0; n < 2; ++n) { const f32x4 xv = *(const f32x4*)(X + off + bj * 128 + n * 16); *(f32x4*)(Hh + off + bj * 128 + n * 16) = xv + acc[ai][bj][m][n]; } }
    }
};
struct EpiGateUp {
    static constexpr bool PERM = true;
    bf16* ACT; const float* bias;
    __device__ __forceinline__ void operator()(const f32x4 (&acc)[2][2][4][2], const pg8::Unit& u, int wr, int wc, int fr, int fq) const {
        const int row0 = u.row0 + wr * 64 + fr, col0 = u.col0 + wc * 32 + 8 * fq;
        const float* bp = bias + (size_t)u.aux * (2 * DFF) + col0;
        f32x4 bv[2][2];
#pragma unroll
        for (int bj = 0; bj < 2; ++bj)
#pragma unroll
            for (int n = 0; n < 2; ++n) bv[bj][n] = *(const f32x4*)(bp + bj * 128 + 4 * n);
#pragma unroll
        for (int ai = 0; ai < 2; ++ai)
#pragma unroll
            for (int m = 0; m < 4; ++m) { bf16* rowp = ACT + (size_t)(row0 + ai * 128 + m * 16) * DFF + (col0 >> 1);
#pragma unroll
                for (int bj = 0; bj < 2; ++bj) { const f32x4 v0 = acc[ai][bj][m][0] + bv[bj][0], v1 = acc[ai][bj][m][1] + bv[bj][1];
                    float a[4];
                    { const float g = fminf(v0[0], 7.f), up = fminf(fmaxf(v0[1], -7.f), 7.f); a[0] = (up + 1.f) * g / (1.f + __expf(-1.702f * g)); }
                    { const float g = fminf(v0[2], 7.f), up = fminf(fmaxf(v0[3], -7.f), 7.f); a[1] = (up + 1.f) * g / (1.f + __expf(-1.702f * g)); }
                    { const float g = fminf(v1[0], 7.f), up = fminf(fmaxf(v1[1], -7.f), 7.f); a[2] = (up + 1.f) * g / (1.f + __expf(-1.702f * g)); }
                    { const float g = fminf(v1[2], 7.f), up = fminf(fmaxf(v1[3], -7.f), 7.f); a[3] = (up + 1.f) * g / (1.f + __expf(-1.702f * g)); }
                    u32x2 w; w.x = pk_bf16(a[0], a[1]); w.y = pk_bf16(a[2], a[3]);
                    *(u32x2*)(rowp + bj * 64) = w; } }
    }
};
struct EpiDown {
    static constexpr bool PERM = true;
    bf16* YR; const float* bias;
    __device__ __forceinline__ void operator()(const f32x4 (&acc)[2][2][4][2], const pg8::Unit& u, int wr, int wc, int fr, int fq) const {
        const int row0 = u.row0 + wr * 64 + fr, col0 = u.col0 + wc * 32 + 8 * fq;
        const float* bp = bias + (size_t)u.aux * D + col0;
        f32x4 bv[2][2];
#pragma unroll
        for (int bj = 0; bj < 2; ++bj)
#pragma unroll
            for (int n = 0; n < 2; ++n) bv[bj][n] = *(const f32x4*)(bp + bj * 128 + 4 * n);
#pragma unroll
        for (int ai = 0; ai < 2; ++ai)
#pragma unroll
            for (int m = 0; m < 4; ++m) { bf16* rowp = YR + (size_t)(row0 + ai * 128 + m * 16) * D + col0;
#pragma unroll
                for (int bj = 0; bj < 2; ++bj) { const f32x4 v0 = acc[ai][bj][m][0] + bv[bj][0], v1 = acc[ai][bj][m][1] + bv[bj][1];
                    u32x4 w; w.x = pk_bf16(v0[0], v0[1]); w.y = pk_bf16(v0[2], v0[3]); w.z = pk_bf16(v1[0], v1[1]); w.w = pk_bf16(v1[2], v1[3]);
                    *(u32x4*)(rowp + bj * 128) = w; } }
    }
};

#define XB_TMO      128
#define XB_XCNT(j)  (256  + 64 * (j))
#define XB_XSUB(j)  (1280 + 64 * (j))
#define XB_XGEN(j)  (2304 + 64 * (j))
#define XB_TOP      3328
#define XB_TOPGEN   3392
#define XCD_BAR_WORDS 3456
#define XB_SPIN_CAP (1u << 18)
__device__ __forceinline__ unsigned xb_ld(unsigned* p)              { return __hip_atomic_load(p, __ATOMIC_RELAXED, __HIP_MEMORY_SCOPE_AGENT); }
__device__ __forceinline__ unsigned xb_add(unsigned* p, unsigned v) { return __hip_atomic_fetch_add(p, v, __ATOMIC_RELAXED, __HIP_MEMORY_SCOPE_AGENT); }
__device__ __forceinline__ unsigned xb_xcc_id() { return (unsigned)__builtin_amdgcn_s_getreg((3 << 11) | 20) & 0xFu; }
#define XB_SPIN(cond, bar) do { unsigned _sp = 0; while (cond) { __builtin_amdgcn_s_sleep(1); \
    if ((++_sp & 255u) == 0u) { if (xb_ld(&(bar)[XB_TMO])) break; if (_sp > XB_SPIN_CAP) { atomicAdd(&(bar)[XB_TMO], 1u); break; } } } } while (0)
struct XcdBarrier { unsigned* bar; unsigned x; volatile LAS unsigned* st; };
__device__ __forceinline__ XcdBarrier xcd_barrier_post(unsigned* bar, volatile LAS unsigned* st) {
    XcdBarrier b; b.bar = bar; b.x = xb_xcc_id(); b.st = st;
    if (threadIdx.x == 0) (void)xb_add(&bar[XB_XCNT(b.x)], 1u);
    return b;
}
__device__ __forceinline__ void xcd_barrier_complete(unsigned* bar, unsigned x, unsigned& nloc, unsigned& nx) {
    const unsigned G = gridDim.x * gridDim.y * gridDim.z;
    unsigned sum, cnt, mine, sp = 0u;
    for (;;) {
        sum = 0u; cnt = 0u; mine = 0u;
#pragma unroll
        for (unsigned j = 0; j < 16; ++j) { const unsigned c = xb_ld(&bar[XB_XCNT(j)]); sum += c; cnt += (c > 0u) ? 1u : 0u; mine = (j == x) ? c : mine; }
        if (sum == G) break;
        __builtin_amdgcn_s_sleep(1);
        if ((++sp & 255u) == 0u) { if (xb_ld(&bar[XB_TMO])) break; if (sp > XB_SPIN_CAP) { atomicAdd(&bar[XB_TMO], 1u); break; } }
    }
    nloc = mine > 0u ? mine : 1u; nx = cnt > 0u ? cnt : 1u;
}
__device__ __forceinline__ void xcd_barrier(const XcdBarrier& b) {
    asm volatile("s_waitcnt vmcnt(0)" ::: "memory");
    __syncthreads();
    if (threadIdx.x == 0) {
        unsigned* bar = b.bar;
        __builtin_amdgcn_s_waitcnt(0);
        unsigned nloc = b.st[0], nx = b.st[1];
        if (nloc == 0u) { xcd_barrier_complete(bar, b.x, nloc, nx); b.st[0] = nloc; b.st[1] = nx; }
        const unsigned old = xb_add(&bar[XB_XSUB(b.x)], 1u);
        const unsigned gen = old / nloc;
        if (old + 1u == (gen + 1u) * nloc) {
            __builtin_amdgcn_fence(__ATOMIC_RELEASE, "agent");
            asm volatile("s_waitcnt vmcnt(0)" ::: "memory");
            const unsigned og = xb_add(&bar[XB_TOP], 1u);
            const unsigned tg = og / nx;
            if (og + 1u == (tg + 1u) * nx) xb_add(&bar[XB_TOPGEN], 1u);
            else XB_SPIN(xb_ld(&bar[XB_TOPGEN]) == tg, bar);
            __builtin_amdgcn_fence(__ATOMIC_ACQUIRE, "agent");
            xb_add(&bar[XB_XGEN(b.x)], 1u);
            asm volatile("s_waitcnt vmcnt(0)" ::: "memory");
        } else {
            XB_SPIN(xb_ld(&bar[XB_XGEN(b.x)]) == gen, bar);
            __builtin_amdgcn_fence(__ATOMIC_ACQUIRE, "agent");
            asm volatile("s_waitcnt vmcnt(0)" ::: "memory");
        }
    }
    __syncthreads();
}

struct Ctx { LAS uchar* lds; int tid, lane, wave, G, bid; uchar* ws; const void* const* in; float* out; };
#define XP_x(X) ((const float*)(X).in[0])
#define XP_pos(X) ((const int*)(X).in[1])
#define XP_ln_mix_w(X) ((const float*)(X).in[2])
#define XP_w_in(X) ((const float*)(X).in[3])
#define XP_conv_w(X) ((const float*)(X).in[4])
#define XP_conv_b(X) ((const float*)(X).in[5])
#define XP_dt_bias(X) ((const float*)(X).in[6])
#define XP_a_log(X) ((const float*)(X).in[7])
#define XP_d_skip(X) ((const float*)(X).in[8])
#define XP_ssm_norm_w(X) ((const float*)(X).in[9])
#define XP_w_out(X) ((const float*)(X).in[10])
#define XP_ln_ffn_w(X) ((const float*)(X).in[11])
#define XP_w_router(X) ((const float*)(X).in[12])
#define XP_b_router(X) ((const float*)(X).in[13])
#define XP_w_gu(X) ((const float*)(X).in[14])
#define XP_b_gu(X) ((const float*)(X).in[15])
#define XP_w_d(X) ((const float*)(X).in[16])
#define XP_b_d(X) ((const float*)(X).in[17])
#define XP_ln_final_w(X) ((const float*)(X).in[18])
#define XP_WinT(X) ((bf16*)((X).ws + WS_WINT))
#define XP_WoutT(X) ((bf16*)((X).ws + WS_WOUTT))
#define XP_WguT(X) ((bf16*)((X).ws + WS_WGUT))
#define XP_WdT(X) ((bf16*)((X).ws + WS_WDT))
#define XP_U(X) ((bf16*)((X).ws + WS_U))
#define XP_U2(X) ((bf16*)((X).ws + WS_U2))
#define XP_MIX(X) ((bf16*)((X).ws + WS_MIX))
#define XP_XBC(X) ((bf16*)((X).ws + WS_XBC))
#define XP_KV(X) ((bf16*)((X).ws + WS_KV))
#define XP_SST(X) ((bf16*)((X).ws + WS_SST))
#define XP_PROJ(X) ((bf16*)((X).ws + WS_PROJ))
#define XP_ACT(X) ((bf16*)((X).ws + WS_ACT))
#define XP_YR(X) ((bf16*)((X).ws + WS_YR))
#define XP_COS(X) ((float*)((X).ws + WS_COS))
#define XP_SIN(X) ((float*)((X).ws + WS_SIN))
#define XP_Hh(X) ((float*)((X).ws + WS_H))
#define XP_ADEC(X) ((float*)((X).ws + WS_ADEC))
#define XP_TOPW(X) ((float*)((X).ws + WS_TOPW))
#define XP_TOPI(X) ((int*)((X).ws + WS_TOPI))
#define XP_TOPR(X) ((int*)((X).ws + WS_TOPR))
#define XP_LIST(X) ((int*)((X).ws + WS_LIST))
#define XP_ctl(X) ((unsigned*)((X).ws + WS_CTL))


__device__ __forceinline__ bf16x8 tr_frag(LAS uchar* p, int rstep) {
    const s16x4 a = __builtin_amdgcn_ds_read_tr16_b64_v4i16((LAS s16x4*)p);
    const s16x4 b = __builtin_amdgcn_ds_read_tr16_b64_v4i16((LAS s16x4*)(p + rstep));
    return (bf16x8){a[0], a[1], a[2], a[3], b[0], b[1], b[2], b[3]};
}
__device__ __forceinline__ f32x4 mma16(bf16x8 xrow, bf16x8 ycol, f32x4 c) { return __builtin_amdgcn_mfma_f32_16x16x32_bf16(xrow, ycol, c, 0, 0, 0); }
__device__ __forceinline__ float wave_incl_scan(float v, int lane) {
#pragma unroll
    for (int o = 1; o < 64; o <<= 1) { const float t = __shfl_up(v, o); if (lane >= o) v += t; }
    return v;
}
__device__ __forceinline__ void rope8(const u32x4 k1, const u32x4 k2, const f32x4 c0, const f32x4 c1, const f32x4 s0, const f32x4 s1, const float sc, u32x4& o1, u32x4& o2) {
    float r1[8], r2[8];
#pragma unroll
    for (int m = 0; m < 4; ++m) {
        const float a0 = bf_lo(k1[m]), a1 = bf_hi(k1[m]), b0 = bf_lo(k2[m]), b1 = bf_hi(k2[m]);
        const float cs0 = (m < 2) ? c0[2 * m] : c1[2 * m - 4], cs1 = (m < 2) ? c0[2 * m + 1] : c1[2 * m - 3];
        const float sn0 = (m < 2) ? s0[2 * m] : s1[2 * m - 4], sn1 = (m < 2) ? s0[2 * m + 1] : s1[2 * m - 3];
        r1[2 * m] = (a0 * cs0 - b0 * sn0) * sc; r1[2 * m + 1] = (a1 * cs1 - b1 * sn1) * sc;
        r2[2 * m] = (b0 * cs0 + a0 * sn0) * sc; r2[2 * m + 1] = (b1 * cs1 + a1 * sn1) * sc;
    }
    o1.x = pk_bf16(r1[0], r1[1]); o1.y = pk_bf16(r1[2], r1[3]); o1.z = pk_bf16(r1[4], r1[5]); o1.w = pk_bf16(r1[6], r1[7]);
    o2.x = pk_bf16(r2[0], r2[1]); o2.y = pk_bf16(r2[2], r2[3]); o2.z = pk_bf16(r2[4], r2[5]); o2.w = pk_bf16(r2[6], r2[7]);
}

__device__ __forceinline__ void tr_decode(const Ctx& X, int r, const float*& W, bf16*& WT, int& N, int& kb, int& nb) {
    constexpr int I_IN = 32 * 209, I_OUT = 32 * 64, I_GU = 32 * 32 * 128;
    if (r < I_IN) { W = XP_w_in(X); WT = XP_WinT(X); N = NPROJ; }
    else if ((r -= I_IN) < I_OUT) { W = XP_w_out(X); WT = XP_WoutT(X); N = D; }
    else if ((r -= I_OUT) < I_GU) { const int e = r >> 12; r &= 4095; W = XP_w_gu(X) + (size_t)e * D * (2 * DFF); WT = XP_WguT(X) + (size_t)e * (2 * DFF) * D; N = 2 * DFF; }
    else { r -= I_GU; const int e = r >> 11; r &= 2047; W = XP_w_d(X) + (size_t)e * DFF * D; WT = XP_WdT(X) + (size_t)e * D * DFF; N = D; }
    const int nbn = (N + 31) >> 5; kb = r / nbn; nb = r - kb * nbn;
}
__device__ __forceinline__ void tr_load(const float* W, int N, int kb, int nb, int lane, f32x4 (&v)[8]) {
    const int k0 = kb * 64 + 8 * (lane & 7), n0 = nb * 32 + 4 * (lane >> 3);
    if (n0 < N) {
#pragma unroll
        for (int i = 0; i < 8; ++i) v[i] = *(const f32x4*)(W + (size_t)(k0 + i) * N + n0);
    }
}
__device__ __forceinline__ void tr_store(bf16* WT, int N, int kb, int nb, int lane, const f32x4 (&v)[8]) {
    const int k0 = kb * 64 + 8 * (lane & 7), n0 = nb * 32 + 4 * (lane >> 3);
    if (n0 < N) {
#pragma unroll
        for (int j = 0; j < 4; ++j) { u32x4 o; o.x = pk_bf16(v[0][j], v[1][j]); o.y = pk_bf16(v[2][j], v[3][j]); o.z = pk_bf16(v[4][j], v[5][j]); o.w = pk_bf16(v[6][j], v[7][j]);
            *(u32x4*)(WT + (size_t)(n0 + j) * 2048 + k0) = o; }
    }
}
__device__ __forceinline__ void p0_prologue(Ctx& X) {
    const int gw = X.bid * NWAVES + X.wave, NGW = X.G * NWAVES, lane = X.lane;
    const int gt = X.bid * NTHR + X.tid, NGT = X.G * NTHR;
    for (int m = gw; m < T; m += NGW) {
        const f32x4* xr = (const f32x4*)(XP_x(X) + (size_t)m * D) + lane; const f32x4* wr_ = (const f32x4*)XP_ln_mix_w(X) + lane;
        f32x4 v[8]; float s = 0.f;
#pragma unroll
        for (int j = 0; j < 8; ++j) { v[j] = xr[64 * j]; s += (v[j].x * v[j].x + v[j].y * v[j].y) + (v[j].z * v[j].z + v[j].w * v[j].w); }
        const float rstd = rsqrtf(wave_sum(s) * (1.f / D) + EPS);
        u32x2* o8 = (u32x2*)(XP_U(X) + (size_t)m * D) + lane;
#pragma unroll
        for (int j = 0; j < 8; ++j) { const f32x4 w = wr_[64 * j]; u32x2 o; o.x = pk_bf16(v[j].x * rstd * w.x, v[j].y * rstd * w.y); o.y = pk_bf16(v[j].z * rstd * w.z, v[j].w * rstd * w.w); o8[64 * j] = o; }
    }
    for (int idx = gt; idx < T * 128; idx += NGT) {
        const int t = idx >> 7, i = idx & 127;
        const double ang = (double)XP_pos(X)[t] * INV_FREQ[i];
        double rev = ang * 0.15915494309189533577; rev -= floor(rev);
        const float f = (float)rev;
        XP_COS(X)[idx] = __builtin_amdgcn_cosf(f); XP_SIN(X)[idx] = __builtin_amdgcn_sinf(f);
    }
    { u32x4* p = (u32x4*)(XP_WinT(X) + (size_t)NPROJ * D); const int n16 = (LDP - NPROJ) * D * 2 / 16; const u32x4 z = {0u, 0u, 0u, 0u};
      for (int i = gt; i < n16; i += NGT) p[i] = z; }
    constexpr int NIT = 32 * 209 + 32 * 64 + 32 * 32 * 128 + 32 * 32 * 64;
    for (int it = gw; it < NIT; it += 2 * NGW) {
        const float *W0, *W1 = nullptr; bf16 *T0, *T1 = nullptr; int N0, N1 = 0, kb0, kb1 = 0, nb0, nb1 = 0;
        f32x4 v0[8], v1[8];
        tr_decode(X, it, W0, T0, N0, kb0, nb0);
        const bool two = (it + NGW) < NIT;
        if (two) tr_decode(X, it + NGW, W1, T1, N1, kb1, nb1);
        tr_load(W0, N0, kb0, nb0, lane, v0);
        if (two) tr_load(W1, N1, kb1, nb1, lane, v1);
        tr_store(T0, N0, kb0, nb0, lane, v0);
        if (two) tr_store(T1, N1, kb1, nb1, lane, v1);
    }
}

__device__ __forceinline__ void p2_ret(Ctx& X, int unit) {
    const int c = unit >> 2, h = unit & 3, t0 = c * CH, tid = X.tid, lane = X.lane, w = X.wave;
    LAS uchar* Vt = X.lds; LAS uchar* Kt = X.lds + 69632;
#pragma unroll 4
    for (int i = 0; i < 8; ++i) { const int q = tid + 512 * i, l = q >> 5, vc = q & 31;
        const u32x4 v = *(const u32x4*)(XP_PROJ(X) + (size_t)(t0 + l) * LDP + C_V + h * 256 + vc * 8);
        *(LAS u32x4*)(Vt + l * 544 + vc * 16) = v; }
    const float lg = LG2_GAMMA[h];
#pragma unroll 2
    for (int i = 0; i < 4; ++i) { const int q = tid + 512 * i, l = q >> 4, ic = q & 15;
        const bf16* kp = XP_PROJ(X) + (size_t)(t0 + l) * LDP + C_K + h * 256 + ic * 8;
        const u32x4 k1 = *(const u32x4*)kp, k2 = *(const u32x4*)(kp + 128);
        const float* cp = XP_COS(X) + (size_t)(t0 + l) * 128 + ic * 8; const float* sp = XP_SIN(X) + (size_t)(t0 + l) * 128 + ic * 8;
        const f32x4 c0 = *(const f32x4*)cp, c1 = *(const f32x4*)(cp + 4), s0 = *(const f32x4*)sp, s1 = *(const f32x4*)(sp + 4);
        u32x4 o1, o2; rope8(k1, k2, c0, c1, s0, s1, 0.0625f * exp2f(lg * (float)(127 - l)), o1, o2);
        *(LAS u32x4*)(Kt + l * 544 + ic * 16) = o1; *(LAS u32x4*)(Kt + l * 544 + 256 + ic * 16) = o2; }
    __syncthreads();
    const int fr = lane & 15, fq = lane >> 4, trs = (8 * fq + ((lane & 15) >> 2)) * 544 + 8 * (lane & 3);
    f32x4 acc[2][16];
#pragma unroll
    for (int a = 0; a < 2; ++a)
#pragma unroll
        for (int n = 0; n < 16; ++n) acc[a][n] = (f32x4){0.f, 0.f, 0.f, 0.f};
#pragma unroll 1
    for (int ks = 0; ks < 4; ++ks) {
        const bf16x8 af0 = tr_frag(Vt + (32 * ks) * 544 + (16 * w) * 2 + trs, 4 * 544);
        const bf16x8 af1 = tr_frag(Vt + (32 * ks) * 544 + (128 + 16 * w) * 2 + trs, 4 * 544);
#pragma unroll
        for (int n = 0; n < 16; ++n) { const bf16x8 bf = tr_frag(Kt + (32 * ks) * 544 + (16 * n) * 2 + trs, 4 * 544);
            acc[0][n] = mma16(bf, af0, acc[0][n]); acc[1][n] = mma16(bf, af1, acc[1][n]); }
    }
    bf16* outp = XP_KV(X) + (size_t)(c * 4 + h) * 65536;
#pragma unroll
    for (int a = 0; a < 2; ++a)
#pragma unroll
        for (int n = 0; n < 16; ++n) { u32x2 o; o.x = pk_bf16(acc[a][n][0], acc[a][n][1]); o.y = pk_bf16(acc[a][n][2], acc[a][n][3]);
            *(u32x2*)(outp + (size_t)(128 * a + 16 * w + fr) * 256 + 16 * n + 4 * fq) = o; }
    __syncthreads();
}
__device__ __forceinline__ void conv8(const Ctx& X, int t, int cx, float (&o)[8]) {
    const f32x4 b0 = *(const f32x4*)(XP_conv_b(X) + cx), b1 = *(const f32x4*)(XP_conv_b(X) + cx + 4);
    o[0] = b0.x; o[1] = b0.y; o[2] = b0.z; o[3] = b0.w; o[4] = b1.x; o[5] = b1.y; o[6] = b1.z; o[7] = b1.w;
#pragma unroll
    for (int j = 0; j < 4; ++j) { const int tt = t - 3 + j;
        if (tt >= 0) { const u32x4 v = *(const u32x4*)(XP_PROJ(X) + (size_t)tt * LDP + C_X + cx);
            const f32x4 w0 = *(const f32x4*)(XP_conv_w(X) + j * XBCW + cx), w1 = *(const f32x4*)(XP_conv_w(X) + j * XBCW + cx + 4);
            o[0] += w0.x * bf_lo(v.x); o[1] += w0.y * bf_hi(v.x); o[2] += w0.z * bf_lo(v.y); o[3] += w0.w * bf_hi(v.y);
            o[4] += w1.x * bf_lo(v.z); o[5] += w1.y * bf_hi(v.z); o[6] += w1.z * bf_lo(v.w); o[7] += w1.w * bf_hi(v.w); } }
#pragma unroll
    for (int i = 0; i < 8; ++i) o[i] = silu_f(o[i]);
}
__device__ __forceinline__ void p2_ssd(Ctx& X, int unit) {
    const int c = unit >> 2, g = (unit >> 1) & 1, hh = unit & 1, t0 = c * CH, tid = X.tid, lane = X.lane, w = X.wave;
    LAS uchar* Xd = X.lds; LAS uchar* Bc = X.lds + 69632;
    LAS float* dtS = (LAS float*)(X.lds + 106496); LAS float* acS = (LAS float*)(X.lds + 108544);
    if (w < 4) { const int h = 8 * g + 4 * hh + w, l0 = 2 * lane;
        const float dtb = XP_dt_bias(X)[h], A = -expf(XP_a_log(X)[h]);
        const float d0 = softplus_f(bf2f(XP_PROJ(X)[(size_t)(t0 + l0) * LDP + C_DT + h]) + dtb), d1 = softplus_f(bf2f(XP_PROJ(X)[(size_t)(t0 + l0 + 1) * LDP + C_DT + h]) + dtb);
        const float a0 = d0 * A, a1 = d1 * A, s = a0 + a1, incl = wave_incl_scan(s, lane);
        dtS[w * 128 + l0] = d0; dtS[w * 128 + l0 + 1] = d1; acS[w * 128 + l0] = incl - a1; acS[w * 128 + l0 + 1] = incl;
        if (lane == 63) XP_ADEC(X)[c * 16 + h] = expf(incl); }
    __syncthreads();
    for (int it = tid; it < 128 * 56; it += NTHR) { const int l = it / 56, j = it - l * 56;
        int cx; if (j < 32) cx = 512 * g + 256 * hh + 8 * j; else if (j < 48) cx = 1024 + 128 * g + 8 * (j - 32); else cx = 1280 + 128 * g + 64 * hh + 8 * (j - 48);
        float o[8]; conv8(X, t0 + l, cx, o);
        u32x4 ov; ov.x = pk_bf16(o[0], o[1]); ov.y = pk_bf16(o[2], o[3]); ov.z = pk_bf16(o[4], o[5]); ov.w = pk_bf16(o[6], o[7]);
        if (j < 32) { const int e = j >> 3; const float sc = dtS[e * 128 + l] * __expf(acS[e * 128 + 127] - acS[e * 128 + l]);
            u32x4 os; os.x = pk_bf16(o[0] * sc, o[1] * sc); os.y = pk_bf16(o[2] * sc, o[3] * sc); os.z = pk_bf16(o[4] * sc, o[5] * sc); os.w = pk_bf16(o[6] * sc, o[7] * sc);
            *(LAS u32x4*)(Xd + l * 544 + j * 16) = os; *(u32x4*)(XP_XBC(X) + (size_t)(t0 + l) * XBCW + cx) = ov; }
        else if (j < 48) { *(LAS u32x4*)(Bc + l * 288 + (j - 32) * 16) = ov; if (hh == 0) *(u32x4*)(XP_XBC(X) + (size_t)(t0 + l) * XBCW + cx) = ov; }
        else *(u32x4*)(XP_XBC(X) + (size_t)(t0 + l) * XBCW + cx) = ov; }
    __syncthreads();
    const int fr = lane & 15, fq = lane >> 4, q4 = (lane & 15) >> 2, p4 = lane & 3;
    const int trx = (8 * fq + q4) * 544 + 8 * p4, trb = (8 * fq + q4) * 288 + 8 * p4;
    f32x4 acc[2][8];
#pragma unroll
    for (int a = 0; a < 2; ++a)
#pragma unroll
        for (int n = 0; n < 8; ++n) acc[a][n] = (f32x4){0.f, 0.f, 0.f, 0.f};
#pragma unroll 1
    for (int ks = 0; ks < 4; ++ks) {
        const bf16x8 af0 = tr_frag(Xd + (32 * ks) * 544 + (16 * w) * 2 + trx, 4 * 544);
        const bf16x8 af1 = tr_frag(Xd + (32 * ks) * 544 + (128 + 16 * w) * 2 + trx, 4 * 544);
#pragma unroll
        for (int n = 0; n < 8; ++n) { const bf16x8 bf = tr_frag(Bc + (32 * ks) * 288 + (16 * n) * 2 + trb, 4 * 288);
            acc[0][n] = mma16(bf, af0, acc[0][n]); acc[1][n] = mma16(bf, af1, acc[1][n]); }
    }
#pragma unroll
    for (int a = 0; a < 2; ++a) { const int m = 128 * a + 16 * w + fr, h = 8 * g + 4 * hh + (m >> 6), p = m & 63;
        bf16* outp = XP_SST(X) + ((size_t)(c * 16 + h) * 64 + p) * 128;
#pragma unroll
        for (int n = 0; n < 8; ++n) { u32x2 o; o.x = pk_bf16(acc[a][n][0], acc[a][n][1]); o.y = pk_bf16(acc[a][n][2], acc[a][n][3]); *(u32x2*)(outp + 16 * n + 4 * fq) = o; } }
    __syncthreads();
}

__device__ __forceinline__ void p3_scan(Ctx& X) {
    const int gt = X.bid * NTHR + X.tid, NGT = X.G * NTHR;
    for (int item = gt; item < 65536 + 32768; item += NGT) {
        const bool ret = item < 65536; const int it2 = ret ? item : item - 65536;
        bf16* p = ret ? (XP_KV(X) + (size_t)it2 * 4) : (XP_SST(X) + (size_t)it2 * 4);
        const size_t stride = ret ? 262144 : 131072;
        const int head = ret ? (it2 >> 14) : (it2 >> 11);
        const float gdec = ret ? GAMMA_CHUNK[head & 3] : 0.f;
        float s0 = 0.f, s1 = 0.f, s2 = 0.f, s3 = 0.f;
        for (int c0 = 0; c0 < NCHUNK; c0 += 8) {
            u32x2 v[8]; float dec[8];
#pragma unroll
            for (int j = 0; j < 8; ++j) { v[j] = *(const u32x2*)(p + (size_t)(c0 + j) * stride); dec[j] = ret ? gdec : XP_ADEC(X)[(c0 + j) * 16 + head]; }
#pragma unroll
            for (int j = 0; j < 8; ++j) { u32x2 o; o.x = pk_bf16(s0, s1); o.y = pk_bf16(s2, s3); *(u32x2*)(p + (size_t)(c0 + j) * stride) = o;
                s0 = dec[j] * s0 + bf_lo(v[j].x); s1 = dec[j] * s1 + bf_hi(v[j].x); s2 = dec[j] * s2 + bf_lo(v[j].y); s3 = dec[j] * s3 + bf_hi(v[j].y); }
        }
    }
}

__device__ __forceinline__ void p4_ret(Ctx& X, int unit) {
    const int c = unit >> 2, h = unit & 3, t0 = c * CH, tid = X.tid, lane = X.lane, w = X.wave;
    LAS uchar* R1 = X.lds; LAS uchar* R2 = X.lds + 69632;
    const float lg = LG2_GAMMA[h];
#pragma unroll 1
    for (int i = 0; i < 4; ++i) { const int q = tid + 512 * i, l = q >> 4, ic = q & 15;
        const float* cp = XP_COS(X) + (size_t)(t0 + l) * 128 + ic * 8; const float* sp = XP_SIN(X) + (size_t)(t0 + l) * 128 + ic * 8;
        const f32x4 c0 = *(const f32x4*)cp, c1 = *(const f32x4*)(cp + 4), s0 = *(const f32x4*)sp, s1 = *(const f32x4*)(sp + 4);
        const bf16* qp = XP_PROJ(X) + (size_t)(t0 + l) * LDP + C_Q + h * 256 + ic * 8; const bf16* kp = XP_PROJ(X) + (size_t)(t0 + l) * LDP + C_K + h * 256 + ic * 8;
        u32x4 o1, o2;
        rope8(*(const u32x4*)qp, *(const u32x4*)(qp + 128), c0, c1, s0, s1, 1.0f, o1, o2);
        *(LAS u32x4*)(R1 + l * 544 + ic * 16) = o1; *(LAS u32x4*)(R1 + l * 544 + 256 + ic * 16) = o2;
        rope8(*(const u32x4*)kp, *(const u32x4*)(kp + 128), c0, c1, s0, s1, 0.0625f, o1, o2);
        *(LAS u32x4*)(R2 + l * 544 + ic * 16) = o1; *(LAS u32x4*)(R2 + l * 544 + 256 + ic * 16) = o2; }
    __syncthreads();
    const int fr = lane & 15, fq = lane >> 4, q4 = (lane & 15) >> 2, p4 = lane & 3, l = 16 * w + fr;
    f32x4 sc[8];
#pragma unroll
    for (int n = 0; n < 8; ++n) sc[n] = (f32x4){0.f, 0.f, 0.f, 0.f};
#pragma unroll 2
    for (int ks = 0; ks < 8; ++ks) {
        const bf16x8 af = *(const LAS bf16x8*)(R1 + l * 544 + (32 * ks + 8 * fq) * 2);
#pragma unroll
        for (int n = 0; n < 8; ++n) if (n <= w) { const bf16x8 bf = *(const LAS bf16x8*)(R2 + (16 * n + fr) * 544 + (32 * ks + 8 * fq) * 2); sc[n] = mma16(bf, af, sc[n]); }
    }
    bf16x8 scf[4];
#pragma unroll
    for (int k2 = 0; k2 < 4; ++k2) { float v[8];
#pragma unroll
        for (int tq = 0; tq < 2; ++tq)
#pragma unroll
            for (int j = 0; j < 4; ++j) { const int s = 16 * (2 * k2 + tq) + 4 * fq + j; v[4 * tq + j] = (s <= l) ? sc[2 * k2 + tq][j] * exp2f(lg * (float)(l - s)) : 0.f; }
        u32x4 pk; pk.x = pk_bf16(v[0], v[1]); pk.y = pk_bf16(v[2], v[3]); pk.z = pk_bf16(v[4], v[5]); pk.w = pk_bf16(v[6], v[7]);
        scf[k2] = __builtin_bit_cast(bf16x8, pk); }
    __syncthreads();
    f32x4 acc[16];
#pragma unroll
    for (int n = 0; n < 16; ++n) acc[n] = (f32x4){0.f, 0.f, 0.f, 0.f};
    const bf16* prev = XP_KV(X) + (size_t)(c * 4 + h) * 65536;
#pragma unroll 1
    for (int dh = 0; dh < 2; ++dh) {
#pragma unroll 4
        for (int i = 0; i < 8; ++i) { const int q = tid + 512 * i, v = q >> 4, dc = q & 15;
            *(LAS u32x4*)(R2 + v * 272 + dc * 16) = *(const u32x4*)(prev + (size_t)v * 256 + dh * 128 + dc * 8); }
        __syncthreads();
#pragma unroll 2
        for (int ks = 0; ks < 4; ++ks) {
            const bf16x8 af = *(const LAS bf16x8*)(R1 + l * 544 + (128 * dh + 32 * ks + 8 * fq) * 2);
#pragma unroll
            for (int n = 0; n < 16; ++n) { const bf16x8 bf = *(const LAS bf16x8*)(R2 + (16 * n + fr) * 272 + (32 * ks + 8 * fq) * 2); acc[n] = mma16(bf, af, acc[n]); }
        }
        __syncthreads();
    }
    { const float qd = exp2f(lg * (float)(l + 1));
#pragma unroll
      for (int n = 0; n < 16; ++n) acc[n] = acc[n] * qd; }
#pragma unroll 4
    for (int i = 0; i < 8; ++i) { const int q = tid + 512 * i, s = q >> 5, vc = q & 31;
        *(LAS u32x4*)(R2 + s * 544 + vc * 16) = *(const u32x4*)(XP_PROJ(X) + (size_t)(t0 + s) * LDP + C_V + h * 256 + vc * 8); }
    __syncthreads();
    const int trp = (4 * fq + q4) * 544 + 8 * p4;
#pragma unroll
    for (int k2 = 0; k2 < 4; ++k2) if (2 * k2 <= w) {
#pragma unroll
        for (int n = 0; n < 16; ++n) { const bf16x8 bf = tr_frag(R2 + (32 * k2) * 544 + (16 * n) * 2 + trp, 16 * 544); acc[n] = mma16(bf, scf[k2], acc[n]); }
    }
    float ss = 0.f;
#pragma unroll
    for (int n = 0; n < 16; ++n) ss += (acc[n][0] * acc[n][0] + acc[n][1] * acc[n][1]) + (acc[n][2] * acc[n][2] + acc[n][3] * acc[n][3]);
    ss += __shfl_xor(ss, 16); ss += __shfl_xor(ss, 32);
    const float rstd = rsqrtf(ss * (1.f / 256.f) + EPS);
    const bf16* gp = XP_PROJ(X) + (size_t)(t0 + l) * LDP + C_G + h * 256 + 4 * fq; bf16* op = XP_MIX(X) + (size_t)(t0 + l) * D + h * 256 + 4 * fq;
#pragma unroll
    for (int n = 0; n < 16; ++n) { const u32x2 gv = *(const u32x2*)(gp + 16 * n);
        u32x2 o; o.x = pk_bf16(acc[n][0] * rstd * silu_f(bf_lo(gv.x)), acc[n][1] * rstd * silu_f(bf_hi(gv.x))); o.y = pk_bf16(acc[n][2] * rstd * silu_f(bf_lo(gv.y)), acc[n][3] * rstd * silu_f(bf_hi(gv.y)));
        *(u32x2*)(op + 16 * n) = o; }
    __syncthreads();
}

__device__ __forceinline__ void p4_ssd(Ctx& X, int unit) {
    const int c = unit >> 1, g = unit & 1, t0 = c * CH, tid = X.tid, lane = X.lane, w = X.wave;
    LAS uchar* Cc = X.lds; LAS uchar* Bc = X.lds + 34816;
    LAS uchar* HP = X.lds + 34816;
    LAS float* dtS = (LAS float*)(X.lds + 110592); LAS float* acS = (LAS float*)(X.lds + 114688);
    { const int h = 8 * g + w, l0 = 2 * lane;
      const float dtb = XP_dt_bias(X)[h], A = -expf(XP_a_log(X)[h]);
      const float d0 = softplus_f(bf2f(XP_PROJ(X)[(size_t)(t0 + l0) * LDP + C_DT + h]) + dtb), d1 = softplus_f(bf2f(XP_PROJ(X)[(size_t)(t0 + l0 + 1) * LDP + C_DT + h]) + dtb);
      const float a0 = d0 * A, a1 = d1 * A, incl = wave_incl_scan(a0 + a1, lane);
      dtS[w * 128 + l0] = d0; dtS[w * 128 + l0 + 1] = d1; acS[w * 128 + l0] = incl - a1; acS[w * 128 + l0 + 1] = incl; }
#pragma unroll
    for (int i = 0; i < 4; ++i) { const int q = tid + 512 * i, l = q >> 4, nc = q & 15;
        *(LAS u32x4*)(Bc + l * 272 + nc * 16) = *(const u32x4*)(XP_XBC(X) + (size_t)(t0 + l) * XBCW + 1024 + 128 * g + nc * 8);
        *(LAS u32x4*)(Cc + l * 272 + nc * 16) = *(const u32x4*)(XP_XBC(X) + (size_t)(t0 + l) * XBCW + 1280 + 128 * g + nc * 8); }
    __syncthreads();
    const int fr = lane & 15, fq = lane >> 4, q4 = (lane & 15) >> 2, p4 = lane & 3, l = 16 * w + fr;
    f32x4 cb[8]; bf16x8 cfr[4];
#pragma unroll
    for (int n = 0; n < 8; ++n) cb[n] = (f32x4){0.f, 0.f, 0.f, 0.f};
#pragma unroll
    for (int ks = 0; ks < 4; ++ks) {
        cfr[ks] = *(const LAS bf16x8*)(Cc + l * 272 + (32 * ks + 8 * fq) * 2);
#pragma unroll
        for (int n = 0; n < 8; ++n) if (n <= w) { const bf16x8 bf = *(const LAS bf16x8*)(Bc + (16 * n + fr) * 272 + (32 * ks + 8 * fq) * 2); cb[n] = mma16(bf, cfr[ks], cb[n]); }
    }
    __syncthreads();
    float ss = 0.f;
    const int trp = (4 * fq + q4) * 144 + 8 * p4;
    const bf16* xp = XP_XBC(X) + (size_t)(t0 + l) * XBCW + 512 * g + 4 * fq; const bf16* zp = XP_PROJ(X) + (size_t)(t0 + l) * LDP + C_Z + 512 * g + 4 * fq;
    bf16* op = XP_MIX(X) + (size_t)(t0 + l) * D + 1024 + 512 * g + 4 * fq;
#pragma unroll 1
    for (int hp = 0; hp < 4; ++hp) {
#pragma unroll
        for (int i = 0; i < 4; ++i) { const int q = tid + 512 * i, e2 = q >> 10, s = (q >> 3) & 127, pc = q & 7, e = 2 * hp + e2;
            const u32x4 v = *(const u32x4*)(XP_XBC(X) + (size_t)(t0 + s) * XBCW + 512 * g + 64 * e + pc * 8); const float d = dtS[e * 128 + s];
            u32x4 o; o.x = pk_bf16(bf_lo(v.x) * d, bf_hi(v.x) * d); o.y = pk_bf16(bf_lo(v.y) * d, bf_hi(v.y) * d); o.z = pk_bf16(bf_lo(v.z) * d, bf_hi(v.z) * d); o.w = pk_bf16(bf_lo(v.w) * d, bf_hi(v.w) * d);
            *(LAS u32x4*)(HP + e2 * 18432 + s * 144 + pc * 16) = o; }
#pragma unroll
        for (int i = 0; i < 4; ++i) { const int q = tid + 512 * i, e2 = q >> 10, p = (q >> 4) & 63, nc = q & 15, e = 2 * hp + e2;
            *(LAS u32x4*)(HP + 36864 + e2 * 17408 + p * 272 + nc * 16) = *(const u32x4*)(XP_SST(X) + ((size_t)(c * 16 + 8 * g + e) * 64 + p) * 128 + nc * 8); }
        __syncthreads();
#pragma unroll 1
        for (int e2 = 0; e2 < 2; ++e2) { const int e = 2 * hp + e2;
            LAS uchar* Xh = HP + e2 * 18432; LAS uchar* Ph = HP + 36864 + e2 * 17408;
            f32x4 y[4];
#pragma unroll
            for (int n = 0; n < 4; ++n) y[n] = (f32x4){0.f, 0.f, 0.f, 0.f};
#pragma unroll
            for (int ks = 0; ks < 4; ++ks)
#pragma unroll
                for (int n = 0; n < 4; ++n) { const bf16x8 bf = *(const LAS bf16x8*)(Ph + (16 * n + fr) * 272 + (32 * ks + 8 * fq) * 2); y[n] = mma16(bf, cfr[ks], y[n]); }
            const float al = acS[e * 128 + l], el = __expf(al);
#pragma unroll
            for (int n = 0; n < 4; ++n) y[n] = y[n] * el;
#pragma unroll
            for (int k2 = 0; k2 < 4; ++k2) if (2 * k2 <= w) { float v[8];
#pragma unroll
                for (int tq = 0; tq < 2; ++tq) { const int s0 = 16 * (2 * k2 + tq) + 4 * fq; const f32x4 as = *(const LAS f32x4*)(acS + e * 128 + s0);
#pragma unroll
                    for (int j = 0; j < 4; ++j) v[4 * tq + j] = (s0 + j <= l) ? cb[2 * k2 + tq][j] * __expf(al - as[j]) : 0.f; }
                u32x4 pk; pk.x = pk_bf16(v[0], v[1]); pk.y = pk_bf16(v[2], v[3]); pk.z = pk_bf16(v[4], v[5]); pk.w = pk_bf16(v[6], v[7]);
                const bf16x8 gf = __builtin_bit_cast(bf16x8, pk);
#pragma unroll
                for (int n = 0; n < 4; ++n) { const bf16x8 bf = tr_frag(Xh + (32 * k2) * 144 + (16 * n) * 2 + trp, 16 * 144); y[n] = mma16(bf, gf, y[n]); }
            }
            const float dsk = XP_d_skip(X)[8 * g + e];
#pragma unroll
            for (int n = 0; n < 4; ++n) { const u32x2 xv = *(const u32x2*)(xp + 64 * e + 16 * n), zv = *(const u32x2*)(zp + 64 * e + 16 * n);
                const float t0_ = (y[n][0] + dsk * bf_lo(xv.x)) * silu_f(bf_lo(zv.x)), t1_ = (y[n][1] + dsk * bf_hi(xv.x)) * silu_f(bf_hi(zv.x));
                const float t2_ = (y[n][2] + dsk * bf_lo(xv.y)) * silu_f(bf_lo(zv.y)), t3_ = (y[n][3] + dsk * bf_hi(xv.y)) * silu_f(bf_hi(zv.y));
                ss += (t0_ * t0_ + t1_ * t1_) + (t2_ * t2_ + t3_ * t3_);
                u32x2 o; o.x = pk_bf16(t0_, t1_); o.y = pk_bf16(t2_, t3_); *(u32x2*)(op + 64 * e + 16 * n) = o; }
        }
        __syncthreads();
    }
    ss += __shfl_xor(ss, 16); ss += __shfl_xor(ss, 32);
    const float rstd = rsqrtf(ss * (1.f / 512.f) + EPS);
    const float* nw = XP_ssm_norm_w(X) + 512 * g + 4 * fq;
#pragma unroll 4
    for (int i = 0; i < 32; ++i) { const f32x4 wv = *(const f32x4*)(nw + 16 * i); const u32x2 t = *(const u32x2*)(op + 16 * i);
        u32x2 o; o.x = pk_bf16(bf_lo(t.x) * rstd * wv.x, bf_hi(t.x) * rstd * wv.y); o.y = pk_bf16(bf_lo(t.y) * rstd * wv.z, bf_hi(t.y) * rstd * wv.w);
        *(u32x2*)(op + 16 * i) = o; }
    __syncthreads();
}

__device__ __forceinline__ void p6_router(Ctx& X) {
    const int tid = X.tid, lane = X.lane, w = X.wave;
    LAS float* u2s = (LAS float*)X.lds;
    LAS float* part = (LAS float*)(X.lds + 65536);
    LAS float* lgt = (LAS float*)(X.lds + 81920);
    const int e = tid & 31, ds = tid >> 5;
    float wreg[128];
#pragma unroll
    for (int i = 0; i < 128; ++i) wreg[i] = XP_w_router(X)[(size_t)(128 * ds + i) * NE + e];
    for (int item = X.bid; item < T / 8; item += X.G) {
        const int tb = item * 8;
        { const int t = tb + w;
            const f32x4* hr = (const f32x4*)(XP_Hh(X) + (size_t)t * D) + lane; const f32x4* wr_ = (const f32x4*)XP_ln_ffn_w(X) + lane;
            f32x4 v[8]; float s = 0.f;
#pragma unroll
            for (int j = 0; j < 8; ++j) { v[j] = hr[64 * j]; s += (v[j].x * v[j].x + v[j].y * v[j].y) + (v[j].z * v[j].z + v[j].w * v[j].w); }
            const float rstd = rsqrtf(wave_sum(s) * (1.f / D) + EPS);
            u32x2* o8 = (u32x2*)(XP_U2(X) + (size_t)t * D) + lane;
#pragma unroll
            for (int j = 0; j < 8; ++j) { const f32x4 wv = wr_[64 * j]; f32x4 u; u.x = v[j].x * rstd * wv.x; u.y = v[j].y * rstd * wv.y; u.z = v[j].z * rstd * wv.z; u.w = v[j].w * rstd * wv.w;
                *(LAS f32x4*)(u2s + w * D + 4 * lane + 256 * j) = u;
                u32x2 o; o.x = pk_bf16(u.x, u.y); o.y = pk_bf16(u.z, u.w); o8[64 * j] = o; } }
        __syncthreads();
#pragma unroll 1
        for (int tk = 0; tk < 8; ++tk) { float a0 = 0.f, a1 = 0.f;
#pragma unroll
            for (int i = 0; i < 128; i += 8) { const f32x4 u = *(const LAS f32x4*)(u2s + tk * D + 128 * ds + i), u2 = *(const LAS f32x4*)(u2s + tk * D + 128 * ds + i + 4);
                a0 += u.x * wreg[i] + u.y * wreg[i + 1] + u.z * wreg[i + 2] + u.w * wreg[i + 3]; a1 += u2.x * wreg[i + 4] + u2.y * wreg[i + 5] + u2.z * wreg[i + 6] + u2.w * wreg[i + 7]; }
            part[(tk * 16 + ds) * 32 + e] = a0 + a1; }
        __syncthreads();
        if (tid < 256) { const int tk = tid >> 5; float a = XP_b_router(X)[e];
#pragma unroll
          for (int d2 = 0; d2 < 16; ++d2) a += part[(tk * 16 + d2) * 32 + e];
          lgt[tk * 32 + e] = a; }
        __syncthreads();
        if (tid < 8) { const int t = tb + tid; unsigned used = 0u; int idx[4]; float val[4];
#pragma unroll
            for (int k = 0; k < 4; ++k) { float best = -3.0e38f; int bi = 0;
                for (int j = 0; j < 32; ++j) { const float v = lgt[tid * 32 + j]; if (!((used >> j) & 1u) && v > best) { best = v; bi = j; } }
                used |= 1u << bi; idx[k] = bi; val[k] = best; }
            const float e1 = __expf(val[1] - val[0]), e2 = __expf(val[2] - val[0]), e3 = __expf(val[3] - val[0]), inv = 1.f / (1.f + e1 + e2 + e3);
            const float wv[4] = {inv, e1 * inv, e2 * inv, e3 * inv};
#pragma unroll
            for (int k = 0; k < 4; ++k) { const int rank = (int)atomicAdd(XP_ctl(X) + CW_CNT + 64 * idx[k], 1u);
                XP_LIST(X)[idx[k] * T + rank] = t; XP_TOPI(X)[t * 4 + k] = idx[k]; XP_TOPR(X)[t * 4 + k] = rank; XP_TOPW(X)[t * 4 + k] = wv[k]; } }
        __syncthreads();
    }
}

__device__ __forceinline__ void moe_tables(Ctx& X) {
    LAS int* tab = (LAS int*)(X.lds + LDS_TAB);
    if (X.tid == 0) { int nb = 0;
        for (int e = 0; e < NE; ++e) { const int cnt = (int)__hip_atomic_load(XP_ctl(X) + CW_CNT + 64 * e, __ATOMIC_RELAXED, __HIP_MEMORY_SCOPE_AGENT); const int k = (cnt + 255) >> 8;
            tab[8 + e] = nb; for (int b = 0; b < k; ++b) { if (nb + b < MAXBLK) { tab[64 + nb + b] = e; tab[256 + nb + b] = (cnt - 256 * b) < 256 ? (cnt - 256 * b) : 256; } } nb += k; }
        tab[8 + NE] = nb; tab[0] = nb < MAXBLK ? nb : MAXBLK; }
    __syncthreads();
}

__device__ __forceinline__ void p9_final(Ctx& X) {
    const LAS int* tab = (const LAS int*)(X.lds + LDS_TAB);
    const int gw = X.bid * NWAVES + X.wave, NGW = X.G * NWAVES, lane = X.lane;
    for (int t = gw; t < T; t += NGW) {
        const f32x4* hr = (const f32x4*)(XP_Hh(X) + (size_t)t * D) + lane;
        f32x4 v[8];
#pragma unroll
        for (int j = 0; j < 8; ++j) v[j] = hr[64 * j];
#pragma unroll
        for (int k = 0; k < 4; ++k) { const int e = XP_TOPI(X)[t * 4 + k], r = XP_TOPR(X)[t * 4 + k]; const float wk = XP_TOPW(X)[t * 4 + k];
            const u32x2* yr = (const u32x2*)(XP_YR(X) + ((size_t)tab[8 + e] * 256 + r) * D) + lane;
#pragma unroll
            for (int j = 0; j < 8; ++j) { const u32x2 y = yr[64 * j]; v[j].x += wk * bf_lo(y.x); v[j].y += wk * bf_hi(y.x); v[j].z += wk * bf_lo(y.y); v[j].w += wk * bf_hi(y.y); } }
        float s = 0.f;
#pragma unroll
        for (int j = 0; j < 8; ++j) s += (v[j].x * v[j].x + v[j].y * v[j].y) + (v[j].z * v[j].z + v[j].w * v[j].w);
        const float rstd = rsqrtf(wave_sum(s) * (1.f / D) + EPS);
        f32x4* o = (f32x4*)(X.out + (size_t)t * D) + lane; const f32x4* wr_ = (const f32x4*)XP_ln_final_w(X) + lane;
#pragma unroll
        for (int j = 0; j < 8; ++j) { const f32x4 wv = wr_[64 * j]; f32x4 r; r.x = v[j].x * rstd * wv.x; r.y = v[j].y * rstd * wv.y; r.z = v[j].z * rstd * wv.z; r.w = v[j].w * rstd * wv.w; o[64 * j] = r; }
    }
}

#ifdef NO_P4R
#define P4R(X,u)
#else
#define P4R(X,u) p4_ret(X,u)
#endif
#ifdef NO_P4S
#define P4S(X,u)
#else
#define P4S(X,u) p4_ssd(X,u)
#endif
struct Args { const void* in[19]; float* out; uchar* ws; int ph_lo, ph_hi; };
__global__ void __launch_bounds__(NTHR, 2) fwd(Args args) {
    extern __shared__ __attribute__((aligned(16))) uchar lds_raw[];
    Ctx X;
    X.lds = (LAS uchar*)lds_raw; X.tid = threadIdx.x; X.lane = X.tid & 63; X.wave = __builtin_amdgcn_readfirstlane(X.tid >> 6); X.G = gridDim.x; X.bid = blockIdx.x;
    X.in = (const void* const*)__builtin_amdgcn_kernarg_segment_ptr(); X.out = args.out; X.ws = args.ws;
    for (int u = X.tid; u < (LDS_BYTES - LDS_PHASE_END) / 4; u += NTHR) ((LAS unsigned*)(X.lds + LDS_PHASE_END))[u] = 0u;
    __syncthreads();
    const int lo = args.ph_lo, hi = args.ph_hi;
    const bool multi = (hi - lo) > 1;
    XcdBarrier bar; bar.bar = XP_ctl(X) + CW_BAR; bar.x = 0; bar.st = nullptr;
    if (multi) bar = xcd_barrier_post(XP_ctl(X) + CW_BAR, (volatile LAS unsigned*)(X.lds + LDS_MISC + 32));
#ifdef ONLY_PHASE
#define IN(k) ((k) == ONLY_PHASE && lo <= (k) && (k) < hi)
#else
#define IN(k) (lo <= (k) && (k) < hi)
#endif
#define SEAM(k) do { if (IN(k) && IN((k) + 1)) xcd_barrier(bar); } while (0)
    if (IN(0)) { p0_prologue(X); } SEAM(0);
    if (IN(1)) { DenseSched S{(const char*)XP_U(X), (const char*)XP_WinT(X), D, T / 256, LDP / 256, (T / 256) * (LDP / 256), X.G, X.bid}; EpiProj E{XP_PROJ(X), LDP};
        pg8::gemm_phase<EpiProj, DenseSched, false>(X.lds, D, S, E); } SEAM(1);
    if (IN(2)) { for (int u = X.bid; u < 512; u += X.G) { if (u < 256) p2_ret(X, u); else p2_ssd(X, u - 256); } } SEAM(2);
    if (IN(3)) { p3_scan(X); } SEAM(3);
    if (IN(4)) { for (int u = X.bid; u < 384; u += X.G) { if (u < 256) { P4R(X, u); } else { P4S(X, u - 256); } } } SEAM(4);
    if (IN(5)) { DenseSched S{(const char*)XP_MIX(X), (const char*)XP_WoutT(X), D, T / 256, D / 256, (T / 256) * (D / 256), X.G, X.bid}; EpiOut E{XP_x(X), XP_Hh(X)};
        pg8::gemm_phase<EpiOut, DenseSched, false>(X.lds, D, S, E); } SEAM(5);
    if (IN(6)) { p6_router(X); } SEAM(6);
    if (IN(7)) { moe_tables(X); MoeSched S{(const LAS int*)(X.lds + LDS_TAB), (const char*)XP_U2(X), (const char*)XP_WguT(X), (size_t)(2 * DFF) * D * 2, XP_LIST(X), D, (2 * DFF) / 256, X.G, X.bid}; EpiGateUp E{XP_ACT(X), XP_b_gu(X)};
        pg8::gemm_phase<EpiGateUp, MoeSched, true>(X.lds, D, S, E); } SEAM(7);
    if (IN(8)) { moe_tables(X); MoeSchedDirect S{(const LAS int*)(X.lds + LDS_TAB), (const char*)XP_ACT(X), (const char*)XP_WdT(X), (size_t)D * DFF * 2, DFF, D / 256, X.G, X.bid}; EpiDown E{XP_YR(X), XP_b_d(X)};
        pg8::gemm_phase<EpiDown, MoeSchedDirect, false>(X.lds, DFF, S, E); } SEAM(8);
    if (IN(9)) { moe_tables(X); p9_final(X); }
#undef IN
#undef SEAM
}

extern "C" void kernel_launch(void* const* d_in, const int* in_sizes, int n_in, void* d_out, int out_size, void* d_ws, size_t ws_size, hipStream_t stream) {
    static int grid = 0;
    if (grid == 0) {
        if (n_in != 19 || out_size != T * D || ws_size < WS_END) { fprintf(stderr, "kernel_launch: unexpected shapes (n_in %d, out %d, ws %zu)\n", n_in, out_size, ws_size); grid = -1; return; }
        int dev = 0, cus = 0, per_cu = 0;
        if (hipGetDevice(&dev) != hipSuccess || hipDeviceGetAttribute(&cus, hipDeviceAttributeMultiprocessorCount, dev) != hipSuccess) { grid = -1; return; }
        if (hipFuncSetAttribute((const void*)fwd, hipFuncAttributeMaxDynamicSharedMemorySize, LDS_BYTES) != hipSuccess) { fprintf(stderr, "kernel_launch: hipFuncSetAttribute failed\n"); grid = -1; return; }
        if (hipOccupancyMaxActiveBlocksPerMultiprocessor(&per_cu, (const void*)fwd, NTHR, LDS_BYTES) != hipSuccess || per_cu < 1) { fprintf(stderr, "kernel_launch: occupancy query reports %d\n", per_cu); }
        (void)hipGetLastError();
        grid = cus;
    }
    if (grid < 0) return;
    (void)hipMemsetAsync((char*)d_ws + WS_CTL, 0, CTL_ZERO_BYTES, stream);
    Args a{};
    for (int i = 0; i < 19; ++i) a.in[i] = d_in[i];
    a.out = (float*)d_out; a.ws = (uchar*)d_ws;
    constexpr int NL = MK_N_LAUNCHES;
    for (int li = 0; li < NL; ++li) {
        a.ph_lo = (NL == 1) ? 0 : li; a.ph_hi = (NL == 1) ? NPHASE : li + 1;
        hipLaunchKernelGGL(fwd, dim3(grid), dim3(NTHR), LDS_BYTES, stream, a);
    }
}
```

```cpp
#include <hip/hip_runtime.h>
#include <cstdio>
#include <cstdint>

#ifndef MK_N_LAUNCHES
#define MK_N_LAUNCHES 1
#endif

#define LAS __attribute__((address_space(3)))
typedef unsigned short bf16;
typedef short bf16x8 __attribute__((ext_vector_type(8)));
typedef short s16x4 __attribute__((ext_vector_type(4)));
typedef float f32x4 __attribute__((ext_vector_type(4)));
typedef float f32x2 __attribute__((ext_vector_type(2)));
typedef unsigned u32x4 __attribute__((ext_vector_type(4)));
typedef unsigned u32x2 __attribute__((ext_vector_type(2)));
typedef unsigned char uchar;
typedef int i32x8 __attribute__((ext_vector_type(8)));
typedef int i32x4 __attribute__((ext_vector_type(4)));
constexpr float W8_SCALE = 64.f, W8_INV = 1.f / 64.f;

constexpr int T = 8192, D = 2048, NPROJ = 6672, LDP = 6912;
constexpr int C_Q = 0, C_K = 1024, C_V = 2048, C_G = 3072, C_Z = 4096, C_X = 5120, C_DT = 6656;
constexpr int XBCW = 1536, NCHUNK = 64, CH = 128;
constexpr int NE = 32, DFF = 2048, MAXBLK = 160;
constexpr float EPS = 1e-6f;
constexpr int NPHASE = 10;
constexpr int NWAVES = 8, NTHR = 512;

constexpr size_t MiB = 1ull << 20;
constexpr size_t WS_CTL = 0, CTL_ZERO_BYTES = 1 * MiB;
constexpr size_t WS_WINT = 2 * MiB, WS_WOUTT = 30 * MiB, WS_COS = 38 * MiB, WS_SIN = 42 * MiB;
constexpr size_t WS_TOPI = 46 * MiB, WS_TOPR = 46 * MiB + 128 * 1024, WS_TOPW = 46 * MiB + 256 * 1024, WS_LIST = 47 * MiB, WS_ADEC = 48 * MiB;
constexpr size_t WS_U = 64 * MiB, WS_U2 = 96 * MiB, WS_MIX = 128 * MiB, WS_XBC = 160 * MiB, WS_KV = 192 * MiB, WS_SST = 224 * MiB;
constexpr size_t WS_H = 256 * MiB, WS_PROJ = 320 * MiB, WS_ACT = 448 * MiB, WS_YR = 608 * MiB, WS_WGUT = 768 * MiB, WS_WDT = 1280 * MiB, WS_END = 1536 * MiB;
constexpr int CW_TMO = 0, CW_BAR = 4096, CW_CNT = 16384;

constexpr int RING_BYTES = 131072;
constexpr int LDS_PHASE_END = 139264;
constexpr int LDS_TAB = LDS_PHASE_END;
constexpr int LDS_MISC = LDS_PHASE_END + 4096;
constexpr int LDS_BYTES = 147456;

__device__ __forceinline__ unsigned pk_bf16(float lo, float hi) { unsigned r; asm("v_cvt_pk_bf16_f32 %0, %1, %2" : "=v"(r) : "v"(lo), "v"(hi)); return r; }
__device__ __forceinline__ float clamp448(float x) { return fminf(fmaxf(x, -448.f), 448.f); }
__device__ __forceinline__ unsigned pk_fp8x4(float a, float b, float c, float d) {
    int p = 0; p = __builtin_amdgcn_cvt_pk_fp8_f32(clamp448(a), clamp448(b), p, false); p = __builtin_amdgcn_cvt_pk_fp8_f32(clamp448(c), clamp448(d), p, true); return (unsigned)p; }
__device__ __forceinline__ float bf_lo(unsigned u) { return __uint_as_float(u << 16); }
__device__ __forceinline__ float bf_hi(unsigned u) { return __uint_as_float(u & 0xffff0000u); }
__device__ __forceinline__ float bf2f(bf16 b) { return __uint_as_float(((unsigned)b) << 16); }
__device__ __forceinline__ float wave_sum(float v) {
#pragma unroll
    for (int o = 1; o < 64; o <<= 1) v += __shfl_xor(v, o);
    return v;
}
__device__ __forceinline__ float silu_f(float x) { return x / (1.0f + __expf(-x)); }
__device__ __forceinline__ float softplus_f(float x) { return x > 20.f ? x : log1pf(__expf(x)); }

__constant__ double INV_FREQ[128] = {1,0.93057204092969903,0.86596432336006535,0.80584218776148187,0.74989420933245587,0.69783058485986638,0.64938163157621132,0.60429639023813286,0.56234132519034907,0.5232991146814947,0.48696752516586311,0.45315836376008178,0.42169650342858223,0.39241897584845359,0.36517412725483772,0.33982083289425596,0.31622776601683794,0.29427271762092816,0.27384196342643613,0.25482967479793467,0.23713737056616552,0.22067340690845899,0.20535250264571461,0.19109529749704404,0.17782794100389229,0.16548170999431813,0.15399265260594919,0.14330125702369628,0.1333521432163324,0.12409377607517195,0.11547819846894582,0.10746078283213174,0.10000000000000001,0.0930572040929699,0.086596432336006529,0.080584218776148187,0.074989420933245579,0.069783058485986635,0.064938163157621132,0.060429639023813285,0.056234132519034911,0.05232991146814947,0.048696752516586311,0.045315836376008181,0.042169650342858224,0.039241897584845357,0.036517412725483769,0.033982083289425591,0.031622776601683791,0.029427271762092817,0.027384196342643614,0.025482967479793464,0.023713737056616554,0.022067340690845899,0.02053525026457146,0.019109529749704406,0.017782794100389229,0.016548170999431813,0.015399265260594919,0.014330125702369627,0.013335214321633241,0.012409377607517195,0.011547819846894581,0.010746078283213174,0.01,0.0093057204092969904,0.0086596432336006543,0.008058421877614819,0.0074989420933245579,0.0069783058485986633,0.006493816315762113,0.0060429639023813278,0.005623413251903491,0.0052329911468149467,0.004869675251658631,0.0045315836376008181,0.0042169650342858229,0.0039241897584845363,0.0036517412725483771,0.0033982083289425592,0.0031622776601683794,0.002942727176209282,0.0027384196342643613,0.0025482967479793467,0.0023713737056616554,0.0022067340690845897,0.002053525026457146,0.0019109529749704406,0.0017782794100389228,0.0016548170999431814,0.001539926526059492,0.0014330125702369627,0.0013335214321633241,0.0012409377607517195,0.0011547819846894581,0.0010746078283213176,0.001,0.00093057204092969893,0.00086596432336006539,0.00080584218776148179,0.00074989420933245586,0.00069783058485986635,0.00064938163157621134,0.00060429639023813287,0.0005623413251903491,0.00052329911468149473,0.0004869675251658631,0.00045315836376008179,0.00042169650342858224,0.00039241897584845359,0.0003651741272548377,0.00033982083289425596,0.00031622776601683794,0.00029427271762092817,0.00027384196342643611,0.00025482967479793463,0.00023713737056616554,0.00022067340690845897,0.00020535250264571461,0.00019109529749704405,0.00017782794100389227,0.00016548170999431815,0.00015399265260594919,0.00014330125702369627,0.0001333521432163324,0.00012409377607517196,0.00011547819846894582,0.00010746078283213175};
__constant__ float LG2_GAMMA[4] = {-0.045803689613124789f, -0.022720076500083529f, -0.011315313227834146f, -0.0056465631411420627f};
__constant__ float GAMMA_CHUNK[4] = {0.017183023570817902f, 0.13321516287964841f, 0.36643771592203728f, 0.60593708822908032f};

namespace pg8 {
constexpr int BM = 256, BK = 64, HALF = 128, HTB = HALF * BK * 2, STAGE_BYTES = 8 * HTB, NXCD = 8, WGM = 8;
__host__ __device__ __forceinline__ int lds_byte(int r, int c) { const int st = (r >> 4) * 2 + (c >> 5), rr = r & 15, cc = c & 31, ob = rr * 64 + cc * 2; return st * 1024 + (ob ^ (((ob >> 9) & 1) << 5)); }
__host__ __device__ __forceinline__ void stage_rc(int b, int& R, int& C) { const int st = b / 1024, sb = b % 1024, swz = sb ^ (((sb >> 9) & 1) << 5); R = (st >> 1) * 16 + swz / 64; C = (st & 1) * 32 + (swz % 64) / 2; }
__host__ __device__ __forceinline__ int perm32(int rho) { const int n = rho >> 4, i = rho & 15; return 8 * (i >> 2) + 4 * n + (i & 3); }

struct Unit { const char* pa; const char* pb; int row0, col0, aux, blk; };

template <class Epi, class Sched, bool GATHER, bool FP8>
__device__ __forceinline__ void gemm_phase(LAS uchar* lds, const int K, const Sched& S, const Epi& E) {
    const int tid = threadIdx.x, wid = __builtin_amdgcn_readfirstlane(tid >> 6), lane = tid & 63, wr = wid >> 2, wc = wid & 3, fr = lane & 15, fq = lane >> 4;
    const int nt = K / BK;
    unsigned voA[2][2], voffB[2];
#pragma unroll
    for (int i = 0; i < 2; ++i) { int R, C; stage_rc(tid * 16 + i * 8192, R, C); const int Rb = Epi::PERM ? ((R & ~31) + perm32(R & 31)) : R;
        voA[0][i] = (unsigned)(R * K + C) * 2u; voA[1][i] = voA[0][i] + (unsigned)(HALF * K * 2); voffB[i] = (unsigned)(Rb * K + C) * 2u; }
    const size_t kstep = (size_t)(BK * 2);
    const size_t hstep = (size_t)HALF * K * 2;
    const unsigned ldsw = (unsigned)wid * 1024u;
    const int aoff = lds_byte(wr * 64 + fr, fq * 8), boff = lds_byte(wc * 32 + fr, fq * 8);
#define PG8_SA(b, h) (((b) * 2 + (h)) * HTB)
#define PG8_SB(b, h) ((4 + (b) * 2 + (h)) * HTB)
#define PG8_STAGE(bufoff, gbase, voff) do { _Pragma("unroll") for (int _i = 0; _i < 2; ++_i) \
        __builtin_amdgcn_global_load_lds((const unsigned*)((const char*)(gbase) + (voff)[_i]), (LAS unsigned*)(lds + (bufoff) + ldsw + _i * 8192), 16, 0, 0); } while (0)
#define PG8_LDA(dst, b, h) do { _Pragma("unroll") for (int m = 0; m < 4; ++m) _Pragma("unroll") for (int k = 0; k < 2; ++k) dst[m][k] = *(const LAS bf16x8*)(lds + PG8_SA(b, h) + aoff + m * 2048 + k * 1024); } while (0)
#define PG8_LDB(dst, b, h) do { _Pragma("unroll") for (int n = 0; n < 2; ++n) _Pragma("unroll") for (int k = 0; k < 2; ++k) dst[n][k] = *(const LAS bf16x8*)(lds + PG8_SB(b, h) + boff + n * 2048 + k * 1024); } while (0)
#define PG8_CAT(x) __builtin_shufflevector(__builtin_bit_cast(i32x4, (x)[0]), __builtin_bit_cast(i32x4, (x)[1]), 0, 1, 2, 3, 4, 5, 6, 7)
#define PG8_MMA(ai, bj, At, Bt) do { __builtin_amdgcn_s_setprio(1); \
        if constexpr (FP8) { _Pragma("unroll") for (int m = 0; m < 4; ++m) _Pragma("unroll") for (int n = 0; n < 2; ++n) \
            acc[ai][bj][m][n] = __builtin_amdgcn_mfma_scale_f32_16x16x128_f8f6f4(PG8_CAT(Bt[n]), PG8_CAT(At[m]), acc[ai][bj][m][n], 0, 0, 0, 0x7f7f7f7f, 0, 0x7f7f7f7f); } \
        else { _Pragma("unroll") for (int m = 0; m < 4; ++m) _Pragma("unroll") for (int n = 0; n < 2; ++n) _Pragma("unroll") for (int k = 0; k < 2; ++k) \
            acc[ai][bj][m][n] = __builtin_amdgcn_mfma_f32_16x16x32_bf16(Bt[n][k], At[m][k], acc[ai][bj][m][n], 0, 0, 0); } \
        __builtin_amdgcn_s_setprio(0); } while (0)
#define PG8_WAIT_V(n) asm volatile("s_waitcnt vmcnt(" #n ")" ::: "memory")
#define PG8_WAIT_L(n) asm volatile("s_waitcnt lgkmcnt(" #n ")" ::: "memory")
#define PG8_BAR __builtin_amdgcn_s_barrier()
#define PG8_SCHED __builtin_amdgcn_sched_barrier(0)
    Unit cur, nxt; int ui = 0;
    if (!S.next(0, cur)) return;
    f32x4 acc[2][2][4][2];
#pragma unroll
    for (int a = 0; a < 2; ++a)
#pragma unroll
        for (int b = 0; b < 2; ++b)
#pragma unroll
            for (int m = 0; m < 4; ++m)
#pragma unroll
                for (int n = 0; n < 2; ++n) acc[a][b][m][n] = (f32x4){0.f, 0.f, 0.f, 0.f};
    bf16x8 At[4][2], B0[2][2], B1[2][2];
    const char* cA = cur.pa; const char* cB = cur.pb;
    if constexpr (GATHER) S.gather(cur, voA);
    PG8_STAGE(PG8_SB(0, 0), cB, voffB); PG8_STAGE(PG8_SB(0, 1), cB + hstep, voffB); PG8_STAGE(PG8_SA(0, 0), cA, voA[0]); PG8_STAGE(PG8_SA(0, 1), cA, voA[1]);
    if (wr == 1) PG8_BAR;
    PG8_WAIT_V(2); PG8_BAR;
    PG8_STAGE(PG8_SB(1, 0), cB + kstep, voffB); PG8_STAGE(PG8_SA(1, 0), cA + kstep, voA[0]); PG8_STAGE(PG8_SB(1, 1), cB + hstep + kstep, voffB);
    PG8_WAIT_V(6); PG8_BAR;
    for (;;) {
        const bool has_next = S.next(ui + 1, nxt);
        const char* nA = has_next ? nxt.pa : cA; const char* nB = has_next ? nxt.pb : cB;
        for (int t = 0; t < nt; t += 2) {
            const bool last = (t == nt - 2);
            const char* a1 = cA + (size_t)(t + 1) * kstep;
            const char* a2 = last ? nA : cA + (size_t)(t + 2) * kstep; const char* b2 = last ? nB : cB + (size_t)(t + 2) * kstep;
            const char* a3 = a2 + kstep; const char* b3 = b2 + kstep;
            PG8_LDB(B0, 0, 0); PG8_LDB(B1, 0, 1); PG8_SCHED; PG8_LDA(At, 0, 0); PG8_STAGE(PG8_SA(1, 1), a1, voA[1]);
            if constexpr (GATHER) { if (last && has_next) S.gather(nxt, voA); }
            PG8_WAIT_V(8); PG8_WAIT_L(0); PG8_BAR; PG8_MMA(0, 0, At, B0); PG8_MMA(0, 1, At, B1); PG8_BAR; PG8_SCHED;
            PG8_LDA(At, 0, 1); PG8_STAGE(PG8_SB(0, 0), b2, voffB); PG8_STAGE(PG8_SB(0, 1), b2 + hstep, voffB); PG8_STAGE(PG8_SA(0, 0), a2, voA[0]);
            PG8_WAIT_V(8); PG8_WAIT_L(0); PG8_BAR; PG8_MMA(1, 0, At, B0); PG8_MMA(1, 1, At, B1); PG8_BAR; PG8_SCHED;
            PG8_LDB(B0, 1, 0); PG8_LDB(B1, 1, 1); PG8_SCHED; PG8_LDA(At, 1, 0); PG8_STAGE(PG8_SA(0, 1), a2, voA[1]);
            PG8_WAIT_V(8); PG8_WAIT_L(0); PG8_BAR; PG8_MMA(0, 0, At, B0); PG8_MMA(0, 1, At, B1); PG8_BAR; PG8_SCHED;
            PG8_LDA(At, 1, 1); PG8_STAGE(PG8_SB(1, 0), b3, voffB); PG8_STAGE(PG8_SB(1, 1), b3 + hstep, voffB); PG8_STAGE(PG8_SA(1, 0), a3, voA[0]);
            PG8_WAIT_V(8); PG8_WAIT_L(0); PG8_BAR; PG8_MMA(1, 0, At, B0); PG8_MMA(1, 1, At, B1); PG8_BAR; PG8_SCHED;
        }
        if (wr == 0) PG8_BAR;
        E(acc, cur, wr, wc, fr, fq);
        if (!has_next) break;
#pragma unroll
        for (int a = 0; a < 2; ++a)
#pragma unroll
            for (int b = 0; b < 2; ++b)
#pragma unroll
                for (int m = 0; m < 4; ++m)
#pragma unroll
                    for (int n = 0; n < 2; ++n) acc[a][b][m][n] = (f32x4){0.f, 0.f, 0.f, 0.f};
        cur = nxt; cA = nA; cB = nB; ++ui;
        if (wr == 1) PG8_BAR;
    }
    PG8_WAIT_V(0);
    PG8_BAR;
#undef PG8_SA
#undef PG8_SB
#undef PG8_STAGE
#undef PG8_LDA
#undef PG8_LDB
#undef PG8_MMA
#undef PG8_CAT
#undef PG8_WAIT_V
#undef PG8_WAIT_L
#undef PG8_BAR
#undef PG8_SCHED
}
}

struct DenseSched {
    const char* A; const char* B; int K, nM, nN, nwg, G, c;
    __device__ __forceinline__ bool next(int i, pg8::Unit& u) const {
        const long L = (long)i * G + c; if (L >= nwg) return false;
        int wgid = (int)L; { const int q = nwg / pg8::NXCD, r = nwg % pg8::NXCD, xcd = wgid % pg8::NXCD, off = wgid / pg8::NXCD; wgid = (xcd < r ? xcd * (q + 1) : r * (q + 1) + (xcd - r) * q) + off; }
        const int nig = pg8::WGM * nN, gid = wgid / nig, fm = gid * pg8::WGM, gsz = (nM - fm) < pg8::WGM ? (nM - fm) : pg8::WGM;
        const int pm = fm + ((wgid % nig) % gsz), pn = (wgid % nig) / gsz;
        u.pa = A + (size_t)pm * 256 * K * 2; u.pb = B + (size_t)pn * 256 * K * 2; u.row0 = pm * 256; u.col0 = pn * 256; u.aux = 0; u.blk = 0; return true;
    }
    __device__ __forceinline__ void gather(const pg8::Unit&, unsigned (&)[2][2]) const {}
};
struct MoeSched {
    const LAS int* tab; const char* A; const char* B; size_t bexp; const int* list; int K, nN, G, c;
    __device__ __forceinline__ bool next(int i, pg8::Unit& u) const {
        const int NB = __builtin_amdgcn_readfirstlane(tab[0]); const int L = i * G + c; if (L >= NB * nN) return false;
        const int b = L / nN, pn = L - b * nN, e = __builtin_amdgcn_readfirstlane(tab[64 + b]);
        u.pa = A; u.pb = B + (size_t)e * bexp + (size_t)pn * 256 * K * 2; u.row0 = b * 256; u.col0 = pn * 256; u.aux = e; u.blk = b; return true;
    }
    __device__ __forceinline__ void gather(const pg8::Unit& u, unsigned (&vo)[2][2]) const {
        const int e = u.aux, lb = (u.blk - __builtin_amdgcn_readfirstlane(tab[8 + e])) * 256, cnt = __builtin_amdgcn_readfirstlane(tab[256 + u.blk]);
#pragma unroll
        for (int i = 0; i < 2; ++i) { int R, C; pg8::stage_rc((int)threadIdx.x * 16 + i * 8192, R, C);
#pragma unroll
            for (int h = 0; h < 2; ++h) { const int r = h * 128 + R; const int tok = (r < cnt) ? list[e * T + lb + r] : 0; vo[h][i] = ((unsigned)tok * (unsigned)K + (unsigned)C) * 2u; } }
    }
};
struct MoeSchedDirect {
    const LAS int* tab; const char* A; const char* B; size_t bexp; int K, nN, G, c;
    __device__ __forceinline__ bool next(int i, pg8::Unit& u) const {
        const int NB = __builtin_amdgcn_readfirstlane(tab[0]); const int L = i * G + c; if (L >= NB * nN) return false;
        const int b = L / nN, pn = L - b * nN, e = __builtin_amdgcn_readfirstlane(tab[64 + b]);
        u.pa = A; u.pb = B + (size_t)e * bexp + (size_t)pn * 256 * K * 2; u.row0 = b * 256; u.col0 = pn * 256; u.aux = e; u.blk = b; return true;
    }
    __device__ __forceinline__ void gather(const pg8::Unit& u, unsigned (&vo)[2][2]) const {
#pragma unroll
        for (int i = 0; i < 2; ++i) { int R, C; pg8::stage_rc((int)threadIdx.x * 16 + i * 8192, R, C);
#pragma unroll
            for (int h = 0; h < 2; ++h) vo[h][i] = ((unsigned)(u.row0 + h * 128 + R) * (unsigned)K + (unsigned)C) * 2u; }
    }
};

struct EpiProj {
    static constexpr bool PERM = true;
    bf16* O; int ldc;
    __device__ __forceinline__ void operator()(const f32x4 (&acc)[2][2][4][2], const pg8::Unit& u, int wr, int wc, int fr_, int fq_) const {
        int tz = threadIdx.x; asm volatile("" : "+v"(tz)); const int fr = tz & 15, fq = (tz >> 4) & 3;
        const int row0 = u.row0 + wr * 64 + fr, col0 = u.col0 + wc * 32 + 8 * fq;
#pragma unroll
        for (int ai = 0; ai < 2; ++ai)
#pragma unroll
            for (int m = 0; m < 4; ++m) { bf16* rowp = O + (size_t)(row0 + ai * 128 + m * 16) * ldc + col0;
#pragma unroll
                for (int bj = 0; bj < 2; ++bj) { const f32x4 v0 = acc[ai][bj][m][0], v1 = acc[ai][bj][m][1];
                    u32x4 w; w.x = pk_bf16(v0[0], v0[1]); w.y = pk_bf16(v0[2], v0[3]); w.z = pk_bf16(v1[0], v1[1]); w.w = pk_bf16(v1[2], v1[3]);
                    *(u32x4*)(rowp + bj * 128) = w; } }
    }
};
struct EpiOut {
    static constexpr bool PERM = false;
    const float* X; float* Hh;
    __device__ __forceinline__ void operator()(const f32x4 (&acc)[2][2][4][2], const pg8::Unit& u, int wr, int wc, int fr_, int fq_) const {
        int tz = threadIdx.x; asm volatile("" : "+v"(tz)); const int fr = tz & 15, fq = (tz >> 4) & 3;
        const int row0 = u.row0 + wr * 64 + fr, col0 = u.col0 + wc * 32 + 4 * fq;
#pragma unroll
        for (int ai = 0; ai < 2; ++ai)
#pragma unroll
            for (int m = 0; m < 4; ++m) { const size_t off = (size_t)(row0 + ai * 128 + m * 16) * D + col0;
#pragma unroll
                for (int bj = 0; bj < 2; ++bj)
#pragma unroll
                    for (int n = 0; n < 2; ++n) { const f32x4 xv = *(const f32x4*)(X + off + bj * 128 + n * 16); *(f32x4*)(Hh + off + bj * 128 + n * 16) = xv + acc[ai][bj][m][n]; } }
    }
};
struct EpiGateUp {
    static constexpr bool PERM = true;
    uchar* ACT; const float* bias;
    __device__ __forceinline__ void operator()(const f32x4 (&acc)[2][2][4][2], const pg8::Unit& u, int wr, int wc, int fr_, int fq_) const {
        int tz = threadIdx.x; asm volatile("" : "+v"(tz)); const int fr = tz & 15, fq = (tz >> 4) & 3;
        const int row0 = u.row0 + wr * 64 + fr, col0 = u.col0 + wc * 32 + 8 * fq;
        const float* bp = bias + (size_t)u.aux * (2 * DFF) + col0;
        f32x4 bv[2][2];
#pragma unroll
        for (int bj = 0; bj < 2; ++bj)
#pragma unroll
            for (int n = 0; n < 2; ++n) bv[bj][n] = *(const f32x4*)(bp + bj * 128 + 4 * n);
#pragma unroll
        for (int ai = 0; ai < 2; ++ai)
#pragma unroll
            for (int m = 0; m < 4; ++m) { uchar* rowp = ACT + (size_t)(row0 + ai * 128 + m * 16) * DFF + (col0 >> 1);
#pragma unroll
                for (int bj = 0; bj < 2; ++bj) { const f32x4 v0 = acc[ai][bj][m][0] * W8_INV + bv[bj][0], v1 = acc[ai][bj][m][1] * W8_INV + bv[bj][1];
                    float a[4];
                    { const float g = fminf(v0[0], 7.f), up = fminf(fmaxf(v0[1], -7.f), 7.f); a[0] = (up + 1.f) * g / (1.f + __expf(-1.702f * g)); }
                    { const float g = fminf(v0[2], 7.f), up = fminf(fmaxf(v0[3], -7.f), 7.f); a[1] = (up + 1.f) * g / (1.f + __expf(-1.702f * g)); }
                    { const float g = fminf(v1[0], 7.f), up = fminf(fmaxf(v1[1], -7.f), 7.f); a[2] = (up + 1.f) * g / (1.f + __expf(-1.702f * g)); }
                    { const float g = fminf(v1[2], 7.f), up = fminf(fmaxf(v1[3], -7.f), 7.f); a[3] = (up + 1.f) * g / (1.f + __expf(-1.702f * g)); }
                    *(unsigned*)(rowp + bj * 64) = pk_fp8x4(a[0], a[1], a[2], a[3]); } }
    }
};
struct EpiDown {
    static constexpr bool PERM = true;
    bf16* YR; const float* bias;
    __device__ __forceinline__ void operator()(const f32x4 (&acc)[2][2][4][2], const pg8::Unit& u, int wr, int wc, int fr_, int fq_) const {
        int tz = threadIdx.x; asm volatile("" : "+v"(tz)); const int fr = tz & 15, fq = (tz >> 4) & 3;
        const int row0 = u.row0 + wr * 64 + fr, col0 = u.col0 + wc * 32 + 8 * fq;
        const float* bp = bias + (size_t)u.aux * D + col0;
        f32x4 bv[2][2];
#pragma unroll
        for (int bj = 0; bj < 2; ++bj)
#pragma unroll
            for (int n = 0; n < 2; ++n) bv[bj][n] = *(const f32x4*)(bp + bj * 128 + 4 * n);
#pragma unroll
        for (int ai = 0; ai < 2; ++ai)
#pragma unroll
            for (int m = 0; m < 4; ++m) { bf16* rowp = YR + (size_t)(row0 + ai * 128 + m * 16) * D + col0;
#pragma unroll
                for (int bj = 0; bj < 2; ++bj) { const f32x4 v0 = acc[ai][bj][m][0] * W8_INV + bv[bj][0], v1 = acc[ai][bj][m][1] * W8_INV + bv[bj][1];
                    u32x4 w; w.x = pk_bf16(v0[0], v0[1]); w.y = pk_bf16(v0[2], v0[3]); w.z = pk_bf16(v1[0], v1[1]); w.w = pk_bf16(v1[2], v1[3]);
                    *(u32x4*)(rowp + bj * 128) = w; }
                asm volatile("" ::: "memory"); }
    }
};

#define XB_TMO      128
#define XB_XCNT(j)  (256  + 64 * (j))
#define XB_XSUB(j)  (1280 + 64 * (j))
#define XB_XGEN(j)  (2304 + 64 * (j))
#define XB_TOP      3328
#define XB_TOPGEN   3392
#define XCD_BAR_WORDS 3456
#define XB_SPIN_CAP (1u << 18)
__device__ __forceinline__ unsigned xb_ld(unsigned* p)              { return __hip_atomic_load(p, __ATOMIC_RELAXED, __HIP_MEMORY_SCOPE_AGENT); }
__device__ __forceinline__ unsigned xb_add(unsigned* p, unsigned v) { return __hip_atomic_fetch_add(p, v, __ATOMIC_RELAXED, __HIP_MEMORY_SCOPE_AGENT); }
__device__ __forceinline__ unsigned xb_xcc_id() { return (unsigned)__builtin_amdgcn_s_getreg((3 << 11) | 20) & 0xFu; }
#define XB_SPIN(cond, bar) do { unsigned _sp = 0; while (cond) { __builtin_amdgcn_s_sleep(1); \
    if ((++_sp & 255u) == 0u) { if (xb_ld(&(bar)[XB_TMO])) break; if (_sp > XB_SPIN_CAP) { atomicAdd(&(bar)[XB_TMO], 1u); break; } } } } while (0)
struct XcdBarrier { unsigned* bar; unsigned x; volatile LAS unsigned* st; };
__device__ __forceinline__ XcdBarrier xcd_barrier_post(unsigned* bar, volatile LAS unsigned* st) {
    XcdBarrier b; b.bar = bar; b.x = xb_xcc_id(); b.st = st;
    if (threadIdx.x == 0) (void)xb_add(&bar[XB_XCNT(b.x)], 1u);
    return b;
}
__device__ __forceinline__ void xcd_barrier_complete(unsigned* bar, unsigned x, unsigned& nloc, unsigned& nx) {
    const unsigned G = gridDim.x * gridDim.y * gridDim.z;
    unsigned sum, cnt, mine, sp = 0u;
    for (;;) {
        sum = 0u; cnt = 0u; mine = 0u;
#pragma unroll
        for (unsigned j = 0; j < 16; ++j) { const unsigned c = xb_ld(&bar[XB_XCNT(j)]); sum += c; cnt += (c > 0u) ? 1u : 0u; mine = (j == x) ? c : mine; }
        if (sum == G) break;
        __builtin_amdgcn_s_sleep(1);
        if ((++sp & 255u) == 0u) { if (xb_ld(&bar[XB_TMO])) break; if (sp > XB_SPIN_CAP) { atomicAdd(&bar[XB_TMO], 1u); break; } }
    }
    nloc = mine > 0u ? mine : 1u; nx = cnt > 0u ? cnt : 1u;
}
__device__ __forceinline__ void xcd_barrier(const XcdBarrier& b) {
    asm volatile("s_waitcnt vmcnt(0)" ::: "memory");
    __syncthreads();
    if (threadIdx.x == 0) {
        unsigned* bar = b.bar;
        __builtin_amdgcn_s_waitcnt(0);
        unsigned nloc = b.st[0], nx = b.st[1];
        if (nloc == 0u) { xcd_barrier_complete(bar, b.x, nloc, nx); b.st[0] = nloc; b.st[1] = nx; }
        const unsigned old = xb_add(&bar[XB_XSUB(b.x)], 1u);
        const unsigned gen = old / nloc;
        if (old + 1u == (gen + 1u) * nloc) {
            __builtin_amdgcn_fence(__ATOMIC_RELEASE, "agent");
            asm volatile("s_waitcnt vmcnt(0)" ::: "memory");
            const unsigned og = xb_add(&bar[XB_TOP], 1u);
            const unsigned tg = og / nx;
            if (og + 1u == (tg + 1u) * nx) xb_add(&bar[XB_TOPGEN], 1u);
            else XB_SPIN(xb_ld(&bar[XB_TOPGEN]) == tg, bar);
            __builtin_amdgcn_fence(__ATOMIC_ACQUIRE, "agent");
            xb_add(&bar[XB_XGEN(b.x)], 1u);
            asm volatile("s_waitcnt vmcnt(0)" ::: "memory");
        } else {
            XB_SPIN(xb_ld(&bar[XB_XGEN(b.x)]) == gen, bar);
            __builtin_amdgcn_fence(__ATOMIC_ACQUIRE, "agent");
            asm volatile("s_waitcnt vmcnt(0)" ::: "memory");
        }
    }
    __syncthreads();
}

struct Ctx { LAS uchar* lds; int tid, lane, wave, G, bid; uchar* ws; const void* const* in; float* out; };
#define XP_x(X) ((const float*)(X).in[0])
#define XP_pos(X) ((const int*)(X).in[1])
#define XP_ln_mix_w(X) ((const float*)(X).in[2])
#define XP_w_in(X) ((const float*)(X).in[3])
#define XP_conv_w(X) ((const float*)(X).in[4])
#define XP_conv_b(X) ((const float*)(X).in[5])
#define XP_dt_bias(X) ((const float*)(X).in[6])
#define XP_a_log(X) ((const float*)(X).in[7])
#define XP_d_skip(X) ((const float*)(X).in[8])
#define XP_ssm_norm_w(X) ((const float*)(X).in[9])
#define XP_w_out(X) ((const float*)(X).in[10])
#define XP_ln_ffn_w(X) ((const float*)(X).in[11])
#define XP_w_router(X) ((const float*)(X).in[12])
#define XP_b_router(X) ((const float*)(X).in[13])
#define XP_w_gu(X) ((const float*)(X).in[14])
#define XP_b_gu(X) ((const float*)(X).in[15])
#define XP_w_d(X) ((const float*)(X).in[16])
#define XP_b_d(X) ((const float*)(X).in[17])
#define XP_ln_final_w(X) ((const float*)(X).in[18])
#define XP_WinT(X) ((bf16*)((X).ws + WS_WINT))
#define XP_WoutT(X) ((bf16*)((X).ws + WS_WOUTT))
#define XP_WguT(X) ((uchar*)((X).ws + WS_WGUT))
#define XP_WdT(X) ((uchar*)((X).ws + WS_WDT))
#define XP_U(X) ((bf16*)((X).ws + WS_U))
#define XP_U2(X) ((uchar*)((X).ws + WS_U2))
#define XP_MIX(X) ((bf16*)((X).ws + WS_MIX))
#define XP_XBC(X) ((bf16*)((X).ws + WS_XBC))
#define XP_KV(X) ((bf16*)((X).ws + WS_KV))
#define XP_SST(X) ((bf16*)((X).ws + WS_SST))
#define XP_PROJ(X) ((bf16*)((X).ws + WS_PROJ))
#define XP_ACT(X) ((uchar*)((X).ws + WS_ACT))
#define XP_YR(X) ((bf16*)((X).ws + WS_YR))
#define XP_COS(X) ((float*)((X).ws + WS_COS))
#define XP_SIN(X) ((float*)((X).ws + WS_SIN))
#define XP_Hh(X) ((float*)((X).ws + WS_H))
#define XP_ADEC(X) ((float*)((X).ws + WS_ADEC))
#define XP_TOPW(X) ((float*)((X).ws + WS_TOPW))
#define XP_TOPI(X) ((int*)((X).ws + WS_TOPI))
#define XP_TOPR(X) ((int*)((X).ws + WS_TOPR))
#define XP_LIST(X) ((int*)((X).ws + WS_LIST))
#define XP_ctl(X) ((unsigned*)((X).ws + WS_CTL))


__device__ __forceinline__ bf16x8 tr_frag(LAS uchar* p, int rstep) {
    const s16x4 a = __builtin_amdgcn_ds_read_tr16_b64_v4i16((LAS s16x4*)p);
    const s16x4 b = __builtin_amdgcn_ds_read_tr16_b64_v4i16((LAS s16x4*)(p + rstep));
    return (bf16x8){a[0], a[1], a[2], a[3], b[0], b[1], b[2], b[3]};
}
__device__ __forceinline__ f32x4 mma16(bf16x8 xrow, bf16x8 ycol, f32x4 c) { return __builtin_amdgcn_mfma_f32_16x16x32_bf16(xrow, ycol, c, 0, 0, 0); }
__device__ __forceinline__ float wave_incl_scan(float v, int lane) {
#pragma unroll
    for (int o = 1; o < 64; o <<= 1) { const float t = __shfl_up(v, o); if (lane >= o) v += t; }
    return v;
}
__device__ __forceinline__ void rope8(const u32x4 k1, const u32x4 k2, const f32x4 c0, const f32x4 c1, const f32x4 s0, const f32x4 s1, const float sc, u32x4& o1, u32x4& o2) {
    float r1[8], r2[8];
#pragma unroll
    for (int m = 0; m < 4; ++m) {
        const float a0 = bf_lo(k1[m]), a1 = bf_hi(k1[m]), b0 = bf_lo(k2[m]), b1 = bf_hi(k2[m]);
        const float cs0 = (m < 2) ? c0[2 * m] : c1[2 * m - 4], cs1 = (m < 2) ? c0[2 * m + 1] : c1[2 * m - 3];
        const float sn0 = (m < 2) ? s0[2 * m] : s1[2 * m - 4], sn1 = (m < 2) ? s0[2 * m + 1] : s1[2 * m - 3];
        r1[2 * m] = (a0 * cs0 - b0 * sn0) * sc; r1[2 * m + 1] = (a1 * cs1 - b1 * sn1) * sc;
        r2[2 * m] = (b0 * cs0 + a0 * sn0) * sc; r2[2 * m + 1] = (b1 * cs1 + a1 * sn1) * sc;
    }
    o1.x = pk_bf16(r1[0], r1[1]); o1.y = pk_bf16(r1[2], r1[3]); o1.z = pk_bf16(r1[4], r1[5]); o1.w = pk_bf16(r1[6], r1[7]);
    o2.x = pk_bf16(r2[0], r2[1]); o2.y = pk_bf16(r2[2], r2[3]); o2.z = pk_bf16(r2[4], r2[5]); o2.w = pk_bf16(r2[6], r2[7]);
}

__device__ __forceinline__ void tr_decode(const Ctx& X, int r, const float*& W, bf16*& WT, int& N, int& kb, int& nb) {
    constexpr int I_IN = 32 * 209;
    if (r < I_IN) { W = XP_w_in(X); WT = XP_WinT(X); N = NPROJ; }
    else { r -= I_IN; W = XP_w_out(X); WT = XP_WoutT(X); N = D; }
    const int nbn = (N + 31) >> 5; kb = r / nbn; nb = r - kb * nbn;
}
__device__ __forceinline__ void tr8_item(const float* W, int N, uchar* WT, int kb, int nb, int lane) {
    const int k0 = kb * 128 + 16 * (lane & 7), n0 = nb * 32 + 4 * (lane >> 3);
    f32x4 v[16];
#pragma unroll
    for (int i = 0; i < 16; ++i) v[i] = *(const f32x4*)(W + (size_t)(k0 + i) * N + n0);
#pragma unroll
    for (int j = 0; j < 4; ++j) { u32x4 o;
        o.x = pk_fp8x4(v[0][j] * W8_SCALE, v[1][j] * W8_SCALE, v[2][j] * W8_SCALE, v[3][j] * W8_SCALE); o.y = pk_fp8x4(v[4][j] * W8_SCALE, v[5][j] * W8_SCALE, v[6][j] * W8_SCALE, v[7][j] * W8_SCALE);
        o.z = pk_fp8x4(v[8][j] * W8_SCALE, v[9][j] * W8_SCALE, v[10][j] * W8_SCALE, v[11][j] * W8_SCALE); o.w = pk_fp8x4(v[12][j] * W8_SCALE, v[13][j] * W8_SCALE, v[14][j] * W8_SCALE, v[15][j] * W8_SCALE);
        *(u32x4*)(WT + (size_t)(n0 + j) * 2048 + k0) = o; }
}
__device__ __forceinline__ void tr_load(const float* W, int N, int kb, int nb, int lane, f32x4 (&v)[8]) {
    const int k0 = kb * 64 + 8 * (lane & 7), n0 = nb * 32 + 4 * (lane >> 3);
    if (n0 < N) {
#pragma unroll
        for (int i = 0; i < 8; ++i) v[i] = *(const f32x4*)(W + (size_t)(k0 + i) * N + n0);
    }
}
__device__ __forceinline__ void tr_store(bf16* WT, int N, int kb, int nb, int lane, const f32x4 (&v)[8]) {
    const int k0 = kb * 64 + 8 * (lane & 7), n0 = nb * 32 + 4 * (lane >> 3);
    if (n0 < N) {
#pragma unroll
        for (int j = 0; j < 4; ++j) { u32x4 o; o.x = pk_bf16(v[0][j], v[1][j]); o.y = pk_bf16(v[2][j], v[3][j]); o.z = pk_bf16(v[4][j], v[5][j]); o.w = pk_bf16(v[6][j], v[7][j]);
            *(u32x4*)(WT + (size_t)(n0 + j) * 2048 + k0) = o; }
    }
}
__device__ __forceinline__ void p0_prologue(Ctx& X) {
    const int gw = X.bid * NWAVES + X.wave, NGW = X.G * NWAVES, lane = X.lane;
    const int gt = X.bid * NTHR + X.tid, NGT = X.G * NTHR;
    for (int m = gw; m < T; m += NGW) {
        const f32x4* xr = (const f32x4*)(XP_x(X) + (size_t)m * D) + lane; const f32x4* wr_ = (const f32x4*)XP_ln_mix_w(X) + lane;
        f32x4 v[8]; float s = 0.f;
#pragma unroll
        for (int j = 0; j < 8; ++j) { v[j] = xr[64 * j]; s += (v[j].x * v[j].x + v[j].y * v[j].y) + (v[j].z * v[j].z + v[j].w * v[j].w); }
        const float rstd = rsqrtf(wave_sum(s) * (1.f / D) + EPS);
        u32x2* o8 = (u32x2*)(XP_U(X) + (size_t)m * D) + lane;
#pragma unroll
        for (int j = 0; j < 8; ++j) { const f32x4 w = wr_[64 * j]; u32x2 o; o.x = pk_bf16(v[j].x * rstd * w.x, v[j].y * rstd * w.y); o.y = pk_bf16(v[j].z * rstd * w.z, v[j].w * rstd * w.w); o8[64 * j] = o; }
    }
    for (int idx = gt; idx < T * 128; idx += NGT) {
        const int t = idx >> 7, i = idx & 127;
        const double ang = (double)XP_pos(X)[t] * INV_FREQ[i];
        double rev = ang * 0.15915494309189533577; rev -= floor(rev);
        const float f = (float)rev;
        XP_COS(X)[idx] = __builtin_amdgcn_cosf(f); XP_SIN(X)[idx] = __builtin_amdgcn_sinf(f);
    }
    { u32x4* p = (u32x4*)(XP_WinT(X) + (size_t)NPROJ * D); const int n16 = (LDP - NPROJ) * D * 2 / 16; const u32x4 z = {0u, 0u, 0u, 0u};
      for (int i = gt; i < n16; i += NGT) p[i] = z; }
    constexpr int NIT = 32 * 209 + 32 * 64;
    for (int it = gw; it < NIT; it += 2 * NGW) {
        const float *W0, *W1 = nullptr; bf16 *T0, *T1 = nullptr; int N0, N1 = 0, kb0, kb1 = 0, nb0, nb1 = 0;
        f32x4 v0[8], v1[8];
        tr_decode(X, it, W0, T0, N0, kb0, nb0);
        const bool two = (it + NGW) < NIT;
        if (two) tr_decode(X, it + NGW, W1, T1, N1, kb1, nb1);
        tr_load(W0, N0, kb0, nb0, lane, v0);
        if (two) tr_load(W1, N1, kb1, nb1, lane, v1);
        tr_store(T0, N0, kb0, nb0, lane, v0);
        if (two) tr_store(T1, N1, kb1, nb1, lane, v1);
    }
    constexpr int I_GU8 = 32 * 16 * 128, I_D8 = 32 * 16 * 64;
    for (int it = gw; it < I_GU8 + I_D8; it += NGW) {
        if (it < I_GU8) { const int e = it >> 11, r = it & 2047; tr8_item(XP_w_gu(X) + (size_t)e * D * (2 * DFF), 2 * DFF, XP_WguT(X) + (size_t)e * (2 * DFF) * D, r >> 7, r & 127, lane); }
        else { const int i2 = it - I_GU8, e = i2 >> 10, r = i2 & 1023; tr8_item(XP_w_d(X) + (size_t)e * DFF * D, D, XP_WdT(X) + (size_t)e * D * DFF, r >> 6, r & 63, lane); }
    }
}

__device__ __forceinline__ void p2_ret(Ctx& X, int unit) {
    const int c = unit >> 2, h = unit & 3, t0 = c * CH, tid = X.tid, lane = X.lane, w = X.wave;
    LAS uchar* Vt = X.lds; LAS uchar* Kt = X.lds + 69632;
#pragma unroll 4
    for (int i = 0; i < 8; ++i) { const int q = tid + 512 * i, l = q >> 5, vc = q & 31;
        const u32x4 v = *(const u32x4*)(XP_PROJ(X) + (size_t)(t0 + l) * LDP + C_V + h * 256 + vc * 8);
        *(LAS u32x4*)(Vt + l * 544 + vc * 16) = v; }
    const float lg = LG2_GAMMA[h];
#pragma unroll 2
    for (int i = 0; i < 4; ++i) { const int q = tid + 512 * i, l = q >> 4, ic = q & 15;
        const bf16* kp = XP_PROJ(X) + (size_t)(t0 + l) * LDP + C_K + h * 256 + ic * 8;
        const u32x4 k1 = *(const u32x4*)kp, k2 = *(const u32x4*)(kp + 128);
        const float* cp = XP_COS(X) + (size_t)(t0 + l) * 128 + ic * 8; const float* sp = XP_SIN(X) + (size_t)(t0 + l) * 128 + ic * 8;
        const f32x4 c0 = *(const f32x4*)cp, c1 = *(const f32x4*)(cp + 4), s0 = *(const f32x4*)sp, s1 = *(const f32x4*)(sp + 4);
        u32x4 o1, o2; rope8(k1, k2, c0, c1, s0, s1, 0.0625f * exp2f(lg * (float)(127 - l)), o1, o2);
        *(LAS u32x4*)(Kt + l * 544 + ic * 16) = o1; *(LAS u32x4*)(Kt + l * 544 + 256 + ic * 16) = o2; }
    __syncthreads();
    const int fr = lane & 15, fq = lane >> 4, trs = (8 * fq + ((lane & 15) >> 2)) * 544 + 8 * (lane & 3);
    f32x4 acc[2][16];
#pragma unroll
    for (int a = 0; a < 2; ++a)
#pragma unroll
        for (int n = 0; n < 16; ++n) acc[a][n] = (f32x4){0.f, 0.f, 0.f, 0.f};
#pragma unroll 1
    for (int ks = 0; ks < 4; ++ks) {
        const bf16x8 af0 = tr_frag(Vt + (32 * ks) * 544 + (16 * w) * 2 + trs, 4 * 544);
        const bf16x8 af1 = tr_frag(Vt + (32 * ks) * 544 + (128 + 16 * w) * 2 + trs, 4 * 544);
#pragma unroll
        for (int n = 0; n < 16; ++n) { const bf16x8 bf = tr_frag(Kt + (32 * ks) * 544 + (16 * n) * 2 + trs, 4 * 544);
            acc[0][n] = mma16(bf, af0, acc[0][n]); acc[1][n] = mma16(bf, af1, acc[1][n]); }
    }
    bf16* outp = XP_KV(X) + (size_t)(c * 4 + h) * 65536;
#pragma unroll
    for (int a = 0; a < 2; ++a)
#pragma unroll
        for (int n = 0; n < 16; ++n) { u32x2 o; o.x = pk_bf16(acc[a][n][0], acc[a][n][1]); o.y = pk_bf16(acc[a][n][2], acc[a][n][3]);
            *(u32x2*)(outp + (size_t)(128 * a + 16 * w + fr) * 256 + 16 * n + 4 * fq) = o; }
    __syncthreads();
}
__device__ __forceinline__ void conv8(const Ctx& X, int t, int cx, float (&o)[8]) {
    const f32x4 b0 = *(const f32x4*)(XP_conv_b(X) + cx), b1 = *(const f32x4*)(XP_conv_b(X) + cx + 4);
    o[0] = b0.x; o[1] = b0.y; o[2] = b0.z; o[3] = b0.w; o[4] = b1.x; o[5] = b1.y; o[6] = b1.z; o[7] = b1.w;
#pragma unroll
    for (int j = 0; j < 4; ++j) { const int tt = t - 3 + j;
        if (tt >= 0) { const u32x4 v = *(const u32x4*)(XP_PROJ(X) + (size_t)tt * LDP + C_X + cx);
            const f32x4 w0 = *(const f32x4*)(XP_conv_w(X) + j * XBCW + cx), w1 = *(const f32x4*)(XP_conv_w(X) + j * XBCW + cx + 4);
            o[0] += w0.x * bf_lo(v.x); o[1] += w0.y * bf_hi(v.x); o[2] += w0.z * bf_lo(v.y); o[3] += w0.w * bf_hi(v.y);
            o[4] += w1.x * bf_lo(v.z); o[5] += w1.y * bf_hi(v.z); o[6] += w1.z * bf_lo(v.w); o[7] += w1.w * bf_hi(v.w); } }
#pragma unroll
    for (int i = 0; i < 8; ++i) o[i] = silu_f(o[i]);
}
__device__ __forceinline__ void p2_ssd(Ctx& X, int unit) {
    const int c = unit >> 2, g = (unit >> 1) & 1, hh = unit & 1, t0 = c * CH, tid = X.tid, lane = X.lane, w = X.wave;
    LAS uchar* Xd = X.lds; LAS uchar* Bc = X.lds + 69632;
    LAS float* dtS = (LAS float*)(X.lds + 106496); LAS float* acS = (LAS float*)(X.lds + 108544);
    if (w < 4) { const int h = 8 * g + 4 * hh + w, l0 = 2 * lane;
        const float dtb = XP_dt_bias(X)[h], A = -expf(XP_a_log(X)[h]);
        const float d0 = softplus_f(bf2f(XP_PROJ(X)[(size_t)(t0 + l0) * LDP + C_DT + h]) + dtb), d1 = softplus_f(bf2f(XP_PROJ(X)[(size_t)(t0 + l0 + 1) * LDP + C_DT + h]) + dtb);
        const float a0 = d0 * A, a1 = d1 * A, s = a0 + a1, incl = wave_incl_scan(s, lane);
        dtS[w * 128 + l0] = d0; dtS[w * 128 + l0 + 1] = d1; acS[w * 128 + l0] = incl - a1; acS[w * 128 + l0 + 1] = incl;
        if (lane == 63) XP_ADEC(X)[c * 16 + h] = expf(incl); }
    __syncthreads();
    for (int it = tid; it < 128 * 56; it += NTHR) { const int l = it / 56, j = it - l * 56;
        int cx; if (j < 32) cx = 512 * g + 256 * hh + 8 * j; else if (j < 48) cx = 1024 + 128 * g + 8 * (j - 32); else cx = 1280 + 128 * g + 64 * hh + 8 * (j - 48);
        float o[8]; conv8(X, t0 + l, cx, o);
        u32x4 ov; ov.x = pk_bf16(o[0], o[1]); ov.y = pk_bf16(o[2], o[3]); ov.z = pk_bf16(o[4], o[5]); ov.w = pk_bf16(o[6], o[7]);
        if (j < 32) { const int e = j >> 3; const float sc = dtS[e * 128 + l] * __expf(acS[e * 128 + 127] - acS[e * 128 + l]);
            u32x4 os; os.x = pk_bf16(o[0] * sc, o[1] * sc); os.y = pk_bf16(o[2] * sc, o[3] * sc); os.z = pk_bf16(o[4] * sc, o[5] * sc); os.w = pk_bf16(o[6] * sc, o[7] * sc);
            *(LAS u32x4*)(Xd + l * 544 + j * 16) = os; *(u32x4*)(XP_XBC(X) + (size_t)(t0 + l) * XBCW + cx) = ov; }
        else if (j < 48) { *(LAS u32x4*)(Bc + l * 288 + (j - 32) * 16) = ov; if (hh == 0) *(u32x4*)(XP_XBC(X) + (size_t)(t0 + l) * XBCW + cx) = ov; }
        else *(u32x4*)(XP_XBC(X) + (size_t)(t0 + l) * XBCW + cx) = ov; }
    __syncthreads();
    const int fr = lane & 15, fq = lane >> 4, q4 = (lane & 15) >> 2, p4 = lane & 3;
    const int trx = (8 * fq + q4) * 544 + 8 * p4, trb = (8 * fq + q4) * 288 + 8 * p4;
    f32x4 acc[2][8];
#pragma unroll
    for (int a = 0; a < 2; ++a)
#pragma unroll
        for (int n = 0; n < 8; ++n) acc[a][n] = (f32x4){0.f, 0.f, 0.f, 0.f};
#pragma unroll 1
    for (int ks = 0; ks < 4; ++ks) {
        const bf16x8 af0 = tr_frag(Xd + (32 * ks) * 544 + (16 * w) * 2 + trx, 4 * 544);
        const bf16x8 af1 = tr_frag(Xd + (32 * ks) * 544 + (128 + 16 * w) * 2 + trx, 4 * 544);
#pragma unroll
        for (int n = 0; n < 8; ++n) { const bf16x8 bf = tr_frag(Bc + (32 * ks) * 288 + (16 * n) * 2 + trb, 4 * 288);
            acc[0][n] = mma16(bf, af0, acc[0][n]); acc[1][n] = mma16(bf, af1, acc[1][n]); }
    }
#pragma unroll
    for (int a = 0; a < 2; ++a) { const int m = 128 * a + 16 * w + fr, h = 8 * g + 4 * hh + (m >> 6), p = m & 63;
        bf16* outp = XP_SST(X) + ((size_t)(c * 16 + h) * 64 + p) * 128;
#pragma unroll
        for (int n = 0; n < 8; ++n) { u32x2 o; o.x = pk_bf16(acc[a][n][0], acc[a][n][1]); o.y = pk_bf16(acc[a][n][2], acc[a][n][3]); *(u32x2*)(outp + 16 * n + 4 * fq) = o; } }
    __syncthreads();
}

__device__ __forceinline__ void p3_scan(Ctx& X) {
    const int gt = X.bid * NTHR + X.tid, NGT = X.G * NTHR;
    for (int item = gt; item < 65536 + 32768; item += NGT) {
        const bool ret = item < 65536; const int it2 = ret ? item : item - 65536;
        bf16* p = ret ? (XP_KV(X) + (size_t)it2 * 4) : (XP_SST(X) + (size_t)it2 * 4);
        const size_t stride = ret ? 262144 : 131072;
        const int head = ret ? (it2 >> 14) : (it2 >> 11);
        const float gdec = ret ? GAMMA_CHUNK[head & 3] : 0.f;
        float s0 = 0.f, s1 = 0.f, s2 = 0.f, s3 = 0.f;
        for (int c0 = 0; c0 < NCHUNK; c0 += 8) {
            u32x2 v[8]; float dec[8];
#pragma unroll
            for (int j = 0; j < 8; ++j) { v[j] = *(const u32x2*)(p + (size_t)(c0 + j) * stride); dec[j] = ret ? gdec : XP_ADEC(X)[(c0 + j) * 16 + head]; }
#pragma unroll
            for (int j = 0; j < 8; ++j) { u32x2 o; o.x = pk_bf16(s0, s1); o.y = pk_bf16(s2, s3); *(u32x2*)(p + (size_t)(c0 + j) * stride) = o;
                s0 = dec[j] * s0 + bf_lo(v[j].x); s1 = dec[j] * s1 + bf_hi(v[j].x); s2 = dec[j] * s2 + bf_lo(v[j].y); s3 = dec[j] * s3 + bf_hi(v[j].y); }
        }
    }
}

__device__ __forceinline__ void p4_ret(Ctx& X, int unit) {
    const int c = unit >> 2, h = unit & 3, t0 = c * CH, tid = X.tid, lane = X.lane, w = X.wave;
    LAS uchar* R1 = X.lds; LAS uchar* R2 = X.lds + 69632;
    const float lg = LG2_GAMMA[h];
#pragma unroll 1
    for (int i = 0; i < 4; ++i) { const int q = tid + 512 * i, l = q >> 4, ic = q & 15;
        const float* cp = XP_COS(X) + (size_t)(t0 + l) * 128 + ic * 8; const float* sp = XP_SIN(X) + (size_t)(t0 + l) * 128 + ic * 8;
        const f32x4 c0 = *(const f32x4*)cp, c1 = *(const f32x4*)(cp + 4), s0 = *(const f32x4*)sp, s1 = *(const f32x4*)(sp + 4);
        const bf16* qp = XP_PROJ(X) + (size_t)(t0 + l) * LDP + C_Q + h * 256 + ic * 8; const bf16* kp = XP_PROJ(X) + (size_t)(t0 + l) * LDP + C_K + h * 256 + ic * 8;
        u32x4 o1, o2;
        rope8(*(const u32x4*)qp, *(const u32x4*)(qp + 128), c0, c1, s0, s1, 1.0f, o1, o2);
        *(LAS u32x4*)(R1 + l * 544 + ic * 16) = o1; *(LAS u32x4*)(R1 + l * 544 + 256 + ic * 16) = o2;
        rope8(*(const u32x4*)kp, *(const u32x4*)(kp + 128), c0, c1, s0, s1, 0.0625f, o1, o2);
        *(LAS u32x4*)(R2 + l * 544 + ic * 16) = o1; *(LAS u32x4*)(R2 + l * 544 + 256 + ic * 16) = o2; }
    __syncthreads();
    const int fr = lane & 15, fq = lane >> 4, q4 = (lane & 15) >> 2, p4 = lane & 3, l = 16 * w + fr;
    f32x4 sc[8];
#pragma unroll
    for (int n = 0; n < 8; ++n) sc[n] = (f32x4){0.f, 0.f, 0.f, 0.f};
#pragma unroll 2
    for (int ks = 0; ks < 8; ++ks) {
        const bf16x8 af = *(const LAS bf16x8*)(R1 + l * 544 + (32 * ks + 8 * fq) * 2);
#pragma unroll
        for (int n = 0; n < 8; ++n) if (n <= w) { const bf16x8 bf = *(const LAS bf16x8*)(R2 + (16 * n + fr) * 544 + (32 * ks + 8 * fq) * 2); sc[n] = mma16(bf, af, sc[n]); }
    }
    bf16x8 scf[4];
#pragma unroll
    for (int k2 = 0; k2 < 4; ++k2) { float v[8];
#pragma unroll
        for (int tq = 0; tq < 2; ++tq)
#pragma unroll
            for (int j = 0; j < 4; ++j) { const int s = 16 * (2 * k2 + tq) + 4 * fq + j; v[4 * tq + j] = (s <= l) ? sc[2 * k2 + tq][j] * exp2f(lg * (float)(l - s)) : 0.f; }
        u32x4 pk; pk.x = pk_bf16(v[0], v[1]); pk.y = pk_bf16(v[2], v[3]); pk.z = pk_bf16(v[4], v[5]); pk.w = pk_bf16(v[6], v[7]);
        scf[k2] = __builtin_bit_cast(bf16x8, pk); }
    __syncthreads();
    f32x4 acc[16];
#pragma unroll
    for (int n = 0; n < 16; ++n) acc[n] = (f32x4){0.f, 0.f, 0.f, 0.f};
    const bf16* prev = XP_KV(X) + (size_t)(c * 4 + h) * 65536;
#pragma unroll 1
    for (int dh = 0; dh < 2; ++dh) {
#pragma unroll 4
        for (int i = 0; i < 8; ++i) { const int q = tid + 512 * i, v = q >> 4, dc = q & 15;
            *(LAS u32x4*)(R2 + v * 272 + dc * 16) = *(const u32x4*)(prev + (size_t)v * 256 + dh * 128 + dc * 8); }
        __syncthreads();
#pragma unroll 2
        for (int ks = 0; ks < 4; ++ks) {
            const bf16x8 af = *(const LAS bf16x8*)(R1 + l * 544 + (128 * dh + 32 * ks + 8 * fq) * 2);
#pragma unroll
            for (int n = 0; n < 16; ++n) { const bf16x8 bf = *(const LAS bf16x8*)(R2 + (16 * n + fr) * 272 + (32 * ks + 8 * fq) * 2); acc[n] = mma16(bf, af, acc[n]); }
        }
        __syncthreads();
    }
    { const float qd = exp2f(lg * (float)(l + 1));
#pragma unroll
      for (int n = 0; n < 16; ++n) acc[n] = acc[n] * qd; }
#pragma unroll 4
    for (int i = 0; i < 8; ++i) { const int q = tid + 512 * i, s = q >> 5, vc = q & 31;
        *(LAS u32x4*)(R2 + s * 544 + vc * 16) = *(const u32x4*)(XP_PROJ(X) + (size_t)(t0 + s) * LDP + C_V + h * 256 + vc * 8); }
    __syncthreads();
    const int trp = (4 * fq + q4) * 544 + 8 * p4;
#pragma unroll
    for (int k2 = 0; k2 < 4; ++k2) if (2 * k2 <= w) {
#pragma unroll
        for (int n = 0; n < 16; ++n) { const bf16x8 bf = tr_frag(R2 + (32 * k2) * 544 + (16 * n) * 2 + trp, 16 * 544); acc[n] = mma16(bf, scf[k2], acc[n]); }
    }
    float ss = 0.f;
#pragma unroll
    for (int n = 0; n < 16; ++n) ss += (acc[n][0] * acc[n][0] + acc[n][1] * acc[n][1]) + (acc[n][2] * acc[n][2] + acc[n][3] * acc[n][3]);
    ss += __shfl_xor(ss, 16); ss += __shfl_xor(ss, 32);
    const float rstd = rsqrtf(ss * (1.f / 256.f) + EPS);
    const bf16* gp = XP_PROJ(X) + (size_t)(t0 + l) * LDP + C_G + h * 256 + 4 * fq; bf16* op = XP_MIX(X) + (size_t)(t0 + l) * D + h * 256 + 4 * fq;
#pragma unroll
    for (int n = 0; n < 16; ++n) { const u32x2 gv = *(const u32x2*)(gp + 16 * n);
        u32x2 o; o.x = pk_bf16(acc[n][0] * rstd * silu_f(bf_lo(gv.x)), acc[n][1] * rstd * silu_f(bf_hi(gv.x))); o.y = pk_bf16(acc[n][2] * rstd * silu_f(bf_lo(gv.y)), acc[n][3] * rstd * silu_f(bf_hi(gv.y)));
        *(u32x2*)(op + 16 * n) = o; }
    __syncthreads();
}

__device__ __forceinline__ void p4_ssd(Ctx& X, int unit) {
    const int c = unit >> 1, g = unit & 1, t0 = c * CH, tid = X.tid, lane = X.lane, w = X.wave;
    LAS uchar* Cc = X.lds; LAS uchar* Bc = X.lds + 34816;
    LAS uchar* HP = X.lds + 34816;
    LAS float* dtS = (LAS float*)(X.lds + 110592); LAS float* acS = (LAS float*)(X.lds + 114688);
    { const int h = 8 * g + w, l0 = 2 * lane;
      const float dtb = XP_dt_bias(X)[h], A = -expf(XP_a_log(X)[h]);
      const float d0 = softplus_f(bf2f(XP_PROJ(X)[(size_t)(t0 + l0) * LDP + C_DT + h]) + dtb), d1 = softplus_f(bf2f(XP_PROJ(X)[(size_t)(t0 + l0 + 1) * LDP + C_DT + h]) + dtb);
      const float a0 = d0 * A, a1 = d1 * A, incl = wave_incl_scan(a0 + a1, lane);
      dtS[w * 128 + l0] = d0; dtS[w * 128 + l0 + 1] = d1; acS[w * 128 + l0] = incl - a1; acS[w * 128 + l0 + 1] = incl; }
#pragma unroll
    for (int i = 0; i < 4; ++i) { const int q = tid + 512 * i, l = q >> 4, nc = q & 15;
        *(LAS u32x4*)(Bc + l * 272 + nc * 16) = *(const u32x4*)(XP_XBC(X) + (size_t)(t0 + l) * XBCW + 1024 + 128 * g + nc * 8);
        *(LAS u32x4*)(Cc + l * 272 + nc * 16) = *(const u32x4*)(XP_XBC(X) + (size_t)(t0 + l) * XBCW + 1280 + 128 * g + nc * 8); }
    __syncthreads();
    const int fr = lane & 15, fq = lane >> 4, q4 = (lane & 15) >> 2, p4 = lane & 3, l = 16 * w + fr;
    f32x4 cb[8]; bf16x8 cfr[4];
#pragma unroll
    for (int n = 0; n < 8; ++n) cb[n] = (f32x4){0.f, 0.f, 0.f, 0.f};
#pragma unroll
    for (int ks = 0; ks < 4; ++ks) {
        cfr[ks] = *(const LAS bf16x8*)(Cc + l * 272 + (32 * ks + 8 * fq) * 2);
#pragma unroll
        for (int n = 0; n < 8; ++n) if (n <= w) { const bf16x8 bf = *(const LAS bf16x8*)(Bc + (16 * n + fr) * 272 + (32 * ks + 8 * fq) * 2); cb[n] = mma16(bf, cfr[ks], cb[n]); }
    }
    __syncthreads();
    float ss = 0.f;
    const int trp = (4 * fq + q4) * 144 + 8 * p4;
    const bf16* xp = XP_XBC(X) + (size_t)(t0 + l) * XBCW + 512 * g + 4 * fq; const bf16* zp = XP_PROJ(X) + (size_t)(t0 + l) * LDP + C_Z + 512 * g + 4 * fq;
    bf16* op = XP_MIX(X) + (size_t)(t0 + l) * D + 1024 + 512 * g + 4 * fq;
#pragma unroll 1
    for (int hp = 0; hp < 4; ++hp) {
#pragma unroll
        for (int i = 0; i < 4; ++i) { const int q = tid + 512 * i, e2 = q >> 10, s = (q >> 3) & 127, pc = q & 7, e = 2 * hp + e2;
            const u32x4 v = *(const u32x4*)(XP_XBC(X) + (size_t)(t0 + s) * XBCW + 512 * g + 64 * e + pc * 8); const float d = dtS[e * 128 + s];
            u32x4 o; o.x = pk_bf16(bf_lo(v.x) * d, bf_hi(v.x) * d); o.y = pk_bf16(bf_lo(v.y) * d, bf_hi(v.y) * d); o.z = pk_bf16(bf_lo(v.z) * d, bf_hi(v.z) * d); o.w = pk_bf16(bf_lo(v.w) * d, bf_hi(v.w) * d);
            *(LAS u32x4*)(HP + e2 * 18432 + s * 144 + pc * 16) = o; }
#pragma unroll
        for (int i = 0; i < 4; ++i) { const int q = tid + 512 * i, e2 = q >> 10, p = (q >> 4) & 63, nc = q & 15, e = 2 * hp + e2;
            *(LAS u32x4*)(HP + 36864 + e2 * 17408 + p * 272 + nc * 16) = *(const u32x4*)(XP_SST(X) + ((size_t)(c * 16 + 8 * g + e) * 64 + p) * 128 + nc * 8); }
        __syncthreads();
#pragma unroll 1
        for (int e2 = 0; e2 < 2; ++e2) { const int e = 2 * hp + e2;
            LAS uchar* Xh = HP + e2 * 18432; LAS uchar* Ph = HP + 36864 + e2 * 17408;
            f32x4 y[4];
#pragma unroll
            for (int n = 0; n < 4; ++n) y[n] = (f32x4){0.f, 0.f, 0.f, 0.f};
#pragma unroll
            for (int ks = 0; ks < 4; ++ks)
#pragma unroll
                for (int n = 0; n < 4; ++n) { const bf16x8 bf = *(const LAS bf16x8*)(Ph + (16 * n + fr) * 272 + (32 * ks + 8 * fq) * 2); y[n] = mma16(bf, cfr[ks], y[n]); }
            const float al = acS[e * 128 + l], el = __expf(al);
#pragma unroll
            for (int n = 0; n < 4; ++n) y[n] = y[n] * el;
#pragma unroll
            for (int k2 = 0; k2 < 4; ++k2) if (2 * k2 <= w) { float v[8];
#pragma unroll
                for (int tq = 0; tq < 2; ++tq) { const int s0 = 16 * (2 * k2 + tq) + 4 * fq; const f32x4 as = *(const LAS f32x4*)(acS + e * 128 + s0);
#pragma unroll
                    for (int j = 0; j < 4; ++j) v[4 * tq + j] = (s0 + j <= l) ? cb[2 * k2 + tq][j] * __expf(al - as[j]) : 0.f; }
                u32x4 pk; pk.x = pk_bf16(v[0], v[1]); pk.y = pk_bf16(v[2], v[3]); pk.z = pk_bf16(v[4], v[5]); pk.w = pk_bf16(v[6], v[7]);
                const bf16x8 gf = __builtin_bit_cast(bf16x8, pk);
#pragma unroll
                for (int n = 0; n < 4; ++n) { const bf16x8 bf = tr_frag(Xh + (32 * k2) * 144 + (16 * n) * 2 + trp, 16 * 144); y[n] = mma16(bf, gf, y[n]); }
            }
            const float dsk = XP_d_skip(X)[8 * g + e];
#pragma unroll
            for (int n = 0; n < 4; ++n) { const u32x2 xv = *(const u32x2*)(xp + 64 * e + 16 * n), zv = *(const u32x2*)(zp + 64 * e + 16 * n);
                const float t0_ = (y[n][0] + dsk * bf_lo(xv.x)) * silu_f(bf_lo(zv.x)), t1_ = (y[n][1] + dsk * bf_hi(xv.x)) * silu_f(bf_hi(zv.x));
                const float t2_ = (y[n][2] + dsk * bf_lo(xv.y)) * silu_f(bf_lo(zv.y)), t3_ = (y[n][3] + dsk * bf_hi(xv.y)) * silu_f(bf_hi(zv.y));
                ss += (t0_ * t0_ + t1_ * t1_) + (t2_ * t2_ + t3_ * t3_);
                u32x2 o; o.x = pk_bf16(t0_, t1_); o.y = pk_bf16(t2_, t3_); *(u32x2*)(op + 64 * e + 16 * n) = o; }
        }
        __syncthreads();
    }
    ss += __shfl_xor(ss, 16); ss += __shfl_xor(ss, 32);
    const float rstd = rsqrtf(ss * (1.f / 512.f) + EPS);
    const float* nw = XP_ssm_norm_w(X) + 512 * g + 4 * fq;
#pragma unroll 4
    for (int i = 0; i < 32; ++i) { const f32x4 wv = *(const f32x4*)(nw + 16 * i); const u32x2 t = *(const u32x2*)(op + 16 * i);
        u32x2 o; o.x = pk_bf16(bf_lo(t.x) * rstd * wv.x, bf_hi(t.x) * rstd * wv.y); o.y = pk_bf16(bf_lo(t.y) * rstd * wv.z, bf_hi(t.y) * rstd * wv.w);
        *(u32x2*)(op + 16 * i) = o; }
    __syncthreads();
}

__device__ __forceinline__ void p6_router(Ctx& X) {
    const int tid = X.tid, lane = X.lane, w = X.wave;
    LAS float* u2s = (LAS float*)X.lds;
    LAS float* part = (LAS float*)(X.lds + 65536);
    LAS float* lgt = (LAS float*)(X.lds + 81920);
    const int e = tid & 31, ds = tid >> 5;
    float wreg[128];
#pragma unroll
    for (int i = 0; i < 128; ++i) wreg[i] = XP_w_router(X)[(size_t)(128 * ds + i) * NE + e];
    for (int item = X.bid; item < T / 8; item += X.G) {
        const int tb = item * 8;
        { const int t = tb + w;
            const f32x4* hr = (const f32x4*)(XP_Hh(X) + (size_t)t * D) + lane; const f32x4* wr_ = (const f32x4*)XP_ln_ffn_w(X) + lane;
            f32x4 v[8]; float s = 0.f;
#pragma unroll
            for (int j = 0; j < 8; ++j) { v[j] = hr[64 * j]; s += (v[j].x * v[j].x + v[j].y * v[j].y) + (v[j].z * v[j].z + v[j].w * v[j].w); }
            const float rstd = rsqrtf(wave_sum(s) * (1.f / D) + EPS);
            unsigned* o8 = (unsigned*)(XP_U2(X) + (size_t)t * D) + lane;
#pragma unroll
            for (int j = 0; j < 8; ++j) { const f32x4 wv = wr_[64 * j]; f32x4 u; u.x = v[j].x * rstd * wv.x; u.y = v[j].y * rstd * wv.y; u.z = v[j].z * rstd * wv.z; u.w = v[j].w * rstd * wv.w;
                *(LAS f32x4*)(u2s + w * D + 4 * lane + 256 * j) = u;
                o8[64 * j] = pk_fp8x4(u.x, u.y, u.z, u.w); } }
        __syncthreads();
#pragma unroll 1
        for (int tk = 0; tk < 8; ++tk) { float a0 = 0.f, a1 = 0.f;
#pragma unroll
            for (int i = 0; i < 128; i += 8) { const f32x4 u = *(const LAS f32x4*)(u2s + tk * D + 128 * ds + i), u2 = *(const LAS f32x4*)(u2s + tk * D + 128 * ds + i + 4);
                a0 += u.x * wreg[i] + u.y * wreg[i + 1] + u.z * wreg[i + 2] + u.w * wreg[i + 3]; a1 += u2.x * wreg[i + 4] + u2.y * wreg[i + 5] + u2.z * wreg[i + 6] + u2.w * wreg[i + 7]; }
            part[(tk * 16 + ds) * 32 + e] = a0 + a1; }
        __syncthreads();
        if (tid < 256) { const int tk = tid >> 5; float a = XP_b_router(X)[e];
#pragma unroll
          for (int d2 = 0; d2 < 16; ++d2) a += part[(tk * 16 + d2) * 32 + e];
          lgt[tk * 32 + e] = a; }
        __syncthreads();
        if (tid < 8) { const int t = tb + tid; unsigned used = 0u; int idx[4]; float val[4];
#pragma unroll
            for (int k = 0; k < 4; ++k) { float best = -3.0e38f; int bi = 0;
                for (int j = 0; j < 32; ++j) { const float v = lgt[tid * 32 + j]; if (!((used >> j) & 1u) && v > best) { best = v; bi = j; } }
                used |= 1u << bi; idx[k] = bi; val[k] = best; }
            const float e1 = __expf(val[1] - val[0]), e2 = __expf(val[2] - val[0]), e3 = __expf(val[3] - val[0]), inv = 1.f / (1.f + e1 + e2 + e3);
            const float wv[4] = {inv, e1 * inv, e2 * inv, e3 * inv};
#pragma unroll
            for (int k = 0; k < 4; ++k) { const int rank = (int)atomicAdd(XP_ctl(X) + CW_CNT + 64 * idx[k], 1u);
                XP_LIST(X)[idx[k] * T + rank] = t; XP_TOPI(X)[t * 4 + k] = idx[k]; XP_TOPR(X)[t * 4 + k] = rank; XP_TOPW(X)[t * 4 + k] = wv[k]; } }
        __syncthreads();
    }
}

__device__ __forceinline__ void moe_tables(Ctx& X) {
    LAS int* tab = (LAS int*)(X.lds + LDS_TAB);
    if (X.tid == 0) { int nb = 0;
        for (int e = 0; e < NE; ++e) { const int cnt = (int)__hip_atomic_load(XP_ctl(X) + CW_CNT + 64 * e, __ATOMIC_RELAXED, __HIP_MEMORY_SCOPE_AGENT); const int k = (cnt + 255) >> 8;
            tab[8 + e] = nb; for (int b = 0; b < k; ++b) { if (nb + b < MAXBLK) { tab[64 + nb + b] = e; tab[256 + nb + b] = (cnt - 256 * b) < 256 ? (cnt - 256 * b) : 256; } } nb += k; }
        tab[8 + NE] = nb; tab[0] = nb < MAXBLK ? nb : MAXBLK; }
    __syncthreads();
}

__device__ __forceinline__ void p9_final(Ctx& X) {
    const LAS int* tab = (const LAS int*)(X.lds + LDS_TAB);
    const int gw = X.bid * NWAVES + X.wave, NGW = X.G * NWAVES, lane = X.lane;
    for (int t = gw; t < T; t += NGW) {
        const f32x4* hr = (const f32x4*)(XP_Hh(X) + (size_t)t * D) + lane;
        f32x4 v[8];
#pragma unroll
        for (int j = 0; j < 8; ++j) v[j] = hr[64 * j];
#pragma unroll
        for (int k = 0; k < 4; ++k) { const int e = XP_TOPI(X)[t * 4 + k], r = XP_TOPR(X)[t * 4 + k]; const float wk = XP_TOPW(X)[t * 4 + k];
            const u32x2* yr = (const u32x2*)(XP_YR(X) + ((size_t)tab[8 + e] * 256 + r) * D) + lane;
#pragma unroll
            for (int j = 0; j < 8; ++j) { const u32x2 y = yr[64 * j]; v[j].x += wk * bf_lo(y.x); v[j].y += wk * bf_hi(y.x); v[j].z += wk * bf_lo(y.y); v[j].w += wk * bf_hi(y.y); } }
        float s = 0.f;
#pragma unroll
        for (int j = 0; j < 8; ++j) s += (v[j].x * v[j].x + v[j].y * v[j].y) + (v[j].z * v[j].z + v[j].w * v[j].w);
        const float rstd = rsqrtf(wave_sum(s) * (1.f / D) + EPS);
        f32x4* o = (f32x4*)(X.out + (size_t)t * D) + lane; const f32x4* wr_ = (const f32x4*)XP_ln_final_w(X) + lane;
#pragma unroll
        for (int j = 0; j < 8; ++j) { const f32x4 wv = wr_[64 * j]; f32x4 r; r.x = v[j].x * rstd * wv.x; r.y = v[j].y * rstd * wv.y; r.z = v[j].z * rstd * wv.z; r.w = v[j].w * rstd * wv.w; o[64 * j] = r; }
    }
}

#ifdef NO_P4R
#define P4R(X,u)
#else
#define P4R(X,u) p4_ret(X,u)
#endif
#ifdef NO_P4S
#define P4S(X,u)
#else
#define P4S(X,u) p4_ssd(X,u)
#endif
struct Args { const void* in[19]; float* out; uchar* ws; int ph_lo, ph_hi; };
__global__ void __launch_bounds__(NTHR, 2) fwd(Args args) {
    extern __shared__ __attribute__((aligned(16))) uchar lds_raw[];
    Ctx X;
    X.lds = (LAS uchar*)lds_raw; X.tid = threadIdx.x; X.lane = X.tid & 63; X.wave = __builtin_amdgcn_readfirstlane(X.tid >> 6); X.G = gridDim.x; X.bid = blockIdx.x;
    X.in = (const void* const*)__builtin_amdgcn_kernarg_segment_ptr(); X.out = args.out; X.ws = args.ws;
    for (int u = X.tid; u < (LDS_BYTES - LDS_PHASE_END) / 4; u += NTHR) ((LAS unsigned*)(X.lds + LDS_PHASE_END))[u] = 0u;
    __syncthreads();
    const int lo = args.ph_lo, hi = args.ph_hi;
    const bool multi = (hi - lo) > 1;
    XcdBarrier bar; bar.bar = XP_ctl(X) + CW_BAR; bar.x = 0; bar.st = nullptr;
    if (multi) bar = xcd_barrier_post(XP_ctl(X) + CW_BAR, (volatile LAS unsigned*)(X.lds + LDS_MISC + 32));
#ifdef ONLY_PHASE
#define IN(k) ((k) == ONLY_PHASE && lo <= (k) && (k) < hi)
#else
#define IN(k) (lo <= (k) && (k) < hi)
#endif
#define SEAM(k) do { if (IN(k) && IN((k) + 1)) xcd_barrier(bar); } while (0)
    if (IN(0)) { p0_prologue(X); } SEAM(0);
    if (IN(1)) { DenseSched S{(const char*)XP_U(X), (const char*)XP_WinT(X), D, T / 256, LDP / 256, (T / 256) * (LDP / 256), X.G, X.bid}; EpiProj E{XP_PROJ(X), LDP};
        pg8::gemm_phase<EpiProj, DenseSched, false, false>(X.lds, D, S, E); } SEAM(1);
    if (IN(2)) { for (int u = X.bid; u < 512; u += X.G) { if (u < 256) p2_ret(X, u); else p2_ssd(X, u - 256); } } SEAM(2);
    if (IN(3)) { p3_scan(X); } SEAM(3);
    if (IN(4)) { for (int u = X.bid; u < 384; u += X.G) { if (u < 256) { P4R(X, u); } else { P4S(X, u - 256); } } } SEAM(4);
    if (IN(5)) { DenseSched S{(const char*)XP_MIX(X), (const char*)XP_WoutT(X), D, T / 256, D / 256, (T / 256) * (D / 256), X.G, X.bid}; EpiOut E{XP_x(X), XP_Hh(X)};
        pg8::gemm_phase<EpiOut, DenseSched, false, false>(X.lds, D, S, E); } SEAM(5);
    if (IN(6)) { p6_router(X); } SEAM(6);
    if (IN(7)) { moe_tables(X); MoeSched S{(const LAS int*)(X.lds + LDS_TAB), (const char*)XP_U2(X), (const char*)XP_WguT(X), (size_t)(2 * DFF) * D, XP_LIST(X), D / 2, (2 * DFF) / 256, X.G, X.bid}; EpiGateUp E{XP_ACT(X), XP_b_gu(X)};
        pg8::gemm_phase<EpiGateUp, MoeSched, true, true>(X.lds, D / 2, S, E); } SEAM(7);
    if (IN(8)) { moe_tables(X); MoeSchedDirect S{(const LAS int*)(X.lds + LDS_TAB), (const char*)XP_ACT(X), (const char*)XP_WdT(X), (size_t)D * DFF, DFF / 2, D / 256, X.G, X.bid}; EpiDown E{XP_YR(X), XP_b_d(X)};
        pg8::gemm_phase<EpiDown, MoeSchedDirect, true, true>(X.lds, DFF / 2, S, E); } SEAM(8);
    if (IN(9)) { moe_tables(X); p9_final(X); }
#undef IN
#undef SEAM
}

extern "C" void kernel_launch(void* const* d_in, const int* in_sizes, int n_in, void* d_out, int out_size, void* d_ws, size_t ws_size, hipStream_t stream) {
    static int grid = 0;
    if (grid == 0) {
        if (n_in != 19 || out_size != T * D || ws_size < WS_END) { fprintf(stderr, "kernel_launch: unexpected shapes (n_in %d, out %d, ws %zu)\n", n_in, out_size, ws_size); grid = -1; return; }
        int dev = 0, cus = 0, per_cu = 0;
        if (hipGetDevice(&dev) != hipSuccess || hipDeviceGetAttribute(&cus, hipDeviceAttributeMultiprocessorCount, dev) != hipSuccess) { grid = -1; return; }
        if (hipFuncSetAttribute((const void*)fwd, hipFuncAttributeMaxDynamicSharedMemorySize, LDS_BYTES) != hipSuccess) { fprintf(stderr, "kernel_launch: hipFuncSetAttribute failed\n"); grid = -1; return; }
        if (hipOccupancyMaxActiveBlocksPerMultiprocessor(&per_cu, (const void*)fwd, NTHR, LDS_BYTES) != hipSuccess || per_cu < 1) { fprintf(stderr, "kernel_launch: occupancy query reports %d\n", per_cu); }
        (void)hipGetLastError();
        grid = cus;
    }
    if (grid < 0) return;
    (void)hipMemsetAsync((char*)d_ws + WS_CTL, 0, CTL_ZERO_BYTES, stream);
    Args a{};
    for (int i = 0; i < 19; ++i) a.in[i] = d_in[i];
    a.out = (float*)d_out; a.ws = (uchar*)d_ws;
    constexpr int NL = MK_N_LAUNCHES;
    for (int li = 0; li < NL; ++li) {
        a.ph_lo = (NL == 1) ? 0 : li; a.ph_hi = (NL == 1) ? NPHASE : li + 1;
        hipLaunchKernelGGL(fwd, dim3(grid), dim3(NTHR), LDS_BYTES, stream, a);
    }
}
```

```cpp
#include <hip/hip_runtime.h>
#include <cstdio>
#include <cstdint>

#ifndef MK_N_LAUNCHES
#define MK_N_LAUNCHES 1
#endif

#define LAS __attribute__((address_space(3)))
typedef unsigned short bf16;
typedef short bf16x8 __attribute__((ext_vector_type(8)));
typedef short s16x4 __attribute__((ext_vector_type(4)));
typedef float f32x4 __attribute__((ext_vector_type(4)));
typedef float f32x2 __attribute__((ext_vector_type(2)));
typedef unsigned u32x4 __attribute__((ext_vector_type(4)));
typedef unsigned u32x2 __attribute__((ext_vector_type(2)));
typedef unsigned char uchar;
typedef int i32x8 __attribute__((ext_vector_type(8)));
typedef int i32x4 __attribute__((ext_vector_type(4)));
constexpr float W8_SCALE = 64.f, W8_INV = 1.f / 64.f;

constexpr int T = 8192, D = 2048, NPROJ = 6672, LDP = 6912;
constexpr int C_Q = 0, C_K = 1024, C_V = 2048, C_G = 3072, C_Z = 4096, C_X = 5120, C_DT = 6656;
constexpr int XBCW = 1536, NCHUNK = 64, CH = 128;
constexpr int NE = 32, DFF = 2048, MAXBLK = 160;
constexpr float EPS = 1e-6f;
constexpr int NPHASE = 10;
constexpr int NWAVES = 8, NTHR = 512;

constexpr size_t MiB = 1ull << 20;
constexpr size_t WS_CTL = 0, CTL_ZERO_BYTES = 1 * MiB;
constexpr size_t WS_WINT = 2 * MiB, WS_WOUTT = 30 * MiB, WS_COS = 38 * MiB, WS_SIN = 42 * MiB;
constexpr size_t WS_TOPI = 46 * MiB, WS_TOPR = 46 * MiB + 128 * 1024, WS_TOPW = 46 * MiB + 256 * 1024, WS_LIST = 47 * MiB, WS_ADEC = 48 * MiB;
constexpr size_t WS_WRH = 49 * MiB, WS_WRL = 49 * MiB + 128 * 1024;
constexpr size_t WS_U = 64 * MiB, WS_U2 = 96 * MiB, WS_MIX = 128 * MiB, WS_XBC = 160 * MiB, WS_KV = 192 * MiB, WS_SST = 224 * MiB;
constexpr size_t WS_H = 256 * MiB, WS_PROJ = 320 * MiB, WS_ACT = 448 * MiB, WS_YR = 608 * MiB, WS_WGUT = 768 * MiB, WS_WDT = 1280 * MiB, WS_END = 1536 * MiB;
constexpr int CW_TMO = 0, CW_BAR = 4096, CW_CNT = 16384;

constexpr int RING_BYTES = 131072;
constexpr int LDS_PHASE_END = 139264;
constexpr int LDS_TAB = LDS_PHASE_END;
constexpr int LDS_IDX = LDS_PHASE_END + 2048;
constexpr int LDS_MISC = LDS_PHASE_END + 4096;
constexpr int LDS_BIAS = LDS_PHASE_END + 5120;
constexpr int LDS_BYTES = 147456;

__device__ __forceinline__ unsigned pk_bf16(float lo, float hi) { unsigned r; asm("v_cvt_pk_bf16_f32 %0, %1, %2" : "=v"(r) : "v"(lo), "v"(hi)); return r; }
__device__ __forceinline__ float clamp448(float x) { return fminf(fmaxf(x, -448.f), 448.f); }
__device__ __forceinline__ unsigned pk_fp8x4(float a, float b, float c, float d) {
    int p = 0; p = __builtin_amdgcn_cvt_pk_fp8_f32(clamp448(a), clamp448(b), p, false); p = __builtin_amdgcn_cvt_pk_fp8_f32(clamp448(c), clamp448(d), p, true); return (unsigned)p; }
__device__ __forceinline__ float bf_lo(unsigned u) { return __uint_as_float(u << 16); }
__device__ __forceinline__ float bf_hi(unsigned u) { return __uint_as_float(u & 0xffff0000u); }
__device__ __forceinline__ float bf2f(bf16 b) { return __uint_as_float(((unsigned)b) << 16); }
__device__ __forceinline__ float wave_sum(float v) {
#pragma unroll
    for (int o = 1; o < 64; o <<= 1) v += __shfl_xor(v, o);
    return v;
}
__device__ __forceinline__ float silu_f(float x) { return x * __builtin_amdgcn_rcpf(1.0f + __expf(-x)); }
__device__ __forceinline__ float softplus_f(float x) { return x > 20.f ? x : log1pf(__expf(x)); }

__constant__ double INV_FREQ[128] = {1,0.93057204092969903,0.86596432336006535,0.80584218776148187,0.74989420933245587,0.69783058485986638,0.64938163157621132,0.60429639023813286,0.56234132519034907,0.5232991146814947,0.48696752516586311,0.45315836376008178,0.42169650342858223,0.39241897584845359,0.36517412725483772,0.33982083289425596,0.31622776601683794,0.29427271762092816,0.27384196342643613,0.25482967479793467,0.23713737056616552,0.22067340690845899,0.20535250264571461,0.19109529749704404,0.17782794100389229,0.16548170999431813,0.15399265260594919,0.14330125702369628,0.1333521432163324,0.12409377607517195,0.11547819846894582,0.10746078283213174,0.10000000000000001,0.0930572040929699,0.086596432336006529,0.080584218776148187,0.074989420933245579,0.069783058485986635,0.064938163157621132,0.060429639023813285,0.056234132519034911,0.05232991146814947,0.048696752516586311,0.045315836376008181,0.042169650342858224,0.039241897584845357,0.036517412725483769,0.033982083289425591,0.031622776601683791,0.029427271762092817,0.027384196342643614,0.025482967479793464,0.023713737056616554,0.022067340690845899,0.02053525026457146,0.019109529749704406,0.017782794100389229,0.016548170999431813,0.015399265260594919,0.014330125702369627,0.013335214321633241,0.012409377607517195,0.011547819846894581,0.010746078283213174,0.01,0.0093057204092969904,0.0086596432336006543,0.008058421877614819,0.0074989420933245579,0.0069783058485986633,0.006493816315762113,0.0060429639023813278,0.005623413251903491,0.0052329911468149467,0.004869675251658631,0.0045315836376008181,0.0042169650342858229,0.0039241897584845363,0.0036517412725483771,0.0033982083289425592,0.0031622776601683794,0.002942727176209282,0.0027384196342643613,0.0025482967479793467,0.0023713737056616554,0.0022067340690845897,0.002053525026457146,0.0019109529749704406,0.0017782794100389228,0.0016548170999431814,0.001539926526059492,0.0014330125702369627,0.0013335214321633241,0.0012409377607517195,0.0011547819846894581,0.0010746078283213176,0.001,0.00093057204092969893,0.00086596432336006539,0.00080584218776148179,0.00074989420933245586,0.00069783058485986635,0.00064938163157621134,0.00060429639023813287,0.0005623413251903491,0.00052329911468149473,0.0004869675251658631,0.00045315836376008179,0.00042169650342858224,0.00039241897584845359,0.0003651741272548377,0.00033982083289425596,0.00031622776601683794,0.00029427271762092817,0.00027384196342643611,0.00025482967479793463,0.00023713737056616554,0.00022067340690845897,0.00020535250264571461,0.00019109529749704405,0.00017782794100389227,0.00016548170999431815,0.00015399265260594919,0.00014330125702369627,0.0001333521432163324,0.00012409377607517196,0.00011547819846894582,0.00010746078283213175};
__constant__ float LG2_GAMMA[4] = {-0.045803689613124789f, -0.022720076500083529f, -0.011315313227834146f, -0.0056465631411420627f};
__constant__ float GAMMA_CHUNK[4] = {0.017183023570817902f, 0.13321516287964841f, 0.36643771592203728f, 0.60593708822908032f};

namespace pg8 {
constexpr int BM = 256, BK = 64, HALF = 128, HTB = HALF * BK * 2, STAGE_BYTES = 8 * HTB, NXCD = 8, WGM = 8;
__host__ __device__ __forceinline__ int lds_byte(int r, int c) { const int st = (r >> 4) * 2 + (c >> 5), rr = r & 15, cc = c & 31, ob = rr * 64 + cc * 2; return st * 1024 + (ob ^ (((ob >> 9) & 1) << 5)); }
__host__ __device__ __forceinline__ void stage_rc(int b, int& R, int& C) { const int st = b / 1024, sb = b % 1024, swz = sb ^ (((sb >> 9) & 1) << 5); R = (st >> 1) * 16 + swz / 64; C = (st & 1) * 32 + (swz % 64) / 2; }
__host__ __device__ __forceinline__ int perm32(int rho) { const int n = rho >> 4, i = rho & 15; return 8 * (i >> 2) + 4 * n + (i & 3); }

struct Unit { const char* pa; const char* pb; int row0, col0, aux, blk; };

template <class Epi, class Sched, bool GATHER, bool FP8>
__device__ __forceinline__ void gemm_phase(LAS uchar* lds, const int K, const Sched& S, const Epi& E) {
    const int tid = threadIdx.x, wid = __builtin_amdgcn_readfirstlane(tid >> 6), lane = tid & 63, wr = wid >> 2, wc = wid & 3, fr = lane & 15, fq = lane >> 4;
    const int nt = K / BK;
    unsigned voA[2][2], voffB[2];
#pragma unroll
    for (int i = 0; i < 2; ++i) { int R, C; stage_rc(tid * 16 + i * 8192, R, C); const int Rb = Epi::PERM == 16 ? 64 * (R >> 5) + 16 * ((R >> 2) & 3) + 4 * ((R >> 4) & 1) + (R & 3) : (Epi::PERM == 8 ? ((R & ~31) + perm32(R & 31)) : R);
        voA[0][i] = (unsigned)(R * K + C) * 2u; voA[1][i] = voA[0][i] + (unsigned)(HALF * K * 2); voffB[i] = (unsigned)(Rb * K + C) * 2u; }
    const size_t kstep = (size_t)(BK * 2);
    const size_t hstep = (size_t)(Epi::PERM == 16 ? 8 : HALF) * K * 2;
    const unsigned ldsw = (unsigned)wid * 1024u;
    const int aoff = lds_byte(wr * 64 + fr, fq * 8), boff = lds_byte(wc * 32 + fr, fq * 8);
#define PG8_SA(b, h) (((b) * 2 + (h)) * HTB)
#define PG8_SB(b, h) ((4 + (b) * 2 + (h)) * HTB)
#define PG8_STAGE(bufoff, gbase, voff) do { _Pragma("unroll") for (int _i = 0; _i < 2; ++_i) \
        __builtin_amdgcn_global_load_lds((const unsigned*)((const char*)(gbase) + (voff)[_i]), (LAS unsigned*)(lds + (bufoff) + ldsw + _i * 8192), 16, 0, 0); } while (0)
#define PG8_LDA(dst, b, h) do { _Pragma("unroll") for (int m = 0; m < 4; ++m) _Pragma("unroll") for (int k = 0; k < 2; ++k) dst[m][k] = *(const LAS bf16x8*)(lds + PG8_SA(b, h) + aoff + m * 2048 + k * 1024); } while (0)
#define PG8_LDB(dst, b, h) do { _Pragma("unroll") for (int n = 0; n < 2; ++n) _Pragma("unroll") for (int k = 0; k < 2; ++k) dst[n][k] = *(const LAS bf16x8*)(lds + PG8_SB(b, h) + boff + n * 2048 + k * 1024); } while (0)
#define PG8_CAT(x) __builtin_shufflevector(__builtin_bit_cast(i32x4, (x)[0]), __builtin_bit_cast(i32x4, (x)[1]), 0, 1, 2, 3, 4, 5, 6, 7)
#define PG8_MMA(ai, bj, At, Bt) do { __builtin_amdgcn_s_setprio(1); \
        if constexpr (FP8) { _Pragma("unroll") for (int m = 0; m < 4; ++m) _Pragma("unroll") for (int n = 0; n < 2; ++n) \
            acc[ai][bj][m][n] = __builtin_amdgcn_mfma_scale_f32_16x16x128_f8f6f4(PG8_CAT(Bt[n]), PG8_CAT(At[m]), acc[ai][bj][m][n], 0, 0, 0, 0x7f7f7f7f, 0, 0x7f7f7f7f); } \
        else { _Pragma("unroll") for (int m = 0; m < 4; ++m) _Pragma("unroll") for (int n = 0; n < 2; ++n) _Pragma("unroll") for (int k = 0; k < 2; ++k) \
            acc[ai][bj][m][n] = __builtin_amdgcn_mfma_f32_16x16x32_bf16(Bt[n][k], At[m][k], acc[ai][bj][m][n], 0, 0, 0); } \
        __builtin_amdgcn_s_setprio(0); } while (0)
#define PG8_WAIT_V(n) asm volatile("s_waitcnt vmcnt(" #n ")" ::: "memory")
#define PG8_WAIT_L(n) asm volatile("s_waitcnt lgkmcnt(" #n ")" ::: "memory")
#define PG8_BAR __builtin_amdgcn_s_barrier()
#define PG8_SCHED __builtin_amdgcn_sched_barrier(0)
    Unit cur, nxt; int ui = 0;
    if (!S.next(0, cur)) return;
    f32x4 acc[2][2][4][2];
#pragma unroll
    for (int a = 0; a < 2; ++a)
#pragma unroll
        for (int b = 0; b < 2; ++b)
#pragma unroll
            for (int m = 0; m < 4; ++m)
#pragma unroll
                for (int n = 0; n < 2; ++n) acc[a][b][m][n] = (f32x4){0.f, 0.f, 0.f, 0.f};
    bf16x8 At[4][2], B0[2][2], B1[2][2];
    const char* cA = cur.pa; const char* cB = cur.pb;
    if constexpr (GATHER) S.gather(cur, voA, (const LAS int*)nullptr);
    PG8_STAGE(PG8_SB(0, 0), cB, voffB); PG8_STAGE(PG8_SB(0, 1), cB + hstep, voffB); PG8_STAGE(PG8_SA(0, 0), cA, voA[0]); PG8_STAGE(PG8_SA(0, 1), cA, voA[1]);
    if (wr == 1) PG8_BAR;
    PG8_WAIT_V(2); PG8_BAR;
    PG8_STAGE(PG8_SB(1, 0), cB + kstep, voffB); PG8_STAGE(PG8_SA(1, 0), cA + kstep, voA[0]); PG8_STAGE(PG8_SB(1, 1), cB + hstep + kstep, voffB);
    PG8_WAIT_V(6); PG8_BAR;
    for (;;) {
        const bool has_next = S.next(ui + 1, nxt);
        if constexpr (GATHER) { if (has_next) S.prefetch(nxt, lds + LDS_IDX + ((ui + 1) & 1) * 1024, wid, lane); }
        E.prefetch(cur, lds + LDS_BIAS + (ui & 1) * 1024, wid, lane);
        const char* nA = has_next ? nxt.pa : cA; const char* nB = has_next ? nxt.pb : cB;
        for (int t = 0; t < nt; t += 2) {
            const bool last = (t == nt - 2);
            const char* a1 = cA + (size_t)(t + 1) * kstep;
            const char* a2 = last ? nA : cA + (size_t)(t + 2) * kstep; const char* b2 = last ? nB : cB + (size_t)(t + 2) * kstep;
            const char* a3 = a2 + kstep; const char* b3 = b2 + kstep;
            PG8_LDB(B0, 0, 0); PG8_LDB(B1, 0, 1); PG8_SCHED; PG8_LDA(At, 0, 0); PG8_STAGE(PG8_SA(1, 1), a1, voA[1]);
            if constexpr (GATHER) { if (last && has_next) S.gather(nxt, voA, (const LAS int*)(lds + LDS_IDX + ((ui + 1) & 1) * 1024)); }
            PG8_WAIT_V(8); PG8_WAIT_L(0); PG8_BAR; PG8_MMA(0, 0, At, B0); PG8_MMA(0, 1, At, B1); PG8_BAR; PG8_SCHED;
            PG8_LDA(At, 0, 1); PG8_STAGE(PG8_SB(0, 0), b2, voffB); PG8_STAGE(PG8_SB(0, 1), b2 + hstep, voffB); PG8_STAGE(PG8_SA(0, 0), a2, voA[0]);
            PG8_WAIT_V(8); PG8_WAIT_L(0); PG8_BAR; PG8_MMA(1, 0, At, B0); PG8_MMA(1, 1, At, B1); PG8_BAR; PG8_SCHED;
            PG8_LDB(B0, 1, 0); PG8_LDB(B1, 1, 1); PG8_SCHED; PG8_LDA(At, 1, 0); PG8_STAGE(PG8_SA(0, 1), a2, voA[1]);
            PG8_WAIT_V(8); PG8_WAIT_L(0); PG8_BAR; PG8_MMA(0, 0, At, B0); PG8_MMA(0, 1, At, B1); PG8_BAR; PG8_SCHED;
            PG8_LDA(At, 1, 1); PG8_STAGE(PG8_SB(1, 0), b3, voffB); PG8_STAGE(PG8_SB(1, 1), b3 + hstep, voffB); PG8_STAGE(PG8_SA(1, 0), a3, voA[0]);
            PG8_WAIT_V(8); PG8_WAIT_L(0); PG8_BAR; PG8_MMA(1, 0, At, B0); PG8_MMA(1, 1, At, B1); PG8_BAR; PG8_SCHED;
        }
        if (wr == 0) PG8_BAR;
        E(acc, cur, wr, wc, fr, fq, lds + LDS_BIAS + (ui & 1) * 1024);
        if (!has_next) break;
#pragma unroll
        for (int a = 0; a < 2; ++a)
#pragma unroll
            for (int b = 0; b < 2; ++b)
#pragma unroll
                for (int m = 0; m < 4; ++m)
#pragma unroll
                    for (int n = 0; n < 2; ++n) acc[a][b][m][n] = (f32x4){0.f, 0.f, 0.f, 0.f};
        cur = nxt; cA = nA; cB = nB; ++ui;
        if (wr == 1) PG8_BAR;
    }
    PG8_WAIT_V(0);
    PG8_BAR;
#undef PG8_SA
#undef PG8_SB
#undef PG8_STAGE
#undef PG8_LDA
#undef PG8_LDB
#undef PG8_MMA
#undef PG8_CAT
#undef PG8_WAIT_V
#undef PG8_WAIT_L
#undef PG8_BAR
#undef PG8_SCHED
}
}

struct DenseSched {
    const char* A; const char* B; int K, nM, nN, nwg, G, c;
    __device__ __forceinline__ bool next(int i, pg8::Unit& u) const {
        const long L = (long)i * G + c; if (L >= nwg) return false;
        int wgid = (int)L; { const int q = nwg / pg8::NXCD, r = nwg % pg8::NXCD, xcd = wgid % pg8::NXCD, off = wgid / pg8::NXCD; wgid = (xcd < r ? xcd * (q + 1) : r * (q + 1) + (xcd - r) * q) + off; }
        const int nig = pg8::WGM * nN, gid = wgid / nig, fm = gid * pg8::WGM, gsz = (nM - fm) < pg8::WGM ? (nM - fm) : pg8::WGM;
        const int pm = fm + ((wgid % nig) % gsz), pn = (wgid % nig) / gsz;
        u.pa = A + (size_t)pm * 256 * K * 2; u.pb = B + (size_t)pn * 256 * K * 2; u.row0 = pm * 256; u.col0 = pn * 256; u.aux = 0; u.blk = 0; return true;
    }
    __device__ __forceinline__ void gather(const pg8::Unit&, unsigned (&)[2][2], const LAS int*) const {}
    __device__ __forceinline__ void prefetch(const pg8::Unit&, LAS uchar*, int, int) const {}
};
struct MoeSched {
    const LAS int* tab; const char* A; const char* B; size_t bexp; const int* list; int K, nN, G, c;
    __device__ __forceinline__ bool next(int i, pg8::Unit& u) const {
        const int NB = __builtin_amdgcn_readfirstlane(tab[0]); const int L = i * G + c; if (L >= NB * nN) return false;
        const int b = L / nN, pn = L - b * nN, e = __builtin_amdgcn_readfirstlane(tab[64 + b]);
        u.pa = A; u.pb = B + (size_t)e * bexp + (size_t)pn * 256 * K * 2; u.row0 = b * 256; u.col0 = pn * 256; u.aux = e; u.blk = b; return true;
    }
    __device__ __forceinline__ void prefetch(const pg8::Unit& u, LAS uchar* buf, int wid, int lane) const {
        if (wid < 4) { const int e = u.aux, lb = (u.blk - __builtin_amdgcn_readfirstlane(tab[8 + e])) * 256;
            __builtin_amdgcn_global_load_lds((const unsigned*)(list + e * T + lb + 64 * wid + lane), (LAS unsigned*)(buf + wid * 256), 4, 0, 0); }
    }
    __device__ __forceinline__ void gather(const pg8::Unit& u, unsigned (&vo)[2][2], const LAS int* idx) const {
        const int e = u.aux, lb = (u.blk - __builtin_amdgcn_readfirstlane(tab[8 + e])) * 256, cnt = __builtin_amdgcn_readfirstlane(tab[256 + u.blk]);
#pragma unroll
        for (int i = 0; i < 2; ++i) { int R, C; pg8::stage_rc((int)threadIdx.x * 16 + i * 8192, R, C);
#pragma unroll
            for (int h = 0; h < 2; ++h) { const int r = h * 128 + R; const int raw = idx ? idx[r] : list[e * T + lb + r]; const int tok = (r < cnt) ? raw : 0; vo[h][i] = ((unsigned)tok * (unsigned)K + (unsigned)C) * 2u; } }
    }
};
struct MoeSchedDirect {
    const LAS int* tab; const char* A; const char* B; size_t bexp; int K, nN, G, c;
    __device__ __forceinline__ bool next(int i, pg8::Unit& u) const {
        const int NB = __builtin_amdgcn_readfirstlane(tab[0]); const int L = i * G + c; if (L >= NB * nN) return false;
        const int b = L / nN, pn = L - b * nN, e = __builtin_amdgcn_readfirstlane(tab[64 + b]);
        u.pa = A; u.pb = B + (size_t)e * bexp + (size_t)pn * 256 * K * 2; u.row0 = b * 256; u.col0 = pn * 256; u.aux = e; u.blk = b; return true;
    }
    __device__ __forceinline__ void prefetch(const pg8::Unit&, LAS uchar*, int, int) const {}
    __device__ __forceinline__ void gather(const pg8::Unit& u, unsigned (&vo)[2][2], const LAS int*) const {
#pragma unroll
        for (int i = 0; i < 2; ++i) { int R, C; pg8::stage_rc((int)threadIdx.x * 16 + i * 8192, R, C);
#pragma unroll
            for (int h = 0; h < 2; ++h) vo[h][i] = ((unsigned)(u.row0 + h * 128 + R) * (unsigned)K + (unsigned)C) * 2u; }
    }
};

#define EPI_LANE() int tz = threadIdx.x; asm volatile("" : "+v"(tz)); const int fr = tz & 15, fq = (tz >> 4) & 3; (void)fr_; (void)fq_
struct EpiProj {
    static constexpr int PERM = 8;
    bf16* O; int ldc;
    __device__ __forceinline__ void prefetch(const pg8::Unit&, LAS uchar*, int, int) const {}
    __device__ __forceinline__ void operator()(const f32x4 (&acc)[2][2][4][2], const pg8::Unit& u, int wr, int wc, int fr_, int fq_, const LAS uchar* bl) const {
        EPI_LANE();
        const int row0 = u.row0 + wr * 64 + fr, col0 = u.col0 + wc * 32 + 8 * fq;
#pragma unroll
        for (int ai = 0; ai < 2; ++ai)
#pragma unroll
            for (int m = 0; m < 4; ++m) { bf16* rowp = O + (size_t)(row0 + ai * 128 + m * 16) * ldc + col0;
#pragma unroll
                for (int bj = 0; bj < 2; ++bj) { const f32x4 v0 = acc[ai][bj][m][0], v1 = acc[ai][bj][m][1];
                    u32x4 w; w.x = pk_bf16(v0[0], v0[1]); w.y = pk_bf16(v0[2], v0[3]); w.z = pk_bf16(v1[0], v1[1]); w.w = pk_bf16(v1[2], v1[3]);
                    *(u32x4*)(rowp + bj * 128) = w; } }
    }
};
struct EpiOut {
    static constexpr int PERM = 4;
    const float* X; float* Hh;
    __device__ __forceinline__ void prefetch(const pg8::Unit&, LAS uchar*, int, int) const {}
    __device__ __forceinline__ void operator()(const f32x4 (&acc)[2][2][4][2], const pg8::Unit& u, int wr, int wc, int fr_, int fq_, const LAS uchar* bl) const {
        EPI_LANE();
        const int row0 = u.row0 + wr * 64 + fr, col0 = u.col0 + wc * 32 + 4 * fq;
#pragma unroll
        for (int ai = 0; ai < 2; ++ai)
#pragma unroll
            for (int m = 0; m < 4; ++m) { const size_t off = (size_t)(row0 + ai * 128 + m * 16) * D + col0;
#pragma unroll
                for (int bj = 0; bj < 2; ++bj)
#pragma unroll
                    for (int n = 0; n < 2; ++n) { const f32x4 xv = *(const f32x4*)(X + off + bj * 128 + n * 16); *(f32x4*)(Hh + off + bj * 128 + n * 16) = xv + acc[ai][bj][m][n]; } }
    }
};
__device__ __forceinline__ float swiglu_f(float gate, float up) { const float g = fminf(gate, 7.f), u = fminf(fmaxf(up, -7.f), 7.f); return (u + 1.f) * g * __builtin_amdgcn_rcpf(1.f + __expf(-1.702f * g)); }
struct EpiGateUp {
    static constexpr int PERM = 16;
    uchar* ACT; const float* bias;
    __device__ __forceinline__ void prefetch(const pg8::Unit& u, LAS uchar* buf, int wid, int lane) const {
        if (wid < 4) __builtin_amdgcn_global_load_lds((const unsigned*)(bias + (size_t)u.aux * (2 * DFF) + u.col0 + 64 * wid + lane), (LAS unsigned*)(buf + wid * 256), 4, 0, 0); }
    __device__ __forceinline__ void operator()(const f32x4 (&acc)[2][2][4][2], const pg8::Unit& u, int wr, int wc, int fr_, int fq_, const LAS uchar* bl) const {
        EPI_LANE();
        const int row0 = u.row0 + wr * 64 + fr, col0 = u.col0 + wc * 64 + 16 * fq;
        const LAS float* bp = (const LAS float*)bl + wc * 64 + 16 * fq;
        f32x4 bv[2][2];
#pragma unroll
        for (int bj = 0; bj < 2; ++bj)
#pragma unroll
            for (int n = 0; n < 2; ++n) bv[bj][n] = *(const LAS f32x4*)(bp + bj * 8 + 4 * n);
#pragma unroll
        for (int ai = 0; ai < 2; ++ai)
#pragma unroll
            for (int m = 0; m < 4; ++m) { uchar* rowp = ACT + (size_t)(row0 + ai * 128 + m * 16) * DFF + (col0 >> 1);
                u32x2 w;
#pragma unroll
                for (int bj = 0; bj < 2; ++bj) { const f32x4 v0 = acc[ai][bj][m][0] * W8_INV + bv[bj][0], v1 = acc[ai][bj][m][1] * W8_INV + bv[bj][1];
                    const unsigned p = pk_fp8x4(swiglu_f(v0[0], v0[1]), swiglu_f(v0[2], v0[3]), swiglu_f(v1[0], v1[1]), swiglu_f(v1[2], v1[3]));
                    if (bj == 0) w.x = p; else w.y = p; }
                *(u32x2*)rowp = w; }
    }
};
struct EpiDown {
    static constexpr int PERM = 8;
    bf16* YR; const float* bias;
    __device__ __forceinline__ void prefetch(const pg8::Unit& u, LAS uchar* buf, int wid, int lane) const {
        if (wid < 4) __builtin_amdgcn_global_load_lds((const unsigned*)(bias + (size_t)u.aux * D + u.col0 + 64 * wid + lane), (LAS unsigned*)(buf + wid * 256), 4, 0, 0); }
    __device__ __forceinline__ void operator()(const f32x4 (&acc)[2][2][4][2], const pg8::Unit& u, int wr, int wc, int fr_, int fq_, const LAS uchar* bl) const {
        EPI_LANE();
        const int row0 = u.row0 + wr * 64 + fr, col0 = u.col0 + wc * 32 + 8 * fq;
        const LAS float* bp = (const LAS float*)bl + wc * 32 + 8 * fq;
        f32x4 bv[2][2];
#pragma unroll
        for (int bj = 0; bj < 2; ++bj)
#pragma unroll
            for (int n = 0; n < 2; ++n) bv[bj][n] = *(const LAS f32x4*)(bp + bj * 128 + 4 * n);
#pragma unroll
        for (int ai = 0; ai < 2; ++ai)
#pragma unroll
            for (int m = 0; m < 4; ++m) { bf16* rowp = YR + (size_t)(row0 + ai * 128 + m * 16) * D + col0;
#pragma unroll
                for (int bj = 0; bj < 2; ++bj) { const f32x4 v0 = acc[ai][bj][m][0] * W8_INV + bv[bj][0], v1 = acc[ai][bj][m][1] * W8_INV + bv[bj][1];
                    u32x4 w; w.x = pk_bf16(v0[0], v0[1]); w.y = pk_bf16(v0[2], v0[3]); w.z = pk_bf16(v1[0], v1[1]); w.w = pk_bf16(v1[2], v1[3]);
                    *(u32x4*)(rowp + bj * 128) = w; } }
    }
};

#define XB_TMO      128
#define XB_XCNT(j)  (256  + 64 * (j))
#define XB_XSUB(j)  (1280 + 64 * (j))
#define XB_XGEN(j)  (2304 + 64 * (j))
#define XB_TOP      3328
#define XB_TOPGEN   3392
#define XCD_BAR_WORDS 3456
#define XB_SPIN_CAP (1u << 18)
__device__ __forceinline__ unsigned xb_ld(unsigned* p)              { return __hip_atomic_load(p, __ATOMIC_RELAXED, __HIP_MEMORY_SCOPE_AGENT); }
__device__ __forceinline__ unsigned xb_add(unsigned* p, unsigned v) { return __hip_atomic_fetch_add(p, v, __ATOMIC_RELAXED, __HIP_MEMORY_SCOPE_AGENT); }
__device__ __forceinline__ unsigned xb_xcc_id() { return (unsigned)__builtin_amdgcn_s_getreg((3 << 11) | 20) & 0xFu; }
#define XB_SPIN(cond, bar) do { unsigned _sp = 0; while (cond) { __builtin_amdgcn_s_sleep(1); \
    if ((++_sp & 255u) == 0u) { if (xb_ld(&(bar)[XB_TMO])) break; if (_sp > XB_SPIN_CAP) { atomicAdd(&(bar)[XB_TMO], 1u); break; } } } } while (0)
struct XcdBarrier { unsigned* bar; unsigned x; volatile LAS unsigned* st; };
__device__ __forceinline__ XcdBarrier xcd_barrier_post(unsigned* bar, volatile LAS unsigned* st) {
    XcdBarrier b; b.bar = bar; b.x = xb_xcc_id(); b.st = st;
    if (threadIdx.x == 0) (void)xb_add(&bar[XB_XCNT(b.x)], 1u);
    return b;
}
__device__ __forceinline__ void xcd_barrier_complete(unsigned* bar, unsigned x, unsigned& nloc, unsigned& nx) {
    const unsigned G = gridDim.x * gridDim.y * gridDim.z;
    unsigned sum, cnt, mine, sp = 0u;
    for (;;) {
        sum = 0u; cnt = 0u; mine = 0u;
#pragma unroll
        for (unsigned j = 0; j < 16; ++j) { const unsigned c = xb_ld(&bar[XB_XCNT(j)]); sum += c; cnt += (c > 0u) ? 1u : 0u; mine = (j == x) ? c : mine; }
        if (sum == G) break;
        __builtin_amdgcn_s_sleep(1);
        if ((++sp & 255u) == 0u) { if (xb_ld(&bar[XB_TMO])) break; if (sp > XB_SPIN_CAP) { atomicAdd(&bar[XB_TMO], 1u); break; } }
    }
    nloc = mine > 0u ? mine : 1u; nx = cnt > 0u ? cnt : 1u;
}
__device__ __forceinline__ void xcd_barrier(const XcdBarrier& b) {
    asm volatile("s_waitcnt vmcnt(0)" ::: "memory");
    __syncthreads();
    if (threadIdx.x == 0) {
        unsigned* bar = b.bar;
        __builtin_amdgcn_s_waitcnt(0);
        unsigned nloc = b.st[0], nx = b.st[1];
        if (nloc == 0u) { xcd_barrier_complete(bar, b.x, nloc, nx); b.st[0] = nloc; b.st[1] = nx; }
        const unsigned old = xb_add(&bar[XB_XSUB(b.x)], 1u);
        const unsigned gen = old / nloc;
        if (old + 1u == (gen + 1u) * nloc) {
            __builtin_amdgcn_fence(__ATOMIC_RELEASE, "agent");
            asm volatile("s_waitcnt vmcnt(0)" ::: "memory");
            const unsigned og = xb_add(&bar[XB_TOP], 1u);
            const unsigned tg = og / nx;
            if (og + 1u == (tg + 1u) * nx) xb_add(&bar[XB_TOPGEN], 1u);
            else XB_SPIN(xb_ld(&bar[XB_TOPGEN]) == tg, bar);
            __builtin_amdgcn_fence(__ATOMIC_ACQUIRE, "agent");
            xb_add(&bar[XB_XGEN(b.x)], 1u);
            asm volatile("s_waitcnt vmcnt(0)" ::: "memory");
        } else {
            XB_SPIN(xb_ld(&bar[XB_XGEN(b.x)]) == gen, bar);
            __builtin_amdgcn_fence(__ATOMIC_ACQUIRE, "agent");
            asm volatile("s_waitcnt vmcnt(0)" ::: "memory");
        }
    }
    __syncthreads();
}

struct Ctx { LAS uchar* lds; int tid, lane, wave, G, bid; uchar* ws; const void* const* in; float* out; };
#define XP_x(X) ((const float*)(X).in[0])
#define XP_pos(X) ((const int*)(X).in[1])
#define XP_ln_mix_w(X) ((const float*)(X).in[2])
#define XP_w_in(X) ((const float*)(X).in[3])
#define XP_conv_w(X) ((const float*)(X).in[4])
#define XP_conv_b(X) ((const float*)(X).in[5])
#define XP_dt_bias(X) ((const float*)(X).in[6])
#define XP_a_log(X) ((const float*)(X).in[7])
#define XP_d_skip(X) ((const float*)(X).in[8])
#define XP_ssm_norm_w(X) ((const float*)(X).in[9])
#define XP_w_out(X) ((const float*)(X).in[10])
#define XP_ln_ffn_w(X) ((const float*)(X).in[11])
#define XP_w_router(X) ((const float*)(X).in[12])
#define XP_b_router(X) ((const float*)(X).in[13])
#define XP_w_gu(X) ((const float*)(X).in[14])
#define XP_b_gu(X) ((const float*)(X).in[15])
#define XP_w_d(X) ((const float*)(X).in[16])
#define XP_b_d(X) ((const float*)(X).in[17])
#define XP_ln_final_w(X) ((const float*)(X).in[18])
#define XP_WinT(X) ((bf16*)((X).ws + WS_WINT))
#define XP_WoutT(X) ((bf16*)((X).ws + WS_WOUTT))
#define XP_WguT(X) ((uchar*)((X).ws + WS_WGUT))
#define XP_WdT(X) ((uchar*)((X).ws + WS_WDT))
#define XP_U(X) ((bf16*)((X).ws + WS_U))
#define XP_U2(X) ((uchar*)((X).ws + WS_U2))
#define XP_MIX(X) ((bf16*)((X).ws + WS_MIX))
#define XP_XBC(X) ((bf16*)((X).ws + WS_XBC))
#define XP_KV(X) ((bf16*)((X).ws + WS_KV))
#define XP_SST(X) ((bf16*)((X).ws + WS_SST))
#define XP_PROJ(X) ((bf16*)((X).ws + WS_PROJ))
#define XP_ACT(X) ((uchar*)((X).ws + WS_ACT))
#define XP_YR(X) ((bf16*)((X).ws + WS_YR))
#define XP_COS(X) ((float*)((X).ws + WS_COS))
#define XP_SIN(X) ((float*)((X).ws + WS_SIN))
#define XP_Hh(X) ((float*)((X).ws + WS_H))
#define XP_ADEC(X) ((float*)((X).ws + WS_ADEC))
#define XP_TOPW(X) ((float*)((X).ws + WS_TOPW))
#define XP_TOPI(X) ((int*)((X).ws + WS_TOPI))
#define XP_TOPR(X) ((int*)((X).ws + WS_TOPR))
#define XP_LIST(X) ((int*)((X).ws + WS_LIST))
#define XP_ctl(X) ((unsigned*)((X).ws + WS_CTL))
#define XP_WRH(X) ((bf16*)((X).ws + WS_WRH))
#define XP_WRL(X) ((bf16*)((X).ws + WS_WRL))


__device__ __forceinline__ bf16x8 tr_frag(LAS uchar* p, int rstep) {
    const s16x4 a = __builtin_amdgcn_ds_read_tr16_b64_v4i16((LAS s16x4*)p);
    const s16x4 b = __builtin_amdgcn_ds_read_tr16_b64_v4i16((LAS s16x4*)(p + rstep));
    return (bf16x8){a[0], a[1], a[2], a[3], b[0], b[1], b[2], b[3]};
}
__device__ __forceinline__ f32x4 mma16(bf16x8 xrow, bf16x8 ycol, f32x4 c) { return __builtin_amdgcn_mfma_f32_16x16x32_bf16(xrow, ycol, c, 0, 0, 0); }
__device__ __forceinline__ float wave_incl_scan(float v, int lane) {
#pragma unroll
    for (int o = 1; o < 64; o <<= 1) { const float t = __shfl_up(v, o); if (lane >= o) v += t; }
    return v;
}
__device__ __forceinline__ void rope8(const u32x4 k1, const u32x4 k2, const f32x4 c0, const f32x4 c1, const f32x4 s0, const f32x4 s1, const float sc, u32x4& o1, u32x4& o2) {
    float r1[8], r2[8];
#pragma unroll
    for (int m = 0; m < 4; ++m) {
        const float a0 = bf_lo(k1[m]), a1 = bf_hi(k1[m]), b0 = bf_lo(k2[m]), b1 = bf_hi(k2[m]);
        const float cs0 = (m < 2) ? c0[2 * m] : c1[2 * m - 4], cs1 = (m < 2) ? c0[2 * m + 1] : c1[2 * m - 3];
        const float sn0 = (m < 2) ? s0[2 * m] : s1[2 * m - 4], sn1 = (m < 2) ? s0[2 * m + 1] : s1[2 * m - 3];
        r1[2 * m] = (a0 * cs0 - b0 * sn0) * sc; r1[2 * m + 1] = (a1 * cs1 - b1 * sn1) * sc;
        r2[2 * m] = (b0 * cs0 + a0 * sn0) * sc; r2[2 * m + 1] = (b1 * cs1 + a1 * sn1) * sc;
    }
    o1.x = pk_bf16(r1[0], r1[1]); o1.y = pk_bf16(r1[2], r1[3]); o1.z = pk_bf16(r1[4], r1[5]); o1.w = pk_bf16(r1[6], r1[7]);
    o2.x = pk_bf16(r2[0], r2[1]); o2.y = pk_bf16(r2[2], r2[3]); o2.z = pk_bf16(r2[4], r2[5]); o2.w = pk_bf16(r2[6], r2[7]);
}

__device__ __forceinline__ void tr_decode(const Ctx& X, int r, const float*& W, bf16*& WT, int& N, int& kb, int& nb) {
    constexpr int I_IN = 32 * 209;
    if (r < I_IN) { W = XP_w_in(X); WT = XP_WinT(X); N = NPROJ; }
    else { r -= I_IN; W = XP_w_out(X); WT = XP_WoutT(X); N = D; }
    const int nbn = (N + 31) >> 5; kb = r / nbn; nb = r - kb * nbn;
}
__device__ __forceinline__ void tr8_item(const float* W, int N, uchar* WT, int kb, int nb, int lane) {
    const int k0 = kb * 128 + 16 * (lane & 7), n0 = nb * 32 + 4 * (lane >> 3);
    f32x4 v[16];
#pragma unroll
    for (int i = 0; i < 16; ++i) v[i] = *(const f32x4*)(W + (size_t)(k0 + i) * N + n0);
#pragma unroll
    for (int j = 0; j < 4; ++j) { u32x4 o;
        o.x = pk_fp8x4(v[0][j] * W8_SCALE, v[1][j] * W8_SCALE, v[2][j] * W8_SCALE, v[3][j] * W8_SCALE); o.y = pk_fp8x4(v[4][j] * W8_SCALE, v[5][j] * W8_SCALE, v[6][j] * W8_SCALE, v[7][j] * W8_SCALE);
        o.z = pk_fp8x4(v[8][j] * W8_SCALE, v[9][j] * W8_SCALE, v[10][j] * W8_SCALE, v[11][j] * W8_SCALE); o.w = pk_fp8x4(v[12][j] * W8_SCALE, v[13][j] * W8_SCALE, v[14][j] * W8_SCALE, v[15][j] * W8_SCALE);
        *(u32x4*)(WT + (size_t)(n0 + j) * 2048 + k0) = o; }
}
__device__ __forceinline__ void tr_load(const float* W, int N, int kb, int nb, int lane, f32x4 (&v)[8]) {
    const int k0 = kb * 64 + 8 * (lane & 7), n0 = nb * 32 + 4 * (lane >> 3);
    if (n0 < N) {
#pragma unroll
        for (int i = 0; i < 8; ++i) v[i] = *(const f32x4*)(W + (size_t)(k0 + i) * N + n0);
    }
}
__device__ __forceinline__ void tr_store(bf16* WT, int N, int kb, int nb, int lane, const f32x4 (&v)[8]) {
    const int k0 = kb * 64 + 8 * (lane & 7), n0 = nb * 32 + 4 * (lane >> 3);
    if (n0 < N) {
#pragma unroll
        for (int j = 0; j < 4; ++j) { u32x4 o; o.x = pk_bf16(v[0][j], v[1][j]); o.y = pk_bf16(v[2][j], v[3][j]); o.z = pk_bf16(v[4][j], v[5][j]); o.w = pk_bf16(v[6][j], v[7][j]);
            *(u32x4*)(WT + (size_t)(n0 + j) * 2048 + k0) = o; }
    }
}
__device__ __forceinline__ void p0_prologue(Ctx& X) {
    const int gw = X.bid * NWAVES + X.wave, NGW = X.G * NWAVES, lane = X.lane;
    const int gt = X.bid * NTHR + X.tid, NGT = X.G * NTHR;
    for (int m = gw; m < T; m += NGW) {
        const f32x4* xr = (const f32x4*)(XP_x(X) + (size_t)m * D) + lane; const f32x4* wr_ = (const f32x4*)XP_ln_mix_w(X) + lane;
        f32x4 v[8]; float s = 0.f;
#pragma unroll
        for (int j = 0; j < 8; ++j) { v[j] = xr[64 * j]; s += (v[j].x * v[j].x + v[j].y * v[j].y) + (v[j].z * v[j].z + v[j].w * v[j].w); }
        const float rstd = rsqrtf(wave_sum(s) * (1.f / D) + EPS);
        u32x2* o8 = (u32x2*)(XP_U(X) + (size_t)m * D) + lane;
#pragma unroll
        for (int j = 0; j < 8; ++j) { const f32x4 w = wr_[64 * j]; u32x2 o; o.x = pk_bf16(v[j].x * rstd * w.x, v[j].y * rstd * w.y); o.y = pk_bf16(v[j].z * rstd * w.z, v[j].w * rstd * w.w); o8[64 * j] = o; }
    }
    for (int idx = gt; idx < T * 128; idx += NGT) {
        const int t = idx >> 7, i = idx & 127;
        const double ang = (double)XP_pos(X)[t] * INV_FREQ[i];
        double rev = ang * 0.15915494309189533577; rev -= floor(rev);
        const float f = (float)rev;
        XP_COS(X)[idx] = __builtin_amdgcn_cosf(f); XP_SIN(X)[idx] = __builtin_amdgcn_sinf(f);
    }
    { u32x4* p = (u32x4*)(XP_WinT(X) + (size_t)NPROJ * D); const int n16 = (LDP - NPROJ) * D * 2 / 16; const u32x4 z = {0u, 0u, 0u, 0u};
      for (int i = gt; i < n16; i += NGT) p[i] = z; }
    for (int idx = gt; idx < NE * D; idx += NGT) { const int e = idx >> 11, d = idx & 2047;
        const float wv = XP_ln_ffn_w(X)[d] * XP_w_router(X)[d * NE + e]; const unsigned hb = pk_bf16(wv, 0.f) & 0xffffu; const float lo = wv - __uint_as_float(hb << 16);
        XP_WRH(X)[idx] = (bf16)hb; XP_WRL(X)[idx] = (bf16)(pk_bf16(lo, 0.f) & 0xffffu); }
    constexpr int NIT = 32 * 209 + 32 * 64;
    for (int it = gw; it < NIT; it += 2 * NGW) {
        const float *W0, *W1 = nullptr; bf16 *T0, *T1 = nullptr; int N0, N1 = 0, kb0, kb1 = 0, nb0, nb1 = 0;
        f32x4 v0[8], v1[8];
        tr_decode(X, it, W0, T0, N0, kb0, nb0);
        const bool two = (it + NGW) < NIT;
        if (two) tr_decode(X, it + NGW, W1, T1, N1, kb1, nb1);
        tr_load(W0, N0, kb0, nb0, lane, v0);
        if (two) tr_load(W1, N1, kb1, nb1, lane, v1);
        tr_store(T0, N0, kb0, nb0, lane, v0);
        if (two) tr_store(T1, N1, kb1, nb1, lane, v1);
    }
    constexpr int I_GU8 = 32 * 16 * 128, I_D8 = 32 * 16 * 64;
    for (int it = gw; it < I_GU8 + I_D8; it += NGW) {
        if (it < I_GU8) { const int e = it >> 11, r = it & 2047; tr8_item(XP_w_gu(X) + (size_t)e * D * (2 * DFF), 2 * DFF, XP_WguT(X) + (size_t)e * (2 * DFF) * D, r >> 7, r & 127, lane); }
        else { const int i2 = it - I_GU8, e = i2 >> 10, r = i2 & 1023; tr8_item(XP_w_d(X) + (size_t)e * DFF * D, D, XP_WdT(X) + (size_t)e * D * DFF, r >> 6, r & 63, lane); }
    }
}

__device__ __forceinline__ void p2_ret(Ctx& X, int unit) {
    const int c = unit >> 2, h = unit & 3, t0 = c * CH, tid = X.tid, lane = X.lane, w = X.wave;
    LAS uchar* Vt = X.lds; LAS uchar* Kt = X.lds + 69632;
#pragma unroll 4
    for (int i = 0; i < 8; ++i) { const int q = tid + 512 * i, l = q >> 5, vc = q & 31;
        const u32x4 v = *(const u32x4*)(XP_PROJ(X) + (size_t)(t0 + l) * LDP + C_V + h * 256 + vc * 8);
        *(LAS u32x4*)(Vt + l * 544 + vc * 16) = v; }
    const float lg = LG2_GAMMA[h];
#pragma unroll 2
    for (int i = 0; i < 4; ++i) { const int q = tid + 512 * i, l = q >> 4, ic = q & 15;
        const bf16* kp = XP_PROJ(X) + (size_t)(t0 + l) * LDP + C_K + h * 256 + ic * 8;
        const u32x4 k1 = *(const u32x4*)kp, k2 = *(const u32x4*)(kp + 128);
        const float* cp = XP_COS(X) + (size_t)(t0 + l) * 128 + ic * 8; const float* sp = XP_SIN(X) + (size_t)(t0 + l) * 128 + ic * 8;
        const f32x4 c0 = *(const f32x4*)cp, c1 = *(const f32x4*)(cp + 4), s0 = *(const f32x4*)sp, s1 = *(const f32x4*)(sp + 4);
        u32x4 o1, o2; rope8(k1, k2, c0, c1, s0, s1, 0.0625f * exp2f(lg * (float)(127 - l)), o1, o2);
        *(LAS u32x4*)(Kt + l * 544 + ic * 16) = o1; *(LAS u32x4*)(Kt + l * 544 + 256 + ic * 16) = o2; }
    __syncthreads();
    const int fr = lane & 15, fq = lane >> 4, trs = (8 * fq + ((lane & 15) >> 2)) * 544 + 8 * (lane & 3);
    f32x4 acc[2][16];
#pragma unroll
    for (int a = 0; a < 2; ++a)
#pragma unroll
        for (int n = 0; n < 16; ++n) acc[a][n] = (f32x4){0.f, 0.f, 0.f, 0.f};
#pragma unroll 1
    for (int ks = 0; ks < 4; ++ks) {
        const bf16x8 af0 = tr_frag(Vt + (32 * ks) * 544 + (16 * w) * 2 + trs, 4 * 544);
        const bf16x8 af1 = tr_frag(Vt + (32 * ks) * 544 + (128 + 16 * w) * 2 + trs, 4 * 544);
#pragma unroll
        for (int n = 0; n < 16; ++n) { const bf16x8 bf = tr_frag(Kt + (32 * ks) * 544 + (16 * n) * 2 + trs, 4 * 544);
            acc[0][n] = mma16(bf, af0, acc[0][n]); acc[1][n] = mma16(bf, af1, acc[1][n]); }
    }
    bf16* outp = XP_KV(X) + (size_t)(c * 4 + h) * 65536;
#pragma unroll
    for (int a = 0; a < 2; ++a)
#pragma unroll
        for (int n = 0; n < 16; ++n) { u32x2 o; o.x = pk_bf16(acc[a][n][0], acc[a][n][1]); o.y = pk_bf16(acc[a][n][2], acc[a][n][3]);
            *(u32x2*)(outp + (size_t)(128 * a + 16 * w + fr) * 256 + 16 * n + 4 * fq) = o; }
    __syncthreads();
}
__device__ __forceinline__ void conv8(const Ctx& X, int t, int cx, float (&o)[8]) {
    const f32x4 b0 = *(const f32x4*)(XP_conv_b(X) + cx), b1 = *(const f32x4*)(XP_conv_b(X) + cx + 4);
    o[0] = b0.x; o[1] = b0.y; o[2] = b0.z; o[3] = b0.w; o[4] = b1.x; o[5] = b1.y; o[6] = b1.z; o[7] = b1.w;
#pragma unroll
    for (int j = 0; j < 4; ++j) { const int tt = t - 3 + j;
        if (tt >= 0) { const u32x4 v = *(const u32x4*)(XP_PROJ(X) + (size_t)tt * LDP + C_X + cx);
            const f32x4 w0 = *(const f32x4*)(XP_conv_w(X) + j * XBCW + cx), w1 = *(const f32x4*)(XP_conv_w(X) + j * XBCW + cx + 4);
            o[0] += w0.x * bf_lo(v.x); o[1] += w0.y * bf_hi(v.x); o[2] += w0.z * bf_lo(v.y); o[3] += w0.w * bf_hi(v.y);
            o[4] += w1.x * bf_lo(v.z); o[5] += w1.y * bf_hi(v.z); o[6] += w1.z * bf_lo(v.w); o[7] += w1.w * bf_hi(v.w); } }
#pragma unroll
    for (int i = 0; i < 8; ++i) o[i] = silu_f(o[i]);
}
__device__ __forceinline__ void p2_ssd(Ctx& X, int unit) {
    const int c = unit >> 2, g = (unit >> 1) & 1, hh = unit & 1, t0 = c * CH, tid = X.tid, lane = X.lane, w = X.wave;
    LAS uchar* Xd = X.lds; LAS uchar* Bc = X.lds + 69632;
    LAS float* dtS = (LAS float*)(X.lds + 106496); LAS float* acS = (LAS float*)(X.lds + 108544);
    if (w < 4) { const int h = 8 * g + 4 * hh + w, l0 = 2 * lane;
        const float dtb = XP_dt_bias(X)[h], A = -expf(XP_a_log(X)[h]);
        const float d0 = softplus_f(bf2f(XP_PROJ(X)[(size_t)(t0 + l0) * LDP + C_DT + h]) + dtb), d1 = softplus_f(bf2f(XP_PROJ(X)[(size_t)(t0 + l0 + 1) * LDP + C_DT + h]) + dtb);
        const float a0 = d0 * A, a1 = d1 * A, s = a0 + a1, incl = wave_incl_scan(s, lane);
        dtS[w * 128 + l0] = d0; dtS[w * 128 + l0 + 1] = d1; acS[w * 128 + l0] = incl - a1; acS[w * 128 + l0 + 1] = incl;
        if (lane == 63) XP_ADEC(X)[c * 16 + h] = expf(incl); }
    __syncthreads();
    for (int it = tid; it < 128 * 56; it += NTHR) { const int l = it / 56, j = it - l * 56;
        int cx; if (j < 32) cx = 512 * g + 256 * hh + 8 * j; else if (j < 48) cx = 1024 + 128 * g + 8 * (j - 32); else cx = 1280 + 128 * g + 64 * hh + 8 * (j - 48);
        float o[8]; conv8(X, t0 + l, cx, o);
        u32x4 ov; ov.x = pk_bf16(o[0], o[1]); ov.y = pk_bf16(o[2], o[3]); ov.z = pk_bf16(o[4], o[5]); ov.w = pk_bf16(o[6], o[7]);
        if (j < 32) { const int e = j >> 3; const float sc = dtS[e * 128 + l] * __expf(acS[e * 128 + 127] - acS[e * 128 + l]);
            u32x4 os; os.x = pk_bf16(o[0] * sc, o[1] * sc); os.y = pk_bf16(o[2] * sc, o[3] * sc); os.z = pk_bf16(o[4] * sc, o[5] * sc); os.w = pk_bf16(o[6] * sc, o[7] * sc);
            *(LAS u32x4*)(Xd + l * 544 + j * 16) = os; *(u32x4*)(XP_XBC(X) + (size_t)(t0 + l) * XBCW + cx) = ov; }
        else if (j < 48) { *(LAS u32x4*)(Bc + l * 288 + (j - 32) * 16) = ov; if (hh == 0) *(u32x4*)(XP_XBC(X) + (size_t)(t0 + l) * XBCW + cx) = ov; }
        else *(u32x4*)(XP_XBC(X) + (size_t)(t0 + l) * XBCW + cx) = ov; }
    __syncthreads();
    const int fr = lane & 15, fq = lane >> 4, q4 = (lane & 15) >> 2, p4 = lane & 3;
    const int trx = (8 * fq + q4) * 544 + 8 * p4, trb = (8 * fq + q4) * 288 + 8 * p4;
    f32x4 acc[2][8];
#pragma unroll
    for (int a = 0; a < 2; ++a)
#pragma unroll
        for (int n = 0; n < 8; ++n) acc[a][n] = (f32x4){0.f, 0.f, 0.f, 0.f};
#pragma unroll 1
    for (int ks = 0; ks < 4; ++ks) {
        const bf16x8 af0 = tr_frag(Xd + (32 * ks) * 544 + (16 * w) * 2 + trx, 4 * 544);
        const bf16x8 af1 = tr_frag(Xd + (32 * ks) * 544 + (128 + 16 * w) * 2 + trx, 4 * 544);
#pragma unroll
        for (int n = 0; n < 8; ++n) { const bf16x8 bf = tr_frag(Bc + (32 * ks) * 288 + (16 * n) * 2 + trb, 4 * 288);
            acc[0][n] = mma16(bf, af0, acc[0][n]); acc[1][n] = mma16(bf, af1, acc[1][n]); }
    }
#pragma unroll
    for (int a = 0; a < 2; ++a) { const int m = 128 * a + 16 * w + fr, h = 8 * g + 4 * hh + (m >> 6), p = m & 63;
        bf16* outp = XP_SST(X) + ((size_t)(c * 16 + h) * 64 + p) * 128;
#pragma unroll
        for (int n = 0; n < 8; ++n) { u32x2 o; o.x = pk_bf16(acc[a][n][0], acc[a][n][1]); o.y = pk_bf16(acc[a][n][2], acc[a][n][3]); *(u32x2*)(outp + 16 * n + 4 * fq) = o; } }
    __syncthreads();
}

__device__ __forceinline__ void p3_scan(Ctx& X) {
    const int gt = X.bid * NTHR + X.tid, NGT = X.G * NTHR;
    for (int item = gt; item < 65536 + 32768; item += NGT) {
        const bool ret = item < 65536; const int it2 = ret ? item : item - 65536;
        bf16* p = ret ? (XP_KV(X) + (size_t)it2 * 4) : (XP_SST(X) + (size_t)it2 * 4);
        const size_t stride = ret ? 262144 : 131072;
        const int head = ret ? (it2 >> 14) : (it2 >> 11);
        const float gdec = ret ? GAMMA_CHUNK[head & 3] : 0.f;
        float s0 = 0.f, s1 = 0.f, s2 = 0.f, s3 = 0.f;
        for (int c0 = 0; c0 < NCHUNK; c0 += 16) {
            u32x2 v[16]; float dec[16];
#pragma unroll
            for (int j = 0; j < 16; ++j) { v[j] = *(const u32x2*)(p + (size_t)(c0 + j) * stride); dec[j] = ret ? gdec : XP_ADEC(X)[(c0 + j) * 16 + head]; }
#pragma unroll
            for (int j = 0; j < 16; ++j) { u32x2 o; o.x = pk_bf16(s0, s1); o.y = pk_bf16(s2, s3); *(u32x2*)(p + (size_t)(c0 + j) * stride) = o;
                s0 = dec[j] * s0 + bf_lo(v[j].x); s1 = dec[j] * s1 + bf_hi(v[j].x); s2 = dec[j] * s2 + bf_lo(v[j].y); s3 = dec[j] * s3 + bf_hi(v[j].y); }
        }
    }
}

__device__ __forceinline__ void p4_ret(Ctx& X, int unit) {
    const int c = unit >> 2, h = unit & 3, t0 = c * CH, tid = X.tid, lane = X.lane, w = X.wave;
    LAS uchar* R1 = X.lds; LAS uchar* R2 = X.lds + 69632;
    const float lg = LG2_GAMMA[h];
#pragma unroll 1
    for (int i = 0; i < 4; ++i) { const int q = tid + 512 * i, l = q >> 4, ic = q & 15;
        const float* cp = XP_COS(X) + (size_t)(t0 + l) * 128 + ic * 8; const float* sp = XP_SIN(X) + (size_t)(t0 + l) * 128 + ic * 8;
        const f32x4 c0 = *(const f32x4*)cp, c1 = *(const f32x4*)(cp + 4), s0 = *(const f32x4*)sp, s1 = *(const f32x4*)(sp + 4);
        const bf16* qp = XP_PROJ(X) + (size_t)(t0 + l) * LDP + C_Q + h * 256 + ic * 8; const bf16* kp = XP_PROJ(X) + (size_t)(t0 + l) * LDP + C_K + h * 256 + ic * 8;
        u32x4 o1, o2;
        rope8(*(const u32x4*)qp, *(const u32x4*)(qp + 128), c0, c1, s0, s1, 1.0f, o1, o2);
        *(LAS u32x4*)(R1 + l * 544 + ic * 16) = o1; *(LAS u32x4*)(R1 + l * 544 + 256 + ic * 16) = o2;
        rope8(*(const u32x4*)kp, *(const u32x4*)(kp + 128), c0, c1, s0, s1, 0.0625f, o1, o2);
        *(LAS u32x4*)(R2 + l * 544 + ic * 16) = o1; *(LAS u32x4*)(R2 + l * 544 + 256 + ic * 16) = o2; }
    __syncthreads();
    const int fr = lane & 15, fq = lane >> 4, q4 = (lane & 15) >> 2, p4 = lane & 3, l = 16 * w + fr;
    f32x4 sc[8];
#pragma unroll
    for (int n = 0; n < 8; ++n) sc[n] = (f32x4){0.f, 0.f, 0.f, 0.f};
#pragma unroll 2
    for (int ks = 0; ks < 8; ++ks) {
        const bf16x8 af = *(const LAS bf16x8*)(R1 + l * 544 + (32 * ks + 8 * fq) * 2);
#pragma unroll
        for (int n = 0; n < 8; ++n) if (n <= w) { const bf16x8 bf = *(const LAS bf16x8*)(R2 + (16 * n + fr) * 544 + (32 * ks + 8 * fq) * 2); sc[n] = mma16(bf, af, sc[n]); }
    }
    bf16x8 scf[4];
#pragma unroll
    for (int k2 = 0; k2 < 4; ++k2) { float v[8];
#pragma unroll
        for (int tq = 0; tq < 2; ++tq)
#pragma unroll
            for (int j = 0; j < 4; ++j) { const int s = 16 * (2 * k2 + tq) + 4 * fq + j; v[4 * tq + j] = (s <= l) ? sc[2 * k2 + tq][j] * exp2f(lg * (float)(l - s)) : 0.f; }
        u32x4 pk; pk.x = pk_bf16(v[0], v[1]); pk.y = pk_bf16(v[2], v[3]); pk.z = pk_bf16(v[4], v[5]); pk.w = pk_bf16(v[6], v[7]);
        scf[k2] = __builtin_bit_cast(bf16x8, pk); }
    __syncthreads();
    f32x4 acc[16];
#pragma unroll
    for (int n = 0; n < 16; ++n) acc[n] = (f32x4){0.f, 0.f, 0.f, 0.f};
    const bf16* prev = XP_KV(X) + (size_t)(c * 4 + h) * 65536;
#pragma unroll 1
    for (int dh = 0; dh < 2; ++dh) {
#pragma unroll 4
        for (int i = 0; i < 8; ++i) { const int q = tid + 512 * i, v = q >> 4, dc = q & 15;
            *(LAS u32x4*)(R2 + v * 272 + dc * 16) = *(const u32x4*)(prev + (size_t)v * 256 + dh * 128 + dc * 8); }
        __syncthreads();
#pragma unroll 2
        for (int ks = 0; ks < 4; ++ks) {
            const bf16x8 af = *(const LAS bf16x8*)(R1 + l * 544 + (128 * dh + 32 * ks + 8 * fq) * 2);
#pragma unroll
            for (int n = 0; n < 16; ++n) { const bf16x8 bf = *(const LAS bf16x8*)(R2 + (16 * n + fr) * 272 + (32 * ks + 8 * fq) * 2); acc[n] = mma16(bf, af, acc[n]); }
        }
        __syncthreads();
    }
    { const float qd = exp2f(lg * (float)(l + 1));
#pragma unroll
      for (int n = 0; n < 16; ++n) acc[n] = acc[n] * qd; }
#pragma unroll 4
    for (int i = 0; i < 8; ++i) { const int q = tid + 512 * i, s = q >> 5, vc = q & 31;
        *(LAS u32x4*)(R2 + s * 544 + vc * 16) = *(const u32x4*)(XP_PROJ(X) + (size_t)(t0 + s) * LDP + C_V + h * 256 + vc * 8); }
    __syncthreads();
    const int trp = (4 * fq + q4) * 544 + 8 * p4;
#pragma unroll
    for (int k2 = 0; k2 < 4; ++k2) if (2 * k2 <= w) {
#pragma unroll
        for (int n = 0; n < 16; ++n) { const bf16x8 bf = tr_frag(R2 + (32 * k2) * 544 + (16 * n) * 2 + trp, 16 * 544); acc[n] = mma16(bf, scf[k2], acc[n]); }
    }
    float ss = 0.f;
#pragma unroll
    for (int n = 0; n < 16; ++n) ss += (acc[n][0] * acc[n][0] + acc[n][1] * acc[n][1]) + (acc[n][2] * acc[n][2] + acc[n][3] * acc[n][3]);
    ss += __shfl_xor(ss, 16); ss += __shfl_xor(ss, 32);
    const float rstd = rsqrtf(ss * (1.f / 256.f) + EPS);
    const bf16* gp = XP_PROJ(X) + (size_t)(t0 + l) * LDP + C_G + h * 256 + 4 * fq; bf16* op = XP_MIX(X) + (size_t)(t0 + l) * D + h * 256 + 4 * fq;
#pragma unroll
    for (int n = 0; n < 16; ++n) { const u32x2 gv = *(const u32x2*)(gp + 16 * n);
        u32x2 o; o.x = pk_bf16(acc[n][0] * rstd * silu_f(bf_lo(gv.x)), acc[n][1] * rstd * silu_f(bf_hi(gv.x))); o.y = pk_bf16(acc[n][2] * rstd * silu_f(bf_lo(gv.y)), acc[n][3] * rstd * silu_f(bf_hi(gv.y)));
        *(u32x2*)(op + 16 * n) = o; }
    __syncthreads();
}

__device__ __forceinline__ void p4_ssd(Ctx& X, int unit) {
    const int c = unit >> 1, g = unit & 1, t0 = c * CH, tid = X.tid, lane = X.lane, w = X.wave;
    LAS uchar* Cc = X.lds; LAS uchar* Bc = X.lds + 34816;
    LAS uchar* HP = X.lds + 34816;
    LAS float* dtS = (LAS float*)(X.lds + 110592); LAS float* acS = (LAS float*)(X.lds + 114688);
    { const int h = 8 * g + w, l0 = 2 * lane;
      const float dtb = XP_dt_bias(X)[h], A = -expf(XP_a_log(X)[h]);
      const float d0 = softplus_f(bf2f(XP_PROJ(X)[(size_t)(t0 + l0) * LDP + C_DT + h]) + dtb), d1 = softplus_f(bf2f(XP_PROJ(X)[(size_t)(t0 + l0 + 1) * LDP + C_DT + h]) + dtb);
      const float a0 = d0 * A, a1 = d1 * A, incl = wave_incl_scan(a0 + a1, lane);
      dtS[w * 128 + l0] = d0; dtS[w * 128 + l0 + 1] = d1; acS[w * 128 + l0] = incl - a1; acS[w * 128 + l0 + 1] = incl; }
#pragma unroll
    for (int i = 0; i < 4; ++i) { const int q = tid + 512 * i, l = q >> 4, nc = q & 15;
        *(LAS u32x4*)(Bc + l * 272 + nc * 16) = *(const u32x4*)(XP_XBC(X) + (size_t)(t0 + l) * XBCW + 1024 + 128 * g + nc * 8);
        *(LAS u32x4*)(Cc + l * 272 + nc * 16) = *(const u32x4*)(XP_XBC(X) + (size_t)(t0 + l) * XBCW + 1280 + 128 * g + nc * 8); }
    __syncthreads();
    const int fr = lane & 15, fq = lane >> 4, q4 = (lane & 15) >> 2, p4 = lane & 3, l = 16 * w + fr;
    f32x4 cb[8]; bf16x8 cfr[4];
#pragma unroll
    for (int n = 0; n < 8; ++n) cb[n] = (f32x4){0.f, 0.f, 0.f, 0.f};
#pragma unroll
    for (int ks = 0; ks < 4; ++ks) {
        cfr[ks] = *(const LAS bf16x8*)(Cc + l * 272 + (32 * ks + 8 * fq) * 2);
#pragma unroll
        for (int n = 0; n < 8; ++n) if (n <= w) { const bf16x8 bf = *(const LAS bf16x8*)(Bc + (16 * n + fr) * 272 + (32 * ks + 8 * fq) * 2); cb[n] = mma16(bf, cfr[ks], cb[n]); }
    }
    __syncthreads();
    float ss = 0.f;
    const int trp = (4 * fq + q4) * 144 + 8 * p4;
    const bf16* xp = XP_XBC(X) + (size_t)(t0 + l) * XBCW + 512 * g + 4 * fq; const bf16* zp = XP_PROJ(X) + (size_t)(t0 + l) * LDP + C_Z + 512 * g + 4 * fq;
    bf16* op = XP_MIX(X) + (size_t)(t0 + l) * D + 1024 + 512 * g + 4 * fq;
#pragma unroll 1
    for (int hp = 0; hp < 4; ++hp) {
#pragma unroll
        for (int i = 0; i < 4; ++i) { const int q = tid + 512 * i, e2 = q >> 10, s = (q >> 3) & 127, pc = q & 7, e = 2 * hp + e2;
            const u32x4 v = *(const u32x4*)(XP_XBC(X) + (size_t)(t0 + s) * XBCW + 512 * g + 64 * e + pc * 8); const float d = dtS[e * 128 + s];
            u32x4 o; o.x = pk_bf16(bf_lo(v.x) * d, bf_hi(v.x) * d); o.y = pk_bf16(bf_lo(v.y) * d, bf_hi(v.y) * d); o.z = pk_bf16(bf_lo(v.z) * d, bf_hi(v.z) * d); o.w = pk_bf16(bf_lo(v.w) * d, bf_hi(v.w) * d);
            *(LAS u32x4*)(HP + e2 * 18432 + s * 144 + pc * 16) = o; }
#pragma unroll
        for (int i = 0; i < 4; ++i) { const int q = tid + 512 * i, e2 = q >> 10, p = (q >> 4) & 63, nc = q & 15, e = 2 * hp + e2;
            *(LAS u32x4*)(HP + 36864 + e2 * 17408 + p * 272 + nc * 16) = *(const u32x4*)(XP_SST(X) + ((size_t)(c * 16 + 8 * g + e) * 64 + p) * 128 + nc * 8); }
        __syncthreads();
#pragma unroll 1
        for (int e2 = 0; e2 < 2; ++e2) { const int e = 2 * hp + e2;
            LAS uchar* Xh = HP + e2 * 18432; LAS uchar* Ph = HP + 36864 + e2 * 17408;
            f32x4 y[4];
#pragma unroll
            for (int n = 0; n < 4; ++n) y[n] = (f32x4){0.f, 0.f, 0.f, 0.f};
#pragma unroll
            for (int ks = 0; ks < 4; ++ks)
#pragma unroll
                for (int n = 0; n < 4; ++n) { const bf16x8 bf = *(const LAS bf16x8*)(Ph + (16 * n + fr) * 272 + (32 * ks + 8 * fq) * 2); y[n] = mma16(bf, cfr[ks], y[n]); }
            const float al = acS[e * 128 + l], el = __expf(al);
#pragma unroll
            for (int n = 0; n < 4; ++n) y[n] = y[n] * el;
#pragma unroll
            for (int k2 = 0; k2 < 4; ++k2) if (2 * k2 <= w) { float v[8];
#pragma unroll
                for (int tq = 0; tq < 2; ++tq) { const int s0 = 16 * (2 * k2 + tq) + 4 * fq; const f32x4 as = *(const LAS f32x4*)(acS + e * 128 + s0);
#pragma unroll
                    for (int j = 0; j < 4; ++j) v[4 * tq + j] = (s0 + j <= l) ? cb[2 * k2 + tq][j] * __expf(al - as[j]) : 0.f; }
                u32x4 pk; pk.x = pk_bf16(v[0], v[1]); pk.y = pk_bf16(v[2], v[3]); pk.z = pk_bf16(v[4], v[5]); pk.w = pk_bf16(v[6], v[7]);
                const bf16x8 gf = __builtin_bit_cast(bf16x8, pk);
#pragma unroll
                for (int n = 0; n < 4; ++n) { const bf16x8 bf = tr_frag(Xh + (32 * k2) * 144 + (16 * n) * 2 + trp, 16 * 144); y[n] = mma16(bf, gf, y[n]); }
            }
            const float dsk = XP_d_skip(X)[8 * g + e];
#pragma unroll
            for (int n = 0; n < 4; ++n) { const u32x2 xv = *(const u32x2*)(xp + 64 * e + 16 * n), zv = *(const u32x2*)(zp + 64 * e + 16 * n);
                const float t0_ = (y[n][0] + dsk * bf_lo(xv.x)) * silu_f(bf_lo(zv.x)), t1_ = (y[n][1] + dsk * bf_hi(xv.x)) * silu_f(bf_hi(zv.x));
                const float t2_ = (y[n][2] + dsk * bf_lo(xv.y)) * silu_f(bf_lo(zv.y)), t3_ = (y[n][3] + dsk * bf_hi(xv.y)) * silu_f(bf_hi(zv.y));
                ss += (t0_ * t0_ + t1_ * t1_) + (t2_ * t2_ + t3_ * t3_);
                u32x2 o; o.x = pk_bf16(t0_, t1_); o.y = pk_bf16(t2_, t3_); *(u32x2*)(op + 64 * e + 16 * n) = o; }
        }
        __syncthreads();
    }
    ss += __shfl_xor(ss, 16); ss += __shfl_xor(ss, 32);
    const float rstd = rsqrtf(ss * (1.f / 512.f) + EPS);
    const float* nw = XP_ssm_norm_w(X) + 512 * g + 4 * fq;
#pragma unroll 4
    for (int i = 0; i < 32; ++i) { const f32x4 wv = *(const f32x4*)(nw + 16 * i); const u32x2 t = *(const u32x2*)(op + 16 * i);
        u32x2 o; o.x = pk_bf16(bf_lo(t.x) * rstd * wv.x, bf_hi(t.x) * rstd * wv.y); o.y = pk_bf16(bf_lo(t.y) * rstd * wv.z, bf_hi(t.y) * rstd * wv.w);
        *(u32x2*)(op + 16 * i) = o; }
    __syncthreads();
}

__device__ __forceinline__ void p6_router(Ctx& X) {
    const int tid = X.tid, lane = X.lane, w = X.wave, fr = lane & 15, fq = lane >> 4;
    LAS float* part = (LAS float*)X.lds;
    LAS float* ssq = (LAS float*)(X.lds + 32768);
    LAS float* lgt = (LAS float*)(X.lds + 32768 + 1024);
    LAS float* rs = (LAS float*)(X.lds + 32768 + 1024 + 4096);
    for (int item = X.bid; item < T / 32; item += X.G) {
        const int tb = item * 32;
        f32x4 acc[2][2]; float ss[2] = {0.f, 0.f};
#pragma unroll
        for (int a = 0; a < 2; ++a)
#pragma unroll
            for (int n = 0; n < 2; ++n) acc[a][n] = (f32x4){0.f, 0.f, 0.f, 0.f};
#pragma unroll 2
        for (int ks = 0; ks < 8; ++ks) { const int kb = 256 * w + 32 * ks + 8 * fq;
            bf16x8 ah[2], al[2], bh[2], bl[2];
#pragma unroll
            for (int mt = 0; mt < 2; ++mt) { const float* hp = XP_Hh(X) + (size_t)(tb + 16 * mt + fr) * D + kb;
                const f32x4 x0 = *(const f32x4*)hp, x1 = *(const f32x4*)(hp + 4);
                ss[mt] += (x0.x * x0.x + x0.y * x0.y) + (x0.z * x0.z + x0.w * x0.w) + (x1.x * x1.x + x1.y * x1.y) + (x1.z * x1.z + x1.w * x1.w);
                u32x4 h, l; h.x = pk_bf16(x0.x, x0.y); h.y = pk_bf16(x0.z, x0.w); h.z = pk_bf16(x1.x, x1.y); h.w = pk_bf16(x1.z, x1.w);
                l.x = pk_bf16(x0.x - bf_lo(h.x), x0.y - bf_hi(h.x)); l.y = pk_bf16(x0.z - bf_lo(h.y), x0.w - bf_hi(h.y)); l.z = pk_bf16(x1.x - bf_lo(h.z), x1.y - bf_hi(h.z)); l.w = pk_bf16(x1.z - bf_lo(h.w), x1.w - bf_hi(h.w));
                ah[mt] = __builtin_bit_cast(bf16x8, h); al[mt] = __builtin_bit_cast(bf16x8, l); }
#pragma unroll
            for (int nt = 0; nt < 2; ++nt) { bh[nt] = *(const bf16x8*)(XP_WRH(X) + (size_t)(16 * nt + fr) * D + kb); bl[nt] = *(const bf16x8*)(XP_WRL(X) + (size_t)(16 * nt + fr) * D + kb); }
#pragma unroll
            for (int mt = 0; mt < 2; ++mt)
#pragma unroll
                for (int nt = 0; nt < 2; ++nt) { acc[mt][nt] = mma16(bh[nt], ah[mt], acc[mt][nt]); acc[mt][nt] = mma16(bl[nt], ah[mt], acc[mt][nt]); acc[mt][nt] = mma16(bh[nt], al[mt], acc[mt][nt]); }
        }
#pragma unroll
        for (int mt = 0; mt < 2; ++mt) { float q = ss[mt]; q += __shfl_xor(q, 16); q += __shfl_xor(q, 32); if (fq == 0) ssq[w * 32 + 16 * mt + fr] = q;
#pragma unroll
            for (int nt = 0; nt < 2; ++nt) *(LAS f32x4*)(part + (w * 32 + 16 * mt + fr) * 32 + 16 * nt + 4 * fq) = acc[mt][nt]; }
        __syncthreads();
        { const int tk = tid >> 4, e0 = 2 * (tid & 15); float q = 0.f, a0 = 0.f, a1 = 0.f;
#pragma unroll
          for (int ww = 0; ww < 8; ++ww) { q += ssq[ww * 32 + tk]; const f32x2 p = *(const LAS f32x2*)(part + (ww * 32 + tk) * 32 + e0); a0 += p.x; a1 += p.y; }
          const float rstd = rsqrtf(q * (1.f / D) + EPS);
          lgt[tk * 32 + e0] = a0 * rstd + XP_b_router(X)[e0]; lgt[tk * 32 + e0 + 1] = a1 * rstd + XP_b_router(X)[e0 + 1];
          if ((tid & 15) == 0) rs[tk] = rstd; }
        __syncthreads();
        if (tid < 32) { const int t = tb + tid; unsigned used = 0u; int idx[4]; float val[4];
#pragma unroll
            for (int k = 0; k < 4; ++k) { float best = -3.0e38f; int bi = 0;
#pragma unroll 8
                for (int j = 0; j < 32; ++j) { const float v = lgt[tid * 32 + j]; if (!((used >> j) & 1u) && v > best) { best = v; bi = j; } }
                used |= 1u << bi; idx[k] = bi; val[k] = best; }
            const float e1 = __expf(val[1] - val[0]), e2 = __expf(val[2] - val[0]), e3 = __expf(val[3] - val[0]), inv = 1.f / (1.f + e1 + e2 + e3);
            const float wv[4] = {inv, e1 * inv, e2 * inv, e3 * inv};
#pragma unroll
            for (int k = 0; k < 4; ++k) { const int rank = (int)atomicAdd(XP_ctl(X) + CW_CNT + 64 * idx[k], 1u);
                XP_LIST(X)[idx[k] * T + rank] = t; XP_TOPI(X)[t * 4 + k] = idx[k]; XP_TOPR(X)[t * 4 + k] = rank; XP_TOPW(X)[t * 4 + k] = wv[k]; } }
#pragma unroll 2
        for (int r = 0; r < 4; ++r) { const int tk = 4 * w + r, t = tb + tk; const float rstd = rs[tk];
            const f32x4* hr = (const f32x4*)(XP_Hh(X) + (size_t)t * D) + lane; const f32x4* wr_ = (const f32x4*)XP_ln_ffn_w(X) + lane;
            unsigned* o8 = (unsigned*)(XP_U2(X) + (size_t)t * D) + lane;
#pragma unroll
            for (int j = 0; j < 8; ++j) { const f32x4 v = hr[64 * j], wv = wr_[64 * j]; o8[64 * j] = pk_fp8x4(v.x * rstd * wv.x, v.y * rstd * wv.y, v.z * rstd * wv.z, v.w * rstd * wv.w); } }
        __syncthreads();
    }
}

__device__ __forceinline__ void moe_tables(Ctx& X) {
    LAS int* tab = (LAS int*)(X.lds + LDS_TAB);
    if (X.tid == 0) { int nb = 0;
        for (int e = 0; e < NE; ++e) { const int cnt = (int)__hip_atomic_load(XP_ctl(X) + CW_CNT + 64 * e, __ATOMIC_RELAXED, __HIP_MEMORY_SCOPE_AGENT); const int k = (cnt + 255) >> 8;
            tab[8 + e] = nb; for (int b = 0; b < k; ++b) { if (nb + b < MAXBLK) { tab[64 + nb + b] = e; tab[256 + nb + b] = (cnt - 256 * b) < 256 ? (cnt - 256 * b) : 256; } } nb += k; }
        tab[8 + NE] = nb; tab[0] = nb < MAXBLK ? nb : MAXBLK; }
    __syncthreads();
}

__device__ __forceinline__ void p9_final(Ctx& X) {
    const LAS int* tab = (const LAS int*)(X.lds + LDS_TAB);
    const int gw = X.bid * NWAVES + X.wave, NGW = X.G * NWAVES, lane = X.lane;
    for (int t = gw; t < T; t += NGW) {
        const f32x4* hr = (const f32x4*)(XP_Hh(X) + (size_t)t * D) + lane;
        f32x4 v[8];
#pragma unroll
        for (int j = 0; j < 8; ++j) v[j] = hr[64 * j];
#pragma unroll
        for (int k = 0; k < 4; ++k) { const int e = XP_TOPI(X)[t * 4 + k], r = XP_TOPR(X)[t * 4 + k]; const float wk = XP_TOPW(X)[t * 4 + k];
            const u32x2* yr = (const u32x2*)(XP_YR(X) + ((size_t)tab[8 + e] * 256 + r) * D) + lane;
#pragma unroll
            for (int j = 0; j < 8; ++j) { const u32x2 y = yr[64 * j]; v[j].x += wk * bf_lo(y.x); v[j].y += wk * bf_hi(y.x); v[j].z += wk * bf_lo(y.y); v[j].w += wk * bf_hi(y.y); } }
        float s = 0.f;
#pragma unroll
        for (int j = 0; j < 8; ++j) s += (v[j].x * v[j].x + v[j].y * v[j].y) + (v[j].z * v[j].z + v[j].w * v[j].w);
        const float rstd = rsqrtf(wave_sum(s) * (1.f / D) + EPS);
        f32x4* o = (f32x4*)(X.out + (size_t)t * D) + lane; const f32x4* wr_ = (const f32x4*)XP_ln_final_w(X) + lane;
#pragma unroll
        for (int j = 0; j < 8; ++j) { const f32x4 wv = wr_[64 * j]; f32x4 r; r.x = v[j].x * rstd * wv.x; r.y = v[j].y * rstd * wv.y; r.z = v[j].z * rstd * wv.z; r.w = v[j].w * rstd * wv.w; o[64 * j] = r; }
    }
}

#ifdef NO_P4R
#define P4R(X,u)
#else
#define P4R(X,u) p4_ret(X,u)
#endif
#ifdef NO_P4S
#define P4S(X,u)
#else
#define P4S(X,u) p4_ssd(X,u)
#endif
struct Args { const void* in[19]; float* out; uchar* ws; int ph_lo, ph_hi; };
__global__ void __launch_bounds__(NTHR, 2) fwd(Args args) {
    extern __shared__ __attribute__((aligned(16))) uchar lds_raw[];
    Ctx X;
    X.lds = (LAS uchar*)lds_raw; X.tid = threadIdx.x; X.lane = X.tid & 63; X.wave = __builtin_amdgcn_readfirstlane(X.tid >> 6); X.G = gridDim.x; X.bid = blockIdx.x;
    X.in = (const void* const*)__builtin_amdgcn_kernarg_segment_ptr(); X.out = args.out; X.ws = args.ws;
    for (int u = X.tid; u < (LDS_BYTES - LDS_PHASE_END) / 4; u += NTHR) ((LAS unsigned*)(X.lds + LDS_PHASE_END))[u] = 0u;
    __syncthreads();
    const int lo = args.ph_lo, hi = args.ph_hi;
    const bool multi = (hi - lo) > 1;
    XcdBarrier bar; bar.bar = XP_ctl(X) + CW_BAR; bar.x = 0; bar.st = nullptr;
    if (multi) bar = xcd_barrier_post(XP_ctl(X) + CW_BAR, (volatile LAS unsigned*)(X.lds + LDS_MISC + 32));
#ifdef ONLY_PHASE
#define IN(k) ((k) == ONLY_PHASE && lo <= (k) && (k) < hi)
#else
#define IN(k) (lo <= (k) && (k) < hi)
#endif
#define SEAM(k) do { if (IN(k) && IN((k) + 1)) xcd_barrier(bar); } while (0)
    if (IN(0)) { p0_prologue(X); } SEAM(0);
    if (IN(1)) { DenseSched S{(const char*)XP_U(X), (const char*)XP_WinT(X), D, T / 256, LDP / 256, (T / 256) * (LDP / 256), X.G, X.bid}; EpiProj E{XP_PROJ(X), LDP};
        pg8::gemm_phase<EpiProj, DenseSched, false, false>(X.lds, D, S, E); } SEAM(1);
    if (IN(2)) { for (int u = X.bid; u < 512; u += X.G) { if (u < 256) p2_ret(X, u); else p2_ssd(X, u - 256); } } SEAM(2);
    if (IN(3)) { p3_scan(X); } SEAM(3);
    if (IN(4)) { for (int u = X.bid; u < 384; u += X.G) { if (u < 256) { P4R(X, u); } else { P4S(X, u - 256); } } } SEAM(4);
    if (IN(5)) { DenseSched S{(const char*)XP_MIX(X), (const char*)XP_WoutT(X), D, T / 256, D / 256, (T / 256) * (D / 256), X.G, X.bid}; EpiOut E{XP_x(X), XP_Hh(X)};
        pg8::gemm_phase<EpiOut, DenseSched, false, false>(X.lds, D, S, E); } SEAM(5);
    if (IN(6)) { p6_router(X); } SEAM(6);
    if (IN(7)) { moe_tables(X); MoeSched S{(const LAS int*)(X.lds + LDS_TAB), (const char*)XP_U2(X), (const char*)XP_WguT(X), (size_t)(2 * DFF) * D, XP_LIST(X), D / 2, (2 * DFF) / 256, X.G, X.bid}; EpiGateUp E{XP_ACT(X), XP_b_gu(X)};
        pg8::gemm_phase<EpiGateUp, MoeSched, true, true>(X.lds, D / 2, S, E); } SEAM(7);
    if (IN(8)) { moe_tables(X); MoeSchedDirect S{(const LAS int*)(X.lds + LDS_TAB), (const char*)XP_ACT(X), (const char*)XP_WdT(X), (size_t)D * DFF, DFF / 2, D / 256, X.G, X.bid}; EpiDown E{XP_YR(X), XP_b_d(X)};
        pg8::gemm_phase<EpiDown, MoeSchedDirect, true, true>(X.lds, DFF / 2, S, E); } SEAM(8);
    if (IN(9)) { moe_tables(X); p9_final(X); }
#undef IN
#undef SEAM
}

extern "C" void kernel_launch(void* const* d_in, const int* in_sizes, int n_in, void* d_out, int out_size, void* d_ws, size_t ws_size, hipStream_t stream) {
    static int grid = 0;
    if (grid == 0) {
        if (n_in != 19 || out_size != T * D || ws_size < WS_END) { fprintf(stderr, "kernel_launch: unexpected shapes (n_in %d, out %d, ws %zu)\n", n_in, out_size, ws_size); grid = -1; return; }
        int dev = 0, cus = 0, per_cu = 0;
        if (hipGetDevice(&dev) != hipSuccess || hipDeviceGetAttribute(&cus, hipDeviceAttributeMultiprocessorCount, dev) != hipSuccess) { grid = -1; return; }
        if (hipFuncSetAttribute((const void*)fwd, hipFuncAttributeMaxDynamicSharedMemorySize, LDS_BYTES) != hipSuccess) { fprintf(stderr, "kernel_launch: hipFuncSetAttribute failed\n"); grid = -1; return; }
        if (hipOccupancyMaxActiveBlocksPerMultiprocessor(&per_cu, (const void*)fwd, NTHR, LDS_BYTES) != hipSuccess || per_cu < 1) { fprintf(stderr, "kernel_launch: occupancy query reports %d\n", per_cu); }
        (void)hipGetLastError();
        grid = cus;
    }
    if (grid < 0) return;
    (void)hipMemsetAsync((char*)d_ws + WS_CTL, 0, CTL_ZERO_BYTES, stream);
    Args a{};
    for (int i = 0; i < 19; ++i) a.in[i] = d_in[i];
    a.out = (float*)d_out; a.ws = (uchar*)d_ws;
    constexpr int NL = MK_N_LAUNCHES;
    for (int li = 0; li < NL; ++li) {
        a.ph_lo = (NL == 1) ? 0 : li; a.ph_hi = (NL == 1) ? NPHASE : li + 1;
        hipLaunchKernelGGL(fwd, dim3(grid), dim3(NTHR), LDS_BYTES, stream, a);
    }
}
```

```cpp
#include <hip/hip_runtime.h>
#include <cstdio>
#include <cstdint>

#ifndef MK_N_LAUNCHES
#define MK_N_LAUNCHES 1
#endif

#define LAS __attribute__((address_space(3)))
typedef unsigned short bf16;
typedef short bf16x8 __attribute__((ext_vector_type(8)));
typedef short s16x4 __attribute__((ext_vector_type(4)));
typedef float f32x4 __attribute__((ext_vector_type(4)));
typedef float f32x2 __attribute__((ext_vector_type(2)));
typedef unsigned u32x4 __attribute__((ext_vector_type(4)));
typedef unsigned u32x2 __attribute__((ext_vector_type(2)));
typedef unsigned char uchar;
typedef int i32x8 __attribute__((ext_vector_type(8)));
typedef int i32x4 __attribute__((ext_vector_type(4)));
constexpr float W8_SCALE = 64.f, W8_INV = 1.f / 64.f;

constexpr int T = 8192, D = 2048, NPROJ = 6672, LDP = 6912;
constexpr int C_Q = 0, C_K = 1024, C_V = 2048, C_G = 3072, C_Z = 4096, C_X = 5120, C_DT = 6656;
constexpr int XBCW = 1536, NCHUNK = 64, CH = 128;
constexpr int NE = 32, DFF = 2048, MAXBLK = 160;
constexpr float EPS = 1e-6f;
constexpr int NPHASE = 10;
constexpr int NWAVES = 8, NTHR = 512;

constexpr size_t MiB = 1ull << 20;
constexpr size_t WS_CTL = 0, CTL_ZERO_BYTES = 1 * MiB;
constexpr size_t WS_WINT = 2 * MiB, WS_WOUTT = 30 * MiB, WS_COS = 38 * MiB, WS_SIN = 42 * MiB;
constexpr size_t WS_TOPI = 46 * MiB, WS_TOPR = 46 * MiB + 128 * 1024, WS_TOPW = 46 * MiB + 256 * 1024, WS_LIST = 47 * MiB, WS_ADEC = 48 * MiB;
constexpr size_t WS_WRH = 49 * MiB, WS_WRL = 49 * MiB + 128 * 1024;
constexpr size_t WS_U = 64 * MiB, WS_U2 = 96 * MiB, WS_MIX = 128 * MiB, WS_XBC = 160 * MiB, WS_KV = 192 * MiB, WS_SST = 224 * MiB;
constexpr size_t WS_H = 256 * MiB, WS_PROJ = 320 * MiB, WS_ACT = 448 * MiB, WS_YR = 608 * MiB, WS_WGUT = 768 * MiB, WS_WDT = 1280 * MiB, WS_END = 1536 * MiB;
constexpr int CW_TMO = 0, CW_BAR = 4096, CW_CNT = 16384;

constexpr int RING_BYTES = 131072;
constexpr int LDS_PHASE_END = 139264;
constexpr int LDS_TAB = LDS_PHASE_END;
constexpr int LDS_IDX = LDS_PHASE_END + 2048;
constexpr int LDS_MISC = LDS_PHASE_END + 4096;
constexpr int LDS_BIAS = LDS_PHASE_END + 5120;
constexpr int LDS_BYTES = 147456;

__device__ __forceinline__ unsigned pk_bf16(float lo, float hi) { unsigned r; asm("v_cvt_pk_bf16_f32 %0, %1, %2" : "=v"(r) : "v"(lo), "v"(hi)); return r; }
__device__ __forceinline__ float clamp448(float x) { return fminf(fmaxf(x, -448.f), 448.f); }
__device__ __forceinline__ unsigned pk_fp8x4(float a, float b, float c, float d) {
    int p = 0; p = __builtin_amdgcn_cvt_pk_fp8_f32(clamp448(a), clamp448(b), p, false); p = __builtin_amdgcn_cvt_pk_fp8_f32(clamp448(c), clamp448(d), p, true); return (unsigned)p; }
__device__ __forceinline__ float bf_lo(unsigned u) { return __uint_as_float(u << 16); }
__device__ __forceinline__ float bf_hi(unsigned u) { return __uint_as_float(u & 0xffff0000u); }
__device__ __forceinline__ float bf2f(bf16 b) { return __uint_as_float(((unsigned)b) << 16); }
__device__ __forceinline__ float wave_sum(float v) {
#pragma unroll
    for (int o = 1; o < 64; o <<= 1) v += __shfl_xor(v, o);
    return v;
}
__device__ __forceinline__ float silu_f(float x) { return x * __builtin_amdgcn_rcpf(1.0f + __expf(-x)); }
__device__ __forceinline__ float softplus_f(float x) { return x > 20.f ? x : log1pf(__expf(x)); }

__constant__ double INV_FREQ[128] = {1,0.93057204092969903,0.86596432336006535,0.80584218776148187,0.74989420933245587,0.69783058485986638,0.64938163157621132,0.60429639023813286,0.56234132519034907,0.5232991146814947,0.48696752516586311,0.45315836376008178,0.42169650342858223,0.39241897584845359,0.36517412725483772,0.33982083289425596,0.31622776601683794,0.29427271762092816,0.27384196342643613,0.25482967479793467,0.23713737056616552,0.22067340690845899,0.20535250264571461,0.19109529749704404,0.17782794100389229,0.16548170999431813,0.15399265260594919,0.14330125702369628,0.1333521432163324,0.12409377607517195,0.11547819846894582,0.10746078283213174,0.10000000000000001,0.0930572040929699,0.086596432336006529,0.080584218776148187,0.074989420933245579,0.069783058485986635,0.064938163157621132,0.060429639023813285,0.056234132519034911,0.05232991146814947,0.048696752516586311,0.045315836376008181,0.042169650342858224,0.039241897584845357,0.036517412725483769,0.033982083289425591,0.031622776601683791,0.029427271762092817,0.027384196342643614,0.025482967479793464,0.023713737056616554,0.022067340690845899,0.02053525026457146,0.019109529749704406,0.017782794100389229,0.016548170999431813,0.015399265260594919,0.014330125702369627,0.013335214321633241,0.012409377607517195,0.011547819846894581,0.010746078283213174,0.01,0.0093057204092969904,0.0086596432336006543,0.008058421877614819,0.0074989420933245579,0.0069783058485986633,0.006493816315762113,0.0060429639023813278,0.005623413251903491,0.0052329911468149467,0.004869675251658631,0.0045315836376008181,0.0042169650342858229,0.0039241897584845363,0.0036517412725483771,0.0033982083289425592,0.0031622776601683794,0.002942727176209282,0.0027384196342643613,0.0025482967479793467,0.0023713737056616554,0.0022067340690845897,0.002053525026457146,0.0019109529749704406,0.0017782794100389228,0.0016548170999431814,0.001539926526059492,0.0014330125702369627,0.0013335214321633241,0.0012409377607517195,0.0011547819846894581,0.0010746078283213176,0.001,0.00093057204092969893,0.00086596432336006539,0.00080584218776148179,0.00074989420933245586,0.00069783058485986635,0.00064938163157621134,0.00060429639023813287,0.0005623413251903491,0.00052329911468149473,0.0004869675251658631,0.00045315836376008179,0.00042169650342858224,0.00039241897584845359,0.0003651741272548377,0.00033982083289425596,0.00031622776601683794,0.00029427271762092817,0.00027384196342643611,0.00025482967479793463,0.00023713737056616554,0.00022067340690845897,0.00020535250264571461,0.00019109529749704405,0.00017782794100389227,0.00016548170999431815,0.00015399265260594919,0.00014330125702369627,0.0001333521432163324,0.00012409377607517196,0.00011547819846894582,0.00010746078283213175};
__constant__ float LG2_GAMMA[4] = {-0.045803689613124789f, -0.022720076500083529f, -0.011315313227834146f, -0.0056465631411420627f};
__constant__ float GAMMA_CHUNK[4] = {0.017183023570817902f, 0.13321516287964841f, 0.36643771592203728f, 0.60593708822908032f};

namespace pg8 {
constexpr int BM = 256, BK = 64, HALF = 128, HTB = HALF * BK * 2, STAGE_BYTES = 8 * HTB, NXCD = 8, WGM = 8;
__host__ __device__ __forceinline__ int lds_byte(int r, int c) { const int st = (r >> 4) * 2 + (c >> 5), rr = r & 15, cc = c & 31, ob = rr * 64 + cc * 2; return st * 1024 + (ob ^ (((ob >> 9) & 1) << 5)); }
__host__ __device__ __forceinline__ void stage_rc(int b, int& R, int& C) { const int st = b / 1024, sb = b % 1024, swz = sb ^ (((sb >> 9) & 1) << 5); R = (st >> 1) * 16 + swz / 64; C = (st & 1) * 32 + (swz % 64) / 2; }
__host__ __device__ __forceinline__ int perm32(int rho) { const int n = rho >> 4, i = rho & 15; return 8 * (i >> 2) + 4 * n + (i & 3); }

struct Unit { const char* pa; const char* pb; int row0, col0, aux, blk; };

template <class Epi, class Sched, bool GATHER, bool FP8>
__device__ __forceinline__ void gemm_phase(LAS uchar* lds, const int K, const Sched& S, const Epi& E) {
    const int tid = threadIdx.x, wid = __builtin_amdgcn_readfirstlane(tid >> 6), lane = tid & 63, wr = wid >> 2, wc = wid & 3, fr = lane & 15, fq = lane >> 4;
    const int nt = K / BK;
    unsigned voA[2][2], voffB[2];
#pragma unroll
    for (int i = 0; i < 2; ++i) { int R, C; stage_rc(tid * 16 + i * 8192, R, C); const int Rb = Epi::PERM == 16 ? 64 * (R >> 5) + 16 * ((R >> 2) & 3) + 4 * ((R >> 4) & 1) + (R & 3) : (Epi::PERM == 8 ? ((R & ~31) + perm32(R & 31)) : R);
        voA[0][i] = (unsigned)(R * K + C) * 2u; voA[1][i] = voA[0][i] + (unsigned)(HALF * K * 2); voffB[i] = (unsigned)(Rb * K + C) * 2u; }
    const size_t kstep = (size_t)(BK * 2);
    const size_t hstep = (size_t)(Epi::PERM == 16 ? 8 : HALF) * K * 2;
    const unsigned ldsw = (unsigned)wid * 1024u;
    const int aoff = lds_byte(wr * 64 + fr, fq * 8), boff = lds_byte(wc * 32 + fr, fq * 8);
#define PG8_SA(b, h) (((b) * 2 + (h)) * HTB)
#define PG8_SB(b, h) ((4 + (b) * 2 + (h)) * HTB)
#define PG8_STAGE(bufoff, gbase, voff) do { _Pragma("unroll") for (int _i = 0; _i < 2; ++_i) \
        __builtin_amdgcn_global_load_lds((const unsigned*)((const char*)(gbase) + (voff)[_i]), (LAS unsigned*)(lds + (bufoff) + ldsw + _i * 8192), 16, 0, 0); } while (0)
#define PG8_LDA(dst, b, h) do { _Pragma("unroll") for (int m = 0; m < 4; ++m) _Pragma("unroll") for (int k = 0; k < 2; ++k) dst[m][k] = *(const LAS bf16x8*)(lds + PG8_SA(b, h) + aoff + m * 2048 + k * 1024); } while (0)
#define PG8_LDB(dst, b, h) do { _Pragma("unroll") for (int n = 0; n < 2; ++n) _Pragma("unroll") for (int k = 0; k < 2; ++k) dst[n][k] = *(const LAS bf16x8*)(lds + PG8_SB(b, h) + boff + n * 2048 + k * 1024); } while (0)
#define PG8_CAT(x) __builtin_shufflevector(__builtin_bit_cast(i32x4, (x)[0]), __builtin_bit_cast(i32x4, (x)[1]), 0, 1, 2, 3, 4, 5, 6, 7)
#define PG8_MMA(ai, bj, At, Bt) do { __builtin_amdgcn_s_setprio(1); \
        if constexpr (FP8) { _Pragma("unroll") for (int m = 0; m < 4; ++m) _Pragma("unroll") for (int n = 0; n < 2; ++n) \
            acc[ai][bj][m][n] = __builtin_amdgcn_mfma_scale_f32_16x16x128_f8f6f4(PG8_CAT(Bt[n]), PG8_CAT(At[m]), acc[ai][bj][m][n], 0, 0, 0, 0x7f7f7f7f, 0, 0x7f7f7f7f); } \
        else { _Pragma("unroll") for (int m = 0; m < 4; ++m) _Pragma("unroll") for (int n = 0; n < 2; ++n) _Pragma("unroll") for (int k = 0; k < 2; ++k) \
            acc[ai][bj][m][n] = __builtin_amdgcn_mfma_f32_16x16x32_bf16(Bt[n][k], At[m][k], acc[ai][bj][m][n], 0, 0, 0); } \
        __builtin_amdgcn_s_setprio(0); } while (0)
#define PG8_WAIT_V(n) asm volatile("s_waitcnt vmcnt(" #n ")" ::: "memory")
#define PG8_WAIT_L(n) asm volatile("s_waitcnt lgkmcnt(" #n ")" ::: "memory")
#define PG8_BAR __builtin_amdgcn_s_barrier()
#define PG8_SCHED __builtin_amdgcn_sched_barrier(0)
    Unit cur, nxt; int ui = 0;
    if (!S.next(0, cur)) return;
    f32x4 acc[2][2][4][2];
#pragma unroll
    for (int a = 0; a < 2; ++a)
#pragma unroll
        for (int b = 0; b < 2; ++b)
#pragma unroll
            for (int m = 0; m < 4; ++m)
#pragma unroll
                for (int n = 0; n < 2; ++n) acc[a][b][m][n] = (f32x4){0.f, 0.f, 0.f, 0.f};
    bf16x8 At[4][2], B0[2][2], B1[2][2];
    const char* cA = cur.pa; const char* cB = cur.pb;
    if constexpr (GATHER) S.gather(cur, voA, (const LAS int*)nullptr);
    PG8_STAGE(PG8_SB(0, 0), cB, voffB); PG8_STAGE(PG8_SB(0, 1), cB + hstep, voffB); PG8_STAGE(PG8_SA(0, 0), cA, voA[0]); PG8_STAGE(PG8_SA(0, 1), cA, voA[1]);
    if (wr == 1) PG8_BAR;
    PG8_WAIT_V(2); PG8_BAR;
    PG8_STAGE(PG8_SB(1, 0), cB + kstep, voffB); PG8_STAGE(PG8_SA(1, 0), cA + kstep, voA[0]); PG8_STAGE(PG8_SB(1, 1), cB + hstep + kstep, voffB);
    PG8_WAIT_V(6); PG8_BAR;
    for (;;) {
        const bool has_next = S.next(ui + 1, nxt);
        if constexpr (GATHER) { if (has_next) S.prefetch(nxt, lds + LDS_IDX + ((ui + 1) & 1) * 1024, wid, lane); }
        E.prefetch(cur, lds + LDS_BIAS + (ui & 1) * 1024, wid, lane);
        const char* nA = has_next ? nxt.pa : cA; const char* nB = has_next ? nxt.pb : cB;
        for (int t = 0; t < nt; t += 2) {
            const bool last = (t == nt - 2);
            const char* a1 = cA + (size_t)(t + 1) * kstep;
            const char* a2 = last ? nA : cA + (size_t)(t + 2) * kstep; const char* b2 = last ? nB : cB + (size_t)(t + 2) * kstep;
            const char* a3 = a2 + kstep; const char* b3 = b2 + kstep;
            PG8_LDB(B0, 0, 0); PG8_LDB(B1, 0, 1); PG8_SCHED; PG8_LDA(At, 0, 0); PG8_STAGE(PG8_SA(1, 1), a1, voA[1]);
            if constexpr (GATHER) { if (last && has_next) S.gather(nxt, voA, (const LAS int*)(lds + LDS_IDX + ((ui + 1) & 1) * 1024)); }
            PG8_WAIT_V(8); PG8_WAIT_L(0); PG8_BAR; PG8_MMA(0, 0, At, B0); PG8_MMA(0, 1, At, B1); PG8_BAR; PG8_SCHED;
            PG8_LDA(At, 0, 1); PG8_STAGE(PG8_SB(0, 0), b2, voffB); PG8_STAGE(PG8_SB(0, 1), b2 + hstep, voffB); PG8_STAGE(PG8_SA(0, 0), a2, voA[0]);
            PG8_WAIT_V(8); PG8_WAIT_L(0); PG8_BAR; PG8_MMA(1, 0, At, B0); PG8_MMA(1, 1, At, B1); PG8_BAR; PG8_SCHED;
            PG8_LDB(B0, 1, 0); PG8_LDB(B1, 1, 1); PG8_SCHED; PG8_LDA(At, 1, 0); PG8_STAGE(PG8_SA(0, 1), a2, voA[1]);
            PG8_WAIT_V(8); PG8_WAIT_L(0); PG8_BAR; PG8_MMA(0, 0, At, B0); PG8_MMA(0, 1, At, B1); PG8_BAR; PG8_SCHED;
            PG8_LDA(At, 1, 1); PG8_STAGE(PG8_SB(1, 0), b3, voffB); PG8_STAGE(PG8_SB(1, 1), b3 + hstep, voffB); PG8_STAGE(PG8_SA(1, 0), a3, voA[0]);
            PG8_WAIT_V(8); PG8_WAIT_L(0); PG8_BAR; PG8_MMA(1, 0, At, B0); PG8_MMA(1, 1, At, B1); PG8_BAR; PG8_SCHED;
        }
        if (wr == 0) PG8_BAR;
        E(acc, cur, wr, wc, fr, fq, lds + LDS_BIAS + (ui & 1) * 1024);
        if (!has_next) break;
#pragma unroll
        for (int a = 0; a < 2; ++a)
#pragma unroll
            for (int b = 0; b < 2; ++b)
#pragma unroll
                for (int m = 0; m < 4; ++m)
#pragma unroll
                    for (int n = 0; n < 2; ++n) acc[a][b][m][n] = (f32x4){0.f, 0.f, 0.f, 0.f};
        cur = nxt; cA = nA; cB = nB; ++ui;
        if (wr == 1) PG8_BAR;
    }
    PG8_WAIT_V(0);
    PG8_BAR;
#undef PG8_SA
#undef PG8_SB
#undef PG8_STAGE
#undef PG8_LDA
#undef PG8_LDB
#undef PG8_MMA
#undef PG8_CAT
#undef PG8_WAIT_V
#undef PG8_WAIT_L
#undef PG8_BAR
#undef PG8_SCHED
}
}

struct DenseSched {
    const char* A; const char* B; int K, nM, nN, nwg, G, c;
    __device__ __forceinline__ bool next(int i, pg8::Unit& u) const {
        const long L = (long)i * G + c; if (L >= nwg) return false;
        int wgid = (int)L; { const int q = nwg / pg8::NXCD, r = nwg % pg8::NXCD, xcd = wgid % pg8::NXCD, off = wgid / pg8::NXCD; wgid = (xcd < r ? xcd * (q + 1) : r * (q + 1) + (xcd - r) * q) + off; }
        const int nig = pg8::WGM * nN, gid = wgid / nig, fm = gid * pg8::WGM, gsz = (nM - fm) < pg8::WGM ? (nM - fm) : pg8::WGM;
        const int pm = fm + ((wgid % nig) % gsz), pn = (wgid % nig) / gsz;
        u.pa = A + (size_t)pm * 256 * K * 2; u.pb = B + (size_t)pn * 256 * K * 2; u.row0 = pm * 256; u.col0 = pn * 256; u.aux = 0; u.blk = 0; return true;
    }
    __device__ __forceinline__ void gather(const pg8::Unit&, unsigned (&)[2][2], const LAS int*) const {}
    __device__ __forceinline__ void prefetch(const pg8::Unit&, LAS uchar*, int, int) const {}
};
struct MoeSched {
    const LAS int* tab; const char* A; const char* B; size_t bexp; const int* list; int K, nN, G, c;
    __device__ __forceinline__ bool next(int i, pg8::Unit& u) const {
        const int NB = __builtin_amdgcn_readfirstlane(tab[0]); const int L = i * G + c; if (L >= NB * nN) return false;
        const int b = L / nN, pn = L - b * nN, e = __builtin_amdgcn_readfirstlane(tab[64 + b]);
        u.pa = A; u.pb = B + (size_t)e * bexp + (size_t)pn * 256 * K * 2; u.row0 = b * 256; u.col0 = pn * 256; u.aux = e; u.blk = b; return true;
    }
    __device__ __forceinline__ void prefetch(const pg8::Unit& u, LAS uchar* buf, int wid, int lane) const {
        if (wid < 4) { const int e = u.aux, lb = (u.blk - __builtin_amdgcn_readfirstlane(tab[8 + e])) * 256;
            __builtin_amdgcn_global_load_lds((const unsigned*)(list + e * T + lb + 64 * wid + lane), (LAS unsigned*)(buf + wid * 256), 4, 0, 0); }
    }
    __device__ __forceinline__ void gather(const pg8::Unit& u, unsigned (&vo)[2][2], const LAS int* idx) const {
        const int e = u.aux, lb = (u.blk - __builtin_amdgcn_readfirstlane(tab[8 + e])) * 256, cnt = __builtin_amdgcn_readfirstlane(tab[256 + u.blk]);
#pragma unroll
        for (int i = 0; i < 2; ++i) { int R, C; pg8::stage_rc((int)threadIdx.x * 16 + i * 8192, R, C);
#pragma unroll
            for (int h = 0; h < 2; ++h) { const int r = h * 128 + R; const int raw = idx ? idx[r] : list[e * T + lb + r]; const int tok = (r < cnt) ? raw : 0; vo[h][i] = ((unsigned)tok * (unsigned)K + (unsigned)C) * 2u; } }
    }
};
struct MoeSchedDirect {
    const LAS int* tab; const char* A; const char* B; size_t bexp; int K, nN, G, c;
    __device__ __forceinline__ bool next(int i, pg8::Unit& u) const {
        const int NB = __builtin_amdgcn_readfirstlane(tab[0]); const int L = i * G + c; if (L >= NB * nN) return false;
        const int b = L / nN, pn = L - b * nN, e = __builtin_amdgcn_readfirstlane(tab[64 + b]);
        u.pa = A; u.pb = B + (size_t)e * bexp + (size_t)pn * 256 * K * 2; u.row0 = b * 256; u.col0 = pn * 256; u.aux = e; u.blk = b; return true;
    }
    __device__ __forceinline__ void prefetch(const pg8::Unit&, LAS uchar*, int, int) const {}
    __device__ __forceinline__ void gather(const pg8::Unit& u, unsigned (&vo)[2][2], const LAS int*) const {
#pragma unroll
        for (int i = 0; i < 2; ++i) { int R, C; pg8::stage_rc((int)threadIdx.x * 16 + i * 8192, R, C);
#pragma unroll
            for (int h = 0; h < 2; ++h) vo[h][i] = ((unsigned)(u.row0 + h * 128 + R) * (unsigned)K + (unsigned)C) * 2u; }
    }
};

#define EPI_LANE() int tz = threadIdx.x; asm volatile("" : "+v"(tz)); const int fr = tz & 15, fq = (tz >> 4) & 3; (void)fr_; (void)fq_
struct EpiProj {
    static constexpr int PERM = 8;
    bf16* O; int ldc;
    __device__ __forceinline__ void prefetch(const pg8::Unit&, LAS uchar*, int, int) const {}
    __device__ __forceinline__ void operator()(const f32x4 (&acc)[2][2][4][2], const pg8::Unit& u, int wr, int wc, int fr_, int fq_, const LAS uchar* bl) const {
        EPI_LANE();
        const int row0 = u.row0 + wr * 64 + fr, col0 = u.col0 + wc * 32 + 8 * fq;
#pragma unroll
        for (int ai = 0; ai < 2; ++ai)
#pragma unroll
            for (int m = 0; m < 4; ++m) { bf16* rowp = O + (size_t)(row0 + ai * 128 + m * 16) * ldc + col0;
#pragma unroll
                for (int bj = 0; bj < 2; ++bj) { const f32x4 v0 = acc[ai][bj][m][0], v1 = acc[ai][bj][m][1];
                    u32x4 w; w.x = pk_bf16(v0[0], v0[1]); w.y = pk_bf16(v0[2], v0[3]); w.z = pk_bf16(v1[0], v1[1]); w.w = pk_bf16(v1[2], v1[3]);
                    *(u32x4*)(rowp + bj * 128) = w; } }
    }
};
struct EpiOut {
    static constexpr int PERM = 4;
    const float* X; float* Hh;
    __device__ __forceinline__ void prefetch(const pg8::Unit&, LAS uchar*, int, int) const {}
    __device__ __forceinline__ void operator()(const f32x4 (&acc)[2][2][4][2], const pg8::Unit& u, int wr, int wc, int fr_, int fq_, const LAS uchar* bl) const {
        EPI_LANE();
        const int row0 = u.row0 + wr * 64 + fr, col0 = u.col0 + wc * 32 + 4 * fq;
#pragma unroll
        for (int ai = 0; ai < 2; ++ai)
#pragma unroll
            for (int m = 0; m < 4; ++m) { const size_t off = (size_t)(row0 + ai * 128 + m * 16) * D + col0;
#pragma unroll
                for (int bj = 0; bj < 2; ++bj)
#pragma unroll
                    for (int n = 0; n < 2; ++n) { const f32x4 xv = *(const f32x4*)(X + off + bj * 128 + n * 16); *(f32x4*)(Hh + off + bj * 128 + n * 16) = xv + acc[ai][bj][m][n]; } }
    }
};
__device__ __forceinline__ float swiglu_f(float gate, float up) { const float g = fminf(gate, 7.f), u = fminf(fmaxf(up, -7.f), 7.f); return (u + 1.f) * g * __builtin_amdgcn_rcpf(1.f + __expf(-1.702f * g)); }
struct EpiGateUp {
    static constexpr int PERM = 16;
    uchar* ACT; const float* bias;
    __device__ __forceinline__ void prefetch(const pg8::Unit& u, LAS uchar* buf, int wid, int lane) const {
        if (wid < 4) __builtin_amdgcn_global_load_lds((const unsigned*)(bias + (size_t)u.aux * (2 * DFF) + u.col0 + 64 * wid + lane), (LAS unsigned*)(buf + wid * 256), 4, 0, 0); }
    __device__ __forceinline__ void operator()(const f32x4 (&acc)[2][2][4][2], const pg8::Unit& u, int wr, int wc, int fr_, int fq_, const LAS uchar* bl) const {
        EPI_LANE();
        const int row0 = u.row0 + wr * 64 + fr, col0 = u.col0 + wc * 64 + 16 * fq;
        const LAS float* bp = (const LAS float*)bl + wc * 64 + 16 * fq;
        f32x4 bv[2][2];
#pragma unroll
        for (int bj = 0; bj < 2; ++bj)
#pragma unroll
            for (int n = 0; n < 2; ++n) bv[bj][n] = *(const LAS f32x4*)(bp + bj * 8 + 4 * n);
#pragma unroll
        for (int ai = 0; ai < 2; ++ai)
#pragma unroll
            for (int m = 0; m < 4; ++m) { uchar* rowp = ACT + (size_t)(row0 + ai * 128 + m * 16) * DFF + (col0 >> 1);
                u32x2 w;
#pragma unroll
                for (int bj = 0; bj < 2; ++bj) { const f32x4 v0 = acc[ai][bj][m][0] * W8_INV + bv[bj][0], v1 = acc[ai][bj][m][1] * W8_INV + bv[bj][1];
                    const unsigned p = pk_fp8x4(swiglu_f(v0[0], v0[1]), swiglu_f(v0[2], v0[3]), swiglu_f(v1[0], v1[1]), swiglu_f(v1[2], v1[3]));
                    if (bj == 0) w.x = p; else w.y = p; }
                *(u32x2*)rowp = w; }
    }
};
struct EpiDown {
    static constexpr int PERM = 8;
    bf16* YR; const float* bias;
    __device__ __forceinline__ void prefetch(const pg8::Unit& u, LAS uchar* buf, int wid, int lane) const {
        if (wid < 4) __builtin_amdgcn_global_load_lds((const unsigned*)(bias + (size_t)u.aux * D + u.col0 + 64 * wid + lane), (LAS unsigned*)(buf + wid * 256), 4, 0, 0); }
    __device__ __forceinline__ void operator()(const f32x4 (&acc)[2][2][4][2], const pg8::Unit& u, int wr, int wc, int fr_, int fq_, const LAS uchar* bl) const {
        EPI_LANE();
        const int row0 = u.row0 + wr * 64 + fr, col0 = u.col0 + wc * 32 + 8 * fq;
        const LAS float* bp = (const LAS float*)bl + wc * 32 + 8 * fq;
        f32x4 bv[2][2];
#pragma unroll
        for (int bj = 0; bj < 2; ++bj)
#pragma unroll
            for (int n = 0; n < 2; ++n) bv[bj][n] = *(const LAS f32x4*)(bp + bj * 128 + 4 * n);
#pragma unroll
        for (int ai = 0; ai < 2; ++ai)
#pragma unroll
            for (int m = 0; m < 4; ++m) { bf16* rowp = YR + (size_t)(row0 + ai * 128 + m * 16) * D + col0;
#pragma unroll
                for (int bj = 0; bj < 2; ++bj) { const f32x4 v0 = acc[ai][bj][m][0] * W8_INV + bv[bj][0], v1 = acc[ai][bj][m][1] * W8_INV + bv[bj][1];
                    u32x4 w; w.x = pk_bf16(v0[0], v0[1]); w.y = pk_bf16(v0[2], v0[3]); w.z = pk_bf16(v1[0], v1[1]); w.w = pk_bf16(v1[2], v1[3]);
                    *(u32x4*)(rowp + bj * 128) = w; } }
    }
};

#define XB_TMO      128
#define XB_XCNT(j)  (256  + 64 * (j))
#define XB_XSUB(j)  (1280 + 64 * (j))
#define XB_XGEN(j)  (2304 + 64 * (j))
#define XB_TOP      3328
#define XB_TOPGEN   3392
#define XCD_BAR_WORDS 3456
#define XB_SPIN_CAP (1u << 18)
__device__ __forceinline__ unsigned xb_ld(unsigned* p)              { return __hip_atomic_load(p, __ATOMIC_RELAXED, __HIP_MEMORY_SCOPE_AGENT); }
__device__ __forceinline__ unsigned xb_add(unsigned* p, unsigned v) { return __hip_atomic_fetch_add(p, v, __ATOMIC_RELAXED, __HIP_MEMORY_SCOPE_AGENT); }
__device__ __forceinline__ unsigned xb_xcc_id() { return (unsigned)__builtin_amdgcn_s_getreg((3 << 11) | 20) & 0xFu; }
#define XB_SPIN(cond, bar) do { unsigned _sp = 0; while (cond) { __builtin_amdgcn_s_sleep(1); \
    if ((++_sp & 255u) == 0u) { if (xb_ld(&(bar)[XB_TMO])) break; if (_sp > XB_SPIN_CAP) { atomicAdd(&(bar)[XB_TMO], 1u); break; } } } } while (0)
struct XcdBarrier { unsigned* bar; unsigned x; volatile LAS unsigned* st; };
__device__ __forceinline__ XcdBarrier xcd_barrier_post(unsigned* bar, volatile LAS unsigned* st) {
    XcdBarrier b; b.bar = bar; b.x = xb_xcc_id(); b.st = st;
    if (threadIdx.x == 0) (void)xb_add(&bar[XB_XCNT(b.x)], 1u);
    return b;
}
__device__ __forceinline__ void xcd_barrier_complete(unsigned* bar, unsigned x, unsigned& nloc, unsigned& nx) {
    const unsigned G = gridDim.x * gridDim.y * gridDim.z;
    unsigned sum, cnt, mine, sp = 0u;
    for (;;) {
        sum = 0u; cnt = 0u; mine = 0u;
#pragma unroll
        for (unsigned j = 0; j < 16; ++j) { const unsigned c = xb_ld(&bar[XB_XCNT(j)]); sum += c; cnt += (c > 0u) ? 1u : 0u; mine = (j == x) ? c : mine; }
        if (sum == G) break;
        __builtin_amdgcn_s_sleep(1);
        if ((++sp & 255u) == 0u) { if (xb_ld(&bar[XB_TMO])) break; if (sp > XB_SPIN_CAP) { atomicAdd(&bar[XB_TMO], 1u); break; } }
    }
    nloc = mine > 0u ? mine : 1u; nx = cnt > 0u ? cnt : 1u;
}
__device__ __forceinline__ void xcd_barrier(const XcdBarrier& b) {
    asm volatile("s_waitcnt vmcnt(0)" ::: "memory");
    __syncthreads();
    if (threadIdx.x == 0) {
        unsigned* bar = b.bar;
        __builtin_amdgcn_s_waitcnt(0);
        unsigned nloc = b.st[0], nx = b.st[1];
        if (nloc == 0u) { xcd_barrier_complete(bar, b.x, nloc, nx); b.st[0] = nloc; b.st[1] = nx; }
        const unsigned old = xb_add(&bar[XB_XSUB(b.x)], 1u);
        const unsigned gen = old / nloc;
        if (old + 1u == (gen + 1u) * nloc) {
            __builtin_amdgcn_fence(__ATOMIC_RELEASE, "agent");
            asm volatile("s_waitcnt vmcnt(0)" ::: "memory");
            const unsigned og = xb_add(&bar[XB_TOP], 1u);
            const unsigned tg = og / nx;
            if (og + 1u == (tg + 1u) * nx) xb_add(&bar[XB_TOPGEN], 1u);
            else XB_SPIN(xb_ld(&bar[XB_TOPGEN]) == tg, bar);
            __builtin_amdgcn_fence(__ATOMIC_ACQUIRE, "agent");
            xb_add(&bar[XB_XGEN(b.x)], 1u);
            asm volatile("s_waitcnt vmcnt(0)" ::: "memory");
        } else {
            XB_SPIN(xb_ld(&bar[XB_XGEN(b.x)]) == gen, bar);
            __builtin_amdgcn_fence(__ATOMIC_ACQUIRE, "agent");
            asm volatile("s_waitcnt vmcnt(0)" ::: "memory");
        }
    }
    __syncthreads();
}

struct Ctx { LAS uchar* lds; int tid, lane, wave, G, bid; uchar* ws; const void* const* in; float* out; };
#define XP_x(X) ((const float*)(X).in[0])
#define XP_pos(X) ((const int*)(X).in[1])
#define XP_ln_mix_w(X) ((const float*)(X).in[2])
#define XP_w_in(X) ((const float*)(X).in[3])
#define XP_conv_w(X) ((const float*)(X).in[4])
#define XP_conv_b(X) ((const float*)(X).in[5])
#define XP_dt_bias(X) ((const float*)(X).in[6])
#define XP_a_log(X) ((const float*)(X).in[7])
#define XP_d_skip(X) ((const float*)(X).in[8])
#define XP_ssm_norm_w(X) ((const float*)(X).in[9])
#define XP_w_out(X) ((const float*)(X).in[10])
#define XP_ln_ffn_w(X) ((const float*)(X).in[11])
#define XP_w_router(X) ((const float*)(X).in[12])
#define XP_b_router(X) ((const float*)(X).in[13])
#define XP_w_gu(X) ((const float*)(X).in[14])
#define XP_b_gu(X) ((const float*)(X).in[15])
#define XP_w_d(X) ((const float*)(X).in[16])
#define XP_b_d(X) ((const float*)(X).in[17])
#define XP_ln_final_w(X) ((const float*)(X).in[18])
#define XP_WinT(X) ((bf16*)((X).ws + WS_WINT))
#define XP_WoutT(X) ((bf16*)((X).ws + WS_WOUTT))
#define XP_WguT(X) ((uchar*)((X).ws + WS_WGUT))
#define XP_WdT(X) ((uchar*)((X).ws + WS_WDT))
#define XP_U(X) ((bf16*)((X).ws + WS_U))
#define XP_U2(X) ((uchar*)((X).ws + WS_U2))
#define XP_MIX(X) ((bf16*)((X).ws + WS_MIX))
#define XP_XBC(X) ((bf16*)((X).ws + WS_XBC))
#define XP_KV(X) ((bf16*)((X).ws + WS_KV))
#define XP_SST(X) ((bf16*)((X).ws + WS_SST))
#define XP_PROJ(X) ((bf16*)((X).ws + WS_PROJ))
#define XP_ACT(X) ((uchar*)((X).ws + WS_ACT))
#define XP_YR(X) ((bf16*)((X).ws + WS_YR))
#define XP_COS(X) ((float*)((X).ws + WS_COS))
#define XP_SIN(X) ((float*)((X).ws + WS_SIN))
#define XP_Hh(X) ((float*)((X).ws + WS_H))
#define XP_ADEC(X) ((float*)((X).ws + WS_ADEC))
#define XP_TOPW(X) ((float*)((X).ws + WS_TOPW))
#define XP_TOPI(X) ((int*)((X).ws + WS_TOPI))
#define XP_TOPR(X) ((int*)((X).ws + WS_TOPR))
#define XP_LIST(X) ((int*)((X).ws + WS_LIST))
#define XP_ctl(X) ((unsigned*)((X).ws + WS_CTL))
#define XP_WRH(X) ((bf16*)((X).ws + WS_WRH))
#define XP_WRL(X) ((bf16*)((X).ws + WS_WRL))


__device__ __forceinline__ bf16x8 tr_frag(LAS uchar* p, int rstep) {
    const s16x4 a = __builtin_amdgcn_ds_read_tr16_b64_v4i16((LAS s16x4*)p);
    const s16x4 b = __builtin_amdgcn_ds_read_tr16_b64_v4i16((LAS s16x4*)(p + rstep));
    return (bf16x8){a[0], a[1], a[2], a[3], b[0], b[1], b[2], b[3]};
}
__device__ __forceinline__ f32x4 mma16(bf16x8 xrow, bf16x8 ycol, f32x4 c) { return __builtin_amdgcn_mfma_f32_16x16x32_bf16(xrow, ycol, c, 0, 0, 0); }
__device__ __forceinline__ float wave_incl_scan(float v, int lane) {
#pragma unroll
    for (int o = 1; o < 64; o <<= 1) { const float t = __shfl_up(v, o); if (lane >= o) v += t; }
    return v;
}
__device__ __forceinline__ void rope8(const u32x4 k1, const u32x4 k2, const f32x4 c0, const f32x4 c1, const f32x4 s0, const f32x4 s1, const float sc, u32x4& o1, u32x4& o2) {
    float r1[8], r2[8];
#pragma unroll
    for (int m = 0; m < 4; ++m) {
        const float a0 = bf_lo(k1[m]), a1 = bf_hi(k1[m]), b0 = bf_lo(k2[m]), b1 = bf_hi(k2[m]);
        const float cs0 = (m < 2) ? c0[2 * m] : c1[2 * m - 4], cs1 = (m < 2) ? c0[2 * m + 1] : c1[2 * m - 3];
        const float sn0 = (m < 2) ? s0[2 * m] : s1[2 * m - 4], sn1 = (m < 2) ? s0[2 * m + 1] : s1[2 * m - 3];
        r1[2 * m] = (a0 * cs0 - b0 * sn0) * sc; r1[2 * m + 1] = (a1 * cs1 - b1 * sn1) * sc;
        r2[2 * m] = (b0 * cs0 + a0 * sn0) * sc; r2[2 * m + 1] = (b1 * cs1 + a1 * sn1) * sc;
    }
    o1.x = pk_bf16(r1[0], r1[1]); o1.y = pk_bf16(r1[2], r1[3]); o1.z = pk_bf16(r1[4], r1[5]); o1.w = pk_bf16(r1[6], r1[7]);
    o2.x = pk_bf16(r2[0], r2[1]); o2.y = pk_bf16(r2[2], r2[3]); o2.z = pk_bf16(r2[4], r2[5]); o2.w = pk_bf16(r2[6], r2[7]);
}

__device__ __forceinline__ void tr_decode(const Ctx& X, int r, const float*& W, bf16*& WT, int& N, int& kb, int& nb) {
    constexpr int I_IN = 32 * 209;
    if (r < I_IN) { W = XP_w_in(X); WT = XP_WinT(X); N = NPROJ; }
    else { r -= I_IN; W = XP_w_out(X); WT = XP_WoutT(X); N = D; }
    const int nbn = (N + 31) >> 5; kb = r / nbn; nb = r - kb * nbn;
}
__device__ __forceinline__ void tr8_item(const float* W, int N, uchar* WT, int kb, int nb, int lane) {
    const int k0 = kb * 128 + 16 * (lane & 7), n0 = nb * 32 + 4 * (lane >> 3);
    f32x4 v[16];
#pragma unroll
    for (int i = 0; i < 16; ++i) v[i] = *(const f32x4*)(W + (size_t)(k0 + i) * N + n0);
#pragma unroll
    for (int j = 0; j < 4; ++j) { u32x4 o;
        o.x = pk_fp8x4(v[0][j] * W8_SCALE, v[1][j] * W8_SCALE, v[2][j] * W8_SCALE, v[3][j] * W8_SCALE); o.y = pk_fp8x4(v[4][j] * W8_SCALE, v[5][j] * W8_SCALE, v[6][j] * W8_SCALE, v[7][j] * W8_SCALE);
        o.z = pk_fp8x4(v[8][j] * W8_SCALE, v[9][j] * W8_SCALE, v[10][j] * W8_SCALE, v[11][j] * W8_SCALE); o.w = pk_fp8x4(v[12][j] * W8_SCALE, v[13][j] * W8_SCALE, v[14][j] * W8_SCALE, v[15][j] * W8_SCALE);
        *(u32x4*)(WT + (size_t)(n0 + j) * 2048 + k0) = o; }
}
__device__ __forceinline__ void tr_load(const float* W, int N, int kb, int nb, int lane, f32x4 (&v)[8]) {
    const int k0 = kb * 64 + 8 * (lane & 7), n0 = nb * 32 + 4 * (lane >> 3);
    if (n0 < N) {
#pragma unroll
        for (int i = 0; i < 8; ++i) v[i] = *(const f32x4*)(W + (size_t)(k0 + i) * N + n0);
    }
}
__device__ __forceinline__ void tr_store(bf16* WT, int N, int kb, int nb, int lane, const f32x4 (&v)[8]) {
    const int k0 = kb * 64 + 8 * (lane & 7), n0 = nb * 32 + 4 * (lane >> 3);
    if (n0 < N) {
#pragma unroll
        for (int j = 0; j < 4; ++j) { u32x4 o; o.x = pk_bf16(v[0][j], v[1][j]); o.y = pk_bf16(v[2][j], v[3][j]); o.z = pk_bf16(v[4][j], v[5][j]); o.w = pk_bf16(v[6][j], v[7][j]);
            *(u32x4*)(WT + (size_t)(n0 + j) * 2048 + k0) = o; }
    }
}
constexpr int I_GU8 = 32 * 16 * 128, I_D8 = 32 * 16 * 64, I_ALL8 = I_GU8 + I_D8;
__device__ __forceinline__ void conv8_id(const Ctx& X, int it, int lane) {
    if (it < I_GU8) { const int e = it >> 11, r = it & 2047; tr8_item(XP_w_gu(X) + (size_t)e * D * (2 * DFF), 2 * DFF, XP_WguT(X) + (size_t)e * (2 * DFF) * D, r >> 7, r & 127, lane); }
    else { const int i2 = it - I_GU8, e = i2 >> 10, r = i2 & 1023; tr8_item(XP_w_d(X) + (size_t)e * DFF * D, D, XP_WdT(X) + (size_t)e * D * DFF, r >> 6, r & 63, lane); }
}
constexpr int FILL_N1 = 10, FILL_W1 = 160 * 8, FILL_N3 = 4, FILL_W3 = 64 * 8, FILL_N4 = 10, FILL_W4 = 128 * 8;
constexpr int FILL_B1 = I_ALL8 - FILL_N1 * FILL_W1 - FILL_N3 * FILL_W3 - FILL_N4 * FILL_W4, FILL_B3 = FILL_B1 + FILL_N1 * FILL_W1, FILL_B4 = FILL_B3 + FILL_N3 * FILL_W3;
__device__ __forceinline__ void conv8_fill(const Ctx& X, int base, int fw, int nw, int n) {
#pragma unroll 1
    for (int j = 0; j < n; ++j) conv8_id(X, base + j * nw + fw, X.lane);
}
__device__ __forceinline__ void p0_prologue(Ctx& X) {
    const int gw = X.bid * NWAVES + X.wave, NGW = X.G * NWAVES, lane = X.lane;
    const int gt = X.bid * NTHR + X.tid, NGT = X.G * NTHR;
    for (int m = gw; m < T; m += NGW) {
        const f32x4* xr = (const f32x4*)(XP_x(X) + (size_t)m * D) + lane; const f32x4* wr_ = (const f32x4*)XP_ln_mix_w(X) + lane;
        f32x4 v[8]; float s = 0.f;
#pragma unroll
        for (int j = 0; j < 8; ++j) { v[j] = xr[64 * j]; s += (v[j].x * v[j].x + v[j].y * v[j].y) + (v[j].z * v[j].z + v[j].w * v[j].w); }
        const float rstd = rsqrtf(wave_sum(s) * (1.f / D) + EPS);
        u32x2* o8 = (u32x2*)(XP_U(X) + (size_t)m * D) + lane;
#pragma unroll
        for (int j = 0; j < 8; ++j) { const f32x4 w = wr_[64 * j]; u32x2 o; o.x = pk_bf16(v[j].x * rstd * w.x, v[j].y * rstd * w.y); o.y = pk_bf16(v[j].z * rstd * w.z, v[j].w * rstd * w.w); o8[64 * j] = o; }
    }
    for (int idx = gt; idx < T * 128; idx += NGT) {
        const int t = idx >> 7, i = idx & 127;
        const double ang = (double)XP_pos(X)[t] * INV_FREQ[i];
        double rev = ang * 0.15915494309189533577; rev -= floor(rev);
        const float f = (float)rev;
        XP_COS(X)[idx] = __builtin_amdgcn_cosf(f); XP_SIN(X)[idx] = __builtin_amdgcn_sinf(f);
    }
    { u32x4* p = (u32x4*)(XP_WinT(X) + (size_t)NPROJ * D); const int n16 = (LDP - NPROJ) * D * 2 / 16; const u32x4 z = {0u, 0u, 0u, 0u};
      for (int i = gt; i < n16; i += NGT) p[i] = z; }
    for (int idx = gt; idx < NE * D; idx += NGT) { const int e = idx >> 11, d = idx & 2047;
        const float wv = XP_ln_ffn_w(X)[d] * XP_w_router(X)[d * NE + e]; const unsigned hb = pk_bf16(wv, 0.f) & 0xffffu; const float lo = wv - __uint_as_float(hb << 16);
        XP_WRH(X)[idx] = (bf16)hb; XP_WRL(X)[idx] = (bf16)(pk_bf16(lo, 0.f) & 0xffffu); }
    constexpr int NIT = 32 * 209 + 32 * 64;
    for (int it = gw; it < NIT; it += 2 * NGW) {
        const float *W0, *W1 = nullptr; bf16 *T0, *T1 = nullptr; int N0, N1 = 0, kb0, kb1 = 0, nb0, nb1 = 0;
        f32x4 v0[8], v1[8];
        tr_decode(X, it, W0, T0, N0, kb0, nb0);
        const bool two = (it + NGW) < NIT;
        if (two) tr_decode(X, it + NGW, W1, T1, N1, kb1, nb1);
        tr_load(W0, N0, kb0, nb0, lane, v0);
        if (two) tr_load(W1, N1, kb1, nb1, lane, v1);
        tr_store(T0, N0, kb0, nb0, lane, v0);
        if (two) tr_store(T1, N1, kb1, nb1, lane, v1);
    }
    const int n_p0 = (X.G == 256) ? FILL_B1 : I_ALL8;
#pragma unroll 1
    for (int it = gw; it < n_p0; it += NGW) conv8_id(X, it, lane);
}

__device__ __forceinline__ void p2_ret(Ctx& X, int unit) {
    const int c = unit >> 2, h = unit & 3, t0 = c * CH, tid = X.tid, lane = X.lane, w = X.wave;
    LAS uchar* Vt = X.lds; LAS uchar* Kt = X.lds + 69632;
#pragma unroll 4
    for (int i = 0; i < 8; ++i) { const int q = tid + 512 * i, l = q >> 5, vc = q & 31;
        const u32x4 v = *(const u32x4*)(XP_PROJ(X) + (size_t)(t0 + l) * LDP + C_V + h * 256 + vc * 8);
        *(LAS u32x4*)(Vt + l * 544 + vc * 16) = v; }
    const float lg = LG2_GAMMA[h];
#pragma unroll 2
    for (int i = 0; i < 4; ++i) { const int q = tid + 512 * i, l = q >> 4, ic = q & 15;
        const bf16* kp = XP_PROJ(X) + (size_t)(t0 + l) * LDP + C_K + h * 256 + ic * 8;
        const u32x4 k1 = *(const u32x4*)kp, k2 = *(const u32x4*)(kp + 128);
        const float* cp = XP_COS(X) + (size_t)(t0 + l) * 128 + ic * 8; const float* sp = XP_SIN(X) + (size_t)(t0 + l) * 128 + ic * 8;
        const f32x4 c0 = *(const f32x4*)cp, c1 = *(const f32x4*)(cp + 4), s0 = *(const f32x4*)sp, s1 = *(const f32x4*)(sp + 4);
        u32x4 o1, o2; rope8(k1, k2, c0, c1, s0, s1, 0.0625f * exp2f(lg * (float)(127 - l)), o1, o2);
        *(LAS u32x4*)(Kt + l * 544 + ic * 16) = o1; *(LAS u32x4*)(Kt + l * 544 + 256 + ic * 16) = o2; }
    __syncthreads();
    const int fr = lane & 15, fq = lane >> 4, trs = (8 * fq + ((lane & 15) >> 2)) * 544 + 8 * (lane & 3);
    f32x4 acc[2][16];
#pragma unroll
    for (int a = 0; a < 2; ++a)
#pragma unroll
        for (int n = 0; n < 16; ++n) acc[a][n] = (f32x4){0.f, 0.f, 0.f, 0.f};
#pragma unroll 1
    for (int ks = 0; ks < 4; ++ks) {
        const bf16x8 af0 = tr_frag(Vt + (32 * ks) * 544 + (16 * w) * 2 + trs, 4 * 544);
        const bf16x8 af1 = tr_frag(Vt + (32 * ks) * 544 + (128 + 16 * w) * 2 + trs, 4 * 544);
#pragma unroll
        for (int n = 0; n < 16; ++n) { const bf16x8 bf = tr_frag(Kt + (32 * ks) * 544 + (16 * n) * 2 + trs, 4 * 544);
            acc[0][n] = mma16(bf, af0, acc[0][n]); acc[1][n] = mma16(bf, af1, acc[1][n]); }
    }
    bf16* outp = XP_KV(X) + (size_t)(c * 4 + h) * 65536;
#pragma unroll
    for (int a = 0; a < 2; ++a)
#pragma unroll
        for (int n = 0; n < 16; ++n) { u32x2 o; o.x = pk_bf16(acc[a][n][0], acc[a][n][1]); o.y = pk_bf16(acc[a][n][2], acc[a][n][3]);
            *(u32x2*)(outp + (size_t)(128 * a + 16 * w + fr) * 256 + 16 * n + 4 * fq) = o; }
    __syncthreads();
}
__device__ __forceinline__ void conv8(const Ctx& X, int t, int cx, float (&o)[8]) {
    const f32x4 b0 = *(const f32x4*)(XP_conv_b(X) + cx), b1 = *(const f32x4*)(XP_conv_b(X) + cx + 4);
    o[0] = b0.x; o[1] = b0.y; o[2] = b0.z; o[3] = b0.w; o[4] = b1.x; o[5] = b1.y; o[6] = b1.z; o[7] = b1.w;
#pragma unroll
    for (int j = 0; j < 4; ++j) { const int tt = t - 3 + j;
        if (tt >= 0) { const u32x4 v = *(const u32x4*)(XP_PROJ(X) + (size_t)tt * LDP + C_X + cx);
            const f32x4 w0 = *(const f32x4*)(XP_conv_w(X) + j * XBCW + cx), w1 = *(const f32x4*)(XP_conv_w(X) + j * XBCW + cx + 4);
            o[0] += w0.x * bf_lo(v.x); o[1] += w0.y * bf_hi(v.x); o[2] += w0.z * bf_lo(v.y); o[3] += w0.w * bf_hi(v.y);
            o[4] += w1.x * bf_lo(v.z); o[5] += w1.y * bf_hi(v.z); o[6] += w1.z * bf_lo(v.w); o[7] += w1.w * bf_hi(v.w); } }
#pragma unroll
    for (int i = 0; i < 8; ++i) o[i] = silu_f(o[i]);
}
__device__ __forceinline__ void p2_ssd(Ctx& X, int unit) {
    const int c = unit >> 2, g = (unit >> 1) & 1, hh = unit & 1, t0 = c * CH, tid = X.tid, lane = X.lane, w = X.wave;
    LAS uchar* Xd = X.lds; LAS uchar* Bc = X.lds + 69632;
    LAS float* dtS = (LAS float*)(X.lds + 106496); LAS float* acS = (LAS float*)(X.lds + 108544);
    if (w < 4) { const int h = 8 * g + 4 * hh + w, l0 = 2 * lane;
        const float dtb = XP_dt_bias(X)[h], A = -expf(XP_a_log(X)[h]);
        const float d0 = softplus_f(bf2f(XP_PROJ(X)[(size_t)(t0 + l0) * LDP + C_DT + h]) + dtb), d1 = softplus_f(bf2f(XP_PROJ(X)[(size_t)(t0 + l0 + 1) * LDP + C_DT + h]) + dtb);
        const float a0 = d0 * A, a1 = d1 * A, s = a0 + a1, incl = wave_incl_scan(s, lane);
        dtS[w * 128 + l0] = d0; dtS[w * 128 + l0 + 1] = d1; acS[w * 128 + l0] = incl - a1; acS[w * 128 + l0 + 1] = incl;
        if (lane == 63) XP_ADEC(X)[c * 16 + h] = expf(incl); }
    __syncthreads();
    for (int it = tid; it < 128 * 56; it += NTHR) { const int l = it / 56, j = it - l * 56;
        int cx; if (j < 32) cx = 512 * g + 256 * hh + 8 * j; else if (j < 48) cx = 1024 + 128 * g + 8 * (j - 32); else cx = 1280 + 128 * g + 64 * hh + 8 * (j - 48);
        float o[8]; conv8(X, t0 + l, cx, o);
        u32x4 ov; ov.x = pk_bf16(o[0], o[1]); ov.y = pk_bf16(o[2], o[3]); ov.z = pk_bf16(o[4], o[5]); ov.w = pk_bf16(o[6], o[7]);
        if (j < 32) { const int e = j >> 3; const float sc = dtS[e * 128 + l] * __expf(acS[e * 128 + 127] - acS[e * 128 + l]);
            u32x4 os; os.x = pk_bf16(o[0] * sc, o[1] * sc); os.y = pk_bf16(o[2] * sc, o[3] * sc); os.z = pk_bf16(o[4] * sc, o[5] * sc); os.w = pk_bf16(o[6] * sc, o[7] * sc);
            *(LAS u32x4*)(Xd + l * 544 + j * 16) = os; *(u32x4*)(XP_XBC(X) + (size_t)(t0 + l) * XBCW + cx) = ov; }
        else if (j < 48) { *(LAS u32x4*)(Bc + l * 288 + (j - 32) * 16) = ov; if (hh == 0) *(u32x4*)(XP_XBC(X) + (size_t)(t0 + l) * XBCW + cx) = ov; }
        else *(u32x4*)(XP_XBC(X) + (size_t)(t0 + l) * XBCW + cx) = ov; }
    __syncthreads();
    const int fr = lane & 15, fq = lane >> 4, q4 = (lane & 15) >> 2, p4 = lane & 3;
    const int trx = (8 * fq + q4) * 544 + 8 * p4, trb = (8 * fq + q4) * 288 + 8 * p4;
    f32x4 acc[2][8];
#pragma unroll
    for (int a = 0; a < 2; ++a)
#pragma unroll
        for (int n = 0; n < 8; ++n) acc[a][n] = (f32x4){0.f, 0.f, 0.f, 0.f};
#pragma unroll 1
    for (int ks = 0; ks < 4; ++ks) {
        const bf16x8 af0 = tr_frag(Xd + (32 * ks) * 544 + (16 * w) * 2 + trx, 4 * 544);
        const bf16x8 af1 = tr_frag(Xd + (32 * ks) * 544 + (128 + 16 * w) * 2 + trx, 4 * 544);
#pragma unroll
        for (int n = 0; n < 8; ++n) { const bf16x8 bf = tr_frag(Bc + (32 * ks) * 288 + (16 * n) * 2 + trb, 4 * 288);
            acc[0][n] = mma16(bf, af0, acc[0][n]); acc[1][n] = mma16(bf, af1, acc[1][n]); }
    }
#pragma unroll
    for (int a = 0; a < 2; ++a) { const int m = 128 * a + 16 * w + fr, h = 8 * g + 4 * hh + (m >> 6), p = m & 63;
        bf16* outp = XP_SST(X) + ((size_t)(c * 16 + h) * 64 + p) * 128;
#pragma unroll
        for (int n = 0; n < 8; ++n) { u32x2 o; o.x = pk_bf16(acc[a][n][0], acc[a][n][1]); o.y = pk_bf16(acc[a][n][2], acc[a][n][3]); *(u32x2*)(outp + 16 * n + 4 * fq) = o; } }
    __syncthreads();
}

__device__ __forceinline__ void p3_scan(Ctx& X) {
    const int gt = X.bid * NTHR + X.tid, NGT = X.G * NTHR;
    for (int item = gt; item < 65536 + 32768; item += NGT) {
        const bool ret = item < 65536; const int it2 = ret ? item : item - 65536;
        bf16* p = ret ? (XP_KV(X) + (size_t)it2 * 4) : (XP_SST(X) + (size_t)it2 * 4);
        const size_t stride = ret ? 262144 : 131072;
        const int head = ret ? (it2 >> 14) : (it2 >> 11);
        const float gdec = ret ? GAMMA_CHUNK[head & 3] : 0.f;
        float s0 = 0.f, s1 = 0.f, s2 = 0.f, s3 = 0.f;
        for (int c0 = 0; c0 < NCHUNK; c0 += 16) {
            u32x2 v[16]; float dec[16];
#pragma unroll
            for (int j = 0; j < 16; ++j) { v[j] = *(const u32x2*)(p + (size_t)(c0 + j) * stride); dec[j] = ret ? gdec : XP_ADEC(X)[(c0 + j) * 16 + head]; }
#pragma unroll
            for (int j = 0; j < 16; ++j) { u32x2 o; o.x = pk_bf16(s0, s1); o.y = pk_bf16(s2, s3); *(u32x2*)(p + (size_t)(c0 + j) * stride) = o;
                s0 = dec[j] * s0 + bf_lo(v[j].x); s1 = dec[j] * s1 + bf_hi(v[j].x); s2 = dec[j] * s2 + bf_lo(v[j].y); s3 = dec[j] * s3 + bf_hi(v[j].y); }
        }
    }
}

__device__ __forceinline__ void p4_ret(Ctx& X, int unit) {
    const int c = unit >> 2, h = unit & 3, t0 = c * CH, tid = X.tid, lane = X.lane, w = X.wave;
    LAS uchar* R1 = X.lds; LAS uchar* R2 = X.lds + 69632;
    const float lg = LG2_GAMMA[h];
#pragma unroll 1
    for (int i = 0; i < 4; ++i) { const int q = tid + 512 * i, l = q >> 4, ic = q & 15;
        const float* cp = XP_COS(X) + (size_t)(t0 + l) * 128 + ic * 8; const float* sp = XP_SIN(X) + (size_t)(t0 + l) * 128 + ic * 8;
        const f32x4 c0 = *(const f32x4*)cp, c1 = *(const f32x4*)(cp + 4), s0 = *(const f32x4*)sp, s1 = *(const f32x4*)(sp + 4);
        const bf16* qp = XP_PROJ(X) + (size_t)(t0 + l) * LDP + C_Q + h * 256 + ic * 8; const bf16* kp = XP_PROJ(X) + (size_t)(t0 + l) * LDP + C_K + h * 256 + ic * 8;
        u32x4 o1, o2;
        rope8(*(const u32x4*)qp, *(const u32x4*)(qp + 128), c0, c1, s0, s1, 1.0f, o1, o2);
        *(LAS u32x4*)(R1 + l * 544 + ic * 16) = o1; *(LAS u32x4*)(R1 + l * 544 + 256 + ic * 16) = o2;
        rope8(*(const u32x4*)kp, *(const u32x4*)(kp + 128), c0, c1, s0, s1, 0.0625f, o1, o2);
        *(LAS u32x4*)(R2 + l * 544 + ic * 16) = o1; *(LAS u32x4*)(R2 + l * 544 + 256 + ic * 16) = o2; }
    __syncthreads();
    const int fr = lane & 15, fq = lane >> 4, q4 = (lane & 15) >> 2, p4 = lane & 3, l = 16 * w + fr;
    f32x4 sc[8];
#pragma unroll
    for (int n = 0; n < 8; ++n) sc[n] = (f32x4){0.f, 0.f, 0.f, 0.f};
#pragma unroll 2
    for (int ks = 0; ks < 8; ++ks) {
        const bf16x8 af = *(const LAS bf16x8*)(R1 + l * 544 + (32 * ks + 8 * fq) * 2);
#pragma unroll
        for (int n = 0; n < 8; ++n) if (n <= w) { const bf16x8 bf = *(const LAS bf16x8*)(R2 + (16 * n + fr) * 544 + (32 * ks + 8 * fq) * 2); sc[n] = mma16(bf, af, sc[n]); }
    }
    bf16x8 scf[4];
#pragma unroll
    for (int k2 = 0; k2 < 4; ++k2) { float v[8];
#pragma unroll
        for (int tq = 0; tq < 2; ++tq)
#pragma unroll
            for (int j = 0; j < 4; ++j) { const int s = 16 * (2 * k2 + tq) + 4 * fq + j; v[4 * tq + j] = (s <= l) ? sc[2 * k2 + tq][j] * exp2f(lg * (float)(l - s)) : 0.f; }
        u32x4 pk; pk.x = pk_bf16(v[0], v[1]); pk.y = pk_bf16(v[2], v[3]); pk.z = pk_bf16(v[4], v[5]); pk.w = pk_bf16(v[6], v[7]);
        scf[k2] = __builtin_bit_cast(bf16x8, pk); }
    __syncthreads();
    f32x4 acc[16];
#pragma unroll
    for (int n = 0; n < 16; ++n) acc[n] = (f32x4){0.f, 0.f, 0.f, 0.f};
    const bf16* prev = XP_KV(X) + (size_t)(c * 4 + h) * 65536;
#pragma unroll 1
    for (int dh = 0; dh < 2; ++dh) {
#pragma unroll 4
        for (int i = 0; i < 8; ++i) { const int q = tid + 512 * i, v = q >> 4, dc = q & 15;
            *(LAS u32x4*)(R2 + v * 272 + dc * 16) = *(const u32x4*)(prev + (size_t)v * 256 + dh * 128 + dc * 8); }
        __syncthreads();
#pragma unroll 2
        for (int ks = 0; ks < 4; ++ks) {
            const bf16x8 af = *(const LAS bf16x8*)(R1 + l * 544 + (128 * dh + 32 * ks + 8 * fq) * 2);
#pragma unroll
            for (int n = 0; n < 16; ++n) { const bf16x8 bf = *(const LAS bf16x8*)(R2 + (16 * n + fr) * 272 + (32 * ks + 8 * fq) * 2); acc[n] = mma16(bf, af, acc[n]); }
        }
        __syncthreads();
    }
    { const float qd = exp2f(lg * (float)(l + 1));
#pragma unroll
      for (int n = 0; n < 16; ++n) acc[n] = acc[n] * qd; }
#pragma unroll 4
    for (int i = 0; i < 8; ++i) { const int q = tid + 512 * i, s = q >> 5, vc = q & 31;
        *(LAS u32x4*)(R2 + s * 544 + vc * 16) = *(const u32x4*)(XP_PROJ(X) + (size_t)(t0 + s) * LDP + C_V + h * 256 + vc * 8); }
    __syncthreads();
    const int trp = (4 * fq + q4) * 544 + 8 * p4;
#pragma unroll
    for (int k2 = 0; k2 < 4; ++k2) if (2 * k2 <= w) {
#pragma unroll
        for (int n = 0; n < 16; ++n) { const bf16x8 bf = tr_frag(R2 + (32 * k2) * 544 + (16 * n) * 2 + trp, 16 * 544); acc[n] = mma16(bf, scf[k2], acc[n]); }
    }
    float ss = 0.f;
#pragma unroll
    for (int n = 0; n < 16; ++n) ss += (acc[n][0] * acc[n][0] + acc[n][1] * acc[n][1]) + (acc[n][2] * acc[n][2] + acc[n][3] * acc[n][3]);
    ss += __shfl_xor(ss, 16); ss += __shfl_xor(ss, 32);
    const float rstd = rsqrtf(ss * (1.f / 256.f) + EPS);
    const bf16* gp = XP_PROJ(X) + (size_t)(t0 + l) * LDP + C_G + h * 256 + 4 * fq; bf16* op = XP_MIX(X) + (size_t)(t0 + l) * D + h * 256 + 4 * fq;
#pragma unroll
    for (int n = 0; n < 16; ++n) { const u32x2 gv = *(const u32x2*)(gp + 16 * n);
        u32x2 o; o.x = pk_bf16(acc[n][0] * rstd * silu_f(bf_lo(gv.x)), acc[n][1] * rstd * silu_f(bf_hi(gv.x))); o.y = pk_bf16(acc[n][2] * rstd * silu_f(bf_lo(gv.y)), acc[n][3] * rstd * silu_f(bf_hi(gv.y)));
        *(u32x2*)(op + 16 * n) = o; }
    __syncthreads();
}

__device__ __forceinline__ void p4_ssd(Ctx& X, int unit) {
    const int c = unit >> 1, g = unit & 1, t0 = c * CH, tid = X.tid, lane = X.lane, w = X.wave;
    LAS uchar* Cc = X.lds; LAS uchar* Bc = X.lds + 34816;
    LAS uchar* HP = X.lds + 34816;
    LAS float* dtS = (LAS float*)(X.lds + 110592); LAS float* acS = (LAS float*)(X.lds + 114688);
    { const int h = 8 * g + w, l0 = 2 * lane;
      const float dtb = XP_dt_bias(X)[h], A = -expf(XP_a_log(X)[h]);
      const float d0 = softplus_f(bf2f(XP_PROJ(X)[(size_t)(t0 + l0) * LDP + C_DT + h]) + dtb), d1 = softplus_f(bf2f(XP_PROJ(X)[(size_t)(t0 + l0 + 1) * LDP + C_DT + h]) + dtb);
      const float a0 = d0 * A, a1 = d1 * A, incl = wave_incl_scan(a0 + a1, lane);
      dtS[w * 128 + l0] = d0; dtS[w * 128 + l0 + 1] = d1; acS[w * 128 + l0] = incl - a1; acS[w * 128 + l0 + 1] = incl; }
#pragma unroll
    for (int i = 0; i < 4; ++i) { const int q = tid + 512 * i, l = q >> 4, nc = q & 15;
        *(LAS u32x4*)(Bc + l * 272 + nc * 16) = *(const u32x4*)(XP_XBC(X) + (size_t)(t0 + l) * XBCW + 1024 + 128 * g + nc * 8);
        *(LAS u32x4*)(Cc + l * 272 + nc * 16) = *(const u32x4*)(XP_XBC(X) + (size_t)(t0 + l) * XBCW + 1280 + 128 * g + nc * 8); }
    __syncthreads();
    const int fr = lane & 15, fq = lane >> 4, q4 = (lane & 15) >> 2, p4 = lane & 3, l = 16 * w + fr;
    f32x4 cb[8]; bf16x8 cfr[4];
#pragma unroll
    for (int n = 0; n < 8; ++n) cb[n] = (f32x4){0.f, 0.f, 0.f, 0.f};
#pragma unroll
    for (int ks = 0; ks < 4; ++ks) {
        cfr[ks] = *(const LAS bf16x8*)(Cc + l * 272 + (32 * ks + 8 * fq) * 2);
#pragma unroll
        for (int n = 0; n < 8; ++n) if (n <= w) { const bf16x8 bf = *(const LAS bf16x8*)(Bc + (16 * n + fr) * 272 + (32 * ks + 8 * fq) * 2); cb[n] = mma16(bf, cfr[ks], cb[n]); }
    }
    __syncthreads();
    float ss = 0.f;
    const int trp = (4 * fq + q4) * 144 + 8 * p4;
    const bf16* xp = XP_XBC(X) + (size_t)(t0 + l) * XBCW + 512 * g + 4 * fq; const bf16* zp = XP_PROJ(X) + (size_t)(t0 + l) * LDP + C_Z + 512 * g + 4 * fq;
    bf16* op = XP_MIX(X) + (size_t)(t0 + l) * D + 1024 + 512 * g + 4 * fq;
#pragma unroll 1
    for (int hp = 0; hp < 4; ++hp) {
#pragma unroll
        for (int i = 0; i < 4; ++i) { const int q = tid + 512 * i, e2 = q >> 10, s = (q >> 3) & 127, pc = q & 7, e = 2 * hp + e2;
            const u32x4 v = *(const u32x4*)(XP_XBC(X) + (size_t)(t0 + s) * XBCW + 512 * g + 64 * e + pc * 8); const float d = dtS[e * 128 + s];
            u32x4 o; o.x = pk_bf16(bf_lo(v.x) * d, bf_hi(v.x) * d); o.y = pk_bf16(bf_lo(v.y) * d, bf_hi(v.y) * d); o.z = pk_bf16(bf_lo(v.z) * d, bf_hi(v.z) * d); o.w = pk_bf16(bf_lo(v.w) * d, bf_hi(v.w) * d);
            *(LAS u32x4*)(HP + e2 * 18432 + s * 144 + pc * 16) = o; }
#pragma unroll
        for (int i = 0; i < 4; ++i) { const int q = tid + 512 * i, e2 = q >> 10, p = (q >> 4) & 63, nc = q & 15, e = 2 * hp + e2;
            *(LAS u32x4*)(HP + 36864 + e2 * 17408 + p * 272 + nc * 16) = *(const u32x4*)(XP_SST(X) + ((size_t)(c * 16 + 8 * g + e) * 64 + p) * 128 + nc * 8); }
        __syncthreads();
#pragma unroll 1
        for (int e2 = 0; e2 < 2; ++e2) { const int e = 2 * hp + e2;
            LAS uchar* Xh = HP + e2 * 18432; LAS uchar* Ph = HP + 36864 + e2 * 17408;
            f32x4 y[4];
#pragma unroll
            for (int n = 0; n < 4; ++n) y[n] = (f32x4){0.f, 0.f, 0.f, 0.f};
#pragma unroll
            for (int ks = 0; ks < 4; ++ks)
#pragma unroll
                for (int n = 0; n < 4; ++n) { const bf16x8 bf = *(const LAS bf16x8*)(Ph + (16 * n + fr) * 272 + (32 * ks + 8 * fq) * 2); y[n] = mma16(bf, cfr[ks], y[n]); }
            const float al = acS[e * 128 + l], el = __expf(al);
#pragma unroll
            for (int n = 0; n < 4; ++n) y[n] = y[n] * el;
#pragma unroll
            for (int k2 = 0; k2 < 4; ++k2) if (2 * k2 <= w) { float v[8];
#pragma unroll
                for (int tq = 0; tq < 2; ++tq) { const int s0 = 16 * (2 * k2 + tq) + 4 * fq; const f32x4 as = *(const LAS f32x4*)(acS + e * 128 + s0);
#pragma unroll
                    for (int j = 0; j < 4; ++j) v[4 * tq + j] = (s0 + j <= l) ? cb[2 * k2 + tq][j] * __expf(al - as[j]) : 0.f; }
                u32x4 pk; pk.x = pk_bf16(v[0], v[1]); pk.y = pk_bf16(v[2], v[3]); pk.z = pk_bf16(v[4], v[5]); pk.w = pk_bf16(v[6], v[7]);
                const bf16x8 gf = __builtin_bit_cast(bf16x8, pk);
#pragma unroll
                for (int n = 0; n < 4; ++n) { const bf16x8 bf = tr_frag(Xh + (32 * k2) * 144 + (16 * n) * 2 + trp, 16 * 144); y[n] = mma16(bf, gf, y[n]); }
            }
            const float dsk = XP_d_skip(X)[8 * g + e];
#pragma unroll
            for (int n = 0; n < 4; ++n) { const u32x2 xv = *(const u32x2*)(xp + 64 * e + 16 * n), zv = *(const u32x2*)(zp + 64 * e + 16 * n);
                const float t0_ = (y[n][0] + dsk * bf_lo(xv.x)) * silu_f(bf_lo(zv.x)), t1_ = (y[n][1] + dsk * bf_hi(xv.x)) * silu_f(bf_hi(zv.x));
                const float t2_ = (y[n][2] + dsk * bf_lo(xv.y)) * silu_f(bf_lo(zv.y)), t3_ = (y[n][3] + dsk * bf_hi(xv.y)) * silu_f(bf_hi(zv.y));
                ss += (t0_ * t0_ + t1_ * t1_) + (t2_ * t2_ + t3_ * t3_);
                u32x2 o; o.x = pk_bf16(t0_, t1_); o.y = pk_bf16(t2_, t3_); *(u32x2*)(op + 64 * e + 16 * n) = o; }
        }
        __syncthreads();
    }
    ss += __shfl_xor(ss, 16); ss += __shfl_xor(ss, 32);
    const float rstd = rsqrtf(ss * (1.f / 512.f) + EPS);
    const float* nw = XP_ssm_norm_w(X) + 512 * g + 4 * fq;
#pragma unroll 4
    for (int i = 0; i < 32; ++i) { const f32x4 wv = *(const f32x4*)(nw + 16 * i); const u32x2 t = *(const u32x2*)(op + 16 * i);
        u32x2 o; o.x = pk_bf16(bf_lo(t.x) * rstd * wv.x, bf_hi(t.x) * rstd * wv.y); o.y = pk_bf16(bf_lo(t.y) * rstd * wv.z, bf_hi(t.y) * rstd * wv.w);
        *(u32x2*)(op + 16 * i) = o; }
    __syncthreads();
}

__device__ __forceinline__ void p6_router(Ctx& X) {
    const int tid = X.tid, lane = X.lane, w = X.wave, fr = lane & 15, fq = lane >> 4;
    LAS float* part = (LAS float*)X.lds;
    LAS float* ssq = (LAS float*)(X.lds + 32768);
    LAS float* lgt = (LAS float*)(X.lds + 32768 + 1024);
    LAS float* rs = (LAS float*)(X.lds + 32768 + 1024 + 4096);
    for (int item = X.bid; item < T / 32; item += X.G) {
        const int tb = item * 32;
        f32x4 acc[2][2]; float ss[2] = {0.f, 0.f};
#pragma unroll
        for (int a = 0; a < 2; ++a)
#pragma unroll
            for (int n = 0; n < 2; ++n) acc[a][n] = (f32x4){0.f, 0.f, 0.f, 0.f};
#pragma unroll 2
        for (int ks = 0; ks < 8; ++ks) { const int kb = 256 * w + 32 * ks + 8 * fq;
            bf16x8 ah[2], al[2], bh[2], bl[2];
#pragma unroll
            for (int mt = 0; mt < 2; ++mt) { const float* hp = XP_Hh(X) + (size_t)(tb + 16 * mt + fr) * D + kb;
                const f32x4 x0 = *(const f32x4*)hp, x1 = *(const f32x4*)(hp + 4);
                ss[mt] += (x0.x * x0.x + x0.y * x0.y) + (x0.z * x0.z + x0.w * x0.w) + (x1.x * x1.x + x1.y * x1.y) + (x1.z * x1.z + x1.w * x1.w);
                u32x4 h, l; h.x = pk_bf16(x0.x, x0.y); h.y = pk_bf16(x0.z, x0.w); h.z = pk_bf16(x1.x, x1.y); h.w = pk_bf16(x1.z, x1.w);
                l.x = pk_bf16(x0.x - bf_lo(h.x), x0.y - bf_hi(h.x)); l.y = pk_bf16(x0.z - bf_lo(h.y), x0.w - bf_hi(h.y)); l.z = pk_bf16(x1.x - bf_lo(h.z), x1.y - bf_hi(h.z)); l.w = pk_bf16(x1.z - bf_lo(h.w), x1.w - bf_hi(h.w));
                ah[mt] = __builtin_bit_cast(bf16x8, h); al[mt] = __builtin_bit_cast(bf16x8, l); }
#pragma unroll
            for (int nt = 0; nt < 2; ++nt) { bh[nt] = *(const bf16x8*)(XP_WRH(X) + (size_t)(16 * nt + fr) * D + kb); bl[nt] = *(const bf16x8*)(XP_WRL(X) + (size_t)(16 * nt + fr) * D + kb); }
#pragma unroll
            for (int mt = 0; mt < 2; ++mt)
#pragma unroll
                for (int nt = 0; nt < 2; ++nt) { acc[mt][nt] = mma16(bh[nt], ah[mt], acc[mt][nt]); acc[mt][nt] = mma16(bl[nt], ah[mt], acc[mt][nt]); acc[mt][nt] = mma16(bh[nt], al[mt], acc[mt][nt]); }
        }
#pragma unroll
        for (int mt = 0; mt < 2; ++mt) { float q = ss[mt]; q += __shfl_xor(q, 16); q += __shfl_xor(q, 32); if (fq == 0) ssq[w * 32 + 16 * mt + fr] = q;
#pragma unroll
            for (int nt = 0; nt < 2; ++nt) *(LAS f32x4*)(part + (w * 32 + 16 * mt + fr) * 32 + 16 * nt + 4 * fq) = acc[mt][nt]; }
        __syncthreads();
        { const int tk = tid >> 4, e0 = 2 * (tid & 15); float q = 0.f, a0 = 0.f, a1 = 0.f;
#pragma unroll
          for (int ww = 0; ww < 8; ++ww) { q += ssq[ww * 32 + tk]; const f32x2 p = *(const LAS f32x2*)(part + (ww * 32 + tk) * 32 + e0); a0 += p.x; a1 += p.y; }
          const float rstd = rsqrtf(q * (1.f / D) + EPS);
          lgt[tk * 32 + e0] = a0 * rstd + XP_b_router(X)[e0]; lgt[tk * 32 + e0 + 1] = a1 * rstd + XP_b_router(X)[e0 + 1];
          if ((tid & 15) == 0) rs[tk] = rstd; }
        __syncthreads();
        if (tid < 32) { const int t = tb + tid; unsigned used = 0u; int idx[4]; float val[4];
#pragma unroll
            for (int k = 0; k < 4; ++k) { float best = -3.0e38f; int bi = 0;
#pragma unroll 8
                for (int j = 0; j < 32; ++j) { const float v = lgt[tid * 32 + j]; if (!((used >> j) & 1u) && v > best) { best = v; bi = j; } }
                used |= 1u << bi; idx[k] = bi; val[k] = best; }
            const float e1 = __expf(val[1] - val[0]), e2 = __expf(val[2] - val[0]), e3 = __expf(val[3] - val[0]), inv = 1.f / (1.f + e1 + e2 + e3);
            const float wv[4] = {inv, e1 * inv, e2 * inv, e3 * inv};
#pragma unroll
            for (int k = 0; k < 4; ++k) { const int rank = (int)atomicAdd(XP_ctl(X) + CW_CNT + 64 * idx[k], 1u);
                XP_LIST(X)[idx[k] * T + rank] = t; XP_TOPI(X)[t * 4 + k] = idx[k]; XP_TOPR(X)[t * 4 + k] = rank; XP_TOPW(X)[t * 4 + k] = wv[k]; } }
#pragma unroll 2
        for (int r = 0; r < 4; ++r) { const int tk = 4 * w + r, t = tb + tk; const float rstd = rs[tk];
            const f32x4* hr = (const f32x4*)(XP_Hh(X) + (size_t)t * D) + lane; const f32x4* wr_ = (const f32x4*)XP_ln_ffn_w(X) + lane;
            unsigned* o8 = (unsigned*)(XP_U2(X) + (size_t)t * D) + lane;
#pragma unroll
            for (int j = 0; j < 8; ++j) { const f32x4 v = hr[64 * j], wv = wr_[64 * j]; o8[64 * j] = pk_fp8x4(v.x * rstd * wv.x, v.y * rstd * wv.y, v.z * rstd * wv.z, v.w * rstd * wv.w); } }
        __syncthreads();
    }
}

__device__ __forceinline__ void moe_tables(Ctx& X) {
    LAS int* tab = (LAS int*)(X.lds + LDS_TAB);
    if (X.tid == 0) { int nb = 0;
        for (int e = 0; e < NE; ++e) { const int cnt = (int)__hip_atomic_load(XP_ctl(X) + CW_CNT + 64 * e, __ATOMIC_RELAXED, __HIP_MEMORY_SCOPE_AGENT); const int k = (cnt + 255) >> 8;
            tab[8 + e] = nb; for (int b = 0; b < k; ++b) { if (nb + b < MAXBLK) { tab[64 + nb + b] = e; tab[256 + nb + b] = (cnt - 256 * b) < 256 ? (cnt - 256 * b) : 256; } } nb += k; }
        tab[8 + NE] = nb; tab[0] = nb < MAXBLK ? nb : MAXBLK; }
    __syncthreads();
}

__device__ __forceinline__ void p9_final(Ctx& X) {
    const LAS int* tab = (const LAS int*)(X.lds + LDS_TAB);
    const int gw = X.bid * NWAVES + X.wave, NGW = X.G * NWAVES, lane = X.lane;
    for (int t = gw; t < T; t += NGW) {
        const f32x4* hr = (const f32x4*)(XP_Hh(X) + (size_t)t * D) + lane;
        f32x4 v[8];
#pragma unroll
        for (int j = 0; j < 8; ++j) v[j] = hr[64 * j];
#pragma unroll
        for (int k = 0; k < 4; ++k) { const int e = XP_TOPI(X)[t * 4 + k], r = XP_TOPR(X)[t * 4 + k]; const float wk = XP_TOPW(X)[t * 4 + k];
            const u32x2* yr = (const u32x2*)(XP_YR(X) + ((size_t)tab[8 + e] * 256 + r) * D) + lane;
#pragma unroll
            for (int j = 0; j < 8; ++j) { const u32x2 y = yr[64 * j]; v[j].x += wk * bf_lo(y.x); v[j].y += wk * bf_hi(y.x); v[j].z += wk * bf_lo(y.y); v[j].w += wk * bf_hi(y.y); } }
        float s = 0.f;
#pragma unroll
        for (int j = 0; j < 8; ++j) s += (v[j].x * v[j].x + v[j].y * v[j].y) + (v[j].z * v[j].z + v[j].w * v[j].w);
        const float rstd = rsqrtf(wave_sum(s) * (1.f / D) + EPS);
        f32x4* o = (f32x4*)(X.out + (size_t)t * D) + lane; const f32x4* wr_ = (const f32x4*)XP_ln_final_w(X) + lane;
#pragma unroll
        for (int j = 0; j < 8; ++j) { const f32x4 wv = wr_[64 * j]; f32x4 r; r.x = v[j].x * rstd * wv.x; r.y = v[j].y * rstd * wv.y; r.z = v[j].z * rstd * wv.z; r.w = v[j].w * rstd * wv.w; o[64 * j] = r; }
    }
}

#ifdef NO_P4R
#define P4R(X,u)
#else
#define P4R(X,u) p4_ret(X,u)
#endif
#ifdef NO_P4S
#define P4S(X,u)
#else
#define P4S(X,u) p4_ssd(X,u)
#endif
struct Args { const void* in[19]; float* out; uchar* ws; int ph_lo, ph_hi; };
__global__ void __launch_bounds__(NTHR, 2) fwd(Args args) {
    extern __shared__ __attribute__((aligned(16))) uchar lds_raw[];
    Ctx X;
    X.lds = (LAS uchar*)lds_raw; X.tid = threadIdx.x; X.lane = X.tid & 63; X.wave = __builtin_amdgcn_readfirstlane(X.tid >> 6); X.G = gridDim.x; X.bid = blockIdx.x;
    X.in = (const void* const*)__builtin_amdgcn_kernarg_segment_ptr(); X.out = args.out; X.ws = args.ws;
    for (int u = X.tid; u < (LDS_BYTES - LDS_PHASE_END) / 4; u += NTHR) ((LAS unsigned*)(X.lds + LDS_PHASE_END))[u] = 0u;
    __syncthreads();
    const int lo = args.ph_lo, hi = args.ph_hi;
    const bool multi = (hi - lo) > 1;
    XcdBarrier bar; bar.bar = XP_ctl(X) + CW_BAR; bar.x = 0; bar.st = nullptr;
    if (multi) bar = xcd_barrier_post(XP_ctl(X) + CW_BAR, (volatile LAS unsigned*)(X.lds + LDS_MISC + 32));
#ifdef ONLY_PHASE
#define IN(k) ((k) == ONLY_PHASE && lo <= (k) && (k) < hi)
#else
#define IN(k) (lo <= (k) && (k) < hi)
#endif
#define SEAM(k) do { if (IN(k) && IN((k) + 1)) xcd_barrier(bar); } while (0)
    if (IN(0)) { p0_prologue(X); } SEAM(0);
    if (IN(1)) { DenseSched S{(const char*)XP_U(X), (const char*)XP_WinT(X), D, T / 256, LDP / 256, (T / 256) * (LDP / 256), X.G, X.bid}; EpiProj E{XP_PROJ(X), LDP};
        pg8::gemm_phase<EpiProj, DenseSched, false, false>(X.lds, D, S, E);
        if (X.G == 256 && X.bid >= 96) conv8_fill(X, FILL_B1, (X.bid - 96) * NWAVES + X.wave, FILL_W1, FILL_N1); } SEAM(1);
    if (IN(2)) { for (int u = X.bid; u < 512; u += X.G) { if (u < 256) p2_ret(X, u); else p2_ssd(X, u - 256); } } SEAM(2);
    if (IN(3)) { p3_scan(X); if (X.G == 256 && X.bid >= 192) conv8_fill(X, FILL_B3, (X.bid - 192) * NWAVES + X.wave, FILL_W3, FILL_N3); } SEAM(3);
    if (IN(4)) { for (int u = X.bid; u < 384; u += X.G) { if (u < 256) { P4R(X, u); } else { P4S(X, u - 256); } }
        if (X.G == 256 && X.bid >= 128) conv8_fill(X, FILL_B4, (X.bid - 128) * NWAVES + X.wave, FILL_W4, FILL_N4); } SEAM(4);
    if (IN(5)) { DenseSched S{(const char*)XP_MIX(X), (const char*)XP_WoutT(X), D, T / 256, D / 256, (T / 256) * (D / 256), X.G, X.bid}; EpiOut E{XP_x(X), XP_Hh(X)};
        pg8::gemm_phase<EpiOut, DenseSched, false, false>(X.lds, D, S, E); } SEAM(5);
    if (IN(6)) { p6_router(X); } SEAM(6);
    if (IN(7)) { moe_tables(X); MoeSched S{(const LAS int*)(X.lds + LDS_TAB), (const char*)XP_U2(X), (const char*)XP_WguT(X), (size_t)(2 * DFF) * D, XP_LIST(X), D / 2, (2 * DFF) / 256, X.G, X.bid}; EpiGateUp E{XP_ACT(X), XP_b_gu(X)};
        pg8::gemm_phase<EpiGateUp, MoeSched, true, true>(X.lds, D / 2, S, E); } SEAM(7);
    if (IN(8)) { moe_tables(X); MoeSchedDirect S{(const LAS int*)(X.lds + LDS_TAB), (const char*)XP_ACT(X), (const char*)XP_WdT(X), (size_t)D * DFF, DFF / 2, D / 256, X.G, X.bid}; EpiDown E{XP_YR(X), XP_b_d(X)};
        pg8::gemm_phase<EpiDown, MoeSchedDirect, true, true>(X.lds, DFF / 2, S, E); } SEAM(8);
    if (IN(9)) { moe_tables(X); p9_final(X); }
#undef IN
#undef SEAM
}

extern "C" void kernel_launch(void* const* d_in, const int* in_sizes, int n_in, void* d_out, int out_size, void* d_ws, size_t ws_size, hipStream_t stream) {
    static int grid = 0;
    if (grid == 0) {
        if (n_in != 19 || out_size != T * D || ws_size < WS_END) { fprintf(stderr, "kernel_launch: unexpected shapes (n_in %d, out %d, ws %zu)\n", n_in, out_size, ws_size); grid = -1; return; }
        int dev = 0, cus = 0, per_cu = 0;
        if (hipGetDevice(&dev) != hipSuccess || hipDeviceGetAttribute(&cus, hipDeviceAttributeMultiprocessorCount, dev) != hipSuccess) { grid = -1; return; }
        if (hipFuncSetAttribute((const void*)fwd, hipFuncAttributeMaxDynamicSharedMemorySize, LDS_BYTES) != hipSuccess) { fprintf(stderr, "kernel_launch: hipFuncSetAttribute failed\n"); grid = -1; return; }
        if (hipOccupancyMaxActiveBlocksPerMultiprocessor(&per_cu, (const void*)fwd, NTHR, LDS_BYTES) != hipSuccess || per_cu < 1) { fprintf(stderr, "kernel_launch: occupancy query reports %d\n", per_cu); }
        (void)hipGetLastError();
        grid = cus;
    }
    if (grid < 0) return;
    (void)hipMemsetAsync((char*)d_ws + WS_CTL, 0, CTL_ZERO_BYTES, stream);
    Args a{};
    for (int i = 0; i < 19; ++i) a.in[i] = d_in[i];
    a.out = (float*)d_out; a.ws = (uchar*)d_ws;
    constexpr int NL = MK_N_LAUNCHES;
    for (int li = 0; li < NL; ++li) {
        a.ph_lo = (NL == 1) ? 0 : li; a.ph_hi = (NL == 1) ? NPHASE : li + 1;
        hipLaunchKernelGGL(fwd, dim3(grid), dim3(NTHR), LDS_BYTES, stream, a);
    }
}
```

```cpp
#include <hip/hip_runtime.h>
#include <cstdio>
#include <cstdint>

#ifndef MK_N_LAUNCHES
#define MK_N_LAUNCHES 1
#endif

#define LAS __attribute__((address_space(3)))
typedef unsigned short bf16;
typedef short bf16x8 __attribute__((ext_vector_type(8)));
typedef short s16x4 __attribute__((ext_vector_type(4)));
typedef float f32x4 __attribute__((ext_vector_type(4)));
typedef float f32x2 __attribute__((ext_vector_type(2)));
typedef unsigned u32x4 __attribute__((ext_vector_type(4)));
typedef unsigned u32x2 __attribute__((ext_vector_type(2)));
typedef unsigned char uchar;
typedef int i32x8 __attribute__((ext_vector_type(8)));
typedef int i32x4 __attribute__((ext_vector_type(4)));
constexpr float W8_SCALE = 64.f, W8_INV = 1.f / 64.f;

constexpr int T = 8192, D = 2048, NPROJ = 6672, LDP = 6912;
constexpr int C_Q = 0, C_K = 1024, C_V = 2048, C_G = 3072, C_Z = 4096, C_X = 5120, C_DT = 6656;
constexpr int XBCW = 1536, NCHUNK = 64, CH = 128;
constexpr int NE = 32, DFF = 2048, MAXBLK = 160;
constexpr float EPS = 1e-6f;
constexpr int NPHASE = 10;
constexpr int NWAVES = 8, NTHR = 512;

constexpr size_t MiB = 1ull << 20;
constexpr size_t WS_CTL = 0, CTL_ZERO_BYTES = 1 * MiB;
constexpr size_t WS_WINT = 2 * MiB, WS_WOUTT = 30 * MiB, WS_COS = 38 * MiB, WS_SIN = 42 * MiB;
constexpr size_t WS_TOPI = 46 * MiB, WS_TOPR = 46 * MiB + 128 * 1024, WS_TOPW = 46 * MiB + 256 * 1024, WS_LIST = 47 * MiB, WS_ADEC = 48 * MiB;
constexpr size_t WS_WRH = 49 * MiB, WS_WRL = 49 * MiB + 128 * 1024;
constexpr size_t WS_U = 64 * MiB, WS_U2 = 96 * MiB, WS_MIX = 128 * MiB, WS_XBC = 160 * MiB, WS_KV = 192 * MiB, WS_SST = 224 * MiB;
constexpr size_t WS_H = 256 * MiB, WS_PROJ = 320 * MiB, WS_ACT = 448 * MiB, WS_YR = 608 * MiB, WS_WGUT = 768 * MiB, WS_WDT = 1280 * MiB, WS_END = 1536 * MiB;
constexpr int CW_TMO = 0, CW_BAR = 4096, CW_CNT = 16384;

constexpr int RING_BYTES = 131072;
constexpr int LDS_PHASE_END = 139264;
constexpr int LDS_TAB = LDS_PHASE_END;
constexpr int LDS_IDX = LDS_PHASE_END + 2048;
constexpr int LDS_MISC = LDS_PHASE_END + 4096;
constexpr int LDS_BIAS = LDS_PHASE_END + 5120;
constexpr int LDS_BYTES = 147456;

__device__ __forceinline__ unsigned pk_bf16(float lo, float hi) { unsigned r; asm("v_cvt_pk_bf16_f32 %0, %1, %2" : "=v"(r) : "v"(lo), "v"(hi)); return r; }
__device__ __forceinline__ float clamp448(float x) { return fminf(fmaxf(x, -448.f), 448.f); }
__device__ __forceinline__ unsigned pk_fp8x4(float a, float b, float c, float d) {
    int p = 0; p = __builtin_amdgcn_cvt_pk_fp8_f32(clamp448(a), clamp448(b), p, false); p = __builtin_amdgcn_cvt_pk_fp8_f32(clamp448(c), clamp448(d), p, true); return (unsigned)p; }
__device__ __forceinline__ float bf_lo(unsigned u) { return __uint_as_float(u << 16); }
__device__ __forceinline__ float bf_hi(unsigned u) { return __uint_as_float(u & 0xffff0000u); }
__device__ __forceinline__ float bf2f(bf16 b) { return __uint_as_float(((unsigned)b) << 16); }
__device__ __forceinline__ float wave_sum(float v) {
#pragma unroll
    for (int o = 1; o < 64; o <<= 1) v += __shfl_xor(v, o);
    return v;
}
__device__ __forceinline__ float silu_f(float x) { return x * __builtin_amdgcn_rcpf(1.0f + __expf(-x)); }
__device__ __forceinline__ float softplus_f(float x) { return x > 20.f ? x : log1pf(__expf(x)); }

__constant__ double INV_FREQ[128] = {1,0.93057204092969903,0.86596432336006535,0.80584218776148187,0.74989420933245587,0.69783058485986638,0.64938163157621132,0.60429639023813286,0.56234132519034907,0.5232991146814947,0.48696752516586311,0.45315836376008178,0.42169650342858223,0.39241897584845359,0.36517412725483772,0.33982083289425596,0.31622776601683794,0.29427271762092816,0.27384196342643613,0.25482967479793467,0.23713737056616552,0.22067340690845899,0.20535250264571461,0.19109529749704404,0.17782794100389229,0.16548170999431813,0.15399265260594919,0.14330125702369628,0.1333521432163324,0.12409377607517195,0.11547819846894582,0.10746078283213174,0.10000000000000001,0.0930572040929699,0.086596432336006529,0.080584218776148187,0.074989420933245579,0.069783058485986635,0.064938163157621132,0.060429639023813285,0.056234132519034911,0.05232991146814947,0.048696752516586311,0.045315836376008181,0.042169650342858224,0.039241897584845357,0.036517412725483769,0.033982083289425591,0.031622776601683791,0.029427271762092817,0.027384196342643614,0.025482967479793464,0.023713737056616554,0.022067340690845899,0.02053525026457146,0.019109529749704406,0.017782794100389229,0.016548170999431813,0.015399265260594919,0.014330125702369627,0.013335214321633241,0.012409377607517195,0.011547819846894581,0.010746078283213174,0.01,0.0093057204092969904,0.0086596432336006543,0.008058421877614819,0.0074989420933245579,0.0069783058485986633,0.006493816315762113,0.0060429639023813278,0.005623413251903491,0.0052329911468149467,0.004869675251658631,0.0045315836376008181,0.0042169650342858229,0.0039241897584845363,0.0036517412725483771,0.0033982083289425592,0.0031622776601683794,0.002942727176209282,0.0027384196342643613,0.0025482967479793467,0.0023713737056616554,0.0022067340690845897,0.002053525026457146,0.0019109529749704406,0.0017782794100389228,0.0016548170999431814,0.001539926526059492,0.0014330125702369627,0.0013335214321633241,0.0012409377607517195,0.0011547819846894581,0.0010746078283213176,0.001,0.00093057204092969893,0.00086596432336006539,0.00080584218776148179,0.00074989420933245586,0.00069783058485986635,0.00064938163157621134,0.00060429639023813287,0.0005623413251903491,0.00052329911468149473,0.0004869675251658631,0.00045315836376008179,0.00042169650342858224,0.00039241897584845359,0.0003651741272548377,0.00033982083289425596,0.00031622776601683794,0.00029427271762092817,0.00027384196342643611,0.00025482967479793463,0.00023713737056616554,0.00022067340690845897,0.00020535250264571461,0.00019109529749704405,0.00017782794100389227,0.00016548170999431815,0.00015399265260594919,0.00014330125702369627,0.0001333521432163324,0.00012409377607517196,0.00011547819846894582,0.00010746078283213175};
__constant__ float LG2_GAMMA[4] = {-0.045803689613124789f, -0.022720076500083529f, -0.011315313227834146f, -0.0056465631411420627f};
__constant__ float GAMMA_CHUNK[4] = {0.017183023570817902f, 0.13321516287964841f, 0.36643771592203728f, 0.60593708822908032f};

namespace pg8 {
constexpr int BM = 256, BK = 64, HALF = 128, HTB = HALF * BK * 2, STAGE_BYTES = 8 * HTB, NXCD = 8, WGM = 8;
__host__ __device__ __forceinline__ int lds_byte(int r, int c) { const int st = (r >> 4) * 2 + (c >> 5), rr = r & 15, cc = c & 31, ob = rr * 64 + cc * 2; return st * 1024 + (ob ^ (((ob >> 9) & 1) << 5)); }
__host__ __device__ __forceinline__ void stage_rc(int b, int& R, int& C) { const int st = b / 1024, sb = b % 1024, swz = sb ^ (((sb >> 9) & 1) << 5); R = (st >> 1) * 16 + swz / 64; C = (st & 1) * 32 + (swz % 64) / 2; }
__host__ __device__ __forceinline__ int perm32(int rho) { const int n = rho >> 4, i = rho & 15; return 8 * (i >> 2) + 4 * n + (i & 3); }

struct Unit { const char* pa; const char* pb; int row0, col0, aux, blk; };

template <class Epi, class Sched, bool GATHER, bool FP8>
__device__ __forceinline__ void gemm_phase(LAS uchar* lds, const int K, const Sched& S, const Epi& E) {
    const int tid = threadIdx.x, wid = __builtin_amdgcn_readfirstlane(tid >> 6), lane = tid & 63, wr = wid >> 2, wc = wid & 3, fr = lane & 15, fq = lane >> 4;
    const int nt = K / BK;
    unsigned voA[2][2], voffB[2];
#pragma unroll
    for (int i = 0; i < 2; ++i) { int R, C; stage_rc(tid * 16 + i * 8192, R, C); const int Rb = Epi::PERM == 16 ? 64 * (R >> 5) + 16 * ((R >> 2) & 3) + 4 * ((R >> 4) & 1) + (R & 3) : (Epi::PERM == 8 ? ((R & ~31) + perm32(R & 31)) : R);
        voA[0][i] = (unsigned)(R * K + C) * 2u; voA[1][i] = voA[0][i] + (unsigned)(HALF * K * 2); voffB[i] = (unsigned)(Rb * K + C) * 2u; }
    const size_t kstep = (size_t)(BK * 2);
    const size_t hstep = (size_t)(Epi::PERM == 16 ? 8 : HALF) * K * 2;
    const unsigned ldsw = (unsigned)wid * 1024u;
    const int aoff = lds_byte(wr * 64 + fr, fq * 8), boff = lds_byte(wc * 32 + fr, fq * 8);
#define PG8_SA(b, h) (((b) * 2 + (h)) * HTB)
#define PG8_SB(b, h) ((4 + (b) * 2 + (h)) * HTB)
#define PG8_STAGE(bufoff, gbase, voff) do { _Pragma("unroll") for (int _i = 0; _i < 2; ++_i) \
        __builtin_amdgcn_global_load_lds((const unsigned*)((const char*)(gbase) + (voff)[_i]), (LAS unsigned*)(lds + (bufoff) + ldsw + _i * 8192), 16, 0, 0); } while (0)
#define PG8_LDA(dst, b, h) do { _Pragma("unroll") for (int m = 0; m < 4; ++m) _Pragma("unroll") for (int k = 0; k < 2; ++k) dst[m][k] = *(const LAS bf16x8*)(lds + PG8_SA(b, h) + aoff + m * 2048 + k * 1024); } while (0)
#define PG8_LDB(dst, b, h) do { _Pragma("unroll") for (int n = 0; n < 2; ++n) _Pragma("unroll") for (int k = 0; k < 2; ++k) dst[n][k] = *(const LAS bf16x8*)(lds + PG8_SB(b, h) + boff + n * 2048 + k * 1024); } while (0)
#define PG8_CAT(x) __builtin_shufflevector(__builtin_bit_cast(i32x4, (x)[0]), __builtin_bit_cast(i32x4, (x)[1]), 0, 1, 2, 3, 4, 5, 6, 7)
#define PG8_MMA(ai, bj, At, Bt) do { __builtin_amdgcn_s_setprio(1); \
        if constexpr (FP8) { _Pragma("unroll") for (int m = 0; m < 4; ++m) _Pragma("unroll") for (int n = 0; n < 2; ++n) \
            acc[ai][bj][m][n] = __builtin_amdgcn_mfma_scale_f32_16x16x128_f8f6f4(PG8_CAT(Bt[n]), PG8_CAT(At[m]), acc[ai][bj][m][n], 0, 0, 0, 0x7f7f7f7f, 0, 0x7f7f7f7f); } \
        else { _Pragma("unroll") for (int m = 0; m < 4; ++m) _Pragma("unroll") for (int n = 0; n < 2; ++n) _Pragma("unroll") for (int k = 0; k < 2; ++k) \
            acc[ai][bj][m][n] = __builtin_amdgcn_mfma_f32_16x16x32_bf16(Bt[n][k], At[m][k], acc[ai][bj][m][n], 0, 0, 0); } \
        __builtin_amdgcn_s_setprio(0); } while (0)
#define PG8_WAIT_V(n) asm volatile("s_waitcnt vmcnt(" #n ")" ::: "memory")
#define PG8_WAIT_L(n) asm volatile("s_waitcnt lgkmcnt(" #n ")" ::: "memory")
#define PG8_BAR __builtin_amdgcn_s_barrier()
#define PG8_SCHED __builtin_amdgcn_sched_barrier(0)
    Unit cur, nxt; int ui = 0;
    if (!S.next(0, cur)) return;
    f32x4 acc[2][2][4][2];
#pragma unroll
    for (int a = 0; a < 2; ++a)
#pragma unroll
        for (int b = 0; b < 2; ++b)
#pragma unroll
            for (int m = 0; m < 4; ++m)
#pragma unroll
                for (int n = 0; n < 2; ++n) acc[a][b][m][n] = (f32x4){0.f, 0.f, 0.f, 0.f};
    bf16x8 At[4][2], B0[2][2], B1[2][2];
    const char* cA = cur.pa; const char* cB = cur.pb;
    if constexpr (GATHER) S.gather(cur, voA, (const LAS int*)nullptr);
    PG8_STAGE(PG8_SB(0, 0), cB, voffB); PG8_STAGE(PG8_SB(0, 1), cB + hstep, voffB); PG8_STAGE(PG8_SA(0, 0), cA, voA[0]); PG8_STAGE(PG8_SA(0, 1), cA, voA[1]);
    if (wr == 1) PG8_BAR;
    PG8_WAIT_V(2); PG8_BAR;
    PG8_STAGE(PG8_SB(1, 0), cB + kstep, voffB); PG8_STAGE(PG8_SA(1, 0), cA + kstep, voA[0]); PG8_STAGE(PG8_SB(1, 1), cB + hstep + kstep, voffB);
    PG8_WAIT_V(6); PG8_BAR;
    for (;;) {
        const bool has_next = S.next(ui + 1, nxt);
        if constexpr (GATHER) { if (has_next) S.prefetch(nxt, lds + LDS_IDX + ((ui + 1) & 1) * 1024, wid, lane); }
        E.prefetch(cur, lds + LDS_BIAS + (ui & 1) * 1024, wid, lane);
        const char* nA = has_next ? nxt.pa : cA; const char* nB = has_next ? nxt.pb : cB;
        for (int t = 0; t < nt; t += 2) {
            const bool last = (t == nt - 2);
            const char* a1 = cA + (size_t)(t + 1) * kstep;
            const char* a2 = last ? nA : cA + (size_t)(t + 2) * kstep; const char* b2 = last ? nB : cB + (size_t)(t + 2) * kstep;
            const char* a3 = a2 + kstep; const char* b3 = b2 + kstep;
            PG8_LDB(B0, 0, 0); PG8_LDB(B1, 0, 1); PG8_SCHED; PG8_LDA(At, 0, 0); PG8_STAGE(PG8_SA(1, 1), a1, voA[1]);
            if constexpr (GATHER) { if (last && has_next) S.gather(nxt, voA, (const LAS int*)(lds + LDS_IDX + ((ui + 1) & 1) * 1024)); }
            PG8_WAIT_V(8); PG8_WAIT_L(0); PG8_BAR; PG8_MMA(0, 0, At, B0); PG8_MMA(0, 1, At, B1); PG8_BAR; PG8_SCHED;
            PG8_LDA(At, 0, 1); PG8_STAGE(PG8_SB(0, 0), b2, voffB); PG8_STAGE(PG8_SB(0, 1), b2 + hstep, voffB); PG8_STAGE(PG8_SA(0, 0), a2, voA[0]);
            PG8_WAIT_V(8); PG8_WAIT_L(0); PG8_BAR; PG8_MMA(1, 0, At, B0); PG8_MMA(1, 1, At, B1); PG8_BAR; PG8_SCHED;
            PG8_LDB(B0, 1, 0); PG8_LDB(B1, 1, 1); PG8_SCHED; PG8_LDA(At, 1, 0); PG8_STAGE(PG8_SA(0, 1), a2, voA[1]);
            PG8_WAIT_V(8); PG8_WAIT_L(0); PG8_BAR; PG8_MMA(0, 0, At, B0); PG8_MMA(0, 1, At, B1); PG8_BAR; PG8_SCHED;
            PG8_LDA(At, 1, 1); PG8_STAGE(PG8_SB(1, 0), b3, voffB); PG8_STAGE(PG8_SB(1, 1), b3 + hstep, voffB); PG8_STAGE(PG8_SA(1, 0), a3, voA[0]);
            PG8_WAIT_V(8); PG8_WAIT_L(0); PG8_BAR; PG8_MMA(1, 0, At, B0); PG8_MMA(1, 1, At, B1); PG8_BAR; PG8_SCHED;
        }
        if (wr == 0) PG8_BAR;
        E(acc, cur, wr, wc, fr, fq, lds + LDS_BIAS + (ui & 1) * 1024);
        if (!has_next) break;
#pragma unroll
        for (int a = 0; a < 2; ++a)
#pragma unroll
            for (int b = 0; b < 2; ++b)
#pragma unroll
                for (int m = 0; m < 4; ++m)
#pragma unroll
                    for (int n = 0; n < 2; ++n) acc[a][b][m][n] = (f32x4){0.f, 0.f, 0.f, 0.f};
        cur = nxt; cA = nA; cB = nB; ++ui;
        if (wr == 1) PG8_BAR;
    }
    PG8_WAIT_V(0);
    PG8_BAR;
#undef PG8_SA
#undef PG8_SB
#undef PG8_STAGE
#undef PG8_LDA
#undef PG8_LDB
#undef PG8_MMA
#undef PG8_CAT
#undef PG8_WAIT_V
#undef PG8_WAIT_L
#undef PG8_BAR
#undef PG8_SCHED
}
}

struct DenseSched {
    const char* A; const char* B; int K, nM, nN, nwg, G, c;
    __device__ __forceinline__ bool next(int i, pg8::Unit& u) const {
        const long L = (long)i * G + c; if (L >= nwg) return false;
        int wgid = (int)L; { const int q = nwg / pg8::NXCD, r = nwg % pg8::NXCD, xcd = wgid % pg8::NXCD, off = wgid / pg8::NXCD; wgid = (xcd < r ? xcd * (q + 1) : r * (q + 1) + (xcd - r) * q) + off; }
        const int nig = pg8::WGM * nN, gid = wgid / nig, fm = gid * pg8::WGM, gsz = (nM - fm) < pg8::WGM ? (nM - fm) : pg8::WGM;
        const int pm = fm + ((wgid % nig) % gsz), pn = (wgid % nig) / gsz;
        u.pa = A + (size_t)pm * 256 * K * 2; u.pb = B + (size_t)pn * 256 * K * 2; u.row0 = pm * 256; u.col0 = pn * 256; u.aux = 0; u.blk = 0; return true;
    }
    __device__ __forceinline__ void gather(const pg8::Unit&, unsigned (&)[2][2], const LAS int*) const {}
    __device__ __forceinline__ void prefetch(const pg8::Unit&, LAS uchar*, int, int) const {}
};
struct MoeSched {
    const LAS int* tab; const char* A; const char* B; size_t bexp; const int* list; int K, nN, G, c;
    __device__ __forceinline__ bool next(int i, pg8::Unit& u) const {
        const int NB = __builtin_amdgcn_readfirstlane(tab[0]); const int L = i * G + c; if (L >= NB * nN) return false;
        const int b = L / nN, pn = L - b * nN, e = __builtin_amdgcn_readfirstlane(tab[64 + b]);
        u.pa = A; u.pb = B + (size_t)e * bexp + (size_t)pn * 256 * K * 2; u.row0 = b * 256; u.col0 = pn * 256; u.aux = e; u.blk = b; return true;
    }
    __device__ __forceinline__ void prefetch(const pg8::Unit& u, LAS uchar* buf, int wid, int lane) const {
        if (wid < 4) { const int e = u.aux, lb = (u.blk - __builtin_amdgcn_readfirstlane(tab[8 + e])) * 256;
            __builtin_amdgcn_global_load_lds((const unsigned*)(list + e * T + lb + 64 * wid + lane), (LAS unsigned*)(buf + wid * 256), 4, 0, 0); }
    }
    __device__ __forceinline__ void gather(const pg8::Unit& u, unsigned (&vo)[2][2], const LAS int* idx) const {
        const int e = u.aux, lb = (u.blk - __builtin_amdgcn_readfirstlane(tab[8 + e])) * 256, cnt = __builtin_amdgcn_readfirstlane(tab[256 + u.blk]);
#pragma unroll
        for (int i = 0; i < 2; ++i) { int R, C; pg8::stage_rc((int)threadIdx.x * 16 + i * 8192, R, C);
#pragma unroll
            for (int h = 0; h < 2; ++h) { const int r = h * 128 + R; const int raw = idx ? idx[r] : list[e * T + lb + r]; const int tok = (r < cnt) ? raw : 0; vo[h][i] = ((unsigned)tok * (unsigned)K + (unsigned)C) * 2u; } }
    }
};
struct MoeSchedDirect {
    const LAS int* tab; const char* A; const char* B; size_t bexp; int K, nN, G, c;
    __device__ __forceinline__ bool next(int i, pg8::Unit& u) const {
        const int NB = __builtin_amdgcn_readfirstlane(tab[0]); const int L = i * G + c; if (L >= NB * nN) return false;
        const int b = L / nN, pn = L - b * nN, e = __builtin_amdgcn_readfirstlane(tab[64 + b]);
        u.pa = A; u.pb = B + (size_t)e * bexp + (size_t)pn * 256 * K * 2; u.row0 = b * 256; u.col0 = pn * 256; u.aux = e; u.blk = b; return true;
    }
    __device__ __forceinline__ void prefetch(const pg8::Unit&, LAS uchar*, int, int) const {}
    __device__ __forceinline__ void gather(const pg8::Unit& u, unsigned (&vo)[2][2], const LAS int*) const {
#pragma unroll
        for (int i = 0; i < 2; ++i) { int R, C; pg8::stage_rc((int)threadIdx.x * 16 + i * 8192, R, C);
#pragma unroll
            for (int h = 0; h < 2; ++h) vo[h][i] = ((unsigned)(u.row0 + h * 128 + R) * (unsigned)K + (unsigned)C) * 2u; }
    }
};

#define EPI_LANE() int tz = threadIdx.x; asm volatile("" : "+v"(tz)); const int fr = tz & 15, fq = (tz >> 4) & 3; (void)fr_; (void)fq_
struct EpiProj {
    static constexpr int PERM = 8;
    bf16* O; int ldc;
    __device__ __forceinline__ void prefetch(const pg8::Unit&, LAS uchar*, int, int) const {}
    __device__ __forceinline__ void operator()(const f32x4 (&acc)[2][2][4][2], const pg8::Unit& u, int wr, int wc, int fr_, int fq_, const LAS uchar* bl) const {
        EPI_LANE();
        const int row0 = u.row0 + wr * 64 + fr, col0 = u.col0 + wc * 32 + 8 * fq;
#pragma unroll
        for (int ai = 0; ai < 2; ++ai)
#pragma unroll
            for (int m = 0; m < 4; ++m) { bf16* rowp = O + (size_t)(row0 + ai * 128 + m * 16) * ldc + col0;
#pragma unroll
                for (int bj = 0; bj < 2; ++bj) { const f32x4 v0 = acc[ai][bj][m][0], v1 = acc[ai][bj][m][1];
                    u32x4 w; w.x = pk_bf16(v0[0], v0[1]); w.y = pk_bf16(v0[2], v0[3]); w.z = pk_bf16(v1[0], v1[1]); w.w = pk_bf16(v1[2], v1[3]);
                    *(u32x4*)(rowp + bj * 128) = w; } }
    }
};
struct EpiOut {
    static constexpr int PERM = 4;
    const float* X; float* Hh;
    __device__ __forceinline__ void prefetch(const pg8::Unit&, LAS uchar*, int, int) const {}
    __device__ __forceinline__ void operator()(const f32x4 (&acc)[2][2][4][2], const pg8::Unit& u, int wr, int wc, int fr_, int fq_, const LAS uchar* bl) const {
        EPI_LANE();
        const int row0 = u.row0 + wr * 64 + fr, col0 = u.col0 + wc * 32 + 4 * fq;
#pragma unroll
        for (int ai = 0; ai < 2; ++ai)
#pragma unroll
            for (int m = 0; m < 4; ++m) { const size_t off = (size_t)(row0 + ai * 128 + m * 16) * D + col0;
#pragma unroll
                for (int bj = 0; bj < 2; ++bj)
#pragma unroll
                    for (int n = 0; n < 2; ++n) { const f32x4 xv = *(const f32x4*)(X + off + bj * 128 + n * 16); *(f32x4*)(Hh + off + bj * 128 + n * 16) = xv + acc[ai][bj][m][n]; } }
    }
};
__device__ __forceinline__ float swiglu_f(float gate, float up) { const float g = fminf(gate, 7.f), u = fminf(fmaxf(up, -7.f), 7.f); return (u + 1.f) * g * __builtin_amdgcn_rcpf(1.f + __expf(-1.702f * g)); }
struct EpiGateUp {
    static constexpr int PERM = 16;
    uchar* ACT; const float* bias;
    __device__ __forceinline__ void prefetch(const pg8::Unit& u, LAS uchar* buf, int wid, int lane) const {
        if (wid < 4) __builtin_amdgcn_global_load_lds((const unsigned*)(bias + (size_t)u.aux * (2 * DFF) + u.col0 + 64 * wid + lane), (LAS unsigned*)(buf + wid * 256), 4, 0, 0); }
    __device__ __forceinline__ void operator()(const f32x4 (&acc)[2][2][4][2], const pg8::Unit& u, int wr, int wc, int fr_, int fq_, const LAS uchar* bl) const {
        EPI_LANE();
        const int row0 = u.row0 + wr * 64 + fr, col0 = u.col0 + wc * 64 + 16 * fq;
        const LAS float* bp = (const LAS float*)bl + wc * 64 + 16 * fq;
        f32x4 bv[2][2];
#pragma unroll
        for (int bj = 0; bj < 2; ++bj)
#pragma unroll
            for (int n = 0; n < 2; ++n) bv[bj][n] = *(const LAS f32x4*)(bp + bj * 8 + 4 * n);
#pragma unroll
        for (int ai = 0; ai < 2; ++ai)
#pragma unroll
            for (int m = 0; m < 4; ++m) { uchar* rowp = ACT + (size_t)(row0 + ai * 128 + m * 16) * DFF + (col0 >> 1);
                u32x2 w;
#pragma unroll
                for (int bj = 0; bj < 2; ++bj) { const f32x4 v0 = acc[ai][bj][m][0] * W8_INV + bv[bj][0], v1 = acc[ai][bj][m][1] * W8_INV + bv[bj][1];
                    const unsigned p = pk_fp8x4(swiglu_f(v0[0], v0[1]), swiglu_f(v0[2], v0[3]), swiglu_f(v1[0], v1[1]), swiglu_f(v1[2], v1[3]));
                    if (bj == 0) w.x = p; else w.y = p; }
                *(u32x2*)rowp = w; }
    }
};
struct EpiDown {
    static constexpr int PERM = 8;
    bf16* YR; const float* bias;
    __device__ __forceinline__ void prefetch(const pg8::Unit& u, LAS uchar* buf, int wid, int lane) const {
        if (wid < 4) __builtin_amdgcn_global_load_lds((const unsigned*)(bias + (size_t)u.aux * D + u.col0 + 64 * wid + lane), (LAS unsigned*)(buf + wid * 256), 4, 0, 0); }
    __device__ __forceinline__ void operator()(const f32x4 (&acc)[2][2][4][2], const pg8::Unit& u, int wr, int wc, int fr_, int fq_, const LAS uchar* bl) const {
        EPI_LANE();
        const int row0 = u.row0 + wr * 64 + fr, col0 = u.col0 + wc * 32 + 8 * fq;
        const LAS float* bp = (const LAS float*)bl + wc * 32 + 8 * fq;
        f32x4 bv[2][2];
#pragma unroll
        for (int bj = 0; bj < 2; ++bj)
#pragma unroll
            for (int n = 0; n < 2; ++n) bv[bj][n] = *(const LAS f32x4*)(bp + bj * 128 + 4 * n);
#pragma unroll
        for (int ai = 0; ai < 2; ++ai)
#pragma unroll
            for (int m = 0; m < 4; ++m) { bf16* rowp = YR + (size_t)(row0 + ai * 128 + m * 16) * D + col0;
#pragma unroll
                for (int bj = 0; bj < 2; ++bj) { const f32x4 v0 = acc[ai][bj][m][0] * W8_INV + bv[bj][0], v1 = acc[ai][bj][m][1] * W8_INV + bv[bj][1];
                    u32x4 w; w.x = pk_bf16(v0[0], v0[1]); w.y = pk_bf16(v0[2], v0[3]); w.z = pk_bf16(v1[0], v1[1]); w.w = pk_bf16(v1[2], v1[3]);
                    *(u32x4*)(rowp + bj * 128) = w; } }
    }
};

#define XB_TMO      128
#define XB_XCNT(j)  (256  + 64 * (j))
#define XB_XSUB(j)  (1280 + 64 * (j))
#define XB_XGEN(j)  (2304 + 64 * (j))
#define XB_TOP      3328
#define XB_TOPGEN   3392
#define XCD_BAR_WORDS 3456
#define XB_SPIN_CAP (1u << 18)
__device__ __forceinline__ unsigned xb_ld(unsigned* p)              { return __hip_atomic_load(p, __ATOMIC_RELAXED, __HIP_MEMORY_SCOPE_AGENT); }
__device__ __forceinline__ unsigned xb_add(unsigned* p, unsigned v) { return __hip_atomic_fetch_add(p, v, __ATOMIC_RELAXED, __HIP_MEMORY_SCOPE_AGENT); }
__device__ __forceinline__ unsigned xb_xcc_id() { return (unsigned)__builtin_amdgcn_s_getreg((3 << 11) | 20) & 0xFu; }
#define XB_SPIN(cond, bar) do { unsigned _sp = 0; while (cond) { __builtin_amdgcn_s_sleep(1); \
    if ((++_sp & 255u) == 0u) { if (xb_ld(&(bar)[XB_TMO])) break; if (_sp > XB_SPIN_CAP) { atomicAdd(&(bar)[XB_TMO], 1u); break; } } } } while (0)
struct XcdBarrier { unsigned* bar; unsigned x; volatile LAS unsigned* st; };
__device__ __forceinline__ XcdBarrier xcd_barrier_post(unsigned* bar, volatile LAS unsigned* st) {
    XcdBarrier b; b.bar = bar; b.x = xb_xcc_id(); b.st = st;
    if (threadIdx.x == 0) (void)xb_add(&bar[XB_XCNT(b.x)], 1u);
    return b;
}
__device__ __forceinline__ void xcd_barrier_complete(unsigned* bar, unsigned x, unsigned& nloc, unsigned& nx) {
    const unsigned G = gridDim.x * gridDim.y * gridDim.z;
    unsigned sum, cnt, mine, sp = 0u;
    for (;;) {
        sum = 0u; cnt = 0u; mine = 0u;
#pragma unroll
        for (unsigned j = 0; j < 16; ++j) { const unsigned c = xb_ld(&bar[XB_XCNT(j)]); sum += c; cnt += (c > 0u) ? 1u : 0u; mine = (j == x) ? c : mine; }
        if (sum == G) break;
        __builtin_amdgcn_s_sleep(1);
        if ((++sp & 255u) == 0u) { if (xb_ld(&bar[XB_TMO])) break; if (sp > XB_SPIN_CAP) { atomicAdd(&bar[XB_TMO], 1u); break; } }
    }
    nloc = mine > 0u ? mine : 1u; nx = cnt > 0u ? cnt : 1u;
}
__device__ __forceinline__ void xcd_barrier(const XcdBarrier& b) {
    asm volatile("s_waitcnt vmcnt(0)" ::: "memory");
    __syncthreads();
    if (threadIdx.x == 0) {
        unsigned* bar = b.bar;
        __builtin_amdgcn_s_waitcnt(0);
        unsigned nloc = b.st[0], nx = b.st[1];
        if (nloc == 0u) { xcd_barrier_complete(bar, b.x, nloc, nx); b.st[0] = nloc; b.st[1] = nx; }
        const unsigned old = xb_add(&bar[XB_XSUB(b.x)], 1u);
        const unsigned gen = old / nloc;
        if (old + 1u == (gen + 1u) * nloc) {
            __builtin_amdgcn_fence(__ATOMIC_RELEASE, "agent");
            asm volatile("s_waitcnt vmcnt(0)" ::: "memory");
            const unsigned og = xb_add(&bar[XB_TOP], 1u);
            const unsigned tg = og / nx;
            if (og + 1u == (tg + 1u) * nx) xb_add(&bar[XB_TOPGEN], 1u);
            else XB_SPIN(xb_ld(&bar[XB_TOPGEN]) == tg, bar);
            __builtin_amdgcn_fence(__ATOMIC_ACQUIRE, "agent");
            xb_add(&bar[XB_XGEN(b.x)], 1u);
            asm volatile("s_waitcnt vmcnt(0)" ::: "memory");
        } else {
            XB_SPIN(xb_ld(&bar[XB_XGEN(b.x)]) == gen, bar);
            __builtin_amdgcn_fence(__ATOMIC_ACQUIRE, "agent");
            asm volatile("s_waitcnt vmcnt(0)" ::: "memory");
        }
    }
    __syncthreads();
}

struct Ctx { LAS uchar* lds; int tid, lane, wave, G, bid; uchar* ws; const void* const* in; float* out; };
#define XP_x(X) ((const float*)(X).in[0])
#define XP_pos(X) ((const int*)(X).in[1])
#define XP_ln_mix_w(X) ((const float*)(X).in[2])
#define XP_w_in(X) ((const float*)(X).in[3])
#define XP_conv_w(X) ((const float*)(X).in[4])
#define XP_conv_b(X) ((const float*)(X).in[5])
#define XP_dt_bias(X) ((const float*)(X).in[6])
#define XP_a_log(X) ((const float*)(X).in[7])
#define XP_d_skip(X) ((const float*)(X).in[8])
#define XP_ssm_norm_w(X) ((const float*)(X).in[9])
#define XP_w_out(X) ((const float*)(X).in[10])
#define XP_ln_ffn_w(X) ((const float*)(X).in[11])
#define XP_w_router(X) ((const float*)(X).in[12])
#define XP_b_router(X) ((const float*)(X).in[13])
#define XP_w_gu(X) ((const float*)(X).in[14])
#define XP_b_gu(X) ((const float*)(X).in[15])
#define XP_w_d(X) ((const float*)(X).in[16])
#define XP_b_d(X) ((const float*)(X).in[17])
#define XP_ln_final_w(X) ((const float*)(X).in[18])
#define XP_WinT(X) ((bf16*)((X).ws + WS_WINT))
#define XP_WoutT(X) ((bf16*)((X).ws + WS_WOUTT))
#define XP_WguT(X) ((uchar*)((X).ws + WS_WGUT))
#define XP_WdT(X) ((uchar*)((X).ws + WS_WDT))
#define XP_U(X) ((bf16*)((X).ws + WS_U))
#define XP_U2(X) ((uchar*)((X).ws + WS_U2))
#define XP_MIX(X) ((bf16*)((X).ws + WS_MIX))
#define XP_XBC(X) ((bf16*)((X).ws + WS_XBC))
#define XP_KV(X) ((bf16*)((X).ws + WS_KV))
#define XP_SST(X) ((bf16*)((X).ws + WS_SST))
#define XP_PROJ(X) ((bf16*)((X).ws + WS_PROJ))
#define XP_ACT(X) ((uchar*)((X).ws + WS_ACT))
#define XP_YR(X) ((bf16*)((X).ws + WS_YR))
#define XP_COS(X) ((float*)((X).ws + WS_COS))
#define XP_SIN(X) ((float*)((X).ws + WS_SIN))
#define XP_Hh(X) ((float*)((X).ws + WS_H))
#define XP_ADEC(X) ((float*)((X).ws + WS_ADEC))
#define XP_TOPW(X) ((float*)((X).ws + WS_TOPW))
#define XP_TOPI(X) ((int*)((X).ws + WS_TOPI))
#define XP_TOPR(X) ((int*)((X).ws + WS_TOPR))
#define XP_LIST(X) ((int*)((X).ws + WS_LIST))
#define XP_ctl(X) ((unsigned*)((X).ws + WS_CTL))
#define XP_WRH(X) ((bf16*)((X).ws + WS_WRH))
#define XP_WRL(X) ((bf16*)((X).ws + WS_WRL))


__device__ __forceinline__ bf16x8 tr_frag(LAS uchar* p, int rstep) {
    const s16x4 a = __builtin_amdgcn_ds_read_tr16_b64_v4i16((LAS s16x4*)p);
    const s16x4 b = __builtin_amdgcn_ds_read_tr16_b64_v4i16((LAS s16x4*)(p + rstep));
    return (bf16x8){a[0], a[1], a[2], a[3], b[0], b[1], b[2], b[3]};
}
__device__ __forceinline__ f32x4 mma16(bf16x8 xrow, bf16x8 ycol, f32x4 c) { return __builtin_amdgcn_mfma_f32_16x16x32_bf16(xrow, ycol, c, 0, 0, 0); }
__device__ __forceinline__ float wave_incl_scan(float v, int lane) {
#pragma unroll
    for (int o = 1; o < 64; o <<= 1) { const float t = __shfl_up(v, o); if (lane >= o) v += t; }
    return v;
}
__device__ __forceinline__ void rope8(const u32x4 k1, const u32x4 k2, const f32x4 c0, const f32x4 c1, const f32x4 s0, const f32x4 s1, const float sc, u32x4& o1, u32x4& o2) {
    float r1[8], r2[8];
#pragma unroll
    for (int m = 0; m < 4; ++m) {
        const float a0 = bf_lo(k1[m]), a1 = bf_hi(k1[m]), b0 = bf_lo(k2[m]), b1 = bf_hi(k2[m]);
        const float cs0 = (m < 2) ? c0[2 * m] : c1[2 * m - 4], cs1 = (m < 2) ? c0[2 * m + 1] : c1[2 * m - 3];
        const float sn0 = (m < 2) ? s0[2 * m] : s1[2 * m - 4], sn1 = (m < 2) ? s0[2 * m + 1] : s1[2 * m - 3];
        r1[2 * m] = (a0 * cs0 - b0 * sn0) * sc; r1[2 * m + 1] = (a1 * cs1 - b1 * sn1) * sc;
        r2[2 * m] = (b0 * cs0 + a0 * sn0) * sc; r2[2 * m + 1] = (b1 * cs1 + a1 * sn1) * sc;
    }
    o1.x = pk_bf16(r1[0], r1[1]); o1.y = pk_bf16(r1[2], r1[3]); o1.z = pk_bf16(r1[4], r1[5]); o1.w = pk_bf16(r1[6], r1[7]);
    o2.x = pk_bf16(r2[0], r2[1]); o2.y = pk_bf16(r2[2], r2[3]); o2.z = pk_bf16(r2[4], r2[5]); o2.w = pk_bf16(r2[6], r2[7]);
}

__device__ __forceinline__ void tr_decode(const Ctx& X, int r, const float*& W, bf16*& WT, int& N, int& kb, int& nb) {
    constexpr int I_IN = 32 * 209;
    if (r < I_IN) { W = XP_w_in(X); WT = XP_WinT(X); N = NPROJ; }
    else { r -= I_IN; W = XP_w_out(X); WT = XP_WoutT(X); N = D; }
    const int nbn = (N + 31) >> 5; kb = r / nbn; nb = r - kb * nbn;
}
__device__ __forceinline__ void tr8_item(const float* W, int N, uchar* WT, int kb, int nb, int lane) {
    const int k0 = kb * 128 + 16 * (lane & 7), n0 = nb * 32 + 4 * (lane >> 3);
    f32x4 v[16];
#pragma unroll
    for (int i = 0; i < 16; ++i) v[i] = __builtin_nontemporal_load((const f32x4*)(W + (size_t)(k0 + i) * N + n0));
#pragma unroll
    for (int j = 0; j < 4; ++j) { u32x4 o;
        o.x = pk_fp8x4(v[0][j] * W8_SCALE, v[1][j] * W8_SCALE, v[2][j] * W8_SCALE, v[3][j] * W8_SCALE); o.y = pk_fp8x4(v[4][j] * W8_SCALE, v[5][j] * W8_SCALE, v[6][j] * W8_SCALE, v[7][j] * W8_SCALE);
        o.z = pk_fp8x4(v[8][j] * W8_SCALE, v[9][j] * W8_SCALE, v[10][j] * W8_SCALE, v[11][j] * W8_SCALE); o.w = pk_fp8x4(v[12][j] * W8_SCALE, v[13][j] * W8_SCALE, v[14][j] * W8_SCALE, v[15][j] * W8_SCALE);
        __builtin_nontemporal_store(o, (u32x4*)(WT + (size_t)(n0 + j) * 2048 + k0)); }
}
__device__ __forceinline__ void tr_load(const float* W, int N, int kb, int nb, int lane, f32x4 (&v)[8]) {
    const int k0 = kb * 64 + 8 * (lane & 7), n0 = nb * 32 + 4 * (lane >> 3);
    if (n0 < N) {
#pragma unroll
        for (int i = 0; i < 8; ++i) v[i] = *(const f32x4*)(W + (size_t)(k0 + i) * N + n0);
    }
}
__device__ __forceinline__ void tr_store(bf16* WT, int N, int kb, int nb, int lane, const f32x4 (&v)[8]) {
    const int k0 = kb * 64 + 8 * (lane & 7), n0 = nb * 32 + 4 * (lane >> 3);
    if (n0 < N) {
#pragma unroll
        for (int j = 0; j < 4; ++j) { u32x4 o; o.x = pk_bf16(v[0][j], v[1][j]); o.y = pk_bf16(v[2][j], v[3][j]); o.z = pk_bf16(v[4][j], v[5][j]); o.w = pk_bf16(v[6][j], v[7][j]);
            *(u32x4*)(WT + (size_t)(n0 + j) * 2048 + k0) = o; }
    }
}
constexpr int I_GU8 = 32 * 16 * 128, I_D8 = 32 * 16 * 64, I_ALL8 = I_GU8 + I_D8;
__device__ __forceinline__ void conv8_id(const Ctx& X, int it, int lane) {
    if (it < I_GU8) { const int e = it >> 11, r = it & 2047; tr8_item(XP_w_gu(X) + (size_t)e * D * (2 * DFF), 2 * DFF, XP_WguT(X) + (size_t)e * (2 * DFF) * D, r >> 7, r & 127, lane); }
    else { const int i2 = it - I_GU8, e = i2 >> 10, r = i2 & 1023; tr8_item(XP_w_d(X) + (size_t)e * DFF * D, D, XP_WdT(X) + (size_t)e * D * DFF, r >> 6, r & 63, lane); }
}
constexpr int FILL_N1 = 6, FILL_W1 = 160 * 8, FILL_N3 = 3, FILL_W3 = 64 * 8, FILL_N4 = 6, FILL_W4 = 128 * 8;
constexpr int FILL_B1 = I_ALL8 - FILL_N1 * FILL_W1 - FILL_N3 * FILL_W3 - FILL_N4 * FILL_W4, FILL_B3 = FILL_B1 + FILL_N1 * FILL_W1, FILL_B4 = FILL_B3 + FILL_N3 * FILL_W3;
__device__ __forceinline__ void conv8_fill(const Ctx& X, int base, int fw, int nw, int n) {
#pragma unroll 1
    for (int j = 0; j < n; ++j) conv8_id(X, base + j * nw + fw, X.lane);
}
__device__ __forceinline__ void p0_prologue(Ctx& X) {
    const int gw = X.bid * NWAVES + X.wave, NGW = X.G * NWAVES, lane = X.lane;
    const int gt = X.bid * NTHR + X.tid, NGT = X.G * NTHR;
    for (int m = gw; m < T; m += NGW) {
        const f32x4* xr = (const f32x4*)(XP_x(X) + (size_t)m * D) + lane; const f32x4* wr_ = (const f32x4*)XP_ln_mix_w(X) + lane;
        f32x4 v[8]; float s = 0.f;
#pragma unroll
        for (int j = 0; j < 8; ++j) { v[j] = xr[64 * j]; s += (v[j].x * v[j].x + v[j].y * v[j].y) + (v[j].z * v[j].z + v[j].w * v[j].w); }
        const float rstd = rsqrtf(wave_sum(s) * (1.f / D) + EPS);
        u32x2* o8 = (u32x2*)(XP_U(X) + (size_t)m * D) + lane;
#pragma unroll
        for (int j = 0; j < 8; ++j) { const f32x4 w = wr_[64 * j]; u32x2 o; o.x = pk_bf16(v[j].x * rstd * w.x, v[j].y * rstd * w.y); o.y = pk_bf16(v[j].z * rstd * w.z, v[j].w * rstd * w.w); o8[64 * j] = o; }
    }
    for (int idx = gt; idx < T * 128; idx += NGT) {
        const int t = idx >> 7, i = idx & 127;
        const double ang = (double)XP_pos(X)[t] * INV_FREQ[i];
        double rev = ang * 0.15915494309189533577; rev -= floor(rev);
        const float f = (float)rev;
        XP_COS(X)[idx] = __builtin_amdgcn_cosf(f); XP_SIN(X)[idx] = __builtin_amdgcn_sinf(f);
    }
    { u32x4* p = (u32x4*)(XP_WinT(X) + (size_t)NPROJ * D); const int n16 = (LDP - NPROJ) * D * 2 / 16; const u32x4 z = {0u, 0u, 0u, 0u};
      for (int i = gt; i < n16; i += NGT) p[i] = z; }
    for (int idx = gt; idx < NE * D; idx += NGT) { const int e = idx >> 11, d = idx & 2047;
        const float wv = XP_ln_ffn_w(X)[d] * XP_w_router(X)[d * NE + e]; const unsigned hb = pk_bf16(wv, 0.f) & 0xffffu; const float lo = wv - __uint_as_float(hb << 16);
        XP_WRH(X)[idx] = (bf16)hb; XP_WRL(X)[idx] = (bf16)(pk_bf16(lo, 0.f) & 0xffffu); }
    constexpr int NIT = 32 * 209 + 32 * 64;
    for (int it = gw; it < NIT; it += 2 * NGW) {
        const float *W0, *W1 = nullptr; bf16 *T0, *T1 = nullptr; int N0, N1 = 0, kb0, kb1 = 0, nb0, nb1 = 0;
        f32x4 v0[8], v1[8];
        tr_decode(X, it, W0, T0, N0, kb0, nb0);
        const bool two = (it + NGW) < NIT;
        if (two) tr_decode(X, it + NGW, W1, T1, N1, kb1, nb1);
        tr_load(W0, N0, kb0, nb0, lane, v0);
        if (two) tr_load(W1, N1, kb1, nb1, lane, v1);
        tr_store(T0, N0, kb0, nb0, lane, v0);
        if (two) tr_store(T1, N1, kb1, nb1, lane, v1);
    }
    const int n_p0 = (X.G == 256) ? FILL_B1 : I_ALL8;
#pragma unroll 1
    for (int it = gw; it < n_p0; it += NGW) conv8_id(X, it, lane);
}

__device__ __forceinline__ void p2_ret(Ctx& X, int unit) {
    const int c = unit >> 2, h = unit & 3, t0 = c * CH, tid = X.tid, lane = X.lane, w = X.wave;
    LAS uchar* Vt = X.lds; LAS uchar* Kt = X.lds + 69632;
#pragma unroll 4
    for (int i = 0; i < 8; ++i) { const int q = tid + 512 * i, l = q >> 5, vc = q & 31;
        const u32x4 v = *(const u32x4*)(XP_PROJ(X) + (size_t)(t0 + l) * LDP + C_V + h * 256 + vc * 8);
        *(LAS u32x4*)(Vt + l * 544 + vc * 16) = v; }
    const float lg = LG2_GAMMA[h];
#pragma unroll 2
    for (int i = 0; i < 4; ++i) { const int q = tid + 512 * i, l = q >> 4, ic = q & 15;
        const bf16* kp = XP_PROJ(X) + (size_t)(t0 + l) * LDP + C_K + h * 256 + ic * 8;
        const u32x4 k1 = *(const u32x4*)kp, k2 = *(const u32x4*)(kp + 128);
        const float* cp = XP_COS(X) + (size_t)(t0 + l) * 128 + ic * 8; const float* sp = XP_SIN(X) + (size_t)(t0 + l) * 128 + ic * 8;
        const f32x4 c0 = *(const f32x4*)cp, c1 = *(const f32x4*)(cp + 4), s0 = *(const f32x4*)sp, s1 = *(const f32x4*)(sp + 4);
        u32x4 o1, o2; rope8(k1, k2, c0, c1, s0, s1, 0.0625f * exp2f(lg * (float)(127 - l)), o1, o2);
        *(LAS u32x4*)(Kt + l * 544 + ic * 16) = o1; *(LAS u32x4*)(Kt + l * 544 + 256 + ic * 16) = o2; }
    __syncthreads();
    const int fr = lane & 15, fq = lane >> 4, trs = (8 * fq + ((lane & 15) >> 2)) * 544 + 8 * (lane & 3);
    f32x4 acc[2][16];
#pragma unroll
    for (int a = 0; a < 2; ++a)
#pragma unroll
        for (int n = 0; n < 16; ++n) acc[a][n] = (f32x4){0.f, 0.f, 0.f, 0.f};
#pragma unroll 1
    for (int ks = 0; ks < 4; ++ks) {
        const bf16x8 af0 = tr_frag(Vt + (32 * ks) * 544 + (16 * w) * 2 + trs, 4 * 544);
        const bf16x8 af1 = tr_frag(Vt + (32 * ks) * 544 + (128 + 16 * w) * 2 + trs, 4 * 544);
#pragma unroll
        for (int n = 0; n < 16; ++n) { const bf16x8 bf = tr_frag(Kt + (32 * ks) * 544 + (16 * n) * 2 + trs, 4 * 544);
            acc[0][n] = mma16(bf, af0, acc[0][n]); acc[1][n] = mma16(bf, af1, acc[1][n]); }
    }
    bf16* outp = XP_KV(X) + (size_t)(c * 4 + h) * 65536;
#pragma unroll
    for (int a = 0; a < 2; ++a)
#pragma unroll
        for (int n = 0; n < 16; ++n) { u32x2 o; o.x = pk_bf16(acc[a][n][0], acc[a][n][1]); o.y = pk_bf16(acc[a][n][2], acc[a][n][3]);
            *(u32x2*)(outp + (size_t)(128 * a + 16 * w + fr) * 256 + 16 * n + 4 * fq) = o; }
    __syncthreads();
}
__device__ __forceinline__ void conv8(const Ctx& X, int t, int cx, float (&o)[8]) {
    const f32x4 b0 = *(const f32x4*)(XP_conv_b(X) + cx), b1 = *(const f32x4*)(XP_conv_b(X) + cx + 4);
    o[0] = b0.x; o[1] = b0.y; o[2] = b0.z; o[3] = b0.w; o[4] = b1.x; o[5] = b1.y; o[6] = b1.z; o[7] = b1.w;
#pragma unroll
    for (int j = 0; j < 4; ++j) { const int tt = t - 3 + j;
        if (tt >= 0) { const u32x4 v = *(const u32x4*)(XP_PROJ(X) + (size_t)tt * LDP + C_X + cx);
            const f32x4 w0 = *(const f32x4*)(XP_conv_w(X) + j * XBCW + cx), w1 = *(const f32x4*)(XP_conv_w(X) + j * XBCW + cx + 4);
            o[0] += w0.x * bf_lo(v.x); o[1] += w0.y * bf_hi(v.x); o[2] += w0.z * bf_lo(v.y); o[3] += w0.w * bf_hi(v.y);
            o[4] += w1.x * bf_lo(v.z); o[5] += w1.y * bf_hi(v.z); o[6] += w1.z * bf_lo(v.w); o[7] += w1.w * bf_hi(v.w); } }
#pragma unroll
    for (int i = 0; i < 8; ++i) o[i] = silu_f(o[i]);
}
__device__ __forceinline__ void p2_ssd(Ctx& X, int unit) {
    const int c = unit >> 2, g = (unit >> 1) & 1, hh = unit & 1, t0 = c * CH, tid = X.tid, lane = X.lane, w = X.wave;
    LAS uchar* Xd = X.lds; LAS uchar* Bc = X.lds + 69632;
    LAS float* dtS = (LAS float*)(X.lds + 106496); LAS float* acS = (LAS float*)(X.lds + 108544);
    if (w < 4) { const int h = 8 * g + 4 * hh + w, l0 = 2 * lane;
        const float dtb = XP_dt_bias(X)[h], A = -expf(XP_a_log(X)[h]);
        const float d0 = softplus_f(bf2f(XP_PROJ(X)[(size_t)(t0 + l0) * LDP + C_DT + h]) + dtb), d1 = softplus_f(bf2f(XP_PROJ(X)[(size_t)(t0 + l0 + 1) * LDP + C_DT + h]) + dtb);
        const float a0 = d0 * A, a1 = d1 * A, s = a0 + a1, incl = wave_incl_scan(s, lane);
        dtS[w * 128 + l0] = d0; dtS[w * 128 + l0 + 1] = d1; acS[w * 128 + l0] = incl - a1; acS[w * 128 + l0 + 1] = incl;
        if (lane == 63) XP_ADEC(X)[c * 16 + h] = expf(incl); }
    __syncthreads();
    for (int it = tid; it < 128 * 56; it += NTHR) { const int l = it / 56, j = it - l * 56;
        int cx; if (j < 32) cx = 512 * g + 256 * hh + 8 * j; else if (j < 48) cx = 1024 + 128 * g + 8 * (j - 32); else cx = 1280 + 128 * g + 64 * hh + 8 * (j - 48);
        float o[8]; conv8(X, t0 + l, cx, o);
        u32x4 ov; ov.x = pk_bf16(o[0], o[1]); ov.y = pk_bf16(o[2], o[3]); ov.z = pk_bf16(o[4], o[5]); ov.w = pk_bf16(o[6], o[7]);
        if (j < 32) { const int e = j >> 3; const float sc = dtS[e * 128 + l] * __expf(acS[e * 128 + 127] - acS[e * 128 + l]);
            u32x4 os; os.x = pk_bf16(o[0] * sc, o[1] * sc); os.y = pk_bf16(o[2] * sc, o[3] * sc); os.z = pk_bf16(o[4] * sc, o[5] * sc); os.w = pk_bf16(o[6] * sc, o[7] * sc);
            *(LAS u32x4*)(Xd + l * 544 + j * 16) = os; *(u32x4*)(XP_XBC(X) + (size_t)(t0 + l) * XBCW + cx) = ov; }
        else if (j < 48) { *(LAS u32x4*)(Bc + l * 288 + (j - 32) * 16) = ov; if (hh == 0) *(u32x4*)(XP_XBC(X) + (size_t)(t0 + l) * XBCW + cx) = ov; }
        else *(u32x4*)(XP_XBC(X) + (size_t)(t0 + l) * XBCW + cx) = ov; }
    __syncthreads();
    const int fr = lane & 15, fq = lane >> 4, q4 = (lane & 15) >> 2, p4 = lane & 3;
    const int trx = (8 * fq + q4) * 544 + 8 * p4, trb = (8 * fq + q4) * 288 + 8 * p4;
    f32x4 acc[2][8];
#pragma unroll
    for (int a = 0; a < 2; ++a)
#pragma unroll
        for (int n = 0; n < 8; ++n) acc[a][n] = (f32x4){0.f, 0.f, 0.f, 0.f};
#pragma unroll 1
    for (int ks = 0; ks < 4; ++ks) {
        const bf16x8 af0 = tr_frag(Xd + (32 * ks) * 544 + (16 * w) * 2 + trx, 4 * 544);
        const bf16x8 af1 = tr_frag(Xd + (32 * ks) * 544 + (128 + 16 * w) * 2 + trx, 4 * 544);
#pragma unroll
        for (int n = 0; n < 8; ++n) { const bf16x8 bf = tr_frag(Bc + (32 * ks) * 288 + (16 * n) * 2 + trb, 4 * 288);
            acc[0][n] = mma16(bf, af0, acc[0][n]); acc[1][n] = mma16(bf, af1, acc[1][n]); }
    }
#pragma unroll
    for (int a = 0; a < 2; ++a) { const int m = 128 * a + 16 * w + fr, h = 8 * g + 4 * hh + (m >> 6), p = m & 63;
        bf16* outp = XP_SST(X) + ((size_t)(c * 16 + h) * 64 + p) * 128;
#pragma unroll
        for (int n = 0; n < 8; ++n) { u32x2 o; o.x = pk_bf16(acc[a][n][0], acc[a][n][1]); o.y = pk_bf16(acc[a][n][2], acc[a][n][3]); *(u32x2*)(outp + 16 * n + 4 * fq) = o; } }
    __syncthreads();
}

__device__ __forceinline__ void p3_scan(Ctx& X) {
    const int gt = X.bid * NTHR + X.tid, NGT = X.G * NTHR;
    for (int item = gt; item < 65536 + 32768; item += NGT) {
        const bool ret = item < 65536; const int it2 = ret ? item : item - 65536;
        bf16* p = ret ? (XP_KV(X) + (size_t)it2 * 4) : (XP_SST(X) + (size_t)it2 * 4);
        const size_t stride = ret ? 262144 : 131072;
        const int head = ret ? (it2 >> 14) : (it2 >> 11);
        const float gdec = ret ? GAMMA_CHUNK[head & 3] : 0.f;
        float s0 = 0.f, s1 = 0.f, s2 = 0.f, s3 = 0.f;
        for (int c0 = 0; c0 < NCHUNK; c0 += 16) {
            u32x2 v[16]; float dec[16];
#pragma unroll
            for (int j = 0; j < 16; ++j) { v[j] = *(const u32x2*)(p + (size_t)(c0 + j) * stride); dec[j] = ret ? gdec : XP_ADEC(X)[(c0 + j) * 16 + head]; }
#pragma unroll
            for (int j = 0; j < 16; ++j) { u32x2 o; o.x = pk_bf16(s0, s1); o.y = pk_bf16(s2, s3); *(u32x2*)(p + (size_t)(c0 + j) * stride) = o;
                s0 = dec[j] * s0 + bf_lo(v[j].x); s1 = dec[j] * s1 + bf_hi(v[j].x); s2 = dec[j] * s2 + bf_lo(v[j].y); s3 = dec[j] * s3 + bf_hi(v[j].y); }
        }
    }
}

__device__ __forceinline__ void p4_ret(Ctx& X, int unit) {
    const int c = unit >> 2, h = unit & 3, t0 = c * CH, tid = X.tid, lane = X.lane, w = X.wave;
    LAS uchar* R1 = X.lds; LAS uchar* R2 = X.lds + 69632;
    const float lg = LG2_GAMMA[h];
#pragma unroll 1
    for (int i = 0; i < 4; ++i) { const int q = tid + 512 * i, l = q >> 4, ic = q & 15;
        const float* cp = XP_COS(X) + (size_t)(t0 + l) * 128 + ic * 8; const float* sp = XP_SIN(X) + (size_t)(t0 + l) * 128 + ic * 8;
        const f32x4 c0 = *(const f32x4*)cp, c1 = *(const f32x4*)(cp + 4), s0 = *(const f32x4*)sp, s1 = *(const f32x4*)(sp + 4);
        const bf16* qp = XP_PROJ(X) + (size_t)(t0 + l) * LDP + C_Q + h * 256 + ic * 8; const bf16* kp = XP_PROJ(X) + (size_t)(t0 + l) * LDP + C_K + h * 256 + ic * 8;
        u32x4 o1, o2;
        rope8(*(const u32x4*)qp, *(const u32x4*)(qp + 128), c0, c1, s0, s1, 1.0f, o1, o2);
        *(LAS u32x4*)(R1 + l * 544 + ic * 16) = o1; *(LAS u32x4*)(R1 + l * 544 + 256 + ic * 16) = o2;
        rope8(*(const u32x4*)kp, *(const u32x4*)(kp + 128), c0, c1, s0, s1, 0.0625f, o1, o2);
        *(LAS u32x4*)(R2 + l * 544 + ic * 16) = o1; *(LAS u32x4*)(R2 + l * 544 + 256 + ic * 16) = o2; }
    __syncthreads();
    const int fr = lane & 15, fq = lane >> 4, q4 = (lane & 15) >> 2, p4 = lane & 3, l = 16 * w + fr;
    f32x4 sc[8];
#pragma unroll
    for (int n = 0; n < 8; ++n) sc[n] = (f32x4){0.f, 0.f, 0.f, 0.f};
#pragma unroll 2
    for (int ks = 0; ks < 8; ++ks) {
        const bf16x8 af = *(const LAS bf16x8*)(R1 + l * 544 + (32 * ks + 8 * fq) * 2);
#pragma unroll
        for (int n = 0; n < 8; ++n) if (n <= w) { const bf16x8 bf = *(const LAS bf16x8*)(R2 + (16 * n + fr) * 544 + (32 * ks + 8 * fq) * 2); sc[n] = mma16(bf, af, sc[n]); }
    }
    bf16x8 scf[4];
#pragma unroll
    for (int k2 = 0; k2 < 4; ++k2) { float v[8];
#pragma unroll
        for (int tq = 0; tq < 2; ++tq)
#pragma unroll
            for (int j = 0; j < 4; ++j) { const int s = 16 * (2 * k2 + tq) + 4 * fq + j; v[4 * tq + j] = (s <= l) ? sc[2 * k2 + tq][j] * exp2f(lg * (float)(l - s)) : 0.f; }
        u32x4 pk; pk.x = pk_bf16(v[0], v[1]); pk.y = pk_bf16(v[2], v[3]); pk.z = pk_bf16(v[4], v[5]); pk.w = pk_bf16(v[6], v[7]);
        scf[k2] = __builtin_bit_cast(bf16x8, pk); }
    __syncthreads();
    f32x4 acc[16];
#pragma unroll
    for (int n = 0; n < 16; ++n) acc[n] = (f32x4){0.f, 0.f, 0.f, 0.f};
    const bf16* prev = XP_KV(X) + (size_t)(c * 4 + h) * 65536;
#pragma unroll 1
    for (int dh = 0; dh < 2; ++dh) {
#pragma unroll 4
        for (int i = 0; i < 8; ++i) { const int q = tid + 512 * i, v = q >> 4, dc = q & 15;
            *(LAS u32x4*)(R2 + v * 272 + dc * 16) = *(const u32x4*)(prev + (size_t)v * 256 + dh * 128 + dc * 8); }
        __syncthreads();
#pragma unroll 2
        for (int ks = 0; ks < 4; ++ks) {
            const bf16x8 af = *(const LAS bf16x8*)(R1 + l * 544 + (128 * dh + 32 * ks + 8 * fq) * 2);
#pragma unroll
            for (int n = 0; n < 16; ++n) { const bf16x8 bf = *(const LAS bf16x8*)(R2 + (16 * n + fr) * 272 + (32 * ks + 8 * fq) * 2); acc[n] = mma16(bf, af, acc[n]); }
        }
        __syncthreads();
    }
    { const float qd = exp2f(lg * (float)(l + 1));
#pragma unroll
      for (int n = 0; n < 16; ++n) acc[n] = acc[n] * qd; }
#pragma unroll 4
    for (int i = 0; i < 8; ++i) { const int q = tid + 512 * i, s = q >> 5, vc = q & 31;
        *(LAS u32x4*)(R2 + s * 544 + vc * 16) = *(const u32x4*)(XP_PROJ(X) + (size_t)(t0 + s) * LDP + C_V + h * 256 + vc * 8); }
    __syncthreads();
    const int trp = (4 * fq + q4) * 544 + 8 * p4;
#pragma unroll
    for (int k2 = 0; k2 < 4; ++k2) if (2 * k2 <= w) {
#pragma unroll
        for (int n = 0; n < 16; ++n) { const bf16x8 bf = tr_frag(R2 + (32 * k2) * 544 + (16 * n) * 2 + trp, 16 * 544); acc[n] = mma16(bf, scf[k2], acc[n]); }
    }
    float ss = 0.f;
#pragma unroll
    for (int n = 0; n < 16; ++n) ss += (acc[n][0] * acc[n][0] + acc[n][1] * acc[n][1]) + (acc[n][2] * acc[n][2] + acc[n][3] * acc[n][3]);
    ss += __shfl_xor(ss, 16); ss += __shfl_xor(ss, 32);
    const float rstd = rsqrtf(ss * (1.f / 256.f) + EPS);
    const bf16* gp = XP_PROJ(X) + (size_t)(t0 + l) * LDP + C_G + h * 256 + 4 * fq; bf16* op = XP_MIX(X) + (size_t)(t0 + l) * D + h * 256 + 4 * fq;
#pragma unroll
    for (int n = 0; n < 16; ++n) { const u32x2 gv = *(const u32x2*)(gp + 16 * n);
        u32x2 o; o.x = pk_bf16(acc[n][0] * rstd * silu_f(bf_lo(gv.x)), acc[n][1] * rstd * silu_f(bf_hi(gv.x))); o.y = pk_bf16(acc[n][2] * rstd * silu_f(bf_lo(gv.y)), acc[n][3] * rstd * silu_f(bf_hi(gv.y)));
        *(u32x2*)(op + 16 * n) = o; }
    __syncthreads();
}

__device__ __forceinline__ void p4_ssd(Ctx& X, int unit) {
    const int c = unit >> 1, g = unit & 1, t0 = c * CH, tid = X.tid, lane = X.lane, w = X.wave;
    LAS uchar* Cc = X.lds; LAS uchar* Bc = X.lds + 34816;
    LAS uchar* HP = X.lds + 34816;
    LAS float* dtS = (LAS float*)(X.lds + 110592); LAS float* acS = (LAS float*)(X.lds + 114688);
    { const int h = 8 * g + w, l0 = 2 * lane;
      const float dtb = XP_dt_bias(X)[h], A = -expf(XP_a_log(X)[h]);
      const float d0 = softplus_f(bf2f(XP_PROJ(X)[(size_t)(t0 + l0) * LDP + C_DT + h]) + dtb), d1 = softplus_f(bf2f(XP_PROJ(X)[(size_t)(t0 + l0 + 1) * LDP + C_DT + h]) + dtb);
      const float a0 = d0 * A, a1 = d1 * A, incl = wave_incl_scan(a0 + a1, lane);
      dtS[w * 128 + l0] = d0; dtS[w * 128 + l0 + 1] = d1; acS[w * 128 + l0] = incl - a1; acS[w * 128 + l0 + 1] = incl; }
#pragma unroll
    for (int i = 0; i < 4; ++i) { const int q = tid + 512 * i, l = q >> 4, nc = q & 15;
        *(LAS u32x4*)(Bc + l * 272 + nc * 16) = *(const u32x4*)(XP_XBC(X) + (size_t)(t0 + l) * XBCW + 1024 + 128 * g + nc * 8);
        *(LAS u32x4*)(Cc + l * 272 + nc * 16) = *(const u32x4*)(XP_XBC(X) + (size_t)(t0 + l) * XBCW + 1280 + 128 * g + nc * 8); }
    __syncthreads();
    const int fr = lane & 15, fq = lane >> 4, q4 = (lane & 15) >> 2, p4 = lane & 3, l = 16 * w + fr;
    f32x4 cb[8]; bf16x8 cfr[4];
#pragma unroll
    for (int n = 0; n < 8; ++n) cb[n] = (f32x4){0.f, 0.f, 0.f, 0.f};
#pragma unroll
    for (int ks = 0; ks < 4; ++ks) {
        cfr[ks] = *(const LAS bf16x8*)(Cc + l * 272 + (32 * ks + 8 * fq) * 2);
#pragma unroll
        for (int n = 0; n < 8; ++n) if (n <= w) { const bf16x8 bf = *(const LAS bf16x8*)(Bc + (16 * n + fr) * 272 + (32 * ks + 8 * fq) * 2); cb[n] = mma16(bf, cfr[ks], cb[n]); }
    }
    __syncthreads();
    float ss = 0.f;
    const int trp = (4 * fq + q4) * 144 + 8 * p4;
    const bf16* xp = XP_XBC(X) + (size_t)(t0 + l) * XBCW + 512 * g + 4 * fq; const bf16* zp = XP_PROJ(X) + (size_t)(t0 + l) * LDP + C_Z + 512 * g + 4 * fq;
    bf16* op = XP_MIX(X) + (size_t)(t0 + l) * D + 1024 + 512 * g + 4 * fq;
#pragma unroll 1
    for (int hp = 0; hp < 4; ++hp) {
#pragma unroll
        for (int i = 0; i < 4; ++i) { const int q = tid + 512 * i, e2 = q >> 10, s = (q >> 3) & 127, pc = q & 7, e = 2 * hp + e2;
            const u32x4 v = *(const u32x4*)(XP_XBC(X) + (size_t)(t0 + s) * XBCW + 512 * g + 64 * e + pc * 8); const float d = dtS[e * 128 + s];
            u32x4 o; o.x = pk_bf16(bf_lo(v.x) * d, bf_hi(v.x) * d); o.y = pk_bf16(bf_lo(v.y) * d, bf_hi(v.y) * d); o.z = pk_bf16(bf_lo(v.z) * d, bf_hi(v.z) * d); o.w = pk_bf16(bf_lo(v.w) * d, bf_hi(v.w) * d);
            *(LAS u32x4*)(HP + e2 * 18432 + s * 144 + pc * 16) = o; }
#pragma unroll
        for (int i = 0; i < 4; ++i) { const int q = tid + 512 * i, e2 = q >> 10, p = (q >> 4) & 63, nc = q & 15, e = 2 * hp + e2;
            *(LAS u32x4*)(HP + 36864 + e2 * 17408 + p * 272 + nc * 16) = *(const u32x4*)(XP_SST(X) + ((size_t)(c * 16 + 8 * g + e) * 64 + p) * 128 + nc * 8); }
        __syncthreads();
#pragma unroll 1
        for (int e2 = 0; e2 < 2; ++e2) { const int e = 2 * hp + e2;
            LAS uchar* Xh = HP + e2 * 18432; LAS uchar* Ph = HP + 36864 + e2 * 17408;
            f32x4 y[4];
#pragma unroll
            for (int n = 0; n < 4; ++n) y[n] = (f32x4){0.f, 0.f, 0.f, 0.f};
#pragma unroll
            for (int ks = 0; ks < 4; ++ks)
#pragma unroll
                for (int n = 0; n < 4; ++n) { const bf16x8 bf = *(const LAS bf16x8*)(Ph + (16 * n + fr) * 272 + (32 * ks + 8 * fq) * 2); y[n] = mma16(bf, cfr[ks], y[n]); }
            const float al = acS[e * 128 + l], el = __expf(al);
#pragma unroll
            for (int n = 0; n < 4; ++n) y[n] = y[n] * el;
#pragma unroll
            for (int k2 = 0; k2 < 4; ++k2) if (2 * k2 <= w) { float v[8];
#pragma unroll
                for (int tq = 0; tq < 2; ++tq) { const int s0 = 16 * (2 * k2 + tq) + 4 * fq; const f32x4 as = *(const LAS f32x4*)(acS + e * 128 + s0);
#pragma unroll
                    for (int j = 0; j < 4; ++j) v[4 * tq + j] = (s0 + j <= l) ? cb[2 * k2 + tq][j] * __expf(al - as[j]) : 0.f; }
                u32x4 pk; pk.x = pk_bf16(v[0], v[1]); pk.y = pk_bf16(v[2], v[3]); pk.z = pk_bf16(v[4], v[5]); pk.w = pk_bf16(v[6], v[7]);
                const bf16x8 gf = __builtin_bit_cast(bf16x8, pk);
#pragma unroll
                for (int n = 0; n < 4; ++n) { const bf16x8 bf = tr_frag(Xh + (32 * k2) * 144 + (16 * n) * 2 + trp, 16 * 144); y[n] = mma16(bf, gf, y[n]); }
            }
            const float dsk = XP_d_skip(X)[8 * g + e];
#pragma unroll
            for (int n = 0; n < 4; ++n) { const u32x2 xv = *(const u32x2*)(xp + 64 * e + 16 * n), zv = *(const u32x2*)(zp + 64 * e + 16 * n);
                const float t0_ = (y[n][0] + dsk * bf_lo(xv.x)) * silu_f(bf_lo(zv.x)), t1_ = (y[n][1] + dsk * bf_hi(xv.x)) * silu_f(bf_hi(zv.x));
                const float t2_ = (y[n][2] + dsk * bf_lo(xv.y)) * silu_f(bf_lo(zv.y)), t3_ = (y[n][3] + dsk * bf_hi(xv.y)) * silu_f(bf_hi(zv.y));
                ss += (t0_ * t0_ + t1_ * t1_) + (t2_ * t2_ + t3_ * t3_);
                u32x2 o; o.x = pk_bf16(t0_, t1_); o.y = pk_bf16(t2_, t3_); *(u32x2*)(op + 64 * e + 16 * n) = o; }
        }
        __syncthreads();
    }
    ss += __shfl_xor(ss, 16); ss += __shfl_xor(ss, 32);
    const float rstd = rsqrtf(ss * (1.f / 512.f) + EPS);
    const float* nw = XP_ssm_norm_w(X) + 512 * g + 4 * fq;
#pragma unroll 4
    for (int i = 0; i < 32; ++i) { const f32x4 wv = *(const f32x4*)(nw + 16 * i); const u32x2 t = *(const u32x2*)(op + 16 * i);
        u32x2 o; o.x = pk_bf16(bf_lo(t.x) * rstd * wv.x, bf_hi(t.x) * rstd * wv.y); o.y = pk_bf16(bf_lo(t.y) * rstd * wv.z, bf_hi(t.y) * rstd * wv.w);
        *(u32x2*)(op + 16 * i) = o; }
    __syncthreads();
}

__device__ __forceinline__ void p6_router(Ctx& X) {
    const int tid = X.tid, lane = X.lane, w = X.wave, fr = lane & 15, fq = lane >> 4;
    LAS float* part = (LAS float*)X.lds;
    LAS float* ssq = (LAS float*)(X.lds + 32768);
    LAS float* lgt = (LAS float*)(X.lds + 32768 + 1024);
    LAS float* rs = (LAS float*)(X.lds + 32768 + 1024 + 4096);
    for (int item = X.bid; item < T / 32; item += X.G) {
        const int tb = item * 32;
        f32x4 acc[2][2]; float ss[2] = {0.f, 0.f};
#pragma unroll
        for (int a = 0; a < 2; ++a)
#pragma unroll
            for (int n = 0; n < 2; ++n) acc[a][n] = (f32x4){0.f, 0.f, 0.f, 0.f};
#pragma unroll 2
        for (int ks = 0; ks < 8; ++ks) { const int kb = 256 * w + 32 * ks + 8 * fq;
            bf16x8 ah[2], al[2], bh[2], bl[2];
#pragma unroll
            for (int mt = 0; mt < 2; ++mt) { const float* hp = XP_Hh(X) + (size_t)(tb + 16 * mt + fr) * D + kb;
                const f32x4 x0 = *(const f32x4*)hp, x1 = *(const f32x4*)(hp + 4);
                ss[mt] += (x0.x * x0.x + x0.y * x0.y) + (x0.z * x0.z + x0.w * x0.w) + (x1.x * x1.x + x1.y * x1.y) + (x1.z * x1.z + x1.w * x1.w);
                u32x4 h, l; h.x = pk_bf16(x0.x, x0.y); h.y = pk_bf16(x0.z, x0.w); h.z = pk_bf16(x1.x, x1.y); h.w = pk_bf16(x1.z, x1.w);
                l.x = pk_bf16(x0.x - bf_lo(h.x), x0.y - bf_hi(h.x)); l.y = pk_bf16(x0.z - bf_lo(h.y), x0.w - bf_hi(h.y)); l.z = pk_bf16(x1.x - bf_lo(h.z), x1.y - bf_hi(h.z)); l.w = pk_bf16(x1.z - bf_lo(h.w), x1.w - bf_hi(h.w));
                ah[mt] = __builtin_bit_cast(bf16x8, h); al[mt] = __builtin_bit_cast(bf16x8, l); }
#pragma unroll
            for (int nt = 0; nt < 2; ++nt) { bh[nt] = *(const bf16x8*)(XP_WRH(X) + (size_t)(16 * nt + fr) * D + kb); bl[nt] = *(const bf16x8*)(XP_WRL(X) + (size_t)(16 * nt + fr) * D + kb); }
#pragma unroll
            for (int mt = 0; mt < 2; ++mt)
#pragma unroll
                for (int nt = 0; nt < 2; ++nt) { acc[mt][nt] = mma16(bh[nt], ah[mt], acc[mt][nt]); acc[mt][nt] = mma16(bl[nt], ah[mt], acc[mt][nt]); acc[mt][nt] = mma16(bh[nt], al[mt], acc[mt][nt]); }
        }
#pragma unroll
        for (int mt = 0; mt < 2; ++mt) { float q = ss[mt]; q += __shfl_xor(q, 16); q += __shfl_xor(q, 32); if (fq == 0) ssq[w * 32 + 16 * mt + fr] = q;
#pragma unroll
            for (int nt = 0; nt < 2; ++nt) *(LAS f32x4*)(part + (w * 32 + 16 * mt + fr) * 32 + 16 * nt + 4 * fq) = acc[mt][nt]; }
        __syncthreads();
        { const int tk = tid >> 4, e0 = 2 * (tid & 15); float q = 0.f, a0 = 0.f, a1 = 0.f;
#pragma unroll
          for (int ww = 0; ww < 8; ++ww) { q += ssq[ww * 32 + tk]; const f32x2 p = *(const LAS f32x2*)(part + (ww * 32 + tk) * 32 + e0); a0 += p.x; a1 += p.y; }
          const float rstd = rsqrtf(q * (1.f / D) + EPS);
          lgt[tk * 32 + e0] = a0 * rstd + XP_b_router(X)[e0]; lgt[tk * 32 + e0 + 1] = a1 * rstd + XP_b_router(X)[e0 + 1];
          if ((tid & 15) == 0) rs[tk] = rstd; }
        __syncthreads();
        if (tid < 32) { const int t = tb + tid; unsigned used = 0u; int idx[4]; float val[4];
#pragma unroll
            for (int k = 0; k < 4; ++k) { float best = -3.0e38f; int bi = 0;
#pragma unroll 8
                for (int j = 0; j < 32; ++j) { const float v = lgt[tid * 32 + j]; if (!((used >> j) & 1u) && v > best) { best = v; bi = j; } }
                used |= 1u << bi; idx[k] = bi; val[k] = best; }
            const float e1 = __expf(val[1] - val[0]), e2 = __expf(val[2] - val[0]), e3 = __expf(val[3] - val[0]), inv = 1.f / (1.f + e1 + e2 + e3);
            const float wv[4] = {inv, e1 * inv, e2 * inv, e3 * inv};
#pragma unroll
            for (int k = 0; k < 4; ++k) { const int rank = (int)atomicAdd(XP_ctl(X) + CW_CNT + 64 * idx[k], 1u);
                XP_LIST(X)[idx[k] * T + rank] = t; XP_TOPI(X)[t * 4 + k] = idx[k]; XP_TOPR(X)[t * 4 + k] = rank; XP_TOPW(X)[t * 4 + k] = wv[k]; } }
#pragma unroll 2
        for (int r = 0; r < 4; ++r) { const int tk = 4 * w + r, t = tb + tk; const float rstd = rs[tk];
            const f32x4* hr = (const f32x4*)(XP_Hh(X) + (size_t)t * D) + lane; const f32x4* wr_ = (const f32x4*)XP_ln_ffn_w(X) + lane;
            unsigned* o8 = (unsigned*)(XP_U2(X) + (size_t)t * D) + lane;
#pragma unroll
            for (int j = 0; j < 8; ++j) { const f32x4 v = hr[64 * j], wv = wr_[64 * j]; o8[64 * j] = pk_fp8x4(v.x * rstd * wv.x, v.y * rstd * wv.y, v.z * rstd * wv.z, v.w * rstd * wv.w); } }
        __syncthreads();
    }
}

__device__ __forceinline__ void moe_tables(Ctx& X) {
    LAS int* tab = (LAS int*)(X.lds + LDS_TAB);
    if (X.tid == 0) { int nb = 0;
        for (int e = 0; e < NE; ++e) { const int cnt = (int)__hip_atomic_load(XP_ctl(X) + CW_CNT + 64 * e, __ATOMIC_RELAXED, __HIP_MEMORY_SCOPE_AGENT); const int k = (cnt + 255) >> 8;
            tab[8 + e] = nb; for (int b = 0; b < k; ++b) { if (nb + b < MAXBLK) { tab[64 + nb + b] = e; tab[256 + nb + b] = (cnt - 256 * b) < 256 ? (cnt - 256 * b) : 256; } } nb += k; }
        tab[8 + NE] = nb; tab[0] = nb < MAXBLK ? nb : MAXBLK; }
    __syncthreads();
}

__device__ __forceinline__ void p9_final(Ctx& X) {
    const LAS int* tab = (const LAS int*)(X.lds + LDS_TAB);
    const int gw = X.bid * NWAVES + X.wave, NGW = X.G * NWAVES, lane = X.lane;
    for (int t = gw; t < T; t += NGW) {
        const f32x4* hr = (const f32x4*)(XP_Hh(X) + (size_t)t * D) + lane;
        f32x4 v[8];
#pragma unroll
        for (int j = 0; j < 8; ++j) v[j] = hr[64 * j];
#pragma unroll
        for (int k = 0; k < 4; ++k) { const int e = XP_TOPI(X)[t * 4 + k], r = XP_TOPR(X)[t * 4 + k]; const float wk = XP_TOPW(X)[t * 4 + k];
            const u32x2* yr = (const u32x2*)(XP_YR(X) + ((size_t)tab[8 + e] * 256 + r) * D) + lane;
#pragma unroll
            for (int j = 0; j < 8; ++j) { const u32x2 y = yr[64 * j]; v[j].x += wk * bf_lo(y.x); v[j].y += wk * bf_hi(y.x); v[j].z += wk * bf_lo(y.y); v[j].w += wk * bf_hi(y.y); } }
        float s = 0.f;
#pragma unroll
        for (int j = 0; j < 8; ++j) s += (v[j].x * v[j].x + v[j].y * v[j].y) + (v[j].z * v[j].z + v[j].w * v[j].w);
        const float rstd = rsqrtf(wave_sum(s) * (1.f / D) + EPS);
        f32x4* o = (f32x4*)(X.out + (size_t)t * D) + lane; const f32x4* wr_ = (const f32x4*)XP_ln_final_w(X) + lane;
#pragma unroll
        for (int j = 0; j < 8; ++j) { const f32x4 wv = wr_[64 * j]; f32x4 r; r.x = v[j].x * rstd * wv.x; r.y = v[j].y * rstd * wv.y; r.z = v[j].z * rstd * wv.z; r.w = v[j].w * rstd * wv.w; o[64 * j] = r; }
    }
}

#ifdef NO_P4R
#define P4R(X,u)
#else
#define P4R(X,u) p4_ret(X,u)
#endif
#ifdef NO_P4S
#define P4S(X,u)
#else
#define P4S(X,u) p4_ssd(X,u)
#endif
struct Args { const void* in[19]; float* out; uchar* ws; int ph_lo, ph_hi; };
__global__ void __launch_bounds__(NTHR, 2) fwd(Args args) {
    extern __shared__ __attribute__((aligned(16))) uchar lds_raw[];
    Ctx X;
    X.lds = (LAS uchar*)lds_raw; X.tid = threadIdx.x; X.lane = X.tid & 63; X.wave = __builtin_amdgcn_readfirstlane(X.tid >> 6); X.G = gridDim.x; X.bid = blockIdx.x;
    X.in = (const void* const*)__builtin_amdgcn_kernarg_segment_ptr(); X.out = args.out; X.ws = args.ws;
    for (int u = X.tid; u < (LDS_BYTES - LDS_PHASE_END) / 4; u += NTHR) ((LAS unsigned*)(X.lds + LDS_PHASE_END))[u] = 0u;
    __syncthreads();
    const int lo = args.ph_lo, hi = args.ph_hi;
    const bool multi = (hi - lo) > 1;
    XcdBarrier bar; bar.bar = XP_ctl(X) + CW_BAR; bar.x = 0; bar.st = nullptr;
    if (multi) bar = xcd_barrier_post(XP_ctl(X) + CW_BAR, (volatile LAS unsigned*)(X.lds + LDS_MISC + 32));
#ifdef ONLY_PHASE
#define IN(k) ((k) == ONLY_PHASE && lo <= (k) && (k) < hi)
#else
#define IN(k) (lo <= (k) && (k) < hi)
#endif
#define SEAM(k) do { if (IN(k) && IN((k) + 1)) xcd_barrier(bar); } while (0)
    if (IN(0)) { p0_prologue(X); } SEAM(0);
    if (IN(1)) { DenseSched S{(const char*)XP_U(X), (const char*)XP_WinT(X), D, T / 256, LDP / 256, (T / 256) * (LDP / 256), X.G, X.bid}; EpiProj E{XP_PROJ(X), LDP};
        pg8::gemm_phase<EpiProj, DenseSched, false, false>(X.lds, D, S, E);
        if (X.G == 256 && X.bid >= 96) conv8_fill(X, FILL_B1, (X.bid - 96) * NWAVES + X.wave, FILL_W1, FILL_N1); } SEAM(1);
    if (IN(2)) { for (int u = X.bid; u < 512; u += X.G) { if (u < 256) p2_ret(X, u); else p2_ssd(X, u - 256); } } SEAM(2);
    if (IN(3)) { p3_scan(X); if (X.G == 256 && X.bid >= 192) conv8_fill(X, FILL_B3, (X.bid - 192) * NWAVES + X.wave, FILL_W3, FILL_N3); } SEAM(3);
    if (IN(4)) { for (int u = X.bid; u < 384; u += X.G) { if (u < 256) { P4R(X, u); } else { P4S(X, u - 256); } }
        if (X.G == 256 && X.bid >= 128) conv8_fill(X, FILL_B4, (X.bid - 128) * NWAVES + X.wave, FILL_W4, FILL_N4); } SEAM(4);
    if (IN(5)) { DenseSched S{(const char*)XP_MIX(X), (const char*)XP_WoutT(X), D, T / 256, D / 256, (T / 256) * (D / 256), X.G, X.bid}; EpiOut E{XP_x(X), XP_Hh(X)};
        pg8::gemm_phase<EpiOut, DenseSched, false, false>(X.lds, D, S, E); } SEAM(5);
    if (IN(6)) { p6_router(X); } SEAM(6);
    if (IN(7)) { moe_tables(X); MoeSched S{(const LAS int*)(X.lds + LDS_TAB), (const char*)XP_U2(X), (const char*)XP_WguT(X), (size_t)(2 * DFF) * D, XP_LIST(X), D / 2, (2 * DFF) / 256, X.G, X.bid}; EpiGateUp E{XP_ACT(X), XP_b_gu(X)};
        pg8::gemm_phase<EpiGateUp, MoeSched, true, true>(X.lds, D / 2, S, E); } SEAM(7);
    if (IN(8)) { moe_tables(X); MoeSchedDirect S{(const LAS int*)(X.lds + LDS_TAB), (const char*)XP_ACT(X), (const char*)XP_WdT(X), (size_t)D * DFF, DFF / 2, D / 256, X.G, X.bid}; EpiDown E{XP_YR(X), XP_b_d(X)};
        pg8::gemm_phase<EpiDown, MoeSchedDirect, true, true>(X.lds, DFF / 2, S, E); } SEAM(8);
    if (IN(9)) { moe_tables(X); p9_final(X); }
#undef IN
#undef SEAM
}

extern "C" void kernel_launch(void* const* d_in, const int* in_sizes, int n_in, void* d_out, int out_size, void* d_ws, size_t ws_size, hipStream_t stream) {
    static int grid = 0;
    if (grid == 0) {
        if (n_in != 19 || out_size != T * D || ws_size < WS_END) { fprintf(stderr, "kernel_launch: unexpected shapes (n_in %d, out %d, ws %zu)\n", n_in, out_size, ws_size); grid = -1; return; }
        int dev = 0, cus = 0, per_cu = 0;
        if (hipGetDevice(&dev) != hipSuccess || hipDeviceGetAttribute(&cus, hipDeviceAttributeMultiprocessorCount, dev) != hipSuccess) { grid = -1; return; }
        if (hipFuncSetAttribute((const void*)fwd, hipFuncAttributeMaxDynamicSharedMemorySize, LDS_BYTES) != hipSuccess) { fprintf(stderr, "kernel_launch: hipFuncSetAttribute failed\n"); grid = -1; return; }
        if (hipOccupancyMaxActiveBlocksPerMultiprocessor(&per_cu, (const void*)fwd, NTHR, LDS_BYTES) != hipSuccess || per_cu < 1) { fprintf(stderr, "kernel_launch: occupancy query reports %d\n", per_cu); }
        (void)hipGetLastError();
        grid = cus;
    }
    if (grid < 0) return;
    (void)hipMemsetAsync((char*)d_ws + WS_CTL, 0, CTL_ZERO_BYTES, stream);
    Args a{};
    for (int i = 0; i < 19; ++i) a.in[i] = d_in[i];
    a.out = (float*)d_out; a.ws = (uchar*)d_ws;
    constexpr int NL = MK_N_LAUNCHES;
    for (int li = 0; li < NL; ++li) {
        a.ph_lo = (NL == 1) ? 0 : li; a.ph_hi = (NL == 1) ? NPHASE : li + 1;
        hipLaunchKernelGGL(fwd, dim3(grid), dim3(NTHR), LDS_BYTES, stream, a);
    }
}
```

```cpp
#include <hip/hip_runtime.h>
#include <cstdio>
#include <cstdint>

#ifndef MK_N_LAUNCHES
#define MK_N_LAUNCHES 1
#endif

#define LAS __attribute__((address_space(3)))
typedef unsigned short bf16;
typedef short bf16x8 __attribute__((ext_vector_type(8)));
typedef short s16x4 __attribute__((ext_vector_type(4)));
typedef float f32x4 __attribute__((ext_vector_type(4)));
typedef float f32x2 __attribute__((ext_vector_type(2)));
typedef unsigned u32x4 __attribute__((ext_vector_type(4)));
typedef unsigned u32x2 __attribute__((ext_vector_type(2)));
typedef unsigned char uchar;
typedef int i32x8 __attribute__((ext_vector_type(8)));
typedef int i32x4 __attribute__((ext_vector_type(4)));
constexpr float W8_SCALE = 64.f, W8_INV = 1.f / 64.f;

constexpr int T = 8192, D = 2048, NPROJ = 6672, LDP = 6912;
constexpr int C_Q = 0, C_K = 1024, C_V = 2048, C_G = 3072, C_Z = 4096, C_X = 5120, C_DT = 6656;
constexpr int XBCW = 1536, NCHUNK = 64, CH = 128;
constexpr int NE = 32, DFF = 2048, MAXBLK = 160;
constexpr float EPS = 1e-6f;
constexpr int NPHASE = 10;
constexpr int NWAVES = 8, NTHR = 512;

constexpr size_t MiB = 1ull << 20;
constexpr size_t WS_CTL = 0, CTL_ZERO_BYTES = 1 * MiB;
constexpr size_t WS_WINT = 2 * MiB, WS_WOUTT = 30 * MiB, WS_COS = 38 * MiB, WS_SIN = 42 * MiB;
constexpr size_t WS_TOPI = 46 * MiB, WS_TOPR = 46 * MiB + 128 * 1024, WS_TOPW = 46 * MiB + 256 * 1024, WS_LIST = 47 * MiB, WS_ADEC = 48 * MiB;
constexpr size_t WS_WRH = 49 * MiB, WS_WRL = 49 * MiB + 128 * 1024;
constexpr size_t WS_U = 64 * MiB, WS_U2 = 96 * MiB, WS_MIX = 128 * MiB, WS_XBC = 160 * MiB, WS_KV = 192 * MiB, WS_SST = 224 * MiB;
constexpr size_t WS_H = 256 * MiB, WS_PROJ = 320 * MiB, WS_ACT = 448 * MiB, WS_YR = 608 * MiB, WS_WGUT = 768 * MiB, WS_WDT = 1280 * MiB, WS_END = 1536 * MiB;
constexpr int CW_TMO = 0, CW_BAR = 4096, CW_CNT = 16384;

constexpr int RING_BYTES = 131072;
constexpr int LDS_PHASE_END = 139264;
constexpr int LDS_TAB = LDS_PHASE_END;
constexpr int LDS_IDX = LDS_PHASE_END + 2048;
constexpr int LDS_MISC = LDS_PHASE_END + 4096;
constexpr int LDS_BIAS = LDS_PHASE_END + 5120;
constexpr int LDS_BYTES = 147456;

__device__ __forceinline__ unsigned pk_bf16(float lo, float hi) { unsigned r; asm("v_cvt_pk_bf16_f32 %0, %1, %2" : "=v"(r) : "v"(lo), "v"(hi)); return r; }
__device__ __forceinline__ float clamp448(float x) { return fminf(fmaxf(x, -448.f), 448.f); }
__device__ __forceinline__ unsigned pk_fp8x4(float a, float b, float c, float d) {
    int p = 0; p = __builtin_amdgcn_cvt_pk_fp8_f32(clamp448(a), clamp448(b), p, false); p = __builtin_amdgcn_cvt_pk_fp8_f32(clamp448(c), clamp448(d), p, true); return (unsigned)p; }
__device__ __forceinline__ float bf_lo(unsigned u) { return __uint_as_float(u << 16); }
__device__ __forceinline__ float bf_hi(unsigned u) { return __uint_as_float(u & 0xffff0000u); }
__device__ __forceinline__ float bf2f(bf16 b) { return __uint_as_float(((unsigned)b) << 16); }
__device__ __forceinline__ float wave_sum(float v) {
#pragma unroll
    for (int o = 1; o < 64; o <<= 1) v += __shfl_xor(v, o);
    return v;
}
__device__ __forceinline__ float silu_f(float x) { return x * __builtin_amdgcn_rcpf(1.0f + __expf(-x)); }
__device__ __forceinline__ float softplus_f(float x) { return x > 20.f ? x : log1pf(__expf(x)); }

__constant__ double INV_FREQ[128] = {1,0.93057204092969903,0.86596432336006535,0.80584218776148187,0.74989420933245587,0.69783058485986638,0.64938163157621132,0.60429639023813286,0.56234132519034907,0.5232991146814947,0.48696752516586311,0.45315836376008178,0.42169650342858223,0.39241897584845359,0.36517412725483772,0.33982083289425596,0.31622776601683794,0.29427271762092816,0.27384196342643613,0.25482967479793467,0.23713737056616552,0.22067340690845899,0.20535250264571461,0.19109529749704404,0.17782794100389229,0.16548170999431813,0.15399265260594919,0.14330125702369628,0.1333521432163324,0.12409377607517195,0.11547819846894582,0.10746078283213174,0.10000000000000001,0.0930572040929699,0.086596432336006529,0.080584218776148187,0.074989420933245579,0.069783058485986635,0.064938163157621132,0.060429639023813285,0.056234132519034911,0.05232991146814947,0.048696752516586311,0.045315836376008181,0.042169650342858224,0.039241897584845357,0.036517412725483769,0.033982083289425591,0.031622776601683791,0.029427271762092817,0.027384196342643614,0.025482967479793464,0.023713737056616554,0.022067340690845899,0.02053525026457146,0.019109529749704406,0.017782794100389229,0.016548170999431813,0.015399265260594919,0.014330125702369627,0.013335214321633241,0.012409377607517195,0.011547819846894581,0.010746078283213174,0.01,0.0093057204092969904,0.0086596432336006543,0.008058421877614819,0.0074989420933245579,0.0069783058485986633,0.006493816315762113,0.0060429639023813278,0.005623413251903491,0.0052329911468149467,0.004869675251658631,0.0045315836376008181,0.0042169650342858229,0.0039241897584845363,0.0036517412725483771,0.0033982083289425592,0.0031622776601683794,0.002942727176209282,0.0027384196342643613,0.0025482967479793467,0.0023713737056616554,0.0022067340690845897,0.002053525026457146,0.0019109529749704406,0.0017782794100389228,0.0016548170999431814,0.001539926526059492,0.0014330125702369627,0.0013335214321633241,0.0012409377607517195,0.0011547819846894581,0.0010746078283213176,0.001,0.00093057204092969893,0.00086596432336006539,0.00080584218776148179,0.00074989420933245586,0.00069783058485986635,0.00064938163157621134,0.00060429639023813287,0.0005623413251903491,0.00052329911468149473,0.0004869675251658631,0.00045315836376008179,0.00042169650342858224,0.00039241897584845359,0.0003651741272548377,0.00033982083289425596,0.00031622776601683794,0.00029427271762092817,0.00027384196342643611,0.00025482967479793463,0.00023713737056616554,0.00022067340690845897,0.00020535250264571461,0.00019109529749704405,0.00017782794100389227,0.00016548170999431815,0.00015399265260594919,0.00014330125702369627,0.0001333521432163324,0.00012409377607517196,0.00011547819846894582,0.00010746078283213175};
__constant__ float LG2_GAMMA[4] = {-0.045803689613124789f, -0.022720076500083529f, -0.011315313227834146f, -0.0056465631411420627f};
__constant__ float GAMMA_CHUNK[4] = {0.017183023570817902f, 0.13321516287964841f, 0.36643771592203728f, 0.60593708822908032f};

namespace pg8 {
constexpr int BM = 256, BK = 64, HALF = 128, HTB = HALF * BK * 2, STAGE_BYTES = 8 * HTB, NXCD = 8, WGM = 8;
__host__ __device__ __forceinline__ int lds_byte(int r, int c) { const int st = (r >> 4) * 2 + (c >> 5), rr = r & 15, cc = c & 31, ob = rr * 64 + cc * 2; return st * 1024 + (ob ^ (((ob >> 9) & 1) << 5)); }
__host__ __device__ __forceinline__ void stage_rc(int b, int& R, int& C) { const int st = b / 1024, sb = b % 1024, swz = sb ^ (((sb >> 9) & 1) << 5); R = (st >> 1) * 16 + swz / 64; C = (st & 1) * 32 + (swz % 64) / 2; }
__host__ __device__ __forceinline__ int perm32(int rho) { const int n = rho >> 4, i = rho & 15; return 8 * (i >> 2) + 4 * n + (i & 3); }

struct Unit { const char* pa; const char* pb; int row0, col0, aux, blk; };

template <class Epi, class Sched, bool GATHER, bool FP8>
__device__ __forceinline__ void gemm_phase(LAS uchar* lds, const int K, const Sched& S, const Epi& E) {
    const int tid = threadIdx.x, wid = __builtin_amdgcn_readfirstlane(tid >> 6), lane = tid & 63, wr = wid >> 2, wc = wid & 3, fr = lane & 15, fq = lane >> 4;
    const int nt = K / BK;
    unsigned voA[2][2], voffB[2];
#pragma unroll
    for (int i = 0; i < 2; ++i) { int R, C; stage_rc(tid * 16 + i * 8192, R, C); const int Rb = Epi::PERM == 16 ? 64 * (R >> 5) + 16 * ((R >> 2) & 3) + 4 * ((R >> 4) & 1) + (R & 3) : (Epi::PERM == 8 ? ((R & ~31) + perm32(R & 31)) : R);
        voA[0][i] = (unsigned)(R * K + C) * 2u; voA[1][i] = voA[0][i] + (unsigned)(HALF * K * 2); voffB[i] = (unsigned)(Rb * K + C) * 2u; }
    const size_t kstep = (size_t)(BK * 2);
    const size_t hstep = (size_t)(Epi::PERM == 16 ? 8 : HALF) * K * 2;
    const unsigned ldsw = (unsigned)wid * 1024u;
    const int aoff = lds_byte(wr * 64 + fr, fq * 8), boff = lds_byte(wc * 32 + fr, fq * 8);
#define PG8_SA(b, h) (((b) * 2 + (h)) * HTB)
#define PG8_SB(b, h) ((4 + (b) * 2 + (h)) * HTB)
#define PG8_STAGE(bufoff, gbase, voff) do { _Pragma("unroll") for (int _i = 0; _i < 2; ++_i) \
        __builtin_amdgcn_global_load_lds((const unsigned*)((const char*)(gbase) + (voff)[_i]), (LAS unsigned*)(lds + (bufoff) + ldsw + _i * 8192), 16, 0, 0); } while (0)
#define PG8_LDA(dst, b, h) do { _Pragma("unroll") for (int m = 0; m < 4; ++m) _Pragma("unroll") for (int k = 0; k < 2; ++k) dst[m][k] = *(const LAS bf16x8*)(lds + PG8_SA(b, h) + aoff + m * 2048 + k * 1024); } while (0)
#define PG8_LDB(dst, b, h) do { _Pragma("unroll") for (int n = 0; n < 2; ++n) _Pragma("unroll") for (int k = 0; k < 2; ++k) dst[n][k] = *(const LAS bf16x8*)(lds + PG8_SB(b, h) + boff + n * 2048 + k * 1024); } while (0)
#define PG8_CAT(x) __builtin_shufflevector(__builtin_bit_cast(i32x4, (x)[0]), __builtin_bit_cast(i32x4, (x)[1]), 0, 1, 2, 3, 4, 5, 6, 7)
#define PG8_MMA(ai, bj, At, Bt) do { __builtin_amdgcn_s_setprio(1); \
        if constexpr (FP8) { _Pragma("unroll") for (int m = 0; m < 4; ++m) _Pragma("unroll") for (int n = 0; n < 2; ++n) \
            acc[ai][bj][m][n] = __builtin_amdgcn_mfma_scale_f32_16x16x128_f8f6f4(PG8_CAT(Bt[n]), PG8_CAT(At[m]), acc[ai][bj][m][n], 0, 0, 0, 0x7f7f7f7f, 0, 0x7f7f7f7f); } \
        else { _Pragma("unroll") for (int m = 0; m < 4; ++m) _Pragma("unroll") for (int n = 0; n < 2; ++n) _Pragma("unroll") for (int k = 0; k < 2; ++k) \
            acc[ai][bj][m][n] = __builtin_amdgcn_mfma_f32_16x16x32_bf16(Bt[n][k], At[m][k], acc[ai][bj][m][n], 0, 0, 0); } \
        __builtin_amdgcn_s_setprio(0); } while (0)
#define PG8_WAIT_V(n) asm volatile("s_waitcnt vmcnt(" #n ")" ::: "memory")
#define PG8_WAIT_L(n) asm volatile("s_waitcnt lgkmcnt(" #n ")" ::: "memory")
#define PG8_BAR __builtin_amdgcn_s_barrier()
#define PG8_SCHED __builtin_amdgcn_sched_barrier(0)
    Unit cur, nxt; int ui = 0;
    if (!S.next(0, cur)) return;
    f32x4 acc[2][2][4][2];
#pragma unroll
    for (int a = 0; a < 2; ++a)
#pragma unroll
        for (int b = 0; b < 2; ++b)
#pragma unroll
            for (int m = 0; m < 4; ++m)
#pragma unroll
                for (int n = 0; n < 2; ++n) acc[a][b][m][n] = (f32x4){0.f, 0.f, 0.f, 0.f};
    bf16x8 At[4][2], B0[2][2], B1[2][2];
    const char* cA = cur.pa; const char* cB = cur.pb;
    if constexpr (GATHER) S.gather(cur, voA, (const LAS int*)nullptr);
    PG8_STAGE(PG8_SB(0, 0), cB, voffB); PG8_STAGE(PG8_SB(0, 1), cB + hstep, voffB); PG8_STAGE(PG8_SA(0, 0), cA, voA[0]); PG8_STAGE(PG8_SA(0, 1), cA, voA[1]);
    if (wr == 1) PG8_BAR;
    PG8_WAIT_V(2); PG8_BAR;
    PG8_STAGE(PG8_SB(1, 0), cB + kstep, voffB); PG8_STAGE(PG8_SA(1, 0), cA + kstep, voA[0]); PG8_STAGE(PG8_SB(1, 1), cB + hstep + kstep, voffB);
    PG8_WAIT_V(6); PG8_BAR;
    for (;;) {
        const bool has_next = S.next(ui + 1, nxt);
        if constexpr (GATHER) { if (has_next) S.prefetch(nxt, lds + LDS_IDX + ((ui + 1) & 1) * 1024, wid, lane); }
        E.prefetch(cur, lds + LDS_BIAS + (ui & 1) * 1024, wid, lane);
        const char* nA = has_next ? nxt.pa : cA; const char* nB = has_next ? nxt.pb : cB;
        for (int t = 0; t < nt; t += 2) {
            const bool last = (t == nt - 2);
            const char* a1 = cA + (size_t)(t + 1) * kstep;
            const char* a2 = last ? nA : cA + (size_t)(t + 2) * kstep; const char* b2 = last ? nB : cB + (size_t)(t + 2) * kstep;
            const char* a3 = a2 + kstep; const char* b3 = b2 + kstep;
            PG8_LDB(B0, 0, 0); PG8_LDB(B1, 0, 1); PG8_SCHED; PG8_LDA(At, 0, 0); PG8_STAGE(PG8_SA(1, 1), a1, voA[1]);
            if constexpr (GATHER) { if (last && has_next) S.gather(nxt, voA, (const LAS int*)(lds + LDS_IDX + ((ui + 1) & 1) * 1024)); }
            PG8_WAIT_V(8); PG8_WAIT_L(0); PG8_BAR; PG8_MMA(0, 0, At, B0); PG8_MMA(0, 1, At, B1); PG8_BAR; PG8_SCHED;
            PG8_LDA(At, 0, 1); PG8_STAGE(PG8_SB(0, 0), b2, voffB); PG8_STAGE(PG8_SB(0, 1), b2 + hstep, voffB); PG8_STAGE(PG8_SA(0, 0), a2, voA[0]);
            PG8_WAIT_V(8); PG8_WAIT_L(0); PG8_BAR; PG8_MMA(1, 0, At, B0); PG8_MMA(1, 1, At, B1); PG8_BAR; PG8_SCHED;
            PG8_LDB(B0, 1, 0); PG8_LDB(B1, 1, 1); PG8_SCHED; PG8_LDA(At, 1, 0); PG8_STAGE(PG8_SA(0, 1), a2, voA[1]);
            PG8_WAIT_V(8); PG8_WAIT_L(0); PG8_BAR; PG8_MMA(0, 0, At, B0); PG8_MMA(0, 1, At, B1); PG8_BAR; PG8_SCHED;
            PG8_LDA(At, 1, 1); PG8_STAGE(PG8_SB(1, 0), b3, voffB); PG8_STAGE(PG8_SB(1, 1), b3 + hstep, voffB); PG8_STAGE(PG8_SA(1, 0), a3, voA[0]);
            PG8_WAIT_V(8); PG8_WAIT_L(0); PG8_BAR; PG8_MMA(1, 0, At, B0); PG8_MMA(1, 1, At, B1); PG8_BAR; PG8_SCHED;
        }
        if (wr == 0) PG8_BAR;
        E(acc, cur, wr, wc, fr, fq, lds + LDS_BIAS + (ui & 1) * 1024);
        if (!has_next) break;
#pragma unroll
        for (int a = 0; a < 2; ++a)
#pragma unroll
            for (int b = 0; b < 2; ++b)
#pragma unroll
                for (int m = 0; m < 4; ++m)
#pragma unroll
                    for (int n = 0; n < 2; ++n) acc[a][b][m][n] = (f32x4){0.f, 0.f, 0.f, 0.f};
        cur = nxt; cA = nA; cB = nB; ++ui;
        if (wr == 1) PG8_BAR;
    }
    PG8_WAIT_V(0);
    PG8_BAR;
#undef PG8_SA
#undef PG8_SB
#undef PG8_STAGE
#undef PG8_LDA
#undef PG8_LDB
#undef PG8_MMA
#undef PG8_CAT
#undef PG8_WAIT_V
#undef PG8_WAIT_L
#undef PG8_BAR
#undef PG8_SCHED
}
}

struct DenseSched {
    const char* A; const char* B; int K, nM, nN, nwg, G, c;
    __device__ __forceinline__ bool next(int i, pg8::Unit& u) const {
        const long L = (long)i * G + c; if (L >= nwg) return false;
        int wgid = (int)L; { const int q = nwg / pg8::NXCD, r = nwg % pg8::NXCD, xcd = wgid % pg8::NXCD, off = wgid / pg8::NXCD; wgid = (xcd < r ? xcd * (q + 1) : r * (q + 1) + (xcd - r) * q) + off; }
        const int nig = pg8::WGM * nN, gid = wgid / nig, fm = gid * pg8::WGM, gsz = (nM - fm) < pg8::WGM ? (nM - fm) : pg8::WGM;
        const int pm = fm + ((wgid % nig) % gsz), pn = (wgid % nig) / gsz;
        u.pa = A + (size_t)pm * 256 * K * 2; u.pb = B + (size_t)pn * 256 * K * 2; u.row0 = pm * 256; u.col0 = pn * 256; u.aux = 0; u.blk = 0; return true;
    }
    __device__ __forceinline__ void gather(const pg8::Unit&, unsigned (&)[2][2], const LAS int*) const {}
    __device__ __forceinline__ void prefetch(const pg8::Unit&, LAS uchar*, int, int) const {}
};
struct MoeSched {
    const LAS int* tab; const char* A; const char* B; size_t bexp; const int* list; int K, nN, G, c;
    __device__ __forceinline__ bool next(int i, pg8::Unit& u) const {
        const int NB = __builtin_amdgcn_readfirstlane(tab[0]); const int L = i * G + c; if (L >= NB * nN) return false;
        const int b = L / nN, pn = L - b * nN, e = __builtin_amdgcn_readfirstlane(tab[64 + b]);
        u.pa = A; u.pb = B + (size_t)e * bexp + (size_t)pn * 256 * K * 2; u.row0 = b * 256; u.col0 = pn * 256; u.aux = e; u.blk = b; return true;
    }
    __device__ __forceinline__ void prefetch(const pg8::Unit& u, LAS uchar* buf, int wid, int lane) const {
        if (wid < 4) { const int e = u.aux, lb = (u.blk - __builtin_amdgcn_readfirstlane(tab[8 + e])) * 256;
            __builtin_amdgcn_global_load_lds((const unsigned*)(list + e * T + lb + 64 * wid + lane), (LAS unsigned*)(buf + wid * 256), 4, 0, 0); }
    }
    __device__ __forceinline__ void gather(const pg8::Unit& u, unsigned (&vo)[2][2], const LAS int* idx) const {
        const int e = u.aux, lb = (u.blk - __builtin_amdgcn_readfirstlane(tab[8 + e])) * 256, cnt = __builtin_amdgcn_readfirstlane(tab[256 + u.blk]);
#pragma unroll
        for (int i = 0; i < 2; ++i) { int R, C; pg8::stage_rc((int)threadIdx.x * 16 + i * 8192, R, C);
#pragma unroll
            for (int h = 0; h < 2; ++h) { const int r = h * 128 + R; const int raw = idx ? idx[r] : list[e * T + lb + r]; const int tok = (r < cnt) ? raw : 0; vo[h][i] = ((unsigned)tok * (unsigned)K + (unsigned)C) * 2u; } }
    }
};
struct MoeSchedDirect {
    const LAS int* tab; const char* A; const char* B; size_t bexp; int K, nN, G, c;
    __device__ __forceinline__ bool next(int i, pg8::Unit& u) const {
        const int NB = __builtin_amdgcn_readfirstlane(tab[0]); const int L = i * G + c; if (L >= NB * nN) return false;
        const int b = L / nN, pn = L - b * nN, e = __builtin_amdgcn_readfirstlane(tab[64 + b]);
        u.pa = A; u.pb = B + (size_t)e * bexp + (size_t)pn * 256 * K * 2; u.row0 = b * 256; u.col0 = pn * 256; u.aux = e; u.blk = b; return true;
    }
    __device__ __forceinline__ void prefetch(const pg8::Unit&, LAS uchar*, int, int) const {}
    __device__ __forceinline__ void gather(const pg8::Unit& u, unsigned (&vo)[2][2], const LAS int*) const {
#pragma unroll
        for (int i = 0; i < 2; ++i) { int R, C; pg8::stage_rc((int)threadIdx.x * 16 + i * 8192, R, C);
#pragma unroll
            for (int h = 0; h < 2; ++h) vo[h][i] = ((unsigned)(u.row0 + h * 128 + R) * (unsigned)K + (unsigned)C) * 2u; }
    }
};

#define EPI_LANE() int tz = threadIdx.x; asm volatile("" : "+v"(tz)); const int fr = tz & 15, fq = (tz >> 4) & 3; (void)fr_; (void)fq_
struct EpiProj {
    static constexpr int PERM = 8;
    bf16* O; int ldc; const float* COS; const float* SIN;
    __device__ __forceinline__ void prefetch(const pg8::Unit&, LAS uchar*, int, int) const {}
    __device__ __forceinline__ void operator()(const f32x4 (&acc)[2][2][4][2], const pg8::Unit& u, int wr, int wc, int fr_, int fq_, const LAS uchar* bl) const {
        EPI_LANE();
        const int row0 = u.row0 + wr * 64 + fr, col0 = u.col0 + wc * 32 + 8 * fq;
        if (u.col0 < 2048) {
            const float sc = (u.col0 >= 1024) ? 0.0625f : 1.0f; const int i0 = wc * 32 + 8 * fq;
#pragma unroll
            for (int ai = 0; ai < 2; ++ai)
#pragma unroll
                for (int m = 0; m < 4; ++m) { const int t = row0 + ai * 128 + m * 16; bf16* rowp = O + (size_t)t * ldc + col0;
                    const f32x4 c0 = *(const f32x4*)(COS + (size_t)t * 128 + i0), c1 = *(const f32x4*)(COS + (size_t)t * 128 + i0 + 4), s0 = *(const f32x4*)(SIN + (size_t)t * 128 + i0), s1 = *(const f32x4*)(SIN + (size_t)t * 128 + i0 + 4);
                    const f32x4 a0 = acc[ai][0][m][0], a1 = acc[ai][0][m][1], b0 = acc[ai][1][m][0], b1 = acc[ai][1][m][1];
                    const f32x4 p0 = (a0 * c0 - b0 * s0) * sc, p1 = (a1 * c1 - b1 * s1) * sc, q0 = (b0 * c0 + a0 * s0) * sc, q1 = (b1 * c1 + a1 * s1) * sc;
                    u32x4 w; w.x = pk_bf16(p0[0], p0[1]); w.y = pk_bf16(p0[2], p0[3]); w.z = pk_bf16(p1[0], p1[1]); w.w = pk_bf16(p1[2], p1[3]); *(u32x4*)rowp = w;
                    w.x = pk_bf16(q0[0], q0[1]); w.y = pk_bf16(q0[2], q0[3]); w.z = pk_bf16(q1[0], q1[1]); w.w = pk_bf16(q1[2], q1[3]); *(u32x4*)(rowp + 128) = w; }
        } else {
#pragma unroll
            for (int ai = 0; ai < 2; ++ai)
#pragma unroll
                for (int m = 0; m < 4; ++m) { bf16* rowp = O + (size_t)(row0 + ai * 128 + m * 16) * ldc + col0;
#pragma unroll
                    for (int bj = 0; bj < 2; ++bj) { const f32x4 v0 = acc[ai][bj][m][0], v1 = acc[ai][bj][m][1];
                        u32x4 w; w.x = pk_bf16(v0[0], v0[1]); w.y = pk_bf16(v0[2], v0[3]); w.z = pk_bf16(v1[0], v1[1]); w.w = pk_bf16(v1[2], v1[3]);
                        *(u32x4*)(rowp + bj * 128) = w; } }
        }
    }
};
struct EpiOut {
    static constexpr int PERM = 4;
    const float* X; float* Hh;
    __device__ __forceinline__ void prefetch(const pg8::Unit&, LAS uchar*, int, int) const {}
    __device__ __forceinline__ void operator()(const f32x4 (&acc)[2][2][4][2], const pg8::Unit& u, int wr, int wc, int fr_, int fq_, const LAS uchar* bl) const {
        EPI_LANE();
        const int row0 = u.row0 + wr * 64 + fr, col0 = u.col0 + wc * 32 + 4 * fq;
#pragma unroll
        for (int ai = 0; ai < 2; ++ai)
#pragma unroll
            for (int m = 0; m < 4; ++m) { const size_t off = (size_t)(row0 + ai * 128 + m * 16) * D + col0;
#pragma unroll
                for (int bj = 0; bj < 2; ++bj)
#pragma unroll
                    for (int n = 0; n < 2; ++n) { const f32x4 xv = *(const f32x4*)(X + off + bj * 128 + n * 16); *(f32x4*)(Hh + off + bj * 128 + n * 16) = xv + acc[ai][bj][m][n]; } }
    }
};
__device__ __forceinline__ float swiglu_f(float gate, float up) { const float g = fminf(gate, 7.f), u = fminf(fmaxf(up, -7.f), 7.f); return (u + 1.f) * g * __builtin_amdgcn_rcpf(1.f + __expf(-1.702f * g)); }
struct EpiGateUp {
    static constexpr int PERM = 16;
    uchar* ACT; const float* bias;
    __device__ __forceinline__ void prefetch(const pg8::Unit& u, LAS uchar* buf, int wid, int lane) const {
        if (wid < 4) __builtin_amdgcn_global_load_lds((const unsigned*)(bias + (size_t)u.aux * (2 * DFF) + u.col0 + 64 * wid + lane), (LAS unsigned*)(buf + wid * 256), 4, 0, 0); }
    __device__ __forceinline__ void operator()(const f32x4 (&acc)[2][2][4][2], const pg8::Unit& u, int wr, int wc, int fr_, int fq_, const LAS uchar* bl) const {
        EPI_LANE();
        const int row0 = u.row0 + wr * 64 + fr, col0 = u.col0 + wc * 64 + 16 * fq;
        const LAS float* bp = (const LAS float*)bl + wc * 64 + 16 * fq;
        f32x4 bv[2][2];
#pragma unroll
        for (int bj = 0; bj < 2; ++bj)
#pragma unroll
            for (int n = 0; n < 2; ++n) bv[bj][n] = *(const LAS f32x4*)(bp + bj * 8 + 4 * n);
#pragma unroll
        for (int ai = 0; ai < 2; ++ai)
#pragma unroll
            for (int m = 0; m < 4; ++m) { uchar* rowp = ACT + (size_t)(row0 + ai * 128 + m * 16) * DFF + (col0 >> 1);
                u32x2 w;
#pragma unroll
                for (int bj = 0; bj < 2; ++bj) { const f32x4 v0 = acc[ai][bj][m][0] * W8_INV + bv[bj][0], v1 = acc[ai][bj][m][1] * W8_INV + bv[bj][1];
                    const unsigned p = pk_fp8x4(swiglu_f(v0[0], v0[1]), swiglu_f(v0[2], v0[3]), swiglu_f(v1[0], v1[1]), swiglu_f(v1[2], v1[3]));
                    if (bj == 0) w.x = p; else w.y = p; }
                *(u32x2*)rowp = w; }
    }
};
struct EpiDown {
    static constexpr int PERM = 8;
    bf16* YR; const float* bias;
    __device__ __forceinline__ void prefetch(const pg8::Unit& u, LAS uchar* buf, int wid, int lane) const {
        if (wid < 4) __builtin_amdgcn_global_load_lds((const unsigned*)(bias + (size_t)u.aux * D + u.col0 + 64 * wid + lane), (LAS unsigned*)(buf + wid * 256), 4, 0, 0); }
    __device__ __forceinline__ void operator()(const f32x4 (&acc)[2][2][4][2], const pg8::Unit& u, int wr, int wc, int fr_, int fq_, const LAS uchar* bl) const {
        EPI_LANE();
        const int row0 = u.row0 + wr * 64 + fr, col0 = u.col0 + wc * 32 + 8 * fq;
        const LAS float* bp = (const LAS float*)bl + wc * 32 + 8 * fq;
        f32x4 bv[2][2];
#pragma unroll
        for (int bj = 0; bj < 2; ++bj)
#pragma unroll
            for (int n = 0; n < 2; ++n) bv[bj][n] = *(const LAS f32x4*)(bp + bj * 128 + 4 * n);
#pragma unroll
        for (int ai = 0; ai < 2; ++ai)
#pragma unroll
            for (int m = 0; m < 4; ++m) { bf16* rowp = YR + (size_t)(row0 + ai * 128 + m * 16) * D + col0;
#pragma unroll
                for (int bj = 0; bj < 2; ++bj) { const f32x4 v0 = acc[ai][bj][m][0] * W8_INV + bv[bj][0], v1 = acc[ai][bj][m][1] * W8_INV + bv[bj][1];
                    u32x4 w; w.x = pk_bf16(v0[0], v0[1]); w.y = pk_bf16(v0[2], v0[3]); w.z = pk_bf16(v1[0], v1[1]); w.w = pk_bf16(v1[2], v1[3]);
                    *(u32x4*)(rowp + bj * 128) = w; } }
    }
};

#define XB_TMO      128
#define XB_XCNT(j)  (256  + 64 * (j))
#define XB_XSUB(j)  (1280 + 64 * (j))
#define XB_XGEN(j)  (2304 + 64 * (j))
#define XB_TOP      3328
#define XB_TOPGEN   3392
#define XCD_BAR_WORDS 3456
#define XB_SPIN_CAP (1u << 18)
__device__ __forceinline__ unsigned xb_ld(unsigned* p)              { return __hip_atomic_load(p, __ATOMIC_RELAXED, __HIP_MEMORY_SCOPE_AGENT); }
__device__ __forceinline__ unsigned xb_add(unsigned* p, unsigned v) { return __hip_atomic_fetch_add(p, v, __ATOMIC_RELAXED, __HIP_MEMORY_SCOPE_AGENT); }
__device__ __forceinline__ unsigned xb_xcc_id() { return (unsigned)__builtin_amdgcn_s_getreg((3 << 11) | 20) & 0xFu; }
#define XB_SPIN(cond, bar) do { unsigned _sp = 0; while (cond) { __builtin_amdgcn_s_sleep(1); \
    if ((++_sp & 255u) == 0u) { if (xb_ld(&(bar)[XB_TMO])) break; if (_sp > XB_SPIN_CAP) { atomicAdd(&(bar)[XB_TMO], 1u); break; } } } } while (0)
struct XcdBarrier { unsigned* bar; unsigned x; volatile LAS unsigned* st; };
__device__ __forceinline__ XcdBarrier xcd_barrier_post(unsigned* bar, volatile LAS unsigned* st) {
    XcdBarrier b; b.bar = bar; b.x = xb_xcc_id(); b.st = st;
    if (threadIdx.x == 0) (void)xb_add(&bar[XB_XCNT(b.x)], 1u);
    return b;
}
__device__ __forceinline__ void xcd_barrier_complete(unsigned* bar, unsigned x, unsigned& nloc, unsigned& nx) {
    const unsigned G = gridDim.x * gridDim.y * gridDim.z;
    unsigned sum, cnt, mine, sp = 0u;
    for (;;) {
        sum = 0u; cnt = 0u; mine = 0u;
#pragma unroll
        for (unsigned j = 0; j < 16; ++j) { const unsigned c = xb_ld(&bar[XB_XCNT(j)]); sum += c; cnt += (c > 0u) ? 1u : 0u; mine = (j == x) ? c : mine; }
        if (sum == G) break;
        __builtin_amdgcn_s_sleep(1);
        if ((++sp & 255u) == 0u) { if (xb_ld(&bar[XB_TMO])) break; if (sp > XB_SPIN_CAP) { atomicAdd(&bar[XB_TMO], 1u); break; } }
    }
    nloc = mine > 0u ? mine : 1u; nx = cnt > 0u ? cnt : 1u;
}
__device__ __forceinline__ void xcd_barrier(const XcdBarrier& b) {
    asm volatile("s_waitcnt vmcnt(0)" ::: "memory");
    __syncthreads();
    if (threadIdx.x == 0) {
        unsigned* bar = b.bar;
        __builtin_amdgcn_s_waitcnt(0);
        unsigned nloc = b.st[0], nx = b.st[1];
        if (nloc == 0u) { xcd_barrier_complete(bar, b.x, nloc, nx); b.st[0] = nloc; b.st[1] = nx; }
        const unsigned old = xb_add(&bar[XB_XSUB(b.x)], 1u);
        const unsigned gen = old / nloc;
        if (old + 1u == (gen + 1u) * nloc) {
            __builtin_amdgcn_fence(__ATOMIC_RELEASE, "agent");
            asm volatile("s_waitcnt vmcnt(0)" ::: "memory");
            const unsigned og = xb_add(&bar[XB_TOP], 1u);
            const unsigned tg = og / nx;
            if (og + 1u == (tg + 1u) * nx) xb_add(&bar[XB_TOPGEN], 1u);
            else XB_SPIN(xb_ld(&bar[XB_TOPGEN]) == tg, bar);
            __builtin_amdgcn_fence(__ATOMIC_ACQUIRE, "agent");
            xb_add(&bar[XB_XGEN(b.x)], 1u);
            asm volatile("s_waitcnt vmcnt(0)" ::: "memory");
        } else {
            XB_SPIN(xb_ld(&bar[XB_XGEN(b.x)]) == gen, bar);
            __builtin_amdgcn_fence(__ATOMIC_ACQUIRE, "agent");
            asm volatile("s_waitcnt vmcnt(0)" ::: "memory");
        }
    }
    __syncthreads();
}

struct Ctx { LAS uchar* lds; int tid, lane, wave, G, bid; uchar* ws; const void* const* in; float* out; };
#define XP_x(X) ((const float*)(X).in[0])
#define XP_pos(X) ((const int*)(X).in[1])
#define XP_ln_mix_w(X) ((const float*)(X).in[2])
#define XP_w_in(X) ((const float*)(X).in[3])
#define XP_conv_w(X) ((const float*)(X).in[4])
#define XP_conv_b(X) ((const float*)(X).in[5])
#define XP_dt_bias(X) ((const float*)(X).in[6])
#define XP_a_log(X) ((const float*)(X).in[7])
#define XP_d_skip(X) ((const float*)(X).in[8])
#define XP_ssm_norm_w(X) ((const float*)(X).in[9])
#define XP_w_out(X) ((const float*)(X).in[10])
#define XP_ln_ffn_w(X) ((const float*)(X).in[11])
#define XP_w_router(X) ((const float*)(X).in[12])
#define XP_b_router(X) ((const float*)(X).in[13])
#define XP_w_gu(X) ((const float*)(X).in[14])
#define XP_b_gu(X) ((const float*)(X).in[15])
#define XP_w_d(X) ((const float*)(X).in[16])
#define XP_b_d(X) ((const float*)(X).in[17])
#define XP_ln_final_w(X) ((const float*)(X).in[18])
#define XP_WinT(X) ((bf16*)((X).ws + WS_WINT))
#define XP_WoutT(X) ((bf16*)((X).ws + WS_WOUTT))
#define XP_WguT(X) ((uchar*)((X).ws + WS_WGUT))
#define XP_WdT(X) ((uchar*)((X).ws + WS_WDT))
#define XP_U(X) ((bf16*)((X).ws + WS_U))
#define XP_U2(X) ((uchar*)((X).ws + WS_U2))
#define XP_MIX(X) ((bf16*)((X).ws + WS_MIX))
#define XP_XBC(X) ((bf16*)((X).ws + WS_XBC))
#define XP_KV(X) ((bf16*)((X).ws + WS_KV))
#define XP_SST(X) ((bf16*)((X).ws + WS_SST))
#define XP_PROJ(X) ((bf16*)((X).ws + WS_PROJ))
#define XP_ACT(X) ((uchar*)((X).ws + WS_ACT))
#define XP_YR(X) ((bf16*)((X).ws + WS_YR))
#define XP_COS(X) ((float*)((X).ws + WS_COS))
#define XP_SIN(X) ((float*)((X).ws + WS_SIN))
#define XP_Hh(X) ((float*)((X).ws + WS_H))
#define XP_ADEC(X) ((float*)((X).ws + WS_ADEC))
#define XP_TOPW(X) ((float*)((X).ws + WS_TOPW))
#define XP_TOPI(X) ((int*)((X).ws + WS_TOPI))
#define XP_TOPR(X) ((int*)((X).ws + WS_TOPR))
#define XP_LIST(X) ((int*)((X).ws + WS_LIST))
#define XP_ctl(X) ((unsigned*)((X).ws + WS_CTL))
#define XP_WRH(X) ((bf16*)((X).ws + WS_WRH))
#define XP_WRL(X) ((bf16*)((X).ws + WS_WRL))


__device__ __forceinline__ bf16x8 tr_frag(LAS uchar* p, int rstep) {
    const s16x4 a = __builtin_amdgcn_ds_read_tr16_b64_v4i16((LAS s16x4*)p);
    const s16x4 b = __builtin_amdgcn_ds_read_tr16_b64_v4i16((LAS s16x4*)(p + rstep));
    return (bf16x8){a[0], a[1], a[2], a[3], b[0], b[1], b[2], b[3]};
}
__device__ __forceinline__ f32x4 mma16(bf16x8 xrow, bf16x8 ycol, f32x4 c) { return __builtin_amdgcn_mfma_f32_16x16x32_bf16(xrow, ycol, c, 0, 0, 0); }
__device__ __forceinline__ float wave_incl_scan(float v, int lane) {
#pragma unroll
    for (int o = 1; o < 64; o <<= 1) { const float t = __shfl_up(v, o); if (lane >= o) v += t; }
    return v;
}
__device__ __forceinline__ void rope8(const u32x4 k1, const u32x4 k2, const f32x4 c0, const f32x4 c1, const f32x4 s0, const f32x4 s1, const float sc, u32x4& o1, u32x4& o2) {
    float r1[8], r2[8];
#pragma unroll
    for (int m = 0; m < 4; ++m) {
        const float a0 = bf_lo(k1[m]), a1 = bf_hi(k1[m]), b0 = bf_lo(k2[m]), b1 = bf_hi(k2[m]);
        const float cs0 = (m < 2) ? c0[2 * m] : c1[2 * m - 4], cs1 = (m < 2) ? c0[2 * m + 1] : c1[2 * m - 3];
        const float sn0 = (m < 2) ? s0[2 * m] : s1[2 * m - 4], sn1 = (m < 2) ? s0[2 * m + 1] : s1[2 * m - 3];
        r1[2 * m] = (a0 * cs0 - b0 * sn0) * sc; r1[2 * m + 1] = (a1 * cs1 - b1 * sn1) * sc;
        r2[2 * m] = (b0 * cs0 + a0 * sn0) * sc; r2[2 * m + 1] = (b1 * cs1 + a1 * sn1) * sc;
    }
    o1.x = pk_bf16(r1[0], r1[1]); o1.y = pk_bf16(r1[2], r1[3]); o1.z = pk_bf16(r1[4], r1[5]); o1.w = pk_bf16(r1[6], r1[7]);
    o2.x = pk_bf16(r2[0], r2[1]); o2.y = pk_bf16(r2[2], r2[3]); o2.z = pk_bf16(r2[4], r2[5]); o2.w = pk_bf16(r2[6], r2[7]);
}

__device__ __forceinline__ void tr_decode(const Ctx& X, int r, const float*& W, bf16*& WT, int& N, int& kb, int& nb) {
    constexpr int I_IN = 32 * 209;
    if (r < I_IN) { W = XP_w_in(X); WT = XP_WinT(X); N = NPROJ; }
    else { r -= I_IN; W = XP_w_out(X); WT = XP_WoutT(X); N = D; }
    const int nbn = (N + 31) >> 5; kb = r / nbn; nb = r - kb * nbn;
}
__device__ __forceinline__ void tr8_item(const float* W, int N, uchar* WT, int kb, int nb, int lane) {
    const int k0 = kb * 128 + 16 * (lane & 7), n0 = nb * 32 + 4 * (lane >> 3);
    f32x4 v[16];
#pragma unroll
    for (int i = 0; i < 16; ++i) v[i] = __builtin_nontemporal_load((const f32x4*)(W + (size_t)(k0 + i) * N + n0));
#pragma unroll
    for (int j = 0; j < 4; ++j) { u32x4 o;
        o.x = pk_fp8x4(v[0][j] * W8_SCALE, v[1][j] * W8_SCALE, v[2][j] * W8_SCALE, v[3][j] * W8_SCALE); o.y = pk_fp8x4(v[4][j] * W8_SCALE, v[5][j] * W8_SCALE, v[6][j] * W8_SCALE, v[7][j] * W8_SCALE);
        o.z = pk_fp8x4(v[8][j] * W8_SCALE, v[9][j] * W8_SCALE, v[10][j] * W8_SCALE, v[11][j] * W8_SCALE); o.w = pk_fp8x4(v[12][j] * W8_SCALE, v[13][j] * W8_SCALE, v[14][j] * W8_SCALE, v[15][j] * W8_SCALE);
        __builtin_nontemporal_store(o, (u32x4*)(WT + (size_t)(n0 + j) * 2048 + k0)); }
}
__device__ __forceinline__ void tr_load(const float* W, int N, int kb, int nb, int lane, f32x4 (&v)[8]) {
    const int k0 = kb * 64 + 8 * (lane & 7), n0 = nb * 32 + 4 * (lane >> 3);
    if (n0 < N) {
#pragma unroll
        for (int i = 0; i < 8; ++i) v[i] = *(const f32x4*)(W + (size_t)(k0 + i) * N + n0);
    }
}
__device__ __forceinline__ void tr_store(bf16* WT, int N, int kb, int nb, int lane, const f32x4 (&v)[8]) {
    const int k0 = kb * 64 + 8 * (lane & 7), n0 = nb * 32 + 4 * (lane >> 3);
    if (n0 < N) {
#pragma unroll
        for (int j = 0; j < 4; ++j) { u32x4 o; o.x = pk_bf16(v[0][j], v[1][j]); o.y = pk_bf16(v[2][j], v[3][j]); o.z = pk_bf16(v[4][j], v[5][j]); o.w = pk_bf16(v[6][j], v[7][j]);
            *(u32x4*)(WT + (size_t)(n0 + j) * 2048 + k0) = o; }
    }
}
constexpr int I_GU8 = 32 * 16 * 128, I_D8 = 32 * 16 * 64, I_ALL8 = I_GU8 + I_D8;
__device__ __forceinline__ void conv8_id(const Ctx& X, int it, int lane) {
    if (it < I_GU8) { const int e = it >> 11, r = it & 2047; tr8_item(XP_w_gu(X) + (size_t)e * D * (2 * DFF), 2 * DFF, XP_WguT(X) + (size_t)e * (2 * DFF) * D, r >> 7, r & 127, lane); }
    else { const int i2 = it - I_GU8, e = i2 >> 10, r = i2 & 1023; tr8_item(XP_w_d(X) + (size_t)e * DFF * D, D, XP_WdT(X) + (size_t)e * D * DFF, r >> 6, r & 63, lane); }
}
constexpr int FILL_N1 = 6, FILL_W1 = 160 * 8, FILL_N3 = 3, FILL_W3 = 64 * 8, FILL_N4 = 6, FILL_W4 = 128 * 8;
constexpr int FILL_B1 = I_ALL8 - FILL_N1 * FILL_W1 - FILL_N3 * FILL_W3 - FILL_N4 * FILL_W4, FILL_B3 = FILL_B1 + FILL_N1 * FILL_W1, FILL_B4 = FILL_B3 + FILL_N3 * FILL_W3;
__device__ __forceinline__ void conv8_fill(const Ctx& X, int base, int fw, int nw, int n) {
#pragma unroll 1
    for (int j = 0; j < n; ++j) conv8_id(X, base + j * nw + fw, X.lane);
}
__device__ __forceinline__ void p0_prologue(Ctx& X) {
    const int gw = X.bid * NWAVES + X.wave, NGW = X.G * NWAVES, lane = X.lane;
    const int gt = X.bid * NTHR + X.tid, NGT = X.G * NTHR;
    for (int m = gw; m < T; m += NGW) {
        const f32x4* xr = (const f32x4*)(XP_x(X) + (size_t)m * D) + lane; const f32x4* wr_ = (const f32x4*)XP_ln_mix_w(X) + lane;
        f32x4 v[8]; float s = 0.f;
#pragma unroll
        for (int j = 0; j < 8; ++j) { v[j] = xr[64 * j]; s += (v[j].x * v[j].x + v[j].y * v[j].y) + (v[j].z * v[j].z + v[j].w * v[j].w); }
        const float rstd = rsqrtf(wave_sum(s) * (1.f / D) + EPS);
        u32x2* o8 = (u32x2*)(XP_U(X) + (size_t)m * D) + lane;
#pragma unroll
        for (int j = 0; j < 8; ++j) { const f32x4 w = wr_[64 * j]; u32x2 o; o.x = pk_bf16(v[j].x * rstd * w.x, v[j].y * rstd * w.y); o.y = pk_bf16(v[j].z * rstd * w.z, v[j].w * rstd * w.w); o8[64 * j] = o; }
    }
    for (int idx = gt; idx < T * 128; idx += NGT) {
        const int t = idx >> 7, i = idx & 127;
        const double ang = (double)XP_pos(X)[t] * INV_FREQ[i];
        double rev = ang * 0.15915494309189533577; rev -= floor(rev);
        const float f = (float)rev;
        XP_COS(X)[idx] = __builtin_amdgcn_cosf(f); XP_SIN(X)[idx] = __builtin_amdgcn_sinf(f);
    }
    { u32x4* p = (u32x4*)(XP_WinT(X) + (size_t)NPROJ * D); const int n16 = (LDP - NPROJ) * D * 2 / 16; const u32x4 z = {0u, 0u, 0u, 0u};
      for (int i = gt; i < n16; i += NGT) p[i] = z; }
    for (int idx = gt; idx < NE * D; idx += NGT) { const int e = idx >> 11, d = idx & 2047;
        const float wv = XP_ln_ffn_w(X)[d] * XP_w_router(X)[d * NE + e]; const unsigned hb = pk_bf16(wv, 0.f) & 0xffffu; const float lo = wv - __uint_as_float(hb << 16);
        XP_WRH(X)[idx] = (bf16)hb; XP_WRL(X)[idx] = (bf16)(pk_bf16(lo, 0.f) & 0xffffu); }
    constexpr int NIT = 32 * 209 + 32 * 64;
    for (int it = gw; it < NIT; it += 2 * NGW) {
        const float *W0, *W1 = nullptr; bf16 *T0, *T1 = nullptr; int N0, N1 = 0, kb0, kb1 = 0, nb0, nb1 = 0;
        f32x4 v0[8], v1[8];
        tr_decode(X, it, W0, T0, N0, kb0, nb0);
        const bool two = (it + NGW) < NIT;
        if (two) tr_decode(X, it + NGW, W1, T1, N1, kb1, nb1);
        tr_load(W0, N0, kb0, nb0, lane, v0);
        if (two) tr_load(W1, N1, kb1, nb1, lane, v1);
        tr_store(T0, N0, kb0, nb0, lane, v0);
        if (two) tr_store(T1, N1, kb1, nb1, lane, v1);
    }
    const int n_p0 = (X.G == 256) ? FILL_B1 : I_ALL8;
#pragma unroll 1
    for (int it = gw; it < n_p0; it += NGW) conv8_id(X, it, lane);
}

__device__ __forceinline__ bf16x8 scale_frag(const bf16x8 f, const float base, const float (&rr)[8]) {
    u32x4 u = __builtin_bit_cast(u32x4, f);
    u.x = pk_bf16(bf_lo(u.x) * (base * rr[0]), bf_hi(u.x) * (base * rr[1])); u.y = pk_bf16(bf_lo(u.y) * (base * rr[2]), bf_hi(u.y) * (base * rr[3]));
    u.z = pk_bf16(bf_lo(u.z) * (base * rr[4]), bf_hi(u.z) * (base * rr[5])); u.w = pk_bf16(bf_lo(u.w) * (base * rr[6]), bf_hi(u.w) * (base * rr[7]));
    return __builtin_bit_cast(bf16x8, u);
}
__device__ __forceinline__ void p2_ret(Ctx& X, int unit) {
    const int c = unit >> 2, h = unit & 3, t0 = c * CH, tid = X.tid, lane = X.lane, w = X.wave;
    LAS uchar* Vt = X.lds; LAS uchar* Kt = X.lds + 69632;
    { u32x4 vv[8], kk[8];
#pragma unroll
      for (int i = 0; i < 8; ++i) { const int q = tid + 512 * i, l = q >> 5, vc = q & 31; const bf16* rp = XP_PROJ(X) + (size_t)(t0 + l) * LDP + h * 256 + vc * 8;
          vv[i] = *(const u32x4*)(rp + C_V); kk[i] = *(const u32x4*)(rp + C_K); }
#pragma unroll
      for (int i = 0; i < 8; ++i) { const int q = tid + 512 * i, l = q >> 5, vc = q & 31; *(LAS u32x4*)(Vt + l * 544 + vc * 16) = vv[i]; *(LAS u32x4*)(Kt + l * 544 + vc * 16) = kk[i]; } }
    __syncthreads();
    const float lg = LG2_GAMMA[h];
    float rr[8];
#pragma unroll
    for (int e = 0; e < 8; ++e) rr[e] = exp2f(-lg * (float)e);
    const int fr = lane & 15, fq = lane >> 4, trs = (8 * fq + ((lane & 15) >> 2)) * 544 + 8 * (lane & 3);
    f32x4 acc[2][16];
#pragma unroll
    for (int a = 0; a < 2; ++a)
#pragma unroll
        for (int n = 0; n < 16; ++n) acc[a][n] = (f32x4){0.f, 0.f, 0.f, 0.f};
#pragma unroll 1
    for (int ks = 0; ks < 4; ++ks) {
        const float base = exp2f(lg * (float)(127 - 32 * ks - 8 * fq));
        const bf16x8 af0 = scale_frag(tr_frag(Vt + (32 * ks) * 544 + (16 * w) * 2 + trs, 4 * 544), base, rr);
        const bf16x8 af1 = scale_frag(tr_frag(Vt + (32 * ks) * 544 + (128 + 16 * w) * 2 + trs, 4 * 544), base, rr);
#pragma unroll
        for (int n = 0; n < 16; ++n) { const bf16x8 bf = tr_frag(Kt + (32 * ks) * 544 + (16 * n) * 2 + trs, 4 * 544);
            acc[0][n] = mma16(bf, af0, acc[0][n]); acc[1][n] = mma16(bf, af1, acc[1][n]); }
    }
    bf16* outp = XP_KV(X) + (size_t)(c * 4 + h) * 65536;
#pragma unroll
    for (int a = 0; a < 2; ++a)
#pragma unroll
        for (int n = 0; n < 16; ++n) { u32x2 o; o.x = pk_bf16(acc[a][n][0], acc[a][n][1]); o.y = pk_bf16(acc[a][n][2], acc[a][n][3]);
            *(u32x2*)(outp + (size_t)(128 * a + 16 * w + fr) * 256 + 16 * n + 4 * fq) = o; }
    __syncthreads();
}
__device__ __forceinline__ void conv8(const Ctx& X, int t, int cx, float (&o)[8]) {
    const f32x4 b0 = *(const f32x4*)(XP_conv_b(X) + cx), b1 = *(const f32x4*)(XP_conv_b(X) + cx + 4);
    o[0] = b0.x; o[1] = b0.y; o[2] = b0.z; o[3] = b0.w; o[4] = b1.x; o[5] = b1.y; o[6] = b1.z; o[7] = b1.w;
#pragma unroll
    for (int j = 0; j < 4; ++j) { const int tt = t - 3 + j;
        if (tt >= 0) { const u32x4 v = *(const u32x4*)(XP_PROJ(X) + (size_t)tt * LDP + C_X + cx);
            const f32x4 w0 = *(const f32x4*)(XP_conv_w(X) + j * XBCW + cx), w1 = *(const f32x4*)(XP_conv_w(X) + j * XBCW + cx + 4);
            o[0] += w0.x * bf_lo(v.x); o[1] += w0.y * bf_hi(v.x); o[2] += w0.z * bf_lo(v.y); o[3] += w0.w * bf_hi(v.y);
            o[4] += w1.x * bf_lo(v.z); o[5] += w1.y * bf_hi(v.z); o[6] += w1.z * bf_lo(v.w); o[7] += w1.w * bf_hi(v.w); } }
#pragma unroll
    for (int i = 0; i < 8; ++i) o[i] = silu_f(o[i]);
}
__device__ __forceinline__ void p2_ssd(Ctx& X, int unit) {
    const int c = unit >> 2, g = (unit >> 1) & 1, hh = unit & 1, t0 = c * CH, tid = X.tid, lane = X.lane, w = X.wave;
    LAS uchar* Xd = X.lds; LAS uchar* Bc = X.lds + 69632;
    LAS float* dtS = (LAS float*)(X.lds + 106496); LAS float* acS = (LAS float*)(X.lds + 108544);
    if (w < 4) { const int h = 8 * g + 4 * hh + w, l0 = 2 * lane;
        const float dtb = XP_dt_bias(X)[h], A = -expf(XP_a_log(X)[h]);
        const float d0 = softplus_f(bf2f(XP_PROJ(X)[(size_t)(t0 + l0) * LDP + C_DT + h]) + dtb), d1 = softplus_f(bf2f(XP_PROJ(X)[(size_t)(t0 + l0 + 1) * LDP + C_DT + h]) + dtb);
        const float a0 = d0 * A, a1 = d1 * A, s = a0 + a1, incl = wave_incl_scan(s, lane);
        dtS[w * 128 + l0] = d0; dtS[w * 128 + l0 + 1] = d1; acS[w * 128 + l0] = incl - a1; acS[w * 128 + l0 + 1] = incl;
        if (lane == 63) XP_ADEC(X)[c * 16 + h] = expf(incl); }
    __syncthreads();
    if (tid < 504) { const int rg = tid / 56, j = tid - rg * 56, l0 = 15 * rg;
        int cx; if (j < 32) cx = 512 * g + 256 * hh + 8 * j; else if (j < 48) cx = 1024 + 128 * g + 8 * (j - 32); else cx = 1280 + 128 * g + 64 * hh + 8 * (j - 48);
        u32x4 rw[18];
#pragma unroll
        for (int r = 0; r < 18; ++r) { const int l = l0 - 3 + r, tt = t0 + l; rw[r] = (tt >= 0 && l < 128) ? *(const u32x4*)(XP_PROJ(X) + (size_t)tt * LDP + C_X + cx) : (u32x4){0u, 0u, 0u, 0u}; }
        f32x4 wa[4], wb[4];
#pragma unroll
        for (int k = 0; k < 4; ++k) { wa[k] = *(const f32x4*)(XP_conv_w(X) + k * XBCW + cx); wb[k] = *(const f32x4*)(XP_conv_w(X) + k * XBCW + cx + 4); }
        const f32x4 ba = *(const f32x4*)(XP_conv_b(X) + cx), bb = *(const f32x4*)(XP_conv_b(X) + cx + 4);
#pragma unroll
        for (int r = 0; r < 15; ++r) { const int l = l0 + r;
            if (l < 128) { float o[8] = {ba.x, ba.y, ba.z, ba.w, bb.x, bb.y, bb.z, bb.w};
#pragma unroll
                for (int k = 0; k < 4; ++k) { const u32x4 v = rw[r + k];
                    o[0] += wa[k].x * bf_lo(v.x); o[1] += wa[k].y * bf_hi(v.x); o[2] += wa[k].z * bf_lo(v.y); o[3] += wa[k].w * bf_hi(v.y);
                    o[4] += wb[k].x * bf_lo(v.z); o[5] += wb[k].y * bf_hi(v.z); o[6] += wb[k].z * bf_lo(v.w); o[7] += wb[k].w * bf_hi(v.w); }
#pragma unroll
                for (int i = 0; i < 8; ++i) o[i] = silu_f(o[i]);
                u32x4 ov; ov.x = pk_bf16(o[0], o[1]); ov.y = pk_bf16(o[2], o[3]); ov.z = pk_bf16(o[4], o[5]); ov.w = pk_bf16(o[6], o[7]);
                if (j < 32) { const int e = j >> 3; const float sc = dtS[e * 128 + l] * __expf(acS[e * 128 + 127] - acS[e * 128 + l]);
                    u32x4 os; os.x = pk_bf16(o[0] * sc, o[1] * sc); os.y = pk_bf16(o[2] * sc, o[3] * sc); os.z = pk_bf16(o[4] * sc, o[5] * sc); os.w = pk_bf16(o[6] * sc, o[7] * sc);
                    *(LAS u32x4*)(Xd + l * 544 + j * 16) = os; *(u32x4*)(XP_XBC(X) + (size_t)(t0 + l) * XBCW + cx) = ov; }
                else if (j < 48) { *(LAS u32x4*)(Bc + l * 288 + (j - 32) * 16) = ov; if (hh == 0) *(u32x4*)(XP_XBC(X) + (size_t)(t0 + l) * XBCW + cx) = ov; }
                else *(u32x4*)(XP_XBC(X) + (size_t)(t0 + l) * XBCW + cx) = ov; } } }
    __syncthreads();
    const int fr = lane & 15, fq = lane >> 4, q4 = (lane & 15) >> 2, p4 = lane & 3;
    const int trx = (8 * fq + q4) * 544 + 8 * p4, trb = (8 * fq + q4) * 288 + 8 * p4;
    f32x4 acc[2][8];
#pragma unroll
    for (int a = 0; a < 2; ++a)
#pragma unroll
        for (int n = 0; n < 8; ++n) acc[a][n] = (f32x4){0.f, 0.f, 0.f, 0.f};
#pragma unroll 1
    for (int ks = 0; ks < 4; ++ks) {
        const bf16x8 af0 = tr_frag(Xd + (32 * ks) * 544 + (16 * w) * 2 + trx, 4 * 544);
        const bf16x8 af1 = tr_frag(Xd + (32 * ks) * 544 + (128 + 16 * w) * 2 + trx, 4 * 544);
#pragma unroll
        for (int n = 0; n < 8; ++n) { const bf16x8 bf = tr_frag(Bc + (32 * ks) * 288 + (16 * n) * 2 + trb, 4 * 288);
            acc[0][n] = mma16(bf, af0, acc[0][n]); acc[1][n] = mma16(bf, af1, acc[1][n]); }
    }
#pragma unroll
    for (int a = 0; a < 2; ++a) { const int m = 128 * a + 16 * w + fr, h = 8 * g + 4 * hh + (m >> 6), p = m & 63;
        bf16* outp = XP_SST(X) + ((size_t)(c * 16 + h) * 64 + p) * 128;
#pragma unroll
        for (int n = 0; n < 8; ++n) { u32x2 o; o.x = pk_bf16(acc[a][n][0], acc[a][n][1]); o.y = pk_bf16(acc[a][n][2], acc[a][n][3]); *(u32x2*)(outp + 16 * n + 4 * fq) = o; } }
    __syncthreads();
}

__device__ __forceinline__ void p3_scan(Ctx& X) {
    const int gt = X.bid * NTHR + X.tid, NGT = X.G * NTHR;
    for (int item = gt; item < 65536 + 32768; item += NGT) {
        const bool ret = item < 65536; const int it2 = ret ? item : item - 65536;
        bf16* p = ret ? (XP_KV(X) + (size_t)it2 * 4) : (XP_SST(X) + (size_t)it2 * 4);
        const size_t stride = ret ? 262144 : 131072;
        const int head = ret ? (it2 >> 14) : (it2 >> 11);
        const float gdec = ret ? GAMMA_CHUNK[head & 3] : 0.f;
        float s0 = 0.f, s1 = 0.f, s2 = 0.f, s3 = 0.f;
        for (int c0 = 0; c0 < NCHUNK; c0 += 16) {
            u32x2 v[16]; float dec[16];
#pragma unroll
            for (int j = 0; j < 16; ++j) { v[j] = *(const u32x2*)(p + (size_t)(c0 + j) * stride); dec[j] = ret ? gdec : XP_ADEC(X)[(c0 + j) * 16 + head]; }
#pragma unroll
            for (int j = 0; j < 16; ++j) { u32x2 o; o.x = pk_bf16(s0, s1); o.y = pk_bf16(s2, s3); *(u32x2*)(p + (size_t)(c0 + j) * stride) = o;
                s0 = dec[j] * s0 + bf_lo(v[j].x); s1 = dec[j] * s1 + bf_hi(v[j].x); s2 = dec[j] * s2 + bf_lo(v[j].y); s3 = dec[j] * s3 + bf_hi(v[j].y); }
        }
    }
}

__device__ __forceinline__ void p4_ret(Ctx& X, int unit) {
    const int c = unit >> 2, h = unit & 3, t0 = c * CH, tid = X.tid, lane = X.lane, w = X.wave;
    LAS uchar* R1 = X.lds; LAS uchar* R2 = X.lds + 69632;
    const float lg = LG2_GAMMA[h];
    u32x4 P[8];
    { u32x4 qq[8];
#pragma unroll
      for (int i = 0; i < 8; ++i) { const int q = tid + 512 * i, l = q >> 5, dc = q & 31; const bf16* rp = XP_PROJ(X) + (size_t)(t0 + l) * LDP + h * 256 + dc * 8;
          qq[i] = *(const u32x4*)(rp + C_Q); P[i] = *(const u32x4*)(rp + C_K); }
#pragma unroll
      for (int i = 0; i < 8; ++i) { const int q = tid + 512 * i, l = q >> 5, dc = q & 31; *(LAS u32x4*)(R1 + l * 544 + dc * 16) = qq[i]; *(LAS u32x4*)(R2 + l * 544 + dc * 16) = P[i]; } }
    __syncthreads();
    const bf16* prev = XP_KV(X) + (size_t)(c * 4 + h) * 65536;
#pragma unroll
    for (int i = 0; i < 8; ++i) { const int q = tid + 512 * i, v = q >> 4, dc = q & 15; P[i] = *(const u32x4*)(prev + (size_t)v * 256 + dc * 8); }
    const int fr = lane & 15, fq = lane >> 4, q4 = (lane & 15) >> 2, p4 = lane & 3, l = 16 * w + fr;
    f32x4 sc[8];
#pragma unroll
    for (int n = 0; n < 8; ++n) sc[n] = (f32x4){0.f, 0.f, 0.f, 0.f};
#pragma unroll 2
    for (int ks = 0; ks < 8; ++ks) {
        const bf16x8 af = *(const LAS bf16x8*)(R1 + l * 544 + (32 * ks + 8 * fq) * 2);
#pragma unroll
        for (int n = 0; n < 8; ++n) if (n <= w) { const bf16x8 bf = *(const LAS bf16x8*)(R2 + (16 * n + fr) * 544 + (32 * ks + 8 * fq) * 2); sc[n] = mma16(bf, af, sc[n]); }
    }
    bf16x8 scf[4];
#pragma unroll
    for (int k2 = 0; k2 < 4; ++k2) { float v[8];
#pragma unroll
        for (int tq = 0; tq < 2; ++tq)
#pragma unroll
            for (int j = 0; j < 4; ++j) { const int s = 16 * (2 * k2 + tq) + 4 * fq + j; v[4 * tq + j] = (s <= l) ? sc[2 * k2 + tq][j] * exp2f(lg * (float)(l - s)) : 0.f; }
        u32x4 pk; pk.x = pk_bf16(v[0], v[1]); pk.y = pk_bf16(v[2], v[3]); pk.z = pk_bf16(v[4], v[5]); pk.w = pk_bf16(v[6], v[7]);
        scf[k2] = __builtin_bit_cast(bf16x8, pk); }
    __syncthreads();
    f32x4 acc[16];
#pragma unroll
    for (int n = 0; n < 16; ++n) acc[n] = (f32x4){0.f, 0.f, 0.f, 0.f};
#pragma unroll
    for (int dh = 0; dh < 2; ++dh) {
#pragma unroll
        for (int i = 0; i < 8; ++i) { const int q = tid + 512 * i, v = q >> 4, dc = q & 15; *(LAS u32x4*)(R2 + v * 272 + dc * 16) = P[i]; }
        __syncthreads();
        if (dh == 0) {
#pragma unroll
            for (int i = 0; i < 8; ++i) { const int q = tid + 512 * i, v = q >> 4, dc = q & 15; P[i] = *(const u32x4*)(prev + (size_t)v * 256 + 128 + dc * 8); }
        } else {
#pragma unroll
            for (int i = 0; i < 8; ++i) { const int q = tid + 512 * i, s_ = q >> 5, vc = q & 31; P[i] = *(const u32x4*)(XP_PROJ(X) + (size_t)(t0 + s_) * LDP + C_V + h * 256 + vc * 8); }
        }
#pragma unroll 2
        for (int ks = 0; ks < 4; ++ks) {
            const bf16x8 af = *(const LAS bf16x8*)(R1 + l * 544 + (128 * dh + 32 * ks + 8 * fq) * 2);
#pragma unroll
            for (int n = 0; n < 16; ++n) { const bf16x8 bf = *(const LAS bf16x8*)(R2 + (16 * n + fr) * 272 + (32 * ks + 8 * fq) * 2); acc[n] = mma16(bf, af, acc[n]); }
        }
        __syncthreads();
    }
    { const float qd = exp2f(lg * (float)(l + 1));
#pragma unroll
      for (int n = 0; n < 16; ++n) acc[n] = acc[n] * qd; }
#pragma unroll
    for (int i = 0; i < 8; ++i) { const int q = tid + 512 * i, s_ = q >> 5, vc = q & 31; *(LAS u32x4*)(R2 + s_ * 544 + vc * 16) = P[i]; }
    __syncthreads();
    const bf16* gp = XP_PROJ(X) + (size_t)(t0 + l) * LDP + C_G + h * 256 + 4 * fq; bf16* op = XP_MIX(X) + (size_t)(t0 + l) * D + h * 256 + 4 * fq;
    u32x2 gv[16];
#pragma unroll
    for (int n = 0; n < 16; ++n) gv[n] = *(const u32x2*)(gp + 16 * n);
    const int trp = (4 * fq + q4) * 544 + 8 * p4;
#pragma unroll
    for (int k2 = 0; k2 < 4; ++k2) if (2 * k2 <= w) {
#pragma unroll
        for (int n = 0; n < 16; ++n) { const bf16x8 bf = tr_frag(R2 + (32 * k2) * 544 + (16 * n) * 2 + trp, 16 * 544); acc[n] = mma16(bf, scf[k2], acc[n]); }
    }
    float ss = 0.f;
#pragma unroll
    for (int n = 0; n < 16; ++n) ss += (acc[n][0] * acc[n][0] + acc[n][1] * acc[n][1]) + (acc[n][2] * acc[n][2] + acc[n][3] * acc[n][3]);
    ss += __shfl_xor(ss, 16); ss += __shfl_xor(ss, 32);
    const float rstd = rsqrtf(ss * (1.f / 256.f) + EPS);
#pragma unroll
    for (int n = 0; n < 16; ++n) {
        u32x2 o; o.x = pk_bf16(acc[n][0] * rstd * silu_f(bf_lo(gv[n].x)), acc[n][1] * rstd * silu_f(bf_hi(gv[n].x))); o.y = pk_bf16(acc[n][2] * rstd * silu_f(bf_lo(gv[n].y)), acc[n][3] * rstd * silu_f(bf_hi(gv[n].y)));
        *(u32x2*)(op + 16 * n) = o; }
    __syncthreads();
}

__device__ __forceinline__ void p4_ssd(Ctx& X, int unit) {
    const int c = unit >> 1, g = unit & 1, t0 = c * CH, tid = X.tid, lane = X.lane, w = X.wave;
    LAS uchar* Cc = X.lds; LAS uchar* Bc = X.lds + 34816;
    LAS uchar* HP = X.lds + 34816;
    LAS float* dtS = (LAS float*)(X.lds + 110592); LAS float* acS = (LAS float*)(X.lds + 114688);
    { const int h = 8 * g + w, l0 = 2 * lane;
      const float dtb = XP_dt_bias(X)[h], A = -expf(XP_a_log(X)[h]);
      const float d0 = softplus_f(bf2f(XP_PROJ(X)[(size_t)(t0 + l0) * LDP + C_DT + h]) + dtb), d1 = softplus_f(bf2f(XP_PROJ(X)[(size_t)(t0 + l0 + 1) * LDP + C_DT + h]) + dtb);
      const float a0 = d0 * A, a1 = d1 * A, incl = wave_incl_scan(a0 + a1, lane);
      dtS[w * 128 + l0] = d0; dtS[w * 128 + l0 + 1] = d1; acS[w * 128 + l0] = incl - a1; acS[w * 128 + l0 + 1] = incl; }
#pragma unroll
    for (int i = 0; i < 4; ++i) { const int q = tid + 512 * i, l = q >> 4, nc = q & 15;
        *(LAS u32x4*)(Bc + l * 272 + nc * 16) = *(const u32x4*)(XP_XBC(X) + (size_t)(t0 + l) * XBCW + 1024 + 128 * g + nc * 8);
        *(LAS u32x4*)(Cc + l * 272 + nc * 16) = *(const u32x4*)(XP_XBC(X) + (size_t)(t0 + l) * XBCW + 1280 + 128 * g + nc * 8); }
    __syncthreads();
    const int fr = lane & 15, fq = lane >> 4, q4 = (lane & 15) >> 2, p4 = lane & 3, l = 16 * w + fr;
    f32x4 cb[8]; bf16x8 cfr[4];
#pragma unroll
    for (int n = 0; n < 8; ++n) cb[n] = (f32x4){0.f, 0.f, 0.f, 0.f};
#pragma unroll
    for (int ks = 0; ks < 4; ++ks) {
        cfr[ks] = *(const LAS bf16x8*)(Cc + l * 272 + (32 * ks + 8 * fq) * 2);
#pragma unroll
        for (int n = 0; n < 8; ++n) if (n <= w) { const bf16x8 bf = *(const LAS bf16x8*)(Bc + (16 * n + fr) * 272 + (32 * ks + 8 * fq) * 2); cb[n] = mma16(bf, cfr[ks], cb[n]); }
    }
    __syncthreads();
    float ss = 0.f;
    const int trp = (4 * fq + q4) * 144 + 8 * p4;
    const bf16* xp = XP_XBC(X) + (size_t)(t0 + l) * XBCW + 512 * g + 4 * fq; const bf16* zp = XP_PROJ(X) + (size_t)(t0 + l) * LDP + C_Z + 512 * g + 4 * fq;
    bf16* op = XP_MIX(X) + (size_t)(t0 + l) * D + 1024 + 512 * g + 4 * fq;
    u32x4 px[4], ps[4];
#pragma unroll
    for (int i = 0; i < 4; ++i) { const int q = tid + 512 * i; { const int e2 = q >> 10, s_ = (q >> 3) & 127, pc = q & 7; px[i] = *(const u32x4*)(XP_XBC(X) + (size_t)(t0 + s_) * XBCW + 512 * g + 64 * e2 + pc * 8); }
        { const int e2 = q >> 10, p = (q >> 4) & 63, nc = q & 15; ps[i] = *(const u32x4*)(XP_SST(X) + ((size_t)(c * 16 + 8 * g + e2) * 64 + p) * 128 + nc * 8); } }
#pragma unroll 1
    for (int hp = 0; hp < 4; ++hp) {
#pragma unroll
        for (int i = 0; i < 4; ++i) { const int q = tid + 512 * i; { const int e2 = q >> 10, s_ = (q >> 3) & 127, pc = q & 7, e = 2 * hp + e2; const u32x4 v = px[i]; const float d = dtS[e * 128 + s_];
            u32x4 o; o.x = pk_bf16(bf_lo(v.x) * d, bf_hi(v.x) * d); o.y = pk_bf16(bf_lo(v.y) * d, bf_hi(v.y) * d); o.z = pk_bf16(bf_lo(v.z) * d, bf_hi(v.z) * d); o.w = pk_bf16(bf_lo(v.w) * d, bf_hi(v.w) * d);
            *(LAS u32x4*)(HP + e2 * 18432 + s_ * 144 + pc * 16) = o; }
            { const int e2 = q >> 10, p = (q >> 4) & 63, nc = q & 15; *(LAS u32x4*)(HP + 36864 + e2 * 17408 + p * 272 + nc * 16) = ps[i]; } }
        __syncthreads();
        if (hp < 3) {
#pragma unroll
            for (int i = 0; i < 4; ++i) { const int q = tid + 512 * i; { const int e2 = q >> 10, s_ = (q >> 3) & 127, pc = q & 7, e = 2 * hp + 2 + e2; px[i] = *(const u32x4*)(XP_XBC(X) + (size_t)(t0 + s_) * XBCW + 512 * g + 64 * e + pc * 8); }
                { const int e2 = q >> 10, p = (q >> 4) & 63, nc = q & 15, e = 2 * hp + 2 + e2; ps[i] = *(const u32x4*)(XP_SST(X) + ((size_t)(c * 16 + 8 * g + e) * 64 + p) * 128 + nc * 8); } }
        }
        u32x2 xq[2][4], zq[2][4];
#pragma unroll
        for (int e2 = 0; e2 < 2; ++e2)
#pragma unroll
            for (int n = 0; n < 4; ++n) { xq[e2][n] = *(const u32x2*)(xp + 64 * (2 * hp + e2) + 16 * n); zq[e2][n] = *(const u32x2*)(zp + 64 * (2 * hp + e2) + 16 * n); }
#pragma unroll
        for (int e2 = 0; e2 < 2; ++e2) { const int e = 2 * hp + e2;
            LAS uchar* Xh = HP + e2 * 18432; LAS uchar* Ph = HP + 36864 + e2 * 17408;
            f32x4 y[4];
#pragma unroll
            for (int n = 0; n < 4; ++n) y[n] = (f32x4){0.f, 0.f, 0.f, 0.f};
#pragma unroll
            for (int ks = 0; ks < 4; ++ks)
#pragma unroll
                for (int n = 0; n < 4; ++n) { const bf16x8 bf = *(const LAS bf16x8*)(Ph + (16 * n + fr) * 272 + (32 * ks + 8 * fq) * 2); y[n] = mma16(bf, cfr[ks], y[n]); }
            const float al = acS[e * 128 + l], el = __expf(al);
#pragma unroll
            for (int n = 0; n < 4; ++n) y[n] = y[n] * el;
#pragma unroll
            for (int k2 = 0; k2 < 4; ++k2) if (2 * k2 <= w) { float v[8];
#pragma unroll
                for (int tq = 0; tq < 2; ++tq) { const int s0 = 16 * (2 * k2 + tq) + 4 * fq; const f32x4 as = *(const LAS f32x4*)(acS + e * 128 + s0);
#pragma unroll
                    for (int j = 0; j < 4; ++j) v[4 * tq + j] = (s0 + j <= l) ? cb[2 * k2 + tq][j] * __expf(al - as[j]) : 0.f; }
                u32x4 pk; pk.x = pk_bf16(v[0], v[1]); pk.y = pk_bf16(v[2], v[3]); pk.z = pk_bf16(v[4], v[5]); pk.w = pk_bf16(v[6], v[7]);
                const bf16x8 gf = __builtin_bit_cast(bf16x8, pk);
#pragma unroll
                for (int n = 0; n < 4; ++n) { const bf16x8 bf = tr_frag(Xh + (32 * k2) * 144 + (16 * n) * 2 + trp, 16 * 144); y[n] = mma16(bf, gf, y[n]); }
            }
            const float dsk = XP_d_skip(X)[8 * g + e];
#pragma unroll
            for (int n = 0; n < 4; ++n) { const u32x2 xv = xq[e2][n], zv = zq[e2][n];
                const float t0_ = (y[n][0] + dsk * bf_lo(xv.x)) * silu_f(bf_lo(zv.x)), t1_ = (y[n][1] + dsk * bf_hi(xv.x)) * silu_f(bf_hi(zv.x));
                const float t2_ = (y[n][2] + dsk * bf_lo(xv.y)) * silu_f(bf_lo(zv.y)), t3_ = (y[n][3] + dsk * bf_hi(xv.y)) * silu_f(bf_hi(zv.y));
                ss += (t0_ * t0_ + t1_ * t1_) + (t2_ * t2_ + t3_ * t3_);
                u32x2 o; o.x = pk_bf16(t0_, t1_); o.y = pk_bf16(t2_, t3_); *(u32x2*)(op + 64 * e + 16 * n) = o; }
        }
        __syncthreads();
    }
    ss += __shfl_xor(ss, 16); ss += __shfl_xor(ss, 32);
    const float rstd = rsqrtf(ss * (1.f / 512.f) + EPS);
    const float* nw = XP_ssm_norm_w(X) + 512 * g + 4 * fq;
#pragma unroll 4
    for (int i = 0; i < 32; ++i) { const f32x4 wv = *(const f32x4*)(nw + 16 * i); const u32x2 t = *(const u32x2*)(op + 16 * i);
        u32x2 o; o.x = pk_bf16(bf_lo(t.x) * rstd * wv.x, bf_hi(t.x) * rstd * wv.y); o.y = pk_bf16(bf_lo(t.y) * rstd * wv.z, bf_hi(t.y) * rstd * wv.w);
        *(u32x2*)(op + 16 * i) = o; }
    __syncthreads();
}

__device__ __forceinline__ void p6_router(Ctx& X) {
    const int tid = X.tid, lane = X.lane, w = X.wave, fr = lane & 15, fq = lane >> 4;
    LAS float* part = (LAS float*)X.lds;
    LAS float* ssq = (LAS float*)(X.lds + 32768);
    LAS float* lgt = (LAS float*)(X.lds + 32768 + 1024);
    LAS float* rs = (LAS float*)(X.lds + 32768 + 1024 + 4096);
    for (int item = X.bid; item < T / 32; item += X.G) {
        const int tb = item * 32;
        f32x4 acc[2][2]; float ss[2] = {0.f, 0.f};
#pragma unroll
        for (int a = 0; a < 2; ++a)
#pragma unroll
            for (int n = 0; n < 2; ++n) acc[a][n] = (f32x4){0.f, 0.f, 0.f, 0.f};
#pragma unroll 2
        for (int ks = 0; ks < 8; ++ks) { const int kb = 256 * w + 32 * ks + 8 * fq;
            bf16x8 ah[2], al[2], bh[2], bl[2];
#pragma unroll
            for (int mt = 0; mt < 2; ++mt) { const float* hp = XP_Hh(X) + (size_t)(tb + 16 * mt + fr) * D + kb;
                const f32x4 x0 = *(const f32x4*)hp, x1 = *(const f32x4*)(hp + 4);
                ss[mt] += (x0.x * x0.x + x0.y * x0.y) + (x0.z * x0.z + x0.w * x0.w) + (x1.x * x1.x + x1.y * x1.y) + (x1.z * x1.z + x1.w * x1.w);
                u32x4 h, l; h.x = pk_bf16(x0.x, x0.y); h.y = pk_bf16(x0.z, x0.w); h.z = pk_bf16(x1.x, x1.y); h.w = pk_bf16(x1.z, x1.w);
                l.x = pk_bf16(x0.x - bf_lo(h.x), x0.y - bf_hi(h.x)); l.y = pk_bf16(x0.z - bf_lo(h.y), x0.w - bf_hi(h.y)); l.z = pk_bf16(x1.x - bf_lo(h.z), x1.y - bf_hi(h.z)); l.w = pk_bf16(x1.z - bf_lo(h.w), x1.w - bf_hi(h.w));
                ah[mt] = __builtin_bit_cast(bf16x8, h); al[mt] = __builtin_bit_cast(bf16x8, l); }
#pragma unroll
            for (int nt = 0; nt < 2; ++nt) { bh[nt] = *(const bf16x8*)(XP_WRH(X) + (size_t)(16 * nt + fr) * D + kb); bl[nt] = *(const bf16x8*)(XP_WRL(X) + (size_t)(16 * nt + fr) * D + kb); }
#pragma unroll
            for (int mt = 0; mt < 2; ++mt)
#pragma unroll
                for (int nt = 0; nt < 2; ++nt) { acc[mt][nt] = mma16(bh[nt], ah[mt], acc[mt][nt]); acc[mt][nt] = mma16(bl[nt], ah[mt], acc[mt][nt]); acc[mt][nt] = mma16(bh[nt], al[mt], acc[mt][nt]); }
        }
#pragma unroll
        for (int mt = 0; mt < 2; ++mt) { float q = ss[mt]; q += __shfl_xor(q, 16); q += __shfl_xor(q, 32); if (fq == 0) ssq[w * 32 + 16 * mt + fr] = q;
#pragma unroll
            for (int nt = 0; nt < 2; ++nt) *(LAS f32x4*)(part + (w * 32 + 16 * mt + fr) * 32 + 16 * nt + 4 * fq) = acc[mt][nt]; }
        __syncthreads();
        { const int tk = tid >> 4, e0 = 2 * (tid & 15); float q = 0.f, a0 = 0.f, a1 = 0.f;
#pragma unroll
          for (int ww = 0; ww < 8; ++ww) { q += ssq[ww * 32 + tk]; const f32x2 p = *(const LAS f32x2*)(part + (ww * 32 + tk) * 32 + e0); a0 += p.x; a1 += p.y; }
          const float rstd = rsqrtf(q * (1.f / D) + EPS);
          lgt[tk * 32 + e0] = a0 * rstd + XP_b_router(X)[e0]; lgt[tk * 32 + e0 + 1] = a1 * rstd + XP_b_router(X)[e0 + 1];
          if ((tid & 15) == 0) rs[tk] = rstd; }
        __syncthreads();
        if (tid < 32) { const int t = tb + tid; unsigned used = 0u; int idx[4]; float val[4];
#pragma unroll
            for (int k = 0; k < 4; ++k) { float best = -3.0e38f; int bi = 0;
#pragma unroll 8
                for (int j = 0; j < 32; ++j) { const float v = lgt[tid * 32 + j]; if (!((used >> j) & 1u) && v > best) { best = v; bi = j; } }
                used |= 1u << bi; idx[k] = bi; val[k] = best; }
            const float e1 = __expf(val[1] - val[0]), e2 = __expf(val[2] - val[0]), e3 = __expf(val[3] - val[0]), inv = 1.f / (1.f + e1 + e2 + e3);
            const float wv[4] = {inv, e1 * inv, e2 * inv, e3 * inv};
#pragma unroll
            for (int k = 0; k < 4; ++k) { const int rank = (int)atomicAdd(XP_ctl(X) + CW_CNT + 64 * idx[k], 1u);
                XP_LIST(X)[idx[k] * T + rank] = t; XP_TOPI(X)[t * 4 + k] = idx[k]; XP_TOPR(X)[t * 4 + k] = rank; XP_TOPW(X)[t * 4 + k] = wv[k]; } }
#pragma unroll 2
        for (int r = 0; r < 4; ++r) { const int tk = 4 * w + r, t = tb + tk; const float rstd = rs[tk];
            const f32x4* hr = (const f32x4*)(XP_Hh(X) + (size_t)t * D) + lane; const f32x4* wr_ = (const f32x4*)XP_ln_ffn_w(X) + lane;
            unsigned* o8 = (unsigned*)(XP_U2(X) + (size_t)t * D) + lane;
#pragma unroll
            for (int j = 0; j < 8; ++j) { const f32x4 v = hr[64 * j], wv = wr_[64 * j]; o8[64 * j] = pk_fp8x4(v.x * rstd * wv.x, v.y * rstd * wv.y, v.z * rstd * wv.z, v.w * rstd * wv.w); } }
        __syncthreads();
    }
}

__device__ __forceinline__ void moe_tables(Ctx& X) {
    LAS int* tab = (LAS int*)(X.lds + LDS_TAB);
    if (X.tid == 0) { int nb = 0;
        for (int e = 0; e < NE; ++e) { const int cnt = (int)__hip_atomic_load(XP_ctl(X) + CW_CNT + 64 * e, __ATOMIC_RELAXED, __HIP_MEMORY_SCOPE_AGENT); const int k = (cnt + 255) >> 8;
            tab[8 + e] = nb; for (int b = 0; b < k; ++b) { if (nb + b < MAXBLK) { tab[64 + nb + b] = e; tab[256 + nb + b] = (cnt - 256 * b) < 256 ? (cnt - 256 * b) : 256; } } nb += k; }
        tab[8 + NE] = nb; tab[0] = nb < MAXBLK ? nb : MAXBLK; }
    __syncthreads();
}

__device__ __forceinline__ void p9_final(Ctx& X) {
    const LAS int* tab = (const LAS int*)(X.lds + LDS_TAB);
    const int gw = X.bid * NWAVES + X.wave, NGW = X.G * NWAVES, lane = X.lane;
    for (int t = gw; t < T; t += NGW) {
        const f32x4* hr = (const f32x4*)(XP_Hh(X) + (size_t)t * D) + lane;
        f32x4 v[8];
#pragma unroll
        for (int j = 0; j < 8; ++j) v[j] = hr[64 * j];
#pragma unroll
        for (int k = 0; k < 4; ++k) { const int e = XP_TOPI(X)[t * 4 + k], r = XP_TOPR(X)[t * 4 + k]; const float wk = XP_TOPW(X)[t * 4 + k];
            const u32x2* yr = (const u32x2*)(XP_YR(X) + ((size_t)tab[8 + e] * 256 + r) * D) + lane;
#pragma unroll
            for (int j = 0; j < 8; ++j) { const u32x2 y = yr[64 * j]; v[j].x += wk * bf_lo(y.x); v[j].y += wk * bf_hi(y.x); v[j].z += wk * bf_lo(y.y); v[j].w += wk * bf_hi(y.y); } }
        float s = 0.f;
#pragma unroll
        for (int j = 0; j < 8; ++j) s += (v[j].x * v[j].x + v[j].y * v[j].y) + (v[j].z * v[j].z + v[j].w * v[j].w);
        const float rstd = rsqrtf(wave_sum(s) * (1.f / D) + EPS);
        f32x4* o = (f32x4*)(X.out + (size_t)t * D) + lane; const f32x4* wr_ = (const f32x4*)XP_ln_final_w(X) + lane;
#pragma unroll
        for (int j = 0; j < 8; ++j) { const f32x4 wv = wr_[64 * j]; f32x4 r; r.x = v[j].x * rstd * wv.x; r.y = v[j].y * rstd * wv.y; r.z = v[j].z * rstd * wv.z; r.w = v[j].w * rstd * wv.w; o[64 * j] = r; }
    }
}

#ifdef NO_P4R
#define P4R(X,u)
#else
#define P4R(X,u) p4_ret(X,u)
#endif
#ifdef NO_P4S
#define P4S(X,u)
#else
#define P4S(X,u) p4_ssd(X,u)
#endif
struct Args { const void* in[19]; float* out; uchar* ws; int ph_lo, ph_hi; };
__global__ void __launch_bounds__(NTHR, 2) fwd(Args args) {
    extern __shared__ __attribute__((aligned(16))) uchar lds_raw[];
    Ctx X;
    X.lds = (LAS uchar*)lds_raw; X.tid = threadIdx.x; X.lane = X.tid & 63; X.wave = __builtin_amdgcn_readfirstlane(X.tid >> 6); X.G = gridDim.x; X.bid = blockIdx.x;
    X.in = (const void* const*)__builtin_amdgcn_kernarg_segment_ptr(); X.out = args.out; X.ws = args.ws;
    for (int u = X.tid; u < (LDS_BYTES - LDS_PHASE_END) / 4; u += NTHR) ((LAS unsigned*)(X.lds + LDS_PHASE_END))[u] = 0u;
    __syncthreads();
    const int lo = args.ph_lo, hi = args.ph_hi;
    const bool multi = (hi - lo) > 1;
    XcdBarrier bar; bar.bar = XP_ctl(X) + CW_BAR; bar.x = 0; bar.st = nullptr;
    if (multi) bar = xcd_barrier_post(XP_ctl(X) + CW_BAR, (volatile LAS unsigned*)(X.lds + LDS_MISC + 32));
#ifdef ONLY_PHASE
#define IN(k) ((k) == ONLY_PHASE && lo <= (k) && (k) < hi)
#else
#define IN(k) (lo <= (k) && (k) < hi)
#endif
#define SEAM(k) do { if (IN(k) && IN((k) + 1)) xcd_barrier(bar); } while (0)
    if (IN(0)) { p0_prologue(X); } SEAM(0);
    if (IN(1)) { DenseSched S{(const char*)XP_U(X), (const char*)XP_WinT(X), D, T / 256, LDP / 256, (T / 256) * (LDP / 256), X.G, X.bid}; EpiProj E{XP_PROJ(X), LDP, XP_COS(X), XP_SIN(X)};
        pg8::gemm_phase<EpiProj, DenseSched, false, false>(X.lds, D, S, E);
        if (X.G == 256 && X.bid >= 96) conv8_fill(X, FILL_B1, (X.bid - 96) * NWAVES + X.wave, FILL_W1, FILL_N1); } SEAM(1);
    if (IN(2)) { for (int u = X.bid; u < 256; u += X.G) p2_ret(X, u);
        for (int u = X.bid; u < 256; u += X.G) p2_ssd(X, u); } SEAM(2);
    if (IN(3)) { p3_scan(X); if (X.G == 256 && X.bid >= 192) conv8_fill(X, FILL_B3, (X.bid - 192) * NWAVES + X.wave, FILL_W3, FILL_N3); } SEAM(3);
    if (IN(4)) { for (int u = X.bid; u < 256; u += X.G) { P4R(X, u); }
        for (int u = X.bid; u < 128; u += X.G) { P4S(X, u); }
        if (X.G == 256 && X.bid >= 128) conv8_fill(X, FILL_B4, (X.bid - 128) * NWAVES + X.wave, FILL_W4, FILL_N4); } SEAM(4);
    if (IN(5)) { DenseSched S{(const char*)XP_MIX(X), (const char*)XP_WoutT(X), D, T / 256, D / 256, (T / 256) * (D / 256), X.G, X.bid}; EpiOut E{XP_x(X), XP_Hh(X)};
        pg8::gemm_phase<EpiOut, DenseSched, false, false>(X.lds, D, S, E); } SEAM(5);
    if (IN(6)) { p6_router(X); } SEAM(6);
    if (IN(7)) { moe_tables(X); MoeSched S{(const LAS int*)(X.lds + LDS_TAB), (const char*)XP_U2(X), (const char*)XP_WguT(X), (size_t)(2 * DFF) * D, XP_LIST(X), D / 2, (2 * DFF) / 256, X.G, X.bid}; EpiGateUp E{XP_ACT(X), XP_b_gu(X)};
        pg8::gemm_phase<EpiGateUp, MoeSched, true, true>(X.lds, D / 2, S, E); } SEAM(7);
    if (IN(8)) { moe_tables(X); MoeSchedDirect S{(const LAS int*)(X.lds + LDS_TAB), (const char*)XP_ACT(X), (const char*)XP_WdT(X), (size_t)D * DFF, DFF / 2, D / 256, X.G, X.bid}; EpiDown E{XP_YR(X), XP_b_d(X)};
        pg8::gemm_phase<EpiDown, MoeSchedDirect, true, true>(X.lds, DFF / 2, S, E); } SEAM(8);
    if (IN(9)) { moe_tables(X); p9_final(X); }
#undef IN
#undef SEAM
}

extern "C" void kernel_launch(void* const* d_in, const int* in_sizes, int n_in, void* d_out, int out_size, void* d_ws, size_t ws_size, hipStream_t stream) {
    static int grid = 0;
    if (grid == 0) {
        if (n_in != 19 || out_size != T * D || ws_size < WS_END) { fprintf(stderr, "kernel_launch: unexpected shapes (n_in %d, out %d, ws %zu)\n", n_in, out_size, ws_size); grid = -1; return; }
        int dev = 0, cus = 0, per_cu = 0;
        if (hipGetDevice(&dev) != hipSuccess || hipDeviceGetAttribute(&cus, hipDeviceAttributeMultiprocessorCount, dev) != hipSuccess) { grid = -1; return; }
        if (hipFuncSetAttribute((const void*)fwd, hipFuncAttributeMaxDynamicSharedMemorySize, LDS_BYTES) != hipSuccess) { fprintf(stderr, "kernel_launch: hipFuncSetAttribute failed\n"); grid = -1; return; }
        if (hipOccupancyMaxActiveBlocksPerMultiprocessor(&per_cu, (const void*)fwd, NTHR, LDS_BYTES) != hipSuccess || per_cu < 1) { fprintf(stderr, "kernel_launch: occupancy query reports %d\n", per_cu); }
        (void)hipGetLastError();
        grid = cus;
    }
    if (grid < 0) return;
    (void)hipMemsetAsync((char*)d_ws + WS_CTL, 0, CTL_ZERO_BYTES, stream);
    Args a{};
    for (int i = 0; i < 19; ++i) a.in[i] = d_in[i];
    a.out = (float*)d_out; a.ws = (uchar*)d_ws;
    constexpr int NL = MK_N_LAUNCHES;
    for (int li = 0; li < NL; ++li) {
        a.ph_lo = (NL == 1) ? 0 : li; a.ph_hi = (NL == 1) ? NPHASE : li + 1;
        hipLaunchKernelGGL(fwd, dim3(grid), dim3(NTHR), LDS_BYTES, stream, a);
    }
}
```

```cpp
#include <hip/hip_runtime.h>
#include <cstdio>
#include <cstdint>

#ifndef MK_N_LAUNCHES
#define MK_N_LAUNCHES 1
#endif

#define LAS __attribute__((address_space(3)))
typedef unsigned short bf16;
typedef short bf16x8 __attribute__((ext_vector_type(8)));
typedef short s16x4 __attribute__((ext_vector_type(4)));
typedef float f32x4 __attribute__((ext_vector_type(4)));
typedef float f32x2 __attribute__((ext_vector_type(2)));
typedef unsigned u32x4 __attribute__((ext_vector_type(4)));
typedef unsigned u32x2 __attribute__((ext_vector_type(2)));
typedef unsigned char uchar;
typedef int i32x8 __attribute__((ext_vector_type(8)));
typedef int i32x4 __attribute__((ext_vector_type(4)));
constexpr float W8_SCALE = 64.f, W8_INV = 1.f / 64.f;

constexpr int T = 8192, D = 2048, NPROJ = 6672, LDP = 6912;
constexpr int C_Q = 0, C_K = 1024, C_V = 2048, C_G = 3072, C_Z = 4096, C_X = 5120, C_DT = 6656;
constexpr int XBCW = 1536, NCHUNK = 64, CH = 128;
constexpr int NE = 32, DFF = 2048, MAXBLK = 160;
constexpr float EPS = 1e-6f;
constexpr int NPHASE = 10;
constexpr int NWAVES = 8, NTHR = 512;

constexpr size_t MiB = 1ull << 20;
constexpr size_t WS_CTL = 0, CTL_ZERO_BYTES = 1 * MiB;
constexpr size_t WS_WINT = 2 * MiB, WS_WOUTT = 30 * MiB, WS_COS = 38 * MiB, WS_SIN = 42 * MiB;
constexpr size_t WS_TOPI = 46 * MiB, WS_TOPR = 46 * MiB + 128 * 1024, WS_TOPW = 46 * MiB + 256 * 1024, WS_LIST = 47 * MiB, WS_ADEC = 48 * MiB;
constexpr size_t WS_WRH = 49 * MiB, WS_WRL = 49 * MiB + 128 * 1024;
constexpr size_t WS_U = 64 * MiB, WS_U2 = 96 * MiB, WS_MIX = 128 * MiB, WS_XBC = 160 * MiB, WS_KV = 192 * MiB, WS_SST = 224 * MiB;
constexpr size_t WS_H = 256 * MiB, WS_PROJ = 320 * MiB, WS_ACT = 448 * MiB, WS_YR = 608 * MiB, WS_WGUT = 768 * MiB, WS_WDT = 1280 * MiB, WS_END = 1536 * MiB;
constexpr int CW_TMO = 0, CW_BAR = 4096, CW_CNT = 16384;

constexpr int RING_BYTES = 131072;
constexpr int LDS_PHASE_END = 139264;
constexpr int LDS_TAB = LDS_PHASE_END;
constexpr int LDS_IDX = LDS_PHASE_END + 2048;
constexpr int LDS_MISC = LDS_PHASE_END + 4096;
constexpr int LDS_BIAS = LDS_PHASE_END + 5120;
constexpr int LDS_BYTES = 147456;

__device__ __forceinline__ unsigned pk_bf16(float lo, float hi) { unsigned r; asm("v_cvt_pk_bf16_f32 %0, %1, %2" : "=v"(r) : "v"(lo), "v"(hi)); return r; }
__device__ __forceinline__ float clamp448(float x) { return fminf(fmaxf(x, -448.f), 448.f); }
__device__ __forceinline__ unsigned pk_fp8x4(float a, float b, float c, float d) {
    int p = 0; p = __builtin_amdgcn_cvt_pk_fp8_f32(clamp448(a), clamp448(b), p, false); p = __builtin_amdgcn_cvt_pk_fp8_f32(clamp448(c), clamp448(d), p, true); return (unsigned)p; }
__device__ __forceinline__ float bf_lo(unsigned u) { return __uint_as_float(u << 16); }
__device__ __forceinline__ float bf_hi(unsigned u) { return __uint_as_float(u & 0xffff0000u); }
__device__ __forceinline__ float bf2f(bf16 b) { return __uint_as_float(((unsigned)b) << 16); }
__device__ __forceinline__ float wave_sum(float v) {
#pragma unroll
    for (int o = 1; o < 64; o <<= 1) v += __shfl_xor(v, o);
    return v;
}
__device__ __forceinline__ float silu_f(float x) { return x * __builtin_amdgcn_rcpf(1.0f + __expf(-x)); }
__device__ __forceinline__ float softplus_f(float x) { return x > 20.f ? x : log1pf(__expf(x)); }

__constant__ double INV_FREQ[128] = {1,0.93057204092969903,0.86596432336006535,0.80584218776148187,0.74989420933245587,0.69783058485986638,0.64938163157621132,0.60429639023813286,0.56234132519034907,0.5232991146814947,0.48696752516586311,0.45315836376008178,0.42169650342858223,0.39241897584845359,0.36517412725483772,0.33982083289425596,0.31622776601683794,0.29427271762092816,0.27384196342643613,0.25482967479793467,0.23713737056616552,0.22067340690845899,0.20535250264571461,0.19109529749704404,0.17782794100389229,0.16548170999431813,0.15399265260594919,0.14330125702369628,0.1333521432163324,0.12409377607517195,0.11547819846894582,0.10746078283213174,0.10000000000000001,0.0930572040929699,0.086596432336006529,0.080584218776148187,0.074989420933245579,0.069783058485986635,0.064938163157621132,0.060429639023813285,0.056234132519034911,0.05232991146814947,0.048696752516586311,0.045315836376008181,0.042169650342858224,0.039241897584845357,0.036517412725483769,0.033982083289425591,0.031622776601683791,0.029427271762092817,0.027384196342643614,0.025482967479793464,0.023713737056616554,0.022067340690845899,0.02053525026457146,0.019109529749704406,0.017782794100389229,0.016548170999431813,0.015399265260594919,0.014330125702369627,0.013335214321633241,0.012409377607517195,0.011547819846894581,0.010746078283213174,0.01,0.0093057204092969904,0.0086596432336006543,0.008058421877614819,0.0074989420933245579,0.0069783058485986633,0.006493816315762113,0.0060429639023813278,0.005623413251903491,0.0052329911468149467,0.004869675251658631,0.0045315836376008181,0.0042169650342858229,0.0039241897584845363,0.0036517412725483771,0.0033982083289425592,0.0031622776601683794,0.002942727176209282,0.0027384196342643613,0.0025482967479793467,0.0023713737056616554,0.0022067340690845897,0.002053525026457146,0.0019109529749704406,0.0017782794100389228,0.0016548170999431814,0.001539926526059492,0.0014330125702369627,0.0013335214321633241,0.0012409377607517195,0.0011547819846894581,0.0010746078283213176,0.001,0.00093057204092969893,0.00086596432336006539,0.00080584218776148179,0.00074989420933245586,0.00069783058485986635,0.00064938163157621134,0.00060429639023813287,0.0005623413251903491,0.00052329911468149473,0.0004869675251658631,0.00045315836376008179,0.00042169650342858224,0.00039241897584845359,0.0003651741272548377,0.00033982083289425596,0.00031622776601683794,0.00029427271762092817,0.00027384196342643611,0.00025482967479793463,0.00023713737056616554,0.00022067340690845897,0.00020535250264571461,0.00019109529749704405,0.00017782794100389227,0.00016548170999431815,0.00015399265260594919,0.00014330125702369627,0.0001333521432163324,0.00012409377607517196,0.00011547819846894582,0.00010746078283213175};
__constant__ float LG2_GAMMA[4] = {-0.045803689613124789f, -0.022720076500083529f, -0.011315313227834146f, -0.0056465631411420627f};
__constant__ float GAMMA_CHUNK[4] = {0.017183023570817902f, 0.13321516287964841f, 0.36643771592203728f, 0.60593708822908032f};

namespace pg8 {
constexpr int BM = 256, BK = 64, HALF = 128, HTB = HALF * BK * 2, STAGE_BYTES = 8 * HTB, NXCD = 8, WGM = 8;
__host__ __device__ __forceinline__ int lds_byte(int r, int c) { const int st = (r >> 4) * 2 + (c >> 5), rr = r & 15, cc = c & 31, ob = rr * 64 + cc * 2; return st * 1024 + (ob ^ (((ob >> 9) & 1) << 5)); }
__host__ __device__ __forceinline__ void stage_rc(int b, int& R, int& C) { const int st = b / 1024, sb = b % 1024, swz = sb ^ (((sb >> 9) & 1) << 5); R = (st >> 1) * 16 + swz / 64; C = (st & 1) * 32 + (swz % 64) / 2; }
__host__ __device__ __forceinline__ int perm32(int rho) { const int n = rho >> 4, i = rho & 15; return 8 * (i >> 2) + 4 * n + (i & 3); }

struct Unit { const char* pa; const char* pb; int row0, col0, aux, blk; };

template <class Epi, class Sched, bool GATHER, bool FP8>
__device__ __forceinline__ void gemm_phase(LAS uchar* lds, const int K, const Sched& S, const Epi& E) {
    const int tid = threadIdx.x, wid = __builtin_amdgcn_readfirstlane(tid >> 6), lane = tid & 63, wr = wid >> 2, wc = wid & 3, fr = lane & 15, fq = lane >> 4;
    const int nt = K / BK;
    unsigned voA[2][2], voffB[2];
#pragma unroll
    for (int i = 0; i < 2; ++i) { int R, C; stage_rc(tid * 16 + i * 8192, R, C); const int Rb = Epi::PERM == 16 ? 64 * (R >> 5) + 16 * ((R >> 2) & 3) + 4 * ((R >> 4) & 1) + (R & 3) : (Epi::PERM == 8 ? ((R & ~31) + perm32(R & 31)) : R);
        voA[0][i] = (unsigned)(R * K + C) * 2u; voA[1][i] = voA[0][i] + (unsigned)(HALF * K * 2); voffB[i] = (unsigned)(Rb * K + C) * 2u; }
    const size_t kstep = (size_t)(BK * 2);
    const size_t hstep = (size_t)(Epi::PERM == 16 ? 8 : HALF) * K * 2;
    const unsigned ldsw = (unsigned)wid * 1024u;
    const int aoff = lds_byte(wr * 64 + fr, fq * 8), boff = lds_byte(wc * 32 + fr, fq * 8);
#define PG8_SA(b, h) (((b) * 2 + (h)) * HTB)
#define PG8_SB(b, h) ((4 + (b) * 2 + (h)) * HTB)
#define PG8_STAGE(bufoff, gbase, voff) do { _Pragma("unroll") for (int _i = 0; _i < 2; ++_i) \
        __builtin_amdgcn_global_load_lds((const unsigned*)((const char*)(gbase) + (voff)[_i]), (LAS unsigned*)(lds + (bufoff) + ldsw + _i * 8192), 16, 0, 0); } while (0)
#define PG8_LDA(dst, b, h) do { _Pragma("unroll") for (int m = 0; m < 4; ++m) _Pragma("unroll") for (int k = 0; k < 2; ++k) dst[m][k] = *(const LAS bf16x8*)(lds + PG8_SA(b, h) + aoff + m * 2048 + k * 1024); } while (0)
#define PG8_LDB(dst, b, h) do { _Pragma("unroll") for (int n = 0; n < 2; ++n) _Pragma("unroll") for (int k = 0; k < 2; ++k) dst[n][k] = *(const LAS bf16x8*)(lds + PG8_SB(b, h) + boff + n * 2048 + k * 1024); } while (0)
#define PG8_CAT(x) __builtin_shufflevector(__builtin_bit_cast(i32x4, (x)[0]), __builtin_bit_cast(i32x4, (x)[1]), 0, 1, 2, 3, 4, 5, 6, 7)
#define PG8_MMA(ai, bj, At, Bt) do { __builtin_amdgcn_s_setprio(1); \
        if constexpr (FP8) { _Pragma("unroll") for (int m = 0; m < 4; ++m) _Pragma("unroll") for (int n = 0; n < 2; ++n) \
            acc[ai][bj][m][n] = __builtin_amdgcn_mfma_scale_f32_16x16x128_f8f6f4(PG8_CAT(Bt[n]), PG8_CAT(At[m]), acc[ai][bj][m][n], 0, 0, 0, 0x7f7f7f7f, 0, 0x7f7f7f7f); } \
        else { _Pragma("unroll") for (int m = 0; m < 4; ++m) _Pragma("unroll") for (int n = 0; n < 2; ++n) _Pragma("unroll") for (int k = 0; k < 2; ++k) \
            acc[ai][bj][m][n] = __builtin_amdgcn_mfma_f32_16x16x32_bf16(Bt[n][k], At[m][k], acc[ai][bj][m][n], 0, 0, 0); } \
        __builtin_amdgcn_s_setprio(0); } while (0)
#define PG8_WAIT_V(n) asm volatile("s_waitcnt vmcnt(" #n ")" ::: "memory")
#define PG8_WAIT_L(n) asm volatile("s_waitcnt lgkmcnt(" #n ")" ::: "memory")
#define PG8_BAR __builtin_amdgcn_s_barrier()
#define PG8_SCHED __builtin_amdgcn_sched_barrier(0)
    Unit cur, nxt; int ui = 0;
    if (!S.next(0, cur)) return;
    f32x4 acc[2][2][4][2];
#pragma unroll
    for (int a = 0; a < 2; ++a)
#pragma unroll
        for (int b = 0; b < 2; ++b)
#pragma unroll
            for (int m = 0; m < 4; ++m)
#pragma unroll
                for (int n = 0; n < 2; ++n) acc[a][b][m][n] = (f32x4){0.f, 0.f, 0.f, 0.f};
    bf16x8 At[4][2], B0[2][2], B1[2][2];
    const char* cA = cur.pa; const char* cB = cur.pb;
    if constexpr (GATHER) S.gather(cur, voA, (const LAS int*)nullptr);
    PG8_STAGE(PG8_SB(0, 0), cB, voffB); PG8_STAGE(PG8_SB(0, 1), cB + hstep, voffB); PG8_STAGE(PG8_SA(0, 0), cA, voA[0]); PG8_STAGE(PG8_SA(0, 1), cA, voA[1]);
    if (wr == 1) PG8_BAR;
    PG8_WAIT_V(2); PG8_BAR;
    PG8_STAGE(PG8_SB(1, 0), cB + kstep, voffB); PG8_STAGE(PG8_SA(1, 0), cA + kstep, voA[0]); PG8_STAGE(PG8_SB(1, 1), cB + hstep + kstep, voffB);
    PG8_WAIT_V(6); PG8_BAR;
    for (;;) {
        const bool has_next = S.next(ui + 1, nxt);
        if constexpr (GATHER) { if (has_next) S.prefetch(nxt, lds + LDS_IDX + ((ui + 1) & 1) * 1024, wid, lane); }
        E.prefetch(cur, lds + LDS_BIAS + (ui & 1) * 1024, wid, lane);
        const char* nA = has_next ? nxt.pa : cA; const char* nB = has_next ? nxt.pb : cB;
        for (int t = 0; t < nt; t += 2) {
            const bool last = (t == nt - 2);
            const char* a1 = cA + (size_t)(t + 1) * kstep;
            const char* a2 = last ? nA : cA + (size_t)(t + 2) * kstep; const char* b2 = last ? nB : cB + (size_t)(t + 2) * kstep;
            const char* a3 = a2 + kstep; const char* b3 = b2 + kstep;
            PG8_LDB(B0, 0, 0); PG8_LDB(B1, 0, 1); PG8_SCHED; PG8_LDA(At, 0, 0); PG8_STAGE(PG8_SA(1, 1), a1, voA[1]);
            if constexpr (GATHER) { if (last && has_next) S.gather(nxt, voA, (const LAS int*)(lds + LDS_IDX + ((ui + 1) & 1) * 1024)); }
            PG8_WAIT_V(8); PG8_WAIT_L(0); PG8_BAR; PG8_MMA(0, 0, At, B0); PG8_MMA(0, 1, At, B1); PG8_BAR; PG8_SCHED;
            PG8_LDA(At, 0, 1); PG8_STAGE(PG8_SB(0, 0), b2, voffB); PG8_STAGE(PG8_SB(0, 1), b2 + hstep, voffB); PG8_STAGE(PG8_SA(0, 0), a2, voA[0]);
            PG8_WAIT_V(8); PG8_WAIT_L(0); PG8_BAR; PG8_MMA(1, 0, At, B0); PG8_MMA(1, 1, At, B1); PG8_BAR; PG8_SCHED;
            PG8_LDB(B0, 1, 0); PG8_LDB(B1, 1, 1); PG8_SCHED; PG8_LDA(At, 1, 0); PG8_STAGE(PG8_SA(0, 1), a2, voA[1]);
            PG8_WAIT_V(8); PG8_WAIT_L(0); PG8_BAR; PG8_MMA(0, 0, At, B0); PG8_MMA(0, 1, At, B1); PG8_BAR; PG8_SCHED;
            PG8_LDA(At, 1, 1); PG8_STAGE(PG8_SB(1, 0), b3, voffB); PG8_STAGE(PG8_SB(1, 1), b3 + hstep, voffB); PG8_STAGE(PG8_SA(1, 0), a3, voA[0]);
            PG8_WAIT_V(8); PG8_WAIT_L(0); PG8_BAR; PG8_MMA(1, 0, At, B0); PG8_MMA(1, 1, At, B1); PG8_BAR; PG8_SCHED;
        }
        if (wr == 0) PG8_BAR;
        E(acc, cur, wr, wc, fr, fq, lds + LDS_BIAS + (ui & 1) * 1024);
        if (!has_next) break;
#pragma unroll
        for (int a = 0; a < 2; ++a)
#pragma unroll
            for (int b = 0; b < 2; ++b)
#pragma unroll
                for (int m = 0; m < 4; ++m)
#pragma unroll
                    for (int n = 0; n < 2; ++n) acc[a][b][m][n] = (f32x4){0.f, 0.f, 0.f, 0.f};
        cur = nxt; cA = nA; cB = nB; ++ui;
        if (wr == 1) PG8_BAR;
    }
    PG8_WAIT_V(0);
    PG8_BAR;
#undef PG8_SA
#undef PG8_SB
#undef PG8_STAGE
#undef PG8_LDA
#undef PG8_LDB
#undef PG8_MMA
#undef PG8_CAT
#undef PG8_WAIT_V
#undef PG8_WAIT_L
#undef PG8_BAR
#undef PG8_SCHED
}
}

struct DenseSched {
    const char* A; const char* B; int K, nM, nN, nwg, G, c;
    __device__ __forceinline__ bool next(int i, pg8::Unit& u) const {
        const long L = (long)i * G + c; if (L >= nwg) return false;
        int wgid = (int)L; { const int q = nwg / pg8::NXCD, r = nwg % pg8::NXCD, xcd = wgid % pg8::NXCD, off = wgid / pg8::NXCD; wgid = (xcd < r ? xcd * (q + 1) : r * (q + 1) + (xcd - r) * q) + off; }
        const int nig = pg8::WGM * nN, gid = wgid / nig, fm = gid * pg8::WGM, gsz = (nM - fm) < pg8::WGM ? (nM - fm) : pg8::WGM;
        const int pm = fm + ((wgid % nig) % gsz), pn = (wgid % nig) / gsz;
        u.pa = A + (size_t)pm * 256 * K * 2; u.pb = B + (size_t)pn * 256 * K * 2; u.row0 = pm * 256; u.col0 = pn * 256; u.aux = 0; u.blk = 0; return true;
    }
    __device__ __forceinline__ void gather(const pg8::Unit&, unsigned (&)[2][2], const LAS int*) const {}
    __device__ __forceinline__ void prefetch(const pg8::Unit&, LAS uchar*, int, int) const {}
};
struct MoeSched {
    const LAS int* tab; const char* A; const char* B; size_t bexp; const int* list; int K, nN, G, c;
    __device__ __forceinline__ bool next(int i, pg8::Unit& u) const {
        const int NB = __builtin_amdgcn_readfirstlane(tab[0]); const int L = i * G + c; if (L >= NB * nN) return false;
        const int b = L / nN, pn = L - b * nN, e = __builtin_amdgcn_readfirstlane(tab[64 + b]);
        u.pa = A; u.pb = B + (size_t)e * bexp + (size_t)pn * 256 * K * 2; u.row0 = b * 256; u.col0 = pn * 256; u.aux = e; u.blk = b; return true;
    }
    __device__ __forceinline__ void prefetch(const pg8::Unit& u, LAS uchar* buf, int wid, int lane) const {
        if (wid < 4) { const int e = u.aux, lb = (u.blk - __builtin_amdgcn_readfirstlane(tab[8 + e])) * 256;
            __builtin_amdgcn_global_load_lds((const unsigned*)(list + e * T + lb + 64 * wid + lane), (LAS unsigned*)(buf + wid * 256), 4, 0, 0); }
    }
    __device__ __forceinline__ void gather(const pg8::Unit& u, unsigned (&vo)[2][2], const LAS int* idx) const {
        const int e = u.aux, lb = (u.blk - __builtin_amdgcn_readfirstlane(tab[8 + e])) * 256, cnt = __builtin_amdgcn_readfirstlane(tab[256 + u.blk]);
#pragma unroll
        for (int i = 0; i < 2; ++i) { int R, C; pg8::stage_rc((int)threadIdx.x * 16 + i * 8192, R, C);
#pragma unroll
            for (int h = 0; h < 2; ++h) { const int r = h * 128 + R; const int raw = idx ? idx[r] : list[e * T + lb + r]; const int tok = (r < cnt) ? raw : 0; vo[h][i] = ((unsigned)tok * (unsigned)K + (unsigned)C) * 2u; } }
    }
};
struct MoeSchedDirect {
    const LAS int* tab; const char* A; const char* B; size_t bexp; int K, nN, G, c;
    __device__ __forceinline__ bool next(int i, pg8::Unit& u) const {
        const int NB = __builtin_amdgcn_readfirstlane(tab[0]); const int L = i * G + c; if (L >= NB * nN) return false;
        const int b = L / nN, pn = L - b * nN, e = __builtin_amdgcn_readfirstlane(tab[64 + b]);
        u.pa = A; u.pb = B + (size_t)e * bexp + (size_t)pn * 256 * K * 2; u.row0 = b * 256; u.col0 = pn * 256; u.aux = e; u.blk = b; return true;
    }
    __device__ __forceinline__ void prefetch(const pg8::Unit&, LAS uchar*, int, int) const {}
    __device__ __forceinline__ void gather(const pg8::Unit& u, unsigned (&vo)[2][2], const LAS int*) const {
#pragma unroll
        for (int i = 0; i < 2; ++i) { int R, C; pg8::stage_rc((int)threadIdx.x * 16 + i * 8192, R, C);
#pragma unroll
            for (int h = 0; h < 2; ++h) vo[h][i] = ((unsigned)(u.row0 + h * 128 + R) * (unsigned)K + (unsigned)C) * 2u; }
    }
};

#define EPI_LANE() int tz = threadIdx.x; asm volatile("" : "+v"(tz)); const int fr = tz & 15, fq = (tz >> 4) & 3; (void)fr_; (void)fq_
struct EpiProj {
    static constexpr int PERM = 8;
    bf16* O; int ldc; const float* COS; const float* SIN;
    __device__ __forceinline__ void prefetch(const pg8::Unit&, LAS uchar*, int, int) const {}
    __device__ __forceinline__ void operator()(const f32x4 (&acc)[2][2][4][2], const pg8::Unit& u, int wr, int wc, int fr_, int fq_, const LAS uchar* bl) const {
        EPI_LANE();
        const int row0 = u.row0 + wr * 64 + fr, col0 = u.col0 + wc * 32 + 8 * fq;
        if (u.col0 < 2048) {
            const float sc = (u.col0 >= 1024) ? 0.0625f : 1.0f; const int i0 = wc * 32 + 8 * fq;
#pragma unroll
            for (int ai = 0; ai < 2; ++ai)
#pragma unroll
                for (int m = 0; m < 4; ++m) { const int t = row0 + ai * 128 + m * 16; bf16* rowp = O + (size_t)t * ldc + col0;
                    const f32x4 c0 = *(const f32x4*)(COS + (size_t)t * 128 + i0), c1 = *(const f32x4*)(COS + (size_t)t * 128 + i0 + 4), s0 = *(const f32x4*)(SIN + (size_t)t * 128 + i0), s1 = *(const f32x4*)(SIN + (size_t)t * 128 + i0 + 4);
                    const f32x4 a0 = acc[ai][0][m][0], a1 = acc[ai][0][m][1], b0 = acc[ai][1][m][0], b1 = acc[ai][1][m][1];
                    const f32x4 p0 = (a0 * c0 - b0 * s0) * sc, p1 = (a1 * c1 - b1 * s1) * sc, q0 = (b0 * c0 + a0 * s0) * sc, q1 = (b1 * c1 + a1 * s1) * sc;
                    u32x4 w; w.x = pk_bf16(p0[0], p0[1]); w.y = pk_bf16(p0[2], p0[3]); w.z = pk_bf16(p1[0], p1[1]); w.w = pk_bf16(p1[2], p1[3]); *(u32x4*)rowp = w;
                    w.x = pk_bf16(q0[0], q0[1]); w.y = pk_bf16(q0[2], q0[3]); w.z = pk_bf16(q1[0], q1[1]); w.w = pk_bf16(q1[2], q1[3]); *(u32x4*)(rowp + 128) = w; }
        } else {
#pragma unroll
            for (int ai = 0; ai < 2; ++ai)
#pragma unroll
                for (int m = 0; m < 4; ++m) { bf16* rowp = O + (size_t)(row0 + ai * 128 + m * 16) * ldc + col0;
#pragma unroll
                    for (int bj = 0; bj < 2; ++bj) { const f32x4 v0 = acc[ai][bj][m][0], v1 = acc[ai][bj][m][1];
                        u32x4 w; w.x = pk_bf16(v0[0], v0[1]); w.y = pk_bf16(v0[2], v0[3]); w.z = pk_bf16(v1[0], v1[1]); w.w = pk_bf16(v1[2], v1[3]);
                        *(u32x4*)(rowp + bj * 128) = w; } }
        }
    }
};
struct EpiOut {
    static constexpr int PERM = 4;
    const float* X; float* Hh;
    __device__ __forceinline__ void prefetch(const pg8::Unit&, LAS uchar*, int, int) const {}
    __device__ __forceinline__ void operator()(const f32x4 (&acc)[2][2][4][2], const pg8::Unit& u, int wr, int wc, int fr_, int fq_, const LAS uchar* bl) const {
        EPI_LANE();
        const int row0 = u.row0 + wr * 64 + fr, col0 = u.col0 + wc * 32 + 4 * fq;
#pragma unroll
        for (int ai = 0; ai < 2; ++ai)
#pragma unroll
            for (int m = 0; m < 4; ++m) { const size_t off = (size_t)(row0 + ai * 128 + m * 16) * D + col0;
#pragma unroll
                for (int bj = 0; bj < 2; ++bj)
#pragma unroll
                    for (int n = 0; n < 2; ++n) { const f32x4 xv = *(const f32x4*)(X + off + bj * 128 + n * 16); *(f32x4*)(Hh + off + bj * 128 + n * 16) = xv + acc[ai][bj][m][n]; } }
    }
};
__device__ __forceinline__ float swiglu_f(float gate, float up) { const float g = fminf(gate, 7.f), u = fminf(fmaxf(up, -7.f), 7.f); return (u + 1.f) * g * __builtin_amdgcn_rcpf(1.f + __expf(-1.702f * g)); }
struct EpiGateUp {
    static constexpr int PERM = 16;
    uchar* ACT; const float* bias;
    __device__ __forceinline__ void prefetch(const pg8::Unit& u, LAS uchar* buf, int wid, int lane) const {
        if (wid < 4) __builtin_amdgcn_global_load_lds((const unsigned*)(bias + (size_t)u.aux * (2 * DFF) + u.col0 + 64 * wid + lane), (LAS unsigned*)(buf + wid * 256), 4, 0, 0); }
    __device__ __forceinline__ void operator()(const f32x4 (&acc)[2][2][4][2], const pg8::Unit& u, int wr, int wc, int fr_, int fq_, const LAS uchar* bl) const {
        EPI_LANE();
        const int row0 = u.row0 + wr * 64 + fr, col0 = u.col0 + wc * 64 + 16 * fq;
        const LAS float* bp = (const LAS float*)bl + wc * 64 + 16 * fq;
        f32x4 bv[2][2];
#pragma unroll
        for (int bj = 0; bj < 2; ++bj)
#pragma unroll
            for (int n = 0; n < 2; ++n) bv[bj][n] = *(const LAS f32x4*)(bp + bj * 8 + 4 * n);
#pragma unroll
        for (int ai = 0; ai < 2; ++ai)
#pragma unroll
            for (int m = 0; m < 4; ++m) { uchar* rowp = ACT + (size_t)(row0 + ai * 128 + m * 16) * DFF + (col0 >> 1);
                u32x2 w;
#pragma unroll
                for (int bj = 0; bj < 2; ++bj) { const f32x4 v0 = acc[ai][bj][m][0] * W8_INV + bv[bj][0], v1 = acc[ai][bj][m][1] * W8_INV + bv[bj][1];
                    const unsigned p = pk_fp8x4(swiglu_f(v0[0], v0[1]), swiglu_f(v0[2], v0[3]), swiglu_f(v1[0], v1[1]), swiglu_f(v1[2], v1[3]));
                    if (bj == 0) w.x = p; else w.y = p; }
                *(u32x2*)rowp = w; }
    }
};
struct EpiDown {
    static constexpr int PERM = 8;
    uchar* YR; const float* bias;
    __device__ __forceinline__ void prefetch(const pg8::Unit& u, LAS uchar* buf, int wid, int lane) const {
        if (wid < 4) __builtin_amdgcn_global_load_lds((const unsigned*)(bias + (size_t)u.aux * D + u.col0 + 64 * wid + lane), (LAS unsigned*)(buf + wid * 256), 4, 0, 0); }
    __device__ __forceinline__ void operator()(const f32x4 (&acc)[2][2][4][2], const pg8::Unit& u, int wr, int wc, int fr_, int fq_, const LAS uchar* bl) const {
        EPI_LANE();
        const int row0 = u.row0 + wr * 64 + fr, col0 = u.col0 + wc * 32 + 8 * fq;
        const LAS float* bp = (const LAS float*)bl + wc * 32 + 8 * fq;
        f32x4 bv[2][2];
#pragma unroll
        for (int bj = 0; bj < 2; ++bj)
#pragma unroll
            for (int n = 0; n < 2; ++n) bv[bj][n] = *(const LAS f32x4*)(bp + bj * 128 + 4 * n);
#pragma unroll
        for (int ai = 0; ai < 2; ++ai)
#pragma unroll
            for (int m = 0; m < 4; ++m) { uchar* rowp = YR + (size_t)(row0 + ai * 128 + m * 16) * D + col0;
#pragma unroll
                for (int bj = 0; bj < 2; ++bj) { const f32x4 v0 = acc[ai][bj][m][0] * W8_INV + bv[bj][0], v1 = acc[ai][bj][m][1] * W8_INV + bv[bj][1];
                    u32x2 w; w.x = pk_fp8x4(v0[0], v0[1], v0[2], v0[3]); w.y = pk_fp8x4(v1[0], v1[1], v1[2], v1[3]);
                    *(u32x2*)(rowp + bj * 128) = w; } }
    }
};

#define XB_TMO      128
#define XB_XCNT(j)  (256  + 64 * (j))
#define XB_XSUB(j)  (1280 + 64 * (j))
#define XB_XGEN(j)  (2304 + 64 * (j))
#define XB_TOP      3328
#define XB_TOPGEN   3392
#define XCD_BAR_WORDS 3456
#define XB_SPIN_CAP (1u << 18)
__device__ __forceinline__ unsigned xb_ld(unsigned* p)              { return __hip_atomic_load(p, __ATOMIC_RELAXED, __HIP_MEMORY_SCOPE_AGENT); }
__device__ __forceinline__ unsigned xb_add(unsigned* p, unsigned v) { return __hip_atomic_fetch_add(p, v, __ATOMIC_RELAXED, __HIP_MEMORY_SCOPE_AGENT); }
__device__ __forceinline__ unsigned xb_xcc_id() { return (unsigned)__builtin_amdgcn_s_getreg((3 << 11) | 20) & 0xFu; }
#define XB_SPIN(cond, bar) do { unsigned _sp = 0; while (cond) { __builtin_amdgcn_s_sleep(1); \
    if ((++_sp & 255u) == 0u) { if (xb_ld(&(bar)[XB_TMO])) break; if (_sp > XB_SPIN_CAP) { atomicAdd(&(bar)[XB_TMO], 1u); break; } } } } while (0)
struct XcdBarrier { unsigned* bar; unsigned x; volatile LAS unsigned* st; };
__device__ __forceinline__ XcdBarrier xcd_barrier_post(unsigned* bar, volatile LAS unsigned* st) {
    XcdBarrier b; b.bar = bar; b.x = xb_xcc_id(); b.st = st;
    if (threadIdx.x == 0) (void)xb_add(&bar[XB_XCNT(b.x)], 1u);
    return b;
}
__device__ __forceinline__ void xcd_barrier_complete(unsigned* bar, unsigned x, unsigned& nloc, unsigned& nx) {
    const unsigned G = gridDim.x * gridDim.y * gridDim.z;
    unsigned sum, cnt, mine, sp = 0u;
    for (;;) {
        sum = 0u; cnt = 0u; mine = 0u;
#pragma unroll
        for (unsigned j = 0; j < 16; ++j) { const unsigned c = xb_ld(&bar[XB_XCNT(j)]); sum += c; cnt += (c > 0u) ? 1u : 0u; mine = (j == x) ? c : mine; }
        if (sum == G) break;
        __builtin_amdgcn_s_sleep(1);
        if ((++sp & 255u) == 0u) { if (xb_ld(&bar[XB_TMO])) break; if (sp > XB_SPIN_CAP) { atomicAdd(&bar[XB_TMO], 1u); break; } }
    }
    nloc = mine > 0u ? mine : 1u; nx = cnt > 0u ? cnt : 1u;
}
__device__ __forceinline__ void xcd_barrier(const XcdBarrier& b) {
    asm volatile("s_waitcnt vmcnt(0)" ::: "memory");
    __syncthreads();
    if (threadIdx.x == 0) {
        unsigned* bar = b.bar;
        __builtin_amdgcn_s_waitcnt(0);
        unsigned nloc = b.st[0], nx = b.st[1];
        if (nloc == 0u) { xcd_barrier_complete(bar, b.x, nloc, nx); b.st[0] = nloc; b.st[1] = nx; }
        const unsigned old = xb_add(&bar[XB_XSUB(b.x)], 1u);
        const unsigned gen = old / nloc;
        if (old + 1u == (gen + 1u) * nloc) {
            __builtin_amdgcn_fence(__ATOMIC_RELEASE, "agent");
            asm volatile("s_waitcnt vmcnt(0)" ::: "memory");
            const unsigned og = xb_add(&bar[XB_TOP], 1u);
            const unsigned tg = og / nx;
            if (og + 1u == (tg + 1u) * nx) xb_add(&bar[XB_TOPGEN], 1u);
            else XB_SPIN(xb_ld(&bar[XB_TOPGEN]) == tg, bar);
            __builtin_amdgcn_fence(__ATOMIC_ACQUIRE, "agent");
            xb_add(&bar[XB_XGEN(b.x)], 1u);
            asm volatile("s_waitcnt vmcnt(0)" ::: "memory");
        } else {
            XB_SPIN(xb_ld(&bar[XB_XGEN(b.x)]) == gen, bar);
            __builtin_amdgcn_fence(__ATOMIC_ACQUIRE, "agent");
            asm volatile("s_waitcnt vmcnt(0)" ::: "memory");
        }
    }
    __syncthreads();
}

struct Ctx { LAS uchar* lds; int tid, lane, wave, G, bid; uchar* ws; const void* const* in; float* out; };
#define XP_x(X) ((const float*)(X).in[0])
#define XP_pos(X) ((const int*)(X).in[1])
#define XP_ln_mix_w(X) ((const float*)(X).in[2])
#define XP_w_in(X) ((const float*)(X).in[3])
#define XP_conv_w(X) ((const float*)(X).in[4])
#define XP_conv_b(X) ((const float*)(X).in[5])
#define XP_dt_bias(X) ((const float*)(X).in[6])
#define XP_a_log(X) ((const float*)(X).in[7])
#define XP_d_skip(X) ((const float*)(X).in[8])
#define XP_ssm_norm_w(X) ((const float*)(X).in[9])
#define XP_w_out(X) ((const float*)(X).in[10])
#define XP_ln_ffn_w(X) ((const float*)(X).in[11])
#define XP_w_router(X) ((const float*)(X).in[12])
#define XP_b_router(X) ((const float*)(X).in[13])
#define XP_w_gu(X) ((const float*)(X).in[14])
#define XP_b_gu(X) ((const float*)(X).in[15])
#define XP_w_d(X) ((const float*)(X).in[16])
#define XP_b_d(X) ((const float*)(X).in[17])
#define XP_ln_final_w(X) ((const float*)(X).in[18])
#define XP_WinT(X) ((bf16*)((X).ws + WS_WINT))
#define XP_WoutT(X) ((bf16*)((X).ws + WS_WOUTT))
#define XP_WguT(X) ((uchar*)((X).ws + WS_WGUT))
#define XP_WdT(X) ((uchar*)((X).ws + WS_WDT))
#define XP_U(X) ((bf16*)((X).ws + WS_U))
#define XP_U2(X) ((uchar*)((X).ws + WS_U2))
#define XP_MIX(X) ((bf16*)((X).ws + WS_MIX))
#define XP_XBC(X) ((bf16*)((X).ws + WS_XBC))
#define XP_KV(X) ((bf16*)((X).ws + WS_KV))
#define XP_SST(X) ((bf16*)((X).ws + WS_SST))
#define XP_PROJ(X) ((bf16*)((X).ws + WS_PROJ))
#define XP_ACT(X) ((uchar*)((X).ws + WS_ACT))
#define XP_YR(X) ((uchar*)((X).ws + WS_YR))
#define XP_COS(X) ((float*)((X).ws + WS_COS))
#define XP_SIN(X) ((float*)((X).ws + WS_SIN))
#define XP_Hh(X) ((float*)((X).ws + WS_H))
#define XP_ADEC(X) ((float*)((X).ws + WS_ADEC))
#define XP_TOPW(X) ((float*)((X).ws + WS_TOPW))
#define XP_TOPI(X) ((int*)((X).ws + WS_TOPI))
#define XP_TOPR(X) ((int*)((X).ws + WS_TOPR))
#define XP_LIST(X) ((int*)((X).ws + WS_LIST))
#define XP_ctl(X) ((unsigned*)((X).ws + WS_CTL))
#define XP_WRH(X) ((bf16*)((X).ws + WS_WRH))
#define XP_WRL(X) ((bf16*)((X).ws + WS_WRL))


__device__ __forceinline__ bf16x8 tr_frag(LAS uchar* p, int rstep) {
    const s16x4 a = __builtin_amdgcn_ds_read_tr16_b64_v4i16((LAS s16x4*)p);
    const s16x4 b = __builtin_amdgcn_ds_read_tr16_b64_v4i16((LAS s16x4*)(p + rstep));
    return (bf16x8){a[0], a[1], a[2], a[3], b[0], b[1], b[2], b[3]};
}
__device__ __forceinline__ f32x4 mma16(bf16x8 xrow, bf16x8 ycol, f32x4 c) { return __builtin_amdgcn_mfma_f32_16x16x32_bf16(xrow, ycol, c, 0, 0, 0); }
__device__ __forceinline__ float wave_incl_scan(float v, int lane) {
#pragma unroll
    for (int o = 1; o < 64; o <<= 1) { const float t = __shfl_up(v, o); if (lane >= o) v += t; }
    return v;
}
__device__ __forceinline__ void rope8(const u32x4 k1, const u32x4 k2, const f32x4 c0, const f32x4 c1, const f32x4 s0, const f32x4 s1, const float sc, u32x4& o1, u32x4& o2) {
    float r1[8], r2[8];
#pragma unroll
    for (int m = 0; m < 4; ++m) {
        const float a0 = bf_lo(k1[m]), a1 = bf_hi(k1[m]), b0 = bf_lo(k2[m]), b1 = bf_hi(k2[m]);
        const float cs0 = (m < 2) ? c0[2 * m] : c1[2 * m - 4], cs1 = (m < 2) ? c0[2 * m + 1] : c1[2 * m - 3];
        const float sn0 = (m < 2) ? s0[2 * m] : s1[2 * m - 4], sn1 = (m < 2) ? s0[2 * m + 1] : s1[2 * m - 3];
        r1[2 * m] = (a0 * cs0 - b0 * sn0) * sc; r1[2 * m + 1] = (a1 * cs1 - b1 * sn1) * sc;
        r2[2 * m] = (b0 * cs0 + a0 * sn0) * sc; r2[2 * m + 1] = (b1 * cs1 + a1 * sn1) * sc;
    }
    o1.x = pk_bf16(r1[0], r1[1]); o1.y = pk_bf16(r1[2], r1[3]); o1.z = pk_bf16(r1[4], r1[5]); o1.w = pk_bf16(r1[6], r1[7]);
    o2.x = pk_bf16(r2[0], r2[1]); o2.y = pk_bf16(r2[2], r2[3]); o2.z = pk_bf16(r2[4], r2[5]); o2.w = pk_bf16(r2[6], r2[7]);
}

__device__ __forceinline__ void tr_decode(const Ctx& X, int r, const float*& W, bf16*& WT, int& N, int& kb, int& nb) {
    constexpr int I_IN = 32 * 209;
    if (r < I_IN) { W = XP_w_in(X); WT = XP_WinT(X); N = NPROJ; }
    else { r -= I_IN; W = XP_w_out(X); WT = XP_WoutT(X); N = D; }
    const int nbn = (N + 31) >> 5; kb = r / nbn; nb = r - kb * nbn;
}
__device__ __forceinline__ void tr8_item(const float* W, int N, uchar* WT, int kb, int nb, int lane) {
    const int k0 = kb * 128 + 16 * (lane & 7), n0 = nb * 32 + 4 * (lane >> 3);
    f32x4 v[16];
#pragma unroll
    for (int i = 0; i < 16; ++i) v[i] = __builtin_nontemporal_load((const f32x4*)(W + (size_t)(k0 + i) * N + n0));
#pragma unroll
    for (int j = 0; j < 4; ++j) { u32x4 o;
        o.x = pk_fp8x4(v[0][j] * W8_SCALE, v[1][j] * W8_SCALE, v[2][j] * W8_SCALE, v[3][j] * W8_SCALE); o.y = pk_fp8x4(v[4][j] * W8_SCALE, v[5][j] * W8_SCALE, v[6][j] * W8_SCALE, v[7][j] * W8_SCALE);
        o.z = pk_fp8x4(v[8][j] * W8_SCALE, v[9][j] * W8_SCALE, v[10][j] * W8_SCALE, v[11][j] * W8_SCALE); o.w = pk_fp8x4(v[12][j] * W8_SCALE, v[13][j] * W8_SCALE, v[14][j] * W8_SCALE, v[15][j] * W8_SCALE);
        __builtin_nontemporal_store(o, (u32x4*)(WT + (size_t)(n0 + j) * 2048 + k0)); }
}
__device__ __forceinline__ void tr_load(const float* W, int N, int kb, int nb, int lane, f32x4 (&v)[8]) {
    const int k0 = kb * 64 + 8 * (lane & 7), n0 = nb * 32 + 4 * (lane >> 3);
    if (n0 < N) {
#pragma unroll
        for (int i = 0; i < 8; ++i) v[i] = *(const f32x4*)(W + (size_t)(k0 + i) * N + n0);
    }
}
__device__ __forceinline__ void tr_store(bf16* WT, int N, int kb, int nb, int lane, const f32x4 (&v)[8]) {
    const int k0 = kb * 64 + 8 * (lane & 7), n0 = nb * 32 + 4 * (lane >> 3);
    if (n0 < N) {
#pragma unroll
        for (int j = 0; j < 4; ++j) { u32x4 o; o.x = pk_bf16(v[0][j], v[1][j]); o.y = pk_bf16(v[2][j], v[3][j]); o.z = pk_bf16(v[4][j], v[5][j]); o.w = pk_bf16(v[6][j], v[7][j]);
            *(u32x4*)(WT + (size_t)(n0 + j) * 2048 + k0) = o; }
    }
}
constexpr int I_GU8 = 32 * 16 * 128, I_D8 = 32 * 16 * 64, I_ALL8 = I_GU8 + I_D8;
__device__ __forceinline__ void conv8_id(const Ctx& X, int it, int lane) {
    if (it < I_GU8) { const int e = it >> 11, r = it & 2047; tr8_item(XP_w_gu(X) + (size_t)e * D * (2 * DFF), 2 * DFF, XP_WguT(X) + (size_t)e * (2 * DFF) * D, r >> 7, r & 127, lane); }
    else { const int i2 = it - I_GU8, e = i2 >> 10, r = i2 & 1023; tr8_item(XP_w_d(X) + (size_t)e * DFF * D, D, XP_WdT(X) + (size_t)e * D * DFF, r >> 6, r & 63, lane); }
}
constexpr int FILL_N1 = 6, FILL_W1 = 160 * 8, FILL_N3 = 3, FILL_W3 = 64 * 8, FILL_N4 = 6, FILL_W4 = 128 * 8;
constexpr int FILL_B1 = I_ALL8 - FILL_N1 * FILL_W1 - FILL_N3 * FILL_W3 - FILL_N4 * FILL_W4, FILL_B3 = FILL_B1 + FILL_N1 * FILL_W1, FILL_B4 = FILL_B3 + FILL_N3 * FILL_W3;
__device__ __forceinline__ void conv8_fill(const Ctx& X, int base, int fw, int nw, int n) {
#pragma unroll 1
    for (int j = 0; j < n; ++j) conv8_id(X, base + j * nw + fw, X.lane);
}
__device__ __forceinline__ void p0_prologue(Ctx& X) {
    const int gw = X.bid * NWAVES + X.wave, NGW = X.G * NWAVES, lane = X.lane;
    const int gt = X.bid * NTHR + X.tid, NGT = X.G * NTHR;
    for (int m = gw; m < T; m += NGW) {
        const f32x4* xr = (const f32x4*)(XP_x(X) + (size_t)m * D) + lane; const f32x4* wr_ = (const f32x4*)XP_ln_mix_w(X) + lane;
        f32x4 v[8]; float s = 0.f;
#pragma unroll
        for (int j = 0; j < 8; ++j) { v[j] = xr[64 * j]; s += (v[j].x * v[j].x + v[j].y * v[j].y) + (v[j].z * v[j].z + v[j].w * v[j].w); }
        const float rstd = rsqrtf(wave_sum(s) * (1.f / D) + EPS);
        u32x2* o8 = (u32x2*)(XP_U(X) + (size_t)m * D) + lane;
#pragma unroll
        for (int j = 0; j < 8; ++j) { const f32x4 w = wr_[64 * j]; u32x2 o; o.x = pk_bf16(v[j].x * rstd * w.x, v[j].y * rstd * w.y); o.y = pk_bf16(v[j].z * rstd * w.z, v[j].w * rstd * w.w); o8[64 * j] = o; }
    }
    for (int idx = gt; idx < T * 128; idx += NGT) {
        const int t = idx >> 7, i = idx & 127;
        const double ang = (double)XP_pos(X)[t] * INV_FREQ[i];
        double rev = ang * 0.15915494309189533577; rev -= floor(rev);
        const float f = (float)rev;
        XP_COS(X)[idx] = __builtin_amdgcn_cosf(f); XP_SIN(X)[idx] = __builtin_amdgcn_sinf(f);
    }
    { u32x4* p = (u32x4*)(XP_WinT(X) + (size_t)NPROJ * D); const int n16 = (LDP - NPROJ) * D * 2 / 16; const u32x4 z = {0u, 0u, 0u, 0u};
      for (int i = gt; i < n16; i += NGT) p[i] = z; }
    for (int idx = gt; idx < NE * D; idx += NGT) { const int e = idx >> 11, d = idx & 2047;
        const float wv = XP_ln_ffn_w(X)[d] * XP_w_router(X)[d * NE + e]; const unsigned hb = pk_bf16(wv, 0.f) & 0xffffu; const float lo = wv - __uint_as_float(hb << 16);
        XP_WRH(X)[idx] = (bf16)hb; XP_WRL(X)[idx] = (bf16)(pk_bf16(lo, 0.f) & 0xffffu); }
    constexpr int NIT = 32 * 209 + 32 * 64;
    for (int it = gw; it < NIT; it += 2 * NGW) {
        const float *W0, *W1 = nullptr; bf16 *T0, *T1 = nullptr; int N0, N1 = 0, kb0, kb1 = 0, nb0, nb1 = 0;
        f32x4 v0[8], v1[8];
        tr_decode(X, it, W0, T0, N0, kb0, nb0);
        const bool two = (it + NGW) < NIT;
        if (two) tr_decode(X, it + NGW, W1, T1, N1, kb1, nb1);
        tr_load(W0, N0, kb0, nb0, lane, v0);
        if (two) tr_load(W1, N1, kb1, nb1, lane, v1);
        tr_store(T0, N0, kb0, nb0, lane, v0);
        if (two) tr_store(T1, N1, kb1, nb1, lane, v1);
    }
    const int n_p0 = (X.G == 256) ? FILL_B1 : I_ALL8;
#pragma unroll 1
    for (int it = gw; it < n_p0; it += NGW) conv8_id(X, it, lane);
}

__device__ __forceinline__ bf16x8 scale_frag(const bf16x8 f, const float base, const float (&rr)[8]) {
    u32x4 u = __builtin_bit_cast(u32x4, f);
    u.x = pk_bf16(bf_lo(u.x) * (base * rr[0]), bf_hi(u.x) * (base * rr[1])); u.y = pk_bf16(bf_lo(u.y) * (base * rr[2]), bf_hi(u.y) * (base * rr[3]));
    u.z = pk_bf16(bf_lo(u.z) * (base * rr[4]), bf_hi(u.z) * (base * rr[5])); u.w = pk_bf16(bf_lo(u.w) * (base * rr[6]), bf_hi(u.w) * (base * rr[7]));
    return __builtin_bit_cast(bf16x8, u);
}
__device__ __forceinline__ void p2_ret(Ctx& X, int unit) {
    const int c = unit >> 2, h = unit & 3, t0 = c * CH, tid = X.tid, lane = X.lane, w = X.wave;
    LAS uchar* Vt = X.lds; LAS uchar* Kt = X.lds + 69632;
    { u32x4 vv[8], kk[8];
#pragma unroll
      for (int i = 0; i < 8; ++i) { const int q = tid + 512 * i, l = q >> 5, vc = q & 31; const bf16* rp = XP_PROJ(X) + (size_t)(t0 + l) * LDP + h * 256 + vc * 8;
          vv[i] = *(const u32x4*)(rp + C_V); kk[i] = *(const u32x4*)(rp + C_K); }
#pragma unroll
      for (int i = 0; i < 8; ++i) { const int q = tid + 512 * i, l = q >> 5, vc = q & 31; *(LAS u32x4*)(Vt + l * 544 + vc * 16) = vv[i]; *(LAS u32x4*)(Kt + l * 544 + vc * 16) = kk[i]; } }
    __syncthreads();
    const float lg = LG2_GAMMA[h];
    float rr[8];
#pragma unroll
    for (int e = 0; e < 8; ++e) rr[e] = exp2f(-lg * (float)e);
    const int fr = lane & 15, fq = lane >> 4, trs = (8 * fq + ((lane & 15) >> 2)) * 544 + 8 * (lane & 3);
    f32x4 acc[2][16];
#pragma unroll
    for (int a = 0; a < 2; ++a)
#pragma unroll
        for (int n = 0; n < 16; ++n) acc[a][n] = (f32x4){0.f, 0.f, 0.f, 0.f};
#pragma unroll 1
    for (int ks = 0; ks < 4; ++ks) {
        const float base = exp2f(lg * (float)(127 - 32 * ks - 8 * fq));
        const bf16x8 af0 = scale_frag(tr_frag(Vt + (32 * ks) * 544 + (16 * w) * 2 + trs, 4 * 544), base, rr);
        const bf16x8 af1 = scale_frag(tr_frag(Vt + (32 * ks) * 544 + (128 + 16 * w) * 2 + trs, 4 * 544), base, rr);
#pragma unroll
        for (int n = 0; n < 16; ++n) { const bf16x8 bf = tr_frag(Kt + (32 * ks) * 544 + (16 * n) * 2 + trs, 4 * 544);
            acc[0][n] = mma16(bf, af0, acc[0][n]); acc[1][n] = mma16(bf, af1, acc[1][n]); }
    }
    bf16* outp = XP_KV(X) + (size_t)(c * 4 + h) * 65536;
#pragma unroll
    for (int a = 0; a < 2; ++a)
#pragma unroll
        for (int n = 0; n < 16; ++n) { u32x2 o; o.x = pk_bf16(acc[a][n][0], acc[a][n][1]); o.y = pk_bf16(acc[a][n][2], acc[a][n][3]);
            *(u32x2*)(outp + (size_t)(128 * a + 16 * w + fr) * 256 + 16 * n + 4 * fq) = o; }
    __syncthreads();
}
__device__ __forceinline__ void conv8(const Ctx& X, int t, int cx, float (&o)[8]) {
    const f32x4 b0 = *(const f32x4*)(XP_conv_b(X) + cx), b1 = *(const f32x4*)(XP_conv_b(X) + cx + 4);
    o[0] = b0.x; o[1] = b0.y; o[2] = b0.z; o[3] = b0.w; o[4] = b1.x; o[5] = b1.y; o[6] = b1.z; o[7] = b1.w;
#pragma unroll
    for (int j = 0; j < 4; ++j) { const int tt = t - 3 + j;
        if (tt >= 0) { const u32x4 v = *(const u32x4*)(XP_PROJ(X) + (size_t)tt * LDP + C_X + cx);
            const f32x4 w0 = *(const f32x4*)(XP_conv_w(X) + j * XBCW + cx), w1 = *(const f32x4*)(XP_conv_w(X) + j * XBCW + cx + 4);
            o[0] += w0.x * bf_lo(v.x); o[1] += w0.y * bf_hi(v.x); o[2] += w0.z * bf_lo(v.y); o[3] += w0.w * bf_hi(v.y);
            o[4] += w1.x * bf_lo(v.z); o[5] += w1.y * bf_hi(v.z); o[6] += w1.z * bf_lo(v.w); o[7] += w1.w * bf_hi(v.w); } }
#pragma unroll
    for (int i = 0; i < 8; ++i) o[i] = silu_f(o[i]);
}
__device__ __forceinline__ void p2_ssd(Ctx& X, int unit) {
    const int c = unit >> 2, g = (unit >> 1) & 1, hh = unit & 1, t0 = c * CH, tid = X.tid, lane = X.lane, w = X.wave;
    LAS uchar* Xd = X.lds; LAS uchar* Bc = X.lds + 69632;
    LAS float* dtS = (LAS float*)(X.lds + 106496); LAS float* acS = (LAS float*)(X.lds + 108544);
    if (w < 4) { const int h = 8 * g + 4 * hh + w, l0 = 2 * lane;
        const float dtb = XP_dt_bias(X)[h], A = -expf(XP_a_log(X)[h]);
        const float d0 = softplus_f(bf2f(XP_PROJ(X)[(size_t)(t0 + l0) * LDP + C_DT + h]) + dtb), d1 = softplus_f(bf2f(XP_PROJ(X)[(size_t)(t0 + l0 + 1) * LDP + C_DT + h]) + dtb);
        const float a0 = d0 * A, a1 = d1 * A, s = a0 + a1, incl = wave_incl_scan(s, lane);
        dtS[w * 128 + l0] = d0; dtS[w * 128 + l0 + 1] = d1; acS[w * 128 + l0] = incl - a1; acS[w * 128 + l0 + 1] = incl;
        if (lane == 63) XP_ADEC(X)[c * 16 + h] = expf(incl); }
    __syncthreads();
    if (tid < 504) { const int rg = tid / 56, j = tid - rg * 56, l0 = 15 * rg;
        int cx; if (j < 32) cx = 512 * g + 256 * hh + 8 * j; else if (j < 48) cx = 1024 + 128 * g + 8 * (j - 32); else cx = 1280 + 128 * g + 64 * hh + 8 * (j - 48);
        u32x4 rw[18];
#pragma unroll
        for (int r = 0; r < 18; ++r) { const int l = l0 - 3 + r, tt = t0 + l; rw[r] = (tt >= 0 && l < 128) ? *(const u32x4*)(XP_PROJ(X) + (size_t)tt * LDP + C_X + cx) : (u32x4){0u, 0u, 0u, 0u}; }
        f32x4 wa[4], wb[4];
#pragma unroll
        for (int k = 0; k < 4; ++k) { wa[k] = *(const f32x4*)(XP_conv_w(X) + k * XBCW + cx); wb[k] = *(const f32x4*)(XP_conv_w(X) + k * XBCW + cx + 4); }
        const f32x4 ba = *(const f32x4*)(XP_conv_b(X) + cx), bb = *(const f32x4*)(XP_conv_b(X) + cx + 4);
#pragma unroll
        for (int r = 0; r < 15; ++r) { const int l = l0 + r;
            if (l < 128) { float o[8] = {ba.x, ba.y, ba.z, ba.w, bb.x, bb.y, bb.z, bb.w};
#pragma unroll
                for (int k = 0; k < 4; ++k) { const u32x4 v = rw[r + k];
                    o[0] += wa[k].x * bf_lo(v.x); o[1] += wa[k].y * bf_hi(v.x); o[2] += wa[k].z * bf_lo(v.y); o[3] += wa[k].w * bf_hi(v.y);
                    o[4] += wb[k].x * bf_lo(v.z); o[5] += wb[k].y * bf_hi(v.z); o[6] += wb[k].z * bf_lo(v.w); o[7] += wb[k].w * bf_hi(v.w); }
#pragma unroll
                for (int i = 0; i < 8; ++i) o[i] = silu_f(o[i]);
                u32x4 ov; ov.x = pk_bf16(o[0], o[1]); ov.y = pk_bf16(o[2], o[3]); ov.z = pk_bf16(o[4], o[5]); ov.w = pk_bf16(o[6], o[7]);
                if (j < 32) { const int e = j >> 3; const float sc = dtS[e * 128 + l] * __expf(acS[e * 128 + 127] - acS[e * 128 + l]);
                    u32x4 os; os.x = pk_bf16(o[0] * sc, o[1] * sc); os.y = pk_bf16(o[2] * sc, o[3] * sc); os.z = pk_bf16(o[4] * sc, o[5] * sc); os.w = pk_bf16(o[6] * sc, o[7] * sc);
                    *(LAS u32x4*)(Xd + l * 544 + j * 16) = os; *(u32x4*)(XP_XBC(X) + (size_t)(t0 + l) * XBCW + cx) = ov; }
                else if (j < 48) { *(LAS u32x4*)(Bc + l * 288 + (j - 32) * 16) = ov; if (hh == 0) *(u32x4*)(XP_XBC(X) + (size_t)(t0 + l) * XBCW + cx) = ov; }
                else *(u32x4*)(XP_XBC(X) + (size_t)(t0 + l) * XBCW + cx) = ov; } } }
    __syncthreads();
    const int fr = lane & 15, fq = lane >> 4, q4 = (lane & 15) >> 2, p4 = lane & 3;
    const int trx = (8 * fq + q4) * 544 + 8 * p4, trb = (8 * fq + q4) * 288 + 8 * p4;
    f32x4 acc[2][8];
#pragma unroll
    for (int a = 0; a < 2; ++a)
#pragma unroll
        for (int n = 0; n < 8; ++n) acc[a][n] = (f32x4){0.f, 0.f, 0.f, 0.f};
#pragma unroll 1
    for (int ks = 0; ks < 4; ++ks) {
        const bf16x8 af0 = tr_frag(Xd + (32 * ks) * 544 + (16 * w) * 2 + trx, 4 * 544);
        const bf16x8 af1 = tr_frag(Xd + (32 * ks) * 544 + (128 + 16 * w) * 2 + trx, 4 * 544);
#pragma unroll
        for (int n = 0; n < 8; ++n) { const bf16x8 bf = tr_frag(Bc + (32 * ks) * 288 + (16 * n) * 2 + trb, 4 * 288);
            acc[0][n] = mma16(bf, af0, acc[0][n]); acc[1][n] = mma16(bf, af1, acc[1][n]); }
    }
#pragma unroll
    for (int a = 0; a < 2; ++a) { const int m = 128 * a + 16 * w + fr, h = 8 * g + 4 * hh + (m >> 6), p = m & 63;
        bf16* outp = XP_SST(X) + ((size_t)(c * 16 + h) * 64 + p) * 128;
#pragma unroll
        for (int n = 0; n < 8; ++n) { u32x2 o; o.x = pk_bf16(acc[a][n][0], acc[a][n][1]); o.y = pk_bf16(acc[a][n][2], acc[a][n][3]); *(u32x2*)(outp + 16 * n + 4 * fq) = o; } }
    __syncthreads();
}

__device__ __forceinline__ void p3_scan(Ctx& X) {
    const int gt = X.bid * NTHR + X.tid, NGT = X.G * NTHR;
    for (int item = gt; item < 65536 + 32768; item += NGT) {
        const bool ret = item < 65536; const int it2 = ret ? item : item - 65536;
        bf16* p = ret ? (XP_KV(X) + (size_t)it2 * 4) : (XP_SST(X) + (size_t)it2 * 4);
        const size_t stride = ret ? 262144 : 131072;
        const int head = ret ? (it2 >> 14) : (it2 >> 11);
        const float gdec = ret ? GAMMA_CHUNK[head & 3] : 0.f;
        float s0 = 0.f, s1 = 0.f, s2 = 0.f, s3 = 0.f;
        for (int c0 = 0; c0 < NCHUNK; c0 += 16) {
            u32x2 v[16]; float dec[16];
#pragma unroll
            for (int j = 0; j < 16; ++j) { v[j] = *(const u32x2*)(p + (size_t)(c0 + j) * stride); dec[j] = ret ? gdec : XP_ADEC(X)[(c0 + j) * 16 + head]; }
#pragma unroll
            for (int j = 0; j < 16; ++j) { u32x2 o; o.x = pk_bf16(s0, s1); o.y = pk_bf16(s2, s3); *(u32x2*)(p + (size_t)(c0 + j) * stride) = o;
                s0 = dec[j] * s0 + bf_lo(v[j].x); s1 = dec[j] * s1 + bf_hi(v[j].x); s2 = dec[j] * s2 + bf_lo(v[j].y); s3 = dec[j] * s3 + bf_hi(v[j].y); }
        }
    }
}

__device__ __forceinline__ void p4_ret(Ctx& X, int unit) {
    const int c = unit >> 2, h = unit & 3, t0 = c * CH, tid = X.tid, lane = X.lane, w = X.wave;
    LAS uchar* R1 = X.lds; LAS uchar* R2 = X.lds + 69632;
    const float lg = LG2_GAMMA[h];
    u32x4 P[8];
    { u32x4 qq[8];
#pragma unroll
      for (int i = 0; i < 8; ++i) { const int q = tid + 512 * i, l = q >> 5, dc = q & 31; const bf16* rp = XP_PROJ(X) + (size_t)(t0 + l) * LDP + h * 256 + dc * 8;
          qq[i] = *(const u32x4*)(rp + C_Q); P[i] = *(const u32x4*)(rp + C_K); }
#pragma unroll
      for (int i = 0; i < 8; ++i) { const int q = tid + 512 * i, l = q >> 5, dc = q & 31; *(LAS u32x4*)(R1 + l * 544 + dc * 16) = qq[i]; *(LAS u32x4*)(R2 + l * 544 + dc * 16) = P[i]; } }
    __syncthreads();
    const bf16* prev = XP_KV(X) + (size_t)(c * 4 + h) * 65536;
#pragma unroll
    for (int i = 0; i < 8; ++i) { const int q = tid + 512 * i, v = q >> 4, dc = q & 15; P[i] = *(const u32x4*)(prev + (size_t)v * 256 + dc * 8); }
    const int fr = lane & 15, fq = lane >> 4, q4 = (lane & 15) >> 2, p4 = lane & 3, l = 16 * w + fr;
    f32x4 sc[8];
#pragma unroll
    for (int n = 0; n < 8; ++n) sc[n] = (f32x4){0.f, 0.f, 0.f, 0.f};
#pragma unroll 2
    for (int ks = 0; ks < 8; ++ks) {
        const bf16x8 af = *(const LAS bf16x8*)(R1 + l * 544 + (32 * ks + 8 * fq) * 2);
#pragma unroll
        for (int n = 0; n < 8; ++n) if (n <= w) { const bf16x8 bf = *(const LAS bf16x8*)(R2 + (16 * n + fr) * 544 + (32 * ks + 8 * fq) * 2); sc[n] = mma16(bf, af, sc[n]); }
    }
    bf16x8 scf[4];
#pragma unroll
    for (int k2 = 0; k2 < 4; ++k2) { float v[8];
#pragma unroll
        for (int tq = 0; tq < 2; ++tq)
#pragma unroll
            for (int j = 0; j < 4; ++j) { const int s = 16 * (2 * k2 + tq) + 4 * fq + j; v[4 * tq + j] = (s <= l) ? sc[2 * k2 + tq][j] * exp2f(lg * (float)(l - s)) : 0.f; }
        u32x4 pk; pk.x = pk_bf16(v[0], v[1]); pk.y = pk_bf16(v[2], v[3]); pk.z = pk_bf16(v[4], v[5]); pk.w = pk_bf16(v[6], v[7]);
        scf[k2] = __builtin_bit_cast(bf16x8, pk); }
    __syncthreads();
    f32x4 acc[16];
#pragma unroll
    for (int n = 0; n < 16; ++n) acc[n] = (f32x4){0.f, 0.f, 0.f, 0.f};
#pragma unroll
    for (int dh = 0; dh < 2; ++dh) {
#pragma unroll
        for (int i = 0; i < 8; ++i) { const int q = tid + 512 * i, v = q >> 4, dc = q & 15; *(LAS u32x4*)(R2 + v * 272 + dc * 16) = P[i]; }
        __syncthreads();
        if (dh == 0) {
#pragma unroll
            for (int i = 0; i < 8; ++i) { const int q = tid + 512 * i, v = q >> 4, dc = q & 15; P[i] = *(const u32x4*)(prev + (size_t)v * 256 + 128 + dc * 8); }
        } else {
#pragma unroll
            for (int i = 0; i < 8; ++i) { const int q = tid + 512 * i, s_ = q >> 5, vc = q & 31; P[i] = *(const u32x4*)(XP_PROJ(X) + (size_t)(t0 + s_) * LDP + C_V + h * 256 + vc * 8); }
        }
#pragma unroll 2
        for (int ks = 0; ks < 4; ++ks) {
            const bf16x8 af = *(const LAS bf16x8*)(R1 + l * 544 + (128 * dh + 32 * ks + 8 * fq) * 2);
#pragma unroll
            for (int n = 0; n < 16; ++n) { const bf16x8 bf = *(const LAS bf16x8*)(R2 + (16 * n + fr) * 272 + (32 * ks + 8 * fq) * 2); acc[n] = mma16(bf, af, acc[n]); }
        }
        __syncthreads();
    }
    { const float qd = exp2f(lg * (float)(l + 1));
#pragma unroll
      for (int n = 0; n < 16; ++n) acc[n] = acc[n] * qd; }
#pragma unroll
    for (int i = 0; i < 8; ++i) { const int q = tid + 512 * i, s_ = q >> 5, vc = q & 31; *(LAS u32x4*)(R2 + s_ * 544 + vc * 16) = P[i]; }
    __syncthreads();
    const bf16* gp = XP_PROJ(X) + (size_t)(t0 + l) * LDP + C_G + h * 256 + 4 * fq; bf16* op = XP_MIX(X) + (size_t)(t0 + l) * D + h * 256 + 4 * fq;
    u32x2 gv[16];
#pragma unroll
    for (int n = 0; n < 16; ++n) gv[n] = *(const u32x2*)(gp + 16 * n);
    const int trp = (4 * fq + q4) * 544 + 8 * p4;
#pragma unroll
    for (int k2 = 0; k2 < 4; ++k2) if (2 * k2 <= w) {
#pragma unroll
        for (int n = 0; n < 16; ++n) { const bf16x8 bf = tr_frag(R2 + (32 * k2) * 544 + (16 * n) * 2 + trp, 16 * 544); acc[n] = mma16(bf, scf[k2], acc[n]); }
    }
    float ss = 0.f;
#pragma unroll
    for (int n = 0; n < 16; ++n) ss += (acc[n][0] * acc[n][0] + acc[n][1] * acc[n][1]) + (acc[n][2] * acc[n][2] + acc[n][3] * acc[n][3]);
    ss += __shfl_xor(ss, 16); ss += __shfl_xor(ss, 32);
    const float rstd = rsqrtf(ss * (1.f / 256.f) + EPS);
#pragma unroll
    for (int n = 0; n < 16; ++n) {
        u32x2 o; o.x = pk_bf16(acc[n][0] * rstd * silu_f(bf_lo(gv[n].x)), acc[n][1] * rstd * silu_f(bf_hi(gv[n].x))); o.y = pk_bf16(acc[n][2] * rstd * silu_f(bf_lo(gv[n].y)), acc[n][3] * rstd * silu_f(bf_hi(gv[n].y)));
        *(u32x2*)(op + 16 * n) = o; }
    __syncthreads();
}

__device__ __forceinline__ void p4_ssd(Ctx& X, int unit) {
    const int c = unit >> 1, g = unit & 1, t0 = c * CH, tid = X.tid, lane = X.lane, w = X.wave;
    LAS uchar* Cc = X.lds; LAS uchar* Bc = X.lds + 34816;
    LAS uchar* HP = X.lds + 34816;
    LAS float* dtS = (LAS float*)(X.lds + 110592); LAS float* acS = (LAS float*)(X.lds + 114688);
    { const int h = 8 * g + w, l0 = 2 * lane;
      const float dtb = XP_dt_bias(X)[h], A = -expf(XP_a_log(X)[h]);
      const float d0 = softplus_f(bf2f(XP_PROJ(X)[(size_t)(t0 + l0) * LDP + C_DT + h]) + dtb), d1 = softplus_f(bf2f(XP_PROJ(X)[(size_t)(t0 + l0 + 1) * LDP + C_DT + h]) + dtb);
      const float a0 = d0 * A, a1 = d1 * A, incl = wave_incl_scan(a0 + a1, lane);
      dtS[w * 128 + l0] = d0; dtS[w * 128 + l0 + 1] = d1; acS[w * 128 + l0] = incl - a1; acS[w * 128 + l0 + 1] = incl; }
#pragma unroll
    for (int i = 0; i < 4; ++i) { const int q = tid + 512 * i, l = q >> 4, nc = q & 15;
        *(LAS u32x4*)(Bc + l * 272 + nc * 16) = *(const u32x4*)(XP_XBC(X) + (size_t)(t0 + l) * XBCW + 1024 + 128 * g + nc * 8);
        *(LAS u32x4*)(Cc + l * 272 + nc * 16) = *(const u32x4*)(XP_XBC(X) + (size_t)(t0 + l) * XBCW + 1280 + 128 * g + nc * 8); }
    __syncthreads();
    const int fr = lane & 15, fq = lane >> 4, q4 = (lane & 15) >> 2, p4 = lane & 3, l = 16 * w + fr;
    f32x4 cb[8]; bf16x8 cfr[4];
#pragma unroll
    for (int n = 0; n < 8; ++n) cb[n] = (f32x4){0.f, 0.f, 0.f, 0.f};
#pragma unroll
    for (int ks = 0; ks < 4; ++ks) {
        cfr[ks] = *(const LAS bf16x8*)(Cc + l * 272 + (32 * ks + 8 * fq) * 2);
#pragma unroll
        for (int n = 0; n < 8; ++n) if (n <= w) { const bf16x8 bf = *(const LAS bf16x8*)(Bc + (16 * n + fr) * 272 + (32 * ks + 8 * fq) * 2); cb[n] = mma16(bf, cfr[ks], cb[n]); }
    }
    __syncthreads();
    float ss = 0.f;
    const int trp = (4 * fq + q4) * 144 + 8 * p4;
    const bf16* xp = XP_XBC(X) + (size_t)(t0 + l) * XBCW + 512 * g + 4 * fq; const bf16* zp = XP_PROJ(X) + (size_t)(t0 + l) * LDP + C_Z + 512 * g + 4 * fq;
    bf16* op = XP_MIX(X) + (size_t)(t0 + l) * D + 1024 + 512 * g + 4 * fq;
    u32x4 px[4], ps[4];
#pragma unroll
    for (int i = 0; i < 4; ++i) { const int q = tid + 512 * i; { const int e2 = q >> 10, s_ = (q >> 3) & 127, pc = q & 7; px[i] = *(const u32x4*)(XP_XBC(X) + (size_t)(t0 + s_) * XBCW + 512 * g + 64 * e2 + pc * 8); }
        { const int e2 = q >> 10, p = (q >> 4) & 63, nc = q & 15; ps[i] = *(const u32x4*)(XP_SST(X) + ((size_t)(c * 16 + 8 * g + e2) * 64 + p) * 128 + nc * 8); } }
#pragma unroll 1
    for (int hp = 0; hp < 4; ++hp) {
#pragma unroll
        for (int i = 0; i < 4; ++i) { const int q = tid + 512 * i; { const int e2 = q >> 10, s_ = (q >> 3) & 127, pc = q & 7, e = 2 * hp + e2; const u32x4 v = px[i]; const float d = dtS[e * 128 + s_];
            u32x4 o; o.x = pk_bf16(bf_lo(v.x) * d, bf_hi(v.x) * d); o.y = pk_bf16(bf_lo(v.y) * d, bf_hi(v.y) * d); o.z = pk_bf16(bf_lo(v.z) * d, bf_hi(v.z) * d); o.w = pk_bf16(bf_lo(v.w) * d, bf_hi(v.w) * d);
            *(LAS u32x4*)(HP + e2 * 18432 + s_ * 144 + pc * 16) = o; }
            { const int e2 = q >> 10, p = (q >> 4) & 63, nc = q & 15; *(LAS u32x4*)(HP + 36864 + e2 * 17408 + p * 272 + nc * 16) = ps[i]; } }
        __syncthreads();
        if (hp < 3) {
#pragma unroll
            for (int i = 0; i < 4; ++i) { const int q = tid + 512 * i; { const int e2 = q >> 10, s_ = (q >> 3) & 127, pc = q & 7, e = 2 * hp + 2 + e2; px[i] = *(const u32x4*)(XP_XBC(X) + (size_t)(t0 + s_) * XBCW + 512 * g + 64 * e + pc * 8); }
                { const int e2 = q >> 10, p = (q >> 4) & 63, nc = q & 15, e = 2 * hp + 2 + e2; ps[i] = *(const u32x4*)(XP_SST(X) + ((size_t)(c * 16 + 8 * g + e) * 64 + p) * 128 + nc * 8); } }
        }
        u32x2 xq[2][4], zq[2][4];
#pragma unroll
        for (int e2 = 0; e2 < 2; ++e2)
#pragma unroll
            for (int n = 0; n < 4; ++n) { xq[e2][n] = *(const u32x2*)(xp + 64 * (2 * hp + e2) + 16 * n); zq[e2][n] = *(const u32x2*)(zp + 64 * (2 * hp + e2) + 16 * n); }
#pragma unroll
        for (int e2 = 0; e2 < 2; ++e2) { const int e = 2 * hp + e2;
            LAS uchar* Xh = HP + e2 * 18432; LAS uchar* Ph = HP + 36864 + e2 * 17408;
            f32x4 y[4];
#pragma unroll
            for (int n = 0; n < 4; ++n) y[n] = (f32x4){0.f, 0.f, 0.f, 0.f};
#pragma unroll
            for (int ks = 0; ks < 4; ++ks)
#pragma unroll
                for (int n = 0; n < 4; ++n) { const bf16x8 bf = *(const LAS bf16x8*)(Ph + (16 * n + fr) * 272 + (32 * ks + 8 * fq) * 2); y[n] = mma16(bf, cfr[ks], y[n]); }
            const float al = acS[e * 128 + l], el = __expf(al);
#pragma unroll
            for (int n = 0; n < 4; ++n) y[n] = y[n] * el;
#pragma unroll
            for (int k2 = 0; k2 < 4; ++k2) if (2 * k2 <= w) { float v[8];
#pragma unroll
                for (int tq = 0; tq < 2; ++tq) { const int s0 = 16 * (2 * k2 + tq) + 4 * fq; const f32x4 as = *(const LAS f32x4*)(acS + e * 128 + s0);
#pragma unroll
                    for (int j = 0; j < 4; ++j) v[4 * tq + j] = (s0 + j <= l) ? cb[2 * k2 + tq][j] * __expf(al - as[j]) : 0.f; }
                u32x4 pk; pk.x = pk_bf16(v[0], v[1]); pk.y = pk_bf16(v[2], v[3]); pk.z = pk_bf16(v[4], v[5]); pk.w = pk_bf16(v[6], v[7]);
                const bf16x8 gf = __builtin_bit_cast(bf16x8, pk);
#pragma unroll
                for (int n = 0; n < 4; ++n) { const bf16x8 bf = tr_frag(Xh + (32 * k2) * 144 + (16 * n) * 2 + trp, 16 * 144); y[n] = mma16(bf, gf, y[n]); }
            }
            const float dsk = XP_d_skip(X)[8 * g + e];
#pragma unroll
            for (int n = 0; n < 4; ++n) { const u32x2 xv = xq[e2][n], zv = zq[e2][n];
                const float t0_ = (y[n][0] + dsk * bf_lo(xv.x)) * silu_f(bf_lo(zv.x)), t1_ = (y[n][1] + dsk * bf_hi(xv.x)) * silu_f(bf_hi(zv.x));
                const float t2_ = (y[n][2] + dsk * bf_lo(xv.y)) * silu_f(bf_lo(zv.y)), t3_ = (y[n][3] + dsk * bf_hi(xv.y)) * silu_f(bf_hi(zv.y));
                ss += (t0_ * t0_ + t1_ * t1_) + (t2_ * t2_ + t3_ * t3_);
                u32x2 o; o.x = pk_bf16(t0_, t1_); o.y = pk_bf16(t2_, t3_); *(u32x2*)(op + 64 * e + 16 * n) = o; }
        }
        __syncthreads();
    }
    ss += __shfl_xor(ss, 16); ss += __shfl_xor(ss, 32);
    const float rstd = rsqrtf(ss * (1.f / 512.f) + EPS);
    const float* nw = XP_ssm_norm_w(X) + 512 * g + 4 * fq;
#pragma unroll 4
    for (int i = 0; i < 32; ++i) { const f32x4 wv = *(const f32x4*)(nw + 16 * i); const u32x2 t = *(const u32x2*)(op + 16 * i);
        u32x2 o; o.x = pk_bf16(bf_lo(t.x) * rstd * wv.x, bf_hi(t.x) * rstd * wv.y); o.y = pk_bf16(bf_lo(t.y) * rstd * wv.z, bf_hi(t.y) * rstd * wv.w);
        *(u32x2*)(op + 16 * i) = o; }
    __syncthreads();
}

__device__ __forceinline__ void p6_router(Ctx& X) {
    const int tid = X.tid, lane = X.lane, w = X.wave, fr = lane & 15, fq = lane >> 4;
    LAS float* part = (LAS float*)X.lds;
    LAS float* ssq = (LAS float*)(X.lds + 32768);
    LAS float* lgt = (LAS float*)(X.lds + 32768 + 1024);
    LAS float* rs = (LAS float*)(X.lds + 32768 + 1024 + 4096);
    for (int item = X.bid; item < T / 32; item += X.G) {
        const int tb = item * 32;
        f32x4 acc[2][2]; float ss[2] = {0.f, 0.f};
#pragma unroll
        for (int a = 0; a < 2; ++a)
#pragma unroll
            for (int n = 0; n < 2; ++n) acc[a][n] = (f32x4){0.f, 0.f, 0.f, 0.f};
#pragma unroll 2
        for (int ks = 0; ks < 8; ++ks) { const int kb = 256 * w + 32 * ks + 8 * fq;
            bf16x8 ah[2], al[2], bh[2], bl[2];
#pragma unroll
            for (int mt = 0; mt < 2; ++mt) { const float* hp = XP_Hh(X) + (size_t)(tb + 16 * mt + fr) * D + kb;
                const f32x4 x0 = *(const f32x4*)hp, x1 = *(const f32x4*)(hp + 4);
                ss[mt] += (x0.x * x0.x + x0.y * x0.y) + (x0.z * x0.z + x0.w * x0.w) + (x1.x * x1.x + x1.y * x1.y) + (x1.z * x1.z + x1.w * x1.w);
                u32x4 h, l; h.x = pk_bf16(x0.x, x0.y); h.y = pk_bf16(x0.z, x0.w); h.z = pk_bf16(x1.x, x1.y); h.w = pk_bf16(x1.z, x1.w);
                l.x = pk_bf16(x0.x - bf_lo(h.x), x0.y - bf_hi(h.x)); l.y = pk_bf16(x0.z - bf_lo(h.y), x0.w - bf_hi(h.y)); l.z = pk_bf16(x1.x - bf_lo(h.z), x1.y - bf_hi(h.z)); l.w = pk_bf16(x1.z - bf_lo(h.w), x1.w - bf_hi(h.w));
                ah[mt] = __builtin_bit_cast(bf16x8, h); al[mt] = __builtin_bit_cast(bf16x8, l); }
#pragma unroll
            for (int nt = 0; nt < 2; ++nt) { bh[nt] = *(const bf16x8*)(XP_WRH(X) + (size_t)(16 * nt + fr) * D + kb); bl[nt] = *(const bf16x8*)(XP_WRL(X) + (size_t)(16 * nt + fr) * D + kb); }
#pragma unroll
            for (int mt = 0; mt < 2; ++mt)
#pragma unroll
                for (int nt = 0; nt < 2; ++nt) { acc[mt][nt] = mma16(bh[nt], ah[mt], acc[mt][nt]); acc[mt][nt] = mma16(bl[nt], ah[mt], acc[mt][nt]); acc[mt][nt] = mma16(bh[nt], al[mt], acc[mt][nt]); }
        }
#pragma unroll
        for (int mt = 0; mt < 2; ++mt) { float q = ss[mt]; q += __shfl_xor(q, 16); q += __shfl_xor(q, 32); if (fq == 0) ssq[w * 32 + 16 * mt + fr] = q;
#pragma unroll
            for (int nt = 0; nt < 2; ++nt) *(LAS f32x4*)(part + (w * 32 + 16 * mt + fr) * 32 + 16 * nt + 4 * fq) = acc[mt][nt]; }
        __syncthreads();
        { const int tk = tid >> 4, e0 = 2 * (tid & 15); float q = 0.f, a0 = 0.f, a1 = 0.f;
#pragma unroll
          for (int ww = 0; ww < 8; ++ww) { q += ssq[ww * 32 + tk]; const f32x2 p = *(const LAS f32x2*)(part + (ww * 32 + tk) * 32 + e0); a0 += p.x; a1 += p.y; }
          const float rstd = rsqrtf(q * (1.f / D) + EPS);
          lgt[tk * 32 + e0] = a0 * rstd + XP_b_router(X)[e0]; lgt[tk * 32 + e0 + 1] = a1 * rstd + XP_b_router(X)[e0 + 1];
          if ((tid & 15) == 0) rs[tk] = rstd; }
        __syncthreads();
        if (tid < 32) { const int t = tb + tid; unsigned used = 0u; int idx[4]; float val[4];
#pragma unroll
            for (int k = 0; k < 4; ++k) { float best = -3.0e38f; int bi = 0;
#pragma unroll 8
                for (int j = 0; j < 32; ++j) { const float v = lgt[tid * 32 + j]; if (!((used >> j) & 1u) && v > best) { best = v; bi = j; } }
                used |= 1u << bi; idx[k] = bi; val[k] = best; }
            const float e1 = __expf(val[1] - val[0]), e2 = __expf(val[2] - val[0]), e3 = __expf(val[3] - val[0]), inv = 1.f / (1.f + e1 + e2 + e3);
            const float wv[4] = {inv, e1 * inv, e2 * inv, e3 * inv};
#pragma unroll
            for (int k = 0; k < 4; ++k) { const int rank = (int)atomicAdd(XP_ctl(X) + CW_CNT + 64 * idx[k], 1u);
                XP_LIST(X)[idx[k] * T + rank] = t; XP_TOPI(X)[t * 4 + k] = idx[k]; XP_TOPR(X)[t * 4 + k] = rank; XP_TOPW(X)[t * 4 + k] = wv[k]; } }
#pragma unroll 2
        for (int r = 0; r < 4; ++r) { const int tk = 4 * w + r, t = tb + tk; const float rstd = rs[tk];
            const f32x4* hr = (const f32x4*)(XP_Hh(X) + (size_t)t * D) + lane; const f32x4* wr_ = (const f32x4*)XP_ln_ffn_w(X) + lane;
            unsigned* o8 = (unsigned*)(XP_U2(X) + (size_t)t * D) + lane;
#pragma unroll
            for (int j = 0; j < 8; ++j) { const f32x4 v = hr[64 * j], wv = wr_[64 * j]; o8[64 * j] = pk_fp8x4(v.x * rstd * wv.x, v.y * rstd * wv.y, v.z * rstd * wv.z, v.w * rstd * wv.w); } }
        __syncthreads();
    }
}

__device__ __forceinline__ void moe_tables(Ctx& X) {
    LAS int* tab = (LAS int*)(X.lds + LDS_TAB);
    if (X.tid == 0) { int nb = 0;
        for (int e = 0; e < NE; ++e) { const int cnt = (int)__hip_atomic_load(XP_ctl(X) + CW_CNT + 64 * e, __ATOMIC_RELAXED, __HIP_MEMORY_SCOPE_AGENT); const int k = (cnt + 255) >> 8;
            tab[8 + e] = nb; for (int b = 0; b < k; ++b) { if (nb + b < MAXBLK) { tab[64 + nb + b] = e; tab[256 + nb + b] = (cnt - 256 * b) < 256 ? (cnt - 256 * b) : 256; } } nb += k; }
        tab[8 + NE] = nb; tab[0] = nb < MAXBLK ? nb : MAXBLK; }
    __syncthreads();
}

__device__ __forceinline__ void p9_final(Ctx& X) {
    const LAS int* tab = (const LAS int*)(X.lds + LDS_TAB);
    const int gw = X.bid * NWAVES + X.wave, NGW = X.G * NWAVES, lane = X.lane;
    for (int t = gw; t < T; t += NGW) {
        const f32x4* hr = (const f32x4*)(XP_Hh(X) + (size_t)t * D) + lane;
        f32x4 v[8];
#pragma unroll
        for (int j = 0; j < 8; ++j) v[j] = hr[64 * j];
#pragma unroll
        for (int k = 0; k < 4; ++k) { const int e = XP_TOPI(X)[t * 4 + k], r = XP_TOPR(X)[t * 4 + k]; const float wk = XP_TOPW(X)[t * 4 + k];
            const unsigned* yr = (const unsigned*)(XP_YR(X) + ((size_t)tab[8 + e] * 256 + r) * D) + lane;
#pragma unroll
            for (int j = 0; j < 8; ++j) { const int y = (int)yr[64 * j]; const f32x2 lo = __builtin_amdgcn_cvt_pk_f32_fp8(y, false), hi = __builtin_amdgcn_cvt_pk_f32_fp8(y, true);
                v[j].x += wk * lo.x; v[j].y += wk * lo.y; v[j].z += wk * hi.x; v[j].w += wk * hi.y; } }
        float s = 0.f;
#pragma unroll
        for (int j = 0; j < 8; ++j) s += (v[j].x * v[j].x + v[j].y * v[j].y) + (v[j].z * v[j].z + v[j].w * v[j].w);
        const float rstd = rsqrtf(wave_sum(s) * (1.f / D) + EPS);
        f32x4* o = (f32x4*)(X.out + (size_t)t * D) + lane; const f32x4* wr_ = (const f32x4*)XP_ln_final_w(X) + lane;
#pragma unroll
        for (int j = 0; j < 8; ++j) { const f32x4 wv = wr_[64 * j]; f32x4 r; r.x = v[j].x * rstd * wv.x; r.y = v[j].y * rstd * wv.y; r.z = v[j].z * rstd * wv.z; r.w = v[j].w * rstd * wv.w; o[64 * j] = r; }
    }
}

#ifdef NO_P4R
#define P4R(X,u)
#else
#define P4R(X,u) p4_ret(X,u)
#endif
#ifdef NO_P4S
#define P4S(X,u)
#else
#define P4S(X,u) p4_ssd(X,u)
#endif
struct Args { const void* in[19]; float* out; uchar* ws; int ph_lo, ph_hi; };
__global__ void __launch_bounds__(NTHR, 2) fwd(Args args) {
    extern __shared__ __attribute__((aligned(16))) uchar lds_raw[];
    Ctx X;
    X.lds = (LAS uchar*)lds_raw; X.tid = threadIdx.x; X.lane = X.tid & 63; X.wave = __builtin_amdgcn_readfirstlane(X.tid >> 6); X.G = gridDim.x; X.bid = blockIdx.x;
    X.in = (const void* const*)__builtin_amdgcn_kernarg_segment_ptr(); X.out = args.out; X.ws = args.ws;
    for (int u = X.tid; u < (LDS_BYTES - LDS_PHASE_END) / 4; u += NTHR) ((LAS unsigned*)(X.lds + LDS_PHASE_END))[u] = 0u;
    __syncthreads();
    const int lo = args.ph_lo, hi = args.ph_hi;
    const bool multi = (hi - lo) > 1;
    XcdBarrier bar; bar.bar = XP_ctl(X) + CW_BAR; bar.x = 0; bar.st = nullptr;
    if (multi) bar = xcd_barrier_post(XP_ctl(X) + CW_BAR, (volatile LAS unsigned*)(X.lds + LDS_MISC + 32));
#ifdef ONLY_PHASE
#define IN(k) ((k) == ONLY_PHASE && lo <= (k) && (k) < hi)
#else
#define IN(k) (lo <= (k) && (k) < hi)
#endif
#define SEAM(k) do { if (IN(k) && IN((k) + 1)) xcd_barrier(bar); } while (0)
    if (IN(0)) { p0_prologue(X); } SEAM(0);
    if (IN(1)) { DenseSched S{(const char*)XP_U(X), (const char*)XP_WinT(X), D, T / 256, LDP / 256, (T / 256) * (LDP / 256), X.G, X.bid}; EpiProj E{XP_PROJ(X), LDP, XP_COS(X), XP_SIN(X)};
        pg8::gemm_phase<EpiProj, DenseSched, false, false>(X.lds, D, S, E);
        if (X.G == 256 && X.bid >= 96) conv8_fill(X, FILL_B1, (X.bid - 96) * NWAVES + X.wave, FILL_W1, FILL_N1); } SEAM(1);
    if (IN(2)) { for (int u = X.bid; u < 256; u += X.G) p2_ret(X, u);
        for (int u = X.bid; u < 256; u += X.G) p2_ssd(X, u); } SEAM(2);
    if (IN(3)) { p3_scan(X); if (X.G == 256 && X.bid >= 192) conv8_fill(X, FILL_B3, (X.bid - 192) * NWAVES + X.wave, FILL_W3, FILL_N3); } SEAM(3);
    if (IN(4)) { for (int u = X.bid; u < 256; u += X.G) { P4R(X, u); }
        for (int u = X.bid; u < 128; u += X.G) { P4S(X, u); }
        if (X.G == 256 && X.bid >= 128) conv8_fill(X, FILL_B4, (X.bid - 128) * NWAVES + X.wave, FILL_W4, FILL_N4); } SEAM(4);
    if (IN(5)) { DenseSched S{(const char*)XP_MIX(X), (const char*)XP_WoutT(X), D, T / 256, D / 256, (T / 256) * (D / 256), X.G, X.bid}; EpiOut E{XP_x(X), XP_Hh(X)};
        pg8::gemm_phase<EpiOut, DenseSched, false, false>(X.lds, D, S, E); } SEAM(5);
    if (IN(6)) { p6_router(X); } SEAM(6);
    if (IN(7)) { moe_tables(X); MoeSched S{(const LAS int*)(X.lds + LDS_TAB), (const char*)XP_U2(X), (const char*)XP_WguT(X), (size_t)(2 * DFF) * D, XP_LIST(X), D / 2, (2 * DFF) / 256, X.G, X.bid}; EpiGateUp E{XP_ACT(X), XP_b_gu(X)};
        pg8::gemm_phase<EpiGateUp, MoeSched, true, true>(X.lds, D / 2, S, E); } SEAM(7);
    if (IN(8)) { moe_tables(X); MoeSchedDirect S{(const LAS int*)(X.lds + LDS_TAB), (const char*)XP_ACT(X), (const char*)XP_WdT(X), (size_t)D * DFF, DFF / 2, D / 256, X.G, X.bid}; EpiDown E{XP_YR(X), XP_b_d(X)};
        pg8::gemm_phase<EpiDown, MoeSchedDirect, true, true>(X.lds, DFF / 2, S, E); } SEAM(8);
    if (IN(9)) { moe_tables(X); p9_final(X); }
#undef IN
#undef SEAM
}

extern "C" void kernel_launch(void* const* d_in, const int* in_sizes, int n_in, void* d_out, int out_size, void* d_ws, size_t ws_size, hipStream_t stream) {
    static int grid = 0;
    if (grid == 0) {
        if (n_in != 19 || out_size != T * D || ws_size < WS_END) { fprintf(stderr, "kernel_launch: unexpected shapes (n_in %d, out %d, ws %zu)\n", n_in, out_size, ws_size); grid = -1; return; }
        int dev = 0, cus = 0, per_cu = 0;
        if (hipGetDevice(&dev) != hipSuccess || hipDeviceGetAttribute(&cus, hipDeviceAttributeMultiprocessorCount, dev) != hipSuccess) { grid = -1; return; }
        if (hipFuncSetAttribute((const void*)fwd, hipFuncAttributeMaxDynamicSharedMemorySize, LDS_BYTES) != hipSuccess) { fprintf(stderr, "kernel_launch: hipFuncSetAttribute failed\n"); grid = -1; return; }
        if (hipOccupancyMaxActiveBlocksPerMultiprocessor(&per_cu, (const void*)fwd, NTHR, LDS_BYTES) != hipSuccess || per_cu < 1) { fprintf(stderr, "kernel_launch: occupancy query reports %d\n", per_cu); }
        (void)hipGetLastError();
        grid = cus;
    }
    if (grid < 0) return;
    (void)hipMemsetAsync((char*)d_ws + WS_CTL, 0, CTL_ZERO_BYTES, stream);
    Args a{};
    for (int i = 0; i < 19; ++i) a.in[i] = d_in[i];
    a.out = (float*)d_out; a.ws = (uchar*)d_ws;
    constexpr int NL = MK_N_LAUNCHES;
    for (int li = 0; li < NL; ++li) {
        a.ph_lo = (NL == 1) ? 0 : li; a.ph_hi = (NL == 1) ? NPHASE : li + 1;
        hipLaunchKernelGGL(fwd, dim3(grid), dim3(NTHR), LDS_BYTES, stream, a);
    }
}
```

```cpp
#include <hip/hip_runtime.h>
#include <cstdio>
#include <cstdint>

#ifndef MK_N_LAUNCHES
#define MK_N_LAUNCHES 1
#endif

#define LAS __attribute__((address_space(3)))
typedef unsigned short bf16;
typedef short bf16x8 __attribute__((ext_vector_type(8)));
typedef short s16x4 __attribute__((ext_vector_type(4)));
typedef float f32x4 __attribute__((ext_vector_type(4)));
typedef float f32x2 __attribute__((ext_vector_type(2)));
typedef unsigned u32x4 __attribute__((ext_vector_type(4)));
typedef unsigned u32x2 __attribute__((ext_vector_type(2)));
typedef unsigned char uchar;
typedef int i32x8 __attribute__((ext_vector_type(8)));
typedef int i32x4 __attribute__((ext_vector_type(4)));
constexpr float W8_SCALE = 64.f, W8_INV = 1.f / 64.f;

constexpr int T = 8192, D = 2048, NPROJ = 6672, LDP = 6912;
constexpr int C_Q = 0, C_K = 1024, C_V = 2048, C_G = 3072, C_Z = 4096, C_X = 5120, C_DT = 6656;
constexpr int XBCW = 1536, NCHUNK = 64, CH = 128;
constexpr int NE = 32, DFF = 2048, MAXBLK = 160;
constexpr float EPS = 1e-6f;
constexpr int NPHASE = 10;
constexpr int NWAVES = 8, NTHR = 512;

constexpr size_t MiB = 1ull << 20;
constexpr size_t WS_CTL = 0, CTL_ZERO_BYTES = 128 * 1024;
constexpr size_t WS_WINT = 2 * MiB, WS_WOUTT = 30 * MiB, WS_COS = 38 * MiB, WS_SIN = 42 * MiB;
constexpr size_t WS_TOPI = 46 * MiB, WS_TOPR = 46 * MiB + 128 * 1024, WS_TOPW = 46 * MiB + 256 * 1024, WS_LIST = 47 * MiB, WS_ADEC = 48 * MiB;
constexpr size_t WS_WRH = 49 * MiB, WS_WRL = 49 * MiB + 128 * 1024;
constexpr size_t WS_U = 64 * MiB, WS_U2 = 96 * MiB, WS_MIX = 128 * MiB, WS_XBC = 160 * MiB, WS_KV = 192 * MiB, WS_SST = 224 * MiB;
constexpr size_t WS_H = 256 * MiB, WS_PROJ = 320 * MiB, WS_ACT = 448 * MiB, WS_YR = 608 * MiB, WS_WGUT = 768 * MiB, WS_WDT = 1280 * MiB, WS_END = 1536 * MiB;
constexpr int CW_TMO = 0, CW_BAR = 4096, CW_CNT = 16384, CW_WQ = 20480;

constexpr int RING_BYTES = 131072;
constexpr int LDS_PHASE_END = 139264;
constexpr int LDS_TAB = LDS_PHASE_END;
constexpr int LDS_IDX = LDS_PHASE_END + 2048;
constexpr int LDS_MISC = LDS_PHASE_END + 4096;
constexpr int LDS_BIAS = LDS_PHASE_END + 5120;
constexpr int LDS_BYTES = 147456;

__device__ __forceinline__ unsigned pk_bf16(float lo, float hi) { unsigned r; asm("v_cvt_pk_bf16_f32 %0, %1, %2" : "=v"(r) : "v"(lo), "v"(hi)); return r; }
__device__ __forceinline__ float clamp448(float x) { return fminf(fmaxf(x, -448.f), 448.f); }
__device__ __forceinline__ unsigned pk_fp8x4(float a, float b, float c, float d) {
    int p = 0; p = __builtin_amdgcn_cvt_pk_fp8_f32(clamp448(a), clamp448(b), p, false); p = __builtin_amdgcn_cvt_pk_fp8_f32(clamp448(c), clamp448(d), p, true); return (unsigned)p; }
__device__ __forceinline__ unsigned pk_fp8x4_nc(float a, float b, float c, float d) {
    int p = 0; p = __builtin_amdgcn_cvt_pk_fp8_f32(a, b, p, false); p = __builtin_amdgcn_cvt_pk_fp8_f32(c, d, p, true); return (unsigned)p; }
__device__ __forceinline__ float bf_lo(unsigned u) { return __uint_as_float(u << 16); }
__device__ __forceinline__ float bf_hi(unsigned u) { return __uint_as_float(u & 0xffff0000u); }
__device__ __forceinline__ float bf2f(bf16 b) { return __uint_as_float(((unsigned)b) << 16); }
__device__ __forceinline__ float wave_sum(float v) {
#pragma unroll
    for (int o = 1; o < 64; o <<= 1) v += __shfl_xor(v, o);
    return v;
}
__device__ __forceinline__ float silu_f(float x) { return x * __builtin_amdgcn_rcpf(1.0f + __expf(-x)); }
__device__ __forceinline__ float softplus_f(float x) { return x > 20.f ? x : log1pf(__expf(x)); }

__constant__ double INV_FREQ[128] = {1,0.93057204092969903,0.86596432336006535,0.80584218776148187,0.74989420933245587,0.69783058485986638,0.64938163157621132,0.60429639023813286,0.56234132519034907,0.5232991146814947,0.48696752516586311,0.45315836376008178,0.42169650342858223,0.39241897584845359,0.36517412725483772,0.33982083289425596,0.31622776601683794,0.29427271762092816,0.27384196342643613,0.25482967479793467,0.23713737056616552,0.22067340690845899,0.20535250264571461,0.19109529749704404,0.17782794100389229,0.16548170999431813,0.15399265260594919,0.14330125702369628,0.1333521432163324,0.12409377607517195,0.11547819846894582,0.10746078283213174,0.10000000000000001,0.0930572040929699,0.086596432336006529,0.080584218776148187,0.074989420933245579,0.069783058485986635,0.064938163157621132,0.060429639023813285,0.056234132519034911,0.05232991146814947,0.048696752516586311,0.045315836376008181,0.042169650342858224,0.039241897584845357,0.036517412725483769,0.033982083289425591,0.031622776601683791,0.029427271762092817,0.027384196342643614,0.025482967479793464,0.023713737056616554,0.022067340690845899,0.02053525026457146,0.019109529749704406,0.017782794100389229,0.016548170999431813,0.015399265260594919,0.014330125702369627,0.013335214321633241,0.012409377607517195,0.011547819846894581,0.010746078283213174,0.01,0.0093057204092969904,0.0086596432336006543,0.008058421877614819,0.0074989420933245579,0.0069783058485986633,0.006493816315762113,0.0060429639023813278,0.005623413251903491,0.0052329911468149467,0.004869675251658631,0.0045315836376008181,0.0042169650342858229,0.0039241897584845363,0.0036517412725483771,0.0033982083289425592,0.0031622776601683794,0.002942727176209282,0.0027384196342643613,0.0025482967479793467,0.0023713737056616554,0.0022067340690845897,0.002053525026457146,0.0019109529749704406,0.0017782794100389228,0.0016548170999431814,0.001539926526059492,0.0014330125702369627,0.0013335214321633241,0.0012409377607517195,0.0011547819846894581,0.0010746078283213176,0.001,0.00093057204092969893,0.00086596432336006539,0.00080584218776148179,0.00074989420933245586,0.00069783058485986635,0.00064938163157621134,0.00060429639023813287,0.0005623413251903491,0.00052329911468149473,0.0004869675251658631,0.00045315836376008179,0.00042169650342858224,0.00039241897584845359,0.0003651741272548377,0.00033982083289425596,0.00031622776601683794,0.00029427271762092817,0.00027384196342643611,0.00025482967479793463,0.00023713737056616554,0.00022067340690845897,0.00020535250264571461,0.00019109529749704405,0.00017782794100389227,0.00016548170999431815,0.00015399265260594919,0.00014330125702369627,0.0001333521432163324,0.00012409377607517196,0.00011547819846894582,0.00010746078283213175};
__constant__ float LG2_GAMMA[4] = {-0.045803689613124789f, -0.022720076500083529f, -0.011315313227834146f, -0.0056465631411420627f};
__constant__ float GAMMA_CHUNK[4] = {0.017183023570817902f, 0.13321516287964841f, 0.36643771592203728f, 0.60593708822908032f};

namespace pg8 {
constexpr int BM = 256, BK = 64, HALF = 128, HTB = HALF * BK * 2, STAGE_BYTES = 8 * HTB, NXCD = 8, WGM = 8;
__host__ __device__ __forceinline__ int lds_byte(int r, int c) { const int st = (r >> 4) * 2 + (c >> 5), rr = r & 15, cc = c & 31, ob = rr * 64 + cc * 2; return st * 1024 + (ob ^ (((ob >> 9) & 1) << 5)); }
__host__ __device__ __forceinline__ void stage_rc(int b, int& R, int& C) { const int st = b / 1024, sb = b % 1024, swz = sb ^ (((sb >> 9) & 1) << 5); R = (st >> 1) * 16 + swz / 64; C = (st & 1) * 32 + (swz % 64) / 2; }
__host__ __device__ __forceinline__ int perm32(int rho) { const int n = rho >> 4, i = rho & 15; return 8 * (i >> 2) + 4 * n + (i & 3); }

struct Unit { const char* pa; const char* pb; int row0, col0, aux, blk; };

template <class Epi, class Sched, bool GATHER, bool FP8>
__device__ __forceinline__ void gemm_phase(LAS uchar* lds, const int K, const Sched& S, const Epi& E) {
    const int tid = threadIdx.x, wid = __builtin_amdgcn_readfirstlane(tid >> 6), lane = tid & 63, wr = wid >> 2, wc = wid & 3, fr = lane & 15, fq = lane >> 4;
    const int nt = K / BK;
    unsigned voA[2][2], voffB[2];
#pragma unroll
    for (int i = 0; i < 2; ++i) { int R, C; stage_rc(tid * 16 + i * 8192, R, C); const int Rb = Epi::PERM == 17 ? 64 * (R >> 5) + 16 * ((R >> 2) & 3) + 2 * (R & 3) + ((R >> 4) & 1) : Epi::PERM == 16 ? 64 * (R >> 5) + 16 * ((R >> 2) & 3) + 4 * ((R >> 4) & 1) + (R & 3) : (Epi::PERM == 8 ? ((R & ~31) + perm32(R & 31)) : R);
        voA[0][i] = (unsigned)(R * K + C) * 2u; voA[1][i] = voA[0][i] + (unsigned)(HALF * K * 2); voffB[i] = (unsigned)(Rb * K + C) * 2u; }
    const size_t kstep = (size_t)(BK * 2);
    const size_t hstep = (size_t)(Epi::PERM >= 16 ? 8 : HALF) * K * 2;
    const unsigned ldsw = (unsigned)wid * 1024u;
    const int aoff = lds_byte(wr * 64 + fr, fq * 8), boff = lds_byte(wc * 32 + fr, fq * 8);
#define PG8_SA(b, h) (((b) * 2 + (h)) * HTB)
#define PG8_SB(b, h) ((4 + (b) * 2 + (h)) * HTB)
#define PG8_STAGE(bufoff, gbase, voff) do { _Pragma("unroll") for (int _i = 0; _i < 2; ++_i) \
        __builtin_amdgcn_global_load_lds((const unsigned*)((const char*)(gbase) + (voff)[_i]), (LAS unsigned*)(lds + (bufoff) + ldsw + _i * 8192), 16, 0, 0); } while (0)
#define PG8_LDA(dst, b, h) do { _Pragma("unroll") for (int m = 0; m < 4; ++m) _Pragma("unroll") for (int k = 0; k < 2; ++k) dst[m][k] = *(const LAS bf16x8*)(lds + PG8_SA(b, h) + aoff + m * 2048 + k * 1024); } while (0)
#define PG8_LDB(dst, b, h) do { _Pragma("unroll") for (int n = 0; n < 2; ++n) _Pragma("unroll") for (int k = 0; k < 2; ++k) dst[n][k] = *(const LAS bf16x8*)(lds + PG8_SB(b, h) + boff + n * 2048 + k * 1024); } while (0)
#define PG8_CAT(x) __builtin_shufflevector(__builtin_bit_cast(i32x4, (x)[0]), __builtin_bit_cast(i32x4, (x)[1]), 0, 1, 2, 3, 4, 5, 6, 7)
#define PG8_MMA(ai, bj, At, Bt) do { __builtin_amdgcn_s_setprio(1); \
        if constexpr (FP8) { _Pragma("unroll") for (int m = 0; m < 4; ++m) _Pragma("unroll") for (int n = 0; n < 2; ++n) \
            acc[ai][bj][m][n] = __builtin_amdgcn_mfma_scale_f32_16x16x128_f8f6f4(PG8_CAT(Bt[n]), PG8_CAT(At[m]), acc[ai][bj][m][n], 0, 0, 0, 0x7f7f7f7f, 0, 0x7f7f7f7f); } \
        else { _Pragma("unroll") for (int m = 0; m < 4; ++m) _Pragma("unroll") for (int n = 0; n < 2; ++n) _Pragma("unroll") for (int k = 0; k < 2; ++k) \
            acc[ai][bj][m][n] = __builtin_amdgcn_mfma_f32_16x16x32_bf16(Bt[n][k], At[m][k], acc[ai][bj][m][n], 0, 0, 0); } \
        __builtin_amdgcn_s_setprio(0); } while (0)
#define PG8_WAIT_V(n) asm volatile("s_waitcnt vmcnt(" #n ")" ::: "memory")
#define PG8_WAIT_V8F(fresh) asm volatile("s_cmp_eq_u32 %0, 0\n\ts_cbranch_scc1 .Lw8_%=\n\ts_waitcnt vmcnt(%1)\n\ts_branch .Lwe_%=\n.Lw8_%=:\n\ts_waitcnt vmcnt(8)\n.Lwe_%=:" :: "s"(fresh), "n"(8 + Epi::NST + Epi::NPF) : "memory", "scc")
#define PG8_WAIT_L(n) asm volatile("s_waitcnt lgkmcnt(" #n ")" ::: "memory")
#define PG8_BAR __builtin_amdgcn_s_barrier()
#define PG8_SCHED __builtin_amdgcn_sched_barrier(0)
    Unit cur, nxt; int ui = 0;
    if (!S.next(0, cur)) return;
    f32x4 acc[2][2][4][2];
#pragma unroll
    for (int a = 0; a < 2; ++a)
#pragma unroll
        for (int b = 0; b < 2; ++b)
#pragma unroll
            for (int m = 0; m < 4; ++m)
#pragma unroll
                for (int n = 0; n < 2; ++n) acc[a][b][m][n] = (f32x4){0.f, 0.f, 0.f, 0.f};
    bf16x8 At[4][2], B0[2][2], B1[2][2];
    const char* cA = cur.pa; const char* cB = cur.pb;
    if constexpr (GATHER) S.gather(cur, voA, (const LAS int*)nullptr);
    PG8_STAGE(PG8_SB(0, 0), cB, voffB); PG8_STAGE(PG8_SB(0, 1), cB + hstep, voffB); PG8_STAGE(PG8_SA(0, 0), cA, voA[0]); PG8_STAGE(PG8_SA(0, 1), cA, voA[1]);
    if (wr == 1) PG8_BAR;
    PG8_WAIT_V(2); PG8_BAR;
    PG8_STAGE(PG8_SB(1, 0), cB + kstep, voffB); PG8_STAGE(PG8_SA(1, 0), cA + kstep, voA[0]); PG8_STAGE(PG8_SB(1, 1), cB + hstep + kstep, voffB);
    PG8_WAIT_V(6); PG8_BAR;
    for (;;) {
        const bool has_next = S.next(ui + 1, nxt);
        if constexpr (GATHER) { if (has_next) S.prefetch(nxt, lds + LDS_IDX + ((ui + 1) & 1) * 1024, wid, lane); }
        E.prefetch(cur, lds + LDS_BIAS + (ui & 1) * 1024, wid, lane);
        const char* nA = has_next ? nxt.pa : cA; const char* nB = has_next ? nxt.pb : cB;
        for (int t = 0; t < nt; t += 2) {
            const bool last = (t == nt - 2);
            const char* a1 = cA + (size_t)(t + 1) * kstep;
            const char* a2 = last ? nA : cA + (size_t)(t + 2) * kstep; const char* b2 = last ? nB : cB + (size_t)(t + 2) * kstep;
            const char* a3 = a2 + kstep; const char* b3 = b2 + kstep;
            int fresh; { const int fv = (t == 0 && ui > 0) ? 1 : 0; asm volatile("s_nop 0\n\tv_readfirstlane_b32 %0, %1" : "=s"(fresh) : "v"(fv)); }
            PG8_LDB(B0, 0, 0); PG8_LDB(B1, 0, 1); PG8_SCHED; PG8_LDA(At, 0, 0); PG8_STAGE(PG8_SA(1, 1), a1, voA[1]);
            if constexpr (GATHER) { if (last && has_next) S.gather(nxt, voA, (const LAS int*)(lds + LDS_IDX + ((ui + 1) & 1) * 1024)); }
            PG8_WAIT_V8F(fresh); PG8_WAIT_L(0); PG8_BAR; PG8_MMA(0, 0, At, B0); PG8_MMA(0, 1, At, B1); PG8_BAR; PG8_SCHED;
            PG8_LDA(At, 0, 1); PG8_STAGE(PG8_SB(0, 0), b2, voffB); PG8_STAGE(PG8_SB(0, 1), b2 + hstep, voffB); PG8_STAGE(PG8_SA(0, 0), a2, voA[0]);
            PG8_WAIT_V8F(fresh); PG8_WAIT_L(0); PG8_BAR; PG8_MMA(1, 0, At, B0); PG8_MMA(1, 1, At, B1); PG8_BAR; PG8_SCHED;
            PG8_LDB(B0, 1, 0); PG8_LDB(B1, 1, 1); PG8_SCHED; PG8_LDA(At, 1, 0); PG8_STAGE(PG8_SA(0, 1), a2, voA[1]);
            PG8_WAIT_V(8); PG8_WAIT_L(0); PG8_BAR; PG8_MMA(0, 0, At, B0); PG8_MMA(0, 1, At, B1); PG8_BAR; PG8_SCHED;
            PG8_LDA(At, 1, 1); PG8_STAGE(PG8_SB(1, 0), b3, voffB); PG8_STAGE(PG8_SB(1, 1), b3 + hstep, voffB); PG8_STAGE(PG8_SA(1, 0), a3, voA[0]);
            PG8_WAIT_V(8); PG8_WAIT_L(0); PG8_BAR; PG8_MMA(1, 0, At, B0); PG8_MMA(1, 1, At, B1); PG8_BAR; PG8_SCHED;
        }
        if (wr == 0) PG8_BAR;
        E(acc, cur, wr, wc, fr, fq, lds + LDS_BIAS + (ui & 1) * 1024);
        if (!has_next) break;
#pragma unroll
        for (int a = 0; a < 2; ++a)
#pragma unroll
            for (int b = 0; b < 2; ++b)
#pragma unroll
                for (int m = 0; m < 4; ++m)
#pragma unroll
                    for (int n = 0; n < 2; ++n) acc[a][b][m][n] = (f32x4){0.f, 0.f, 0.f, 0.f};
        cur = nxt; cA = nA; cB = nB; ++ui;
        if (wr == 1) PG8_BAR;
    }
    PG8_WAIT_V(0);
    PG8_BAR;
#undef PG8_SA
#undef PG8_SB
#undef PG8_STAGE
#undef PG8_LDA
#undef PG8_LDB
#undef PG8_MMA
#undef PG8_CAT
#undef PG8_WAIT_V
#undef PG8_WAIT_V8F
#undef PG8_WAIT_L
#undef PG8_BAR
#undef PG8_SCHED
}
}

struct DenseSched {
    const char* A; const char* B; int K, nM, nN, nwg, G, c;
    __device__ __forceinline__ bool next(int i, pg8::Unit& u) const {
        const long L = (long)i * G + c; if (L >= nwg) return false;
        int wgid = (int)L; { const int q = nwg / pg8::NXCD, r = nwg % pg8::NXCD, xcd = wgid % pg8::NXCD, off = wgid / pg8::NXCD; wgid = (xcd < r ? xcd * (q + 1) : r * (q + 1) + (xcd - r) * q) + off; }
        const int nig = pg8::WGM * nN, gid = wgid / nig, fm = gid * pg8::WGM, gsz = (nM - fm) < pg8::WGM ? (nM - fm) : pg8::WGM;
        const int pm = fm + ((wgid % nig) % gsz), pn = (wgid % nig) / gsz;
        u.pa = A + (size_t)pm * 256 * K * 2; u.pb = B + (size_t)pn * 256 * K * 2; u.row0 = pm * 256; u.col0 = pn * 256; u.aux = 0; u.blk = 0; return true;
    }
    __device__ __forceinline__ void gather(const pg8::Unit&, unsigned (&)[2][2], const LAS int*) const {}
    __device__ __forceinline__ void prefetch(const pg8::Unit&, LAS uchar*, int, int) const {}
};
struct MoeSched {
    const LAS int* tab; const char* A; const char* B; size_t bexp; const int* list; int K, nN, G, c;
    __device__ __forceinline__ bool next(int i, pg8::Unit& u) const {
        const int NB = __builtin_amdgcn_readfirstlane(tab[0]); const int L = i * G + c; if (L >= NB * nN) return false;
        const int b = L / nN, pn = L - b * nN, e = __builtin_amdgcn_readfirstlane(tab[64 + b]);
        u.pa = A; u.pb = B + (size_t)e * bexp + (size_t)pn * 256 * K * 2; u.row0 = b * 256; u.col0 = pn * 256; u.aux = e; u.blk = b; return true;
    }
    __device__ __forceinline__ void prefetch(const pg8::Unit& u, LAS uchar* buf, int wid, int lane) const {
        { const int e = u.aux, lb = (u.blk - __builtin_amdgcn_readfirstlane(tab[8 + e])) * 256, w4 = wid & 3;
            __builtin_amdgcn_global_load_lds((const unsigned*)(list + e * T + lb + 64 * w4 + lane), (LAS unsigned*)(buf + w4 * 256), 4, 0, 0); }
    }
    __device__ __forceinline__ void gather(const pg8::Unit& u, unsigned (&vo)[2][2], const LAS int* idx) const {
        const int e = u.aux, lb = (u.blk - __builtin_amdgcn_readfirstlane(tab[8 + e])) * 256, cnt = __builtin_amdgcn_readfirstlane(tab[256 + u.blk]);
#pragma unroll
        for (int i = 0; i < 2; ++i) { int R, C; pg8::stage_rc((int)threadIdx.x * 16 + i * 8192, R, C);
#pragma unroll
            for (int h = 0; h < 2; ++h) { const int r = h * 128 + R; const int raw = idx ? idx[r] : list[e * T + lb + r]; const int tok = (r < cnt) ? raw : 0; vo[h][i] = ((unsigned)tok * (unsigned)K + (unsigned)C) * 2u; } }
    }
};
struct MoeSchedDirect {
    const LAS int* tab; const char* A; const char* B; size_t bexp; int K, nN, G, c;
    __device__ __forceinline__ bool next(int i, pg8::Unit& u) const {
        const int NB = __builtin_amdgcn_readfirstlane(tab[0]); const int L = i * G + c; if (L >= NB * nN) return false;
        const int b = L / nN, pn = L - b * nN, e = __builtin_amdgcn_readfirstlane(tab[64 + b]);
        u.pa = A; u.pb = B + (size_t)e * bexp + (size_t)pn * 256 * K * 2; u.row0 = b * 256; u.col0 = pn * 256; u.aux = e; u.blk = b; return true;
    }
    __device__ __forceinline__ void prefetch(const pg8::Unit&, LAS uchar*, int, int) const {}
    __device__ __forceinline__ void gather(const pg8::Unit& u, unsigned (&vo)[2][2], const LAS int*) const {
#pragma unroll
        for (int i = 0; i < 2; ++i) { int R, C; pg8::stage_rc((int)threadIdx.x * 16 + i * 8192, R, C);
#pragma unroll
            for (int h = 0; h < 2; ++h) vo[h][i] = ((unsigned)(u.row0 + h * 128 + R) * (unsigned)K + (unsigned)C) * 2u; }
    }
};

#define EPI_LANE() int tz = threadIdx.x; asm volatile("" : "+v"(tz)); const int fr = tz & 15, fq = (tz >> 4) & 3; (void)fr_; (void)fq_
struct EpiProj {
    static constexpr int NST = 16, NPF = 0;
    static constexpr int PERM = 8;
    bf16* O; int ldc; const float* COS; const float* SIN;
    __device__ __forceinline__ void prefetch(const pg8::Unit&, LAS uchar*, int, int) const {}
    __device__ __forceinline__ void operator()(const f32x4 (&acc)[2][2][4][2], const pg8::Unit& u, int wr, int wc, int fr_, int fq_, const LAS uchar* bl) const {
        EPI_LANE();
        const int row0 = u.row0 + wr * 64 + fr, col0 = u.col0 + wc * 32 + 8 * fq;
        if (u.col0 < 2048) {
            const float sc = (u.col0 >= 1024) ? 0.0625f : 1.0f; const int i0 = wc * 32 + 8 * fq;
#pragma unroll
            for (int ai = 0; ai < 2; ++ai)
#pragma unroll
                for (int m = 0; m < 4; ++m) { const int t = row0 + ai * 128 + m * 16; bf16* rowp = O + (size_t)t * ldc + col0;
                    const f32x4 c0 = *(const f32x4*)(COS + (size_t)t * 128 + i0), c1 = *(const f32x4*)(COS + (size_t)t * 128 + i0 + 4), s0 = *(const f32x4*)(SIN + (size_t)t * 128 + i0), s1 = *(const f32x4*)(SIN + (size_t)t * 128 + i0 + 4);
                    const f32x4 a0 = acc[ai][0][m][0], a1 = acc[ai][0][m][1], b0 = acc[ai][1][m][0], b1 = acc[ai][1][m][1];
                    const f32x4 p0 = (a0 * c0 - b0 * s0) * sc, p1 = (a1 * c1 - b1 * s1) * sc, q0 = (b0 * c0 + a0 * s0) * sc, q1 = (b1 * c1 + a1 * s1) * sc;
                    u32x4 w; w.x = pk_bf16(p0[0], p0[1]); w.y = pk_bf16(p0[2], p0[3]); w.z = pk_bf16(p1[0], p1[1]); w.w = pk_bf16(p1[2], p1[3]); *(u32x4*)rowp = w;
                    w.x = pk_bf16(q0[0], q0[1]); w.y = pk_bf16(q0[2], q0[3]); w.z = pk_bf16(q1[0], q1[1]); w.w = pk_bf16(q1[2], q1[3]); *(u32x4*)(rowp + 128) = w; }
        } else {
#pragma unroll
            for (int ai = 0; ai < 2; ++ai)
#pragma unroll
                for (int m = 0; m < 4; ++m) { bf16* rowp = O + (size_t)(row0 + ai * 128 + m * 16) * ldc + col0;
#pragma unroll
                    for (int bj = 0; bj < 2; ++bj) { const f32x4 v0 = acc[ai][bj][m][0], v1 = acc[ai][bj][m][1];
                        u32x4 w; w.x = pk_bf16(v0[0], v0[1]); w.y = pk_bf16(v0[2], v0[3]); w.z = pk_bf16(v1[0], v1[1]); w.w = pk_bf16(v1[2], v1[3]);
                        *(u32x4*)(rowp + bj * 128) = w; } }
        }
    }
};
struct EpiOut {
    static constexpr int PERM = 8, NST = 16, NPF = 0;
    const float* X; bf16* Hh;
    __device__ __forceinline__ void prefetch(const pg8::Unit&, LAS uchar*, int, int) const {}
    __device__ __forceinline__ void operator()(const f32x4 (&acc)[2][2][4][2], const pg8::Unit& u, int wr, int wc, int fr_, int fq_, const LAS uchar* bl) const {
        EPI_LANE();
        const int row0 = u.row0 + wr * 64 + fr, col0 = u.col0 + wc * 32 + 8 * fq;
#pragma unroll
        for (int ai = 0; ai < 2; ++ai)
#pragma unroll
            for (int m = 0; m < 4; ++m) { const size_t off = (size_t)(row0 + ai * 128 + m * 16) * D + col0;
#pragma unroll
                for (int bj = 0; bj < 2; ++bj) { const f32x4 x0 = *(const f32x4*)(X + off + bj * 128), x1 = *(const f32x4*)(X + off + bj * 128 + 4);
                    const f32x4 v0 = x0 + acc[ai][bj][m][0], v1 = x1 + acc[ai][bj][m][1];
                    u32x4 w; w.x = pk_bf16(v0[0], v0[1]); w.y = pk_bf16(v0[2], v0[3]); w.z = pk_bf16(v1[0], v1[1]); w.w = pk_bf16(v1[2], v1[3]);
                    *(u32x4*)(Hh + off + bj * 128) = w; } }
    }
};
__device__ __forceinline__ float swiglu_f(float gate, float up) { const float g = fminf(gate, 7.f), u = fminf(fmaxf(up, -7.f), 7.f); return (u + 1.f) * g * __builtin_amdgcn_rcpf(1.f + __builtin_amdgcn_exp2f(-1.702f * 1.44269504f * g)); }
struct EpiGateUp {
    static constexpr int PERM = 17, NST = 8, NPF = 1;
    uchar* ACT; const float* bias;
    __device__ __forceinline__ void prefetch(const pg8::Unit& u, LAS uchar* buf, int wid, int lane) const {
        const int w4 = wid & 3; __builtin_amdgcn_global_load_lds((const unsigned*)(bias + (size_t)u.aux * (2 * DFF) + u.col0 + 64 * w4 + lane), (LAS unsigned*)(buf + w4 * 256), 4, 0, 0); }
    __device__ __forceinline__ void operator()(const f32x4 (&acc)[2][2][4][2], const pg8::Unit& u, int wr, int wc, int fr_, int fq_, const LAS uchar* bl) const {
        EPI_LANE();
        const int row0 = u.row0 + wr * 64 + fr, col0 = u.col0 + wc * 64 + 16 * fq;
        const LAS float* bp = (const LAS float*)bl + wc * 64 + 16 * fq;
        f32x4 bg[2], bu[2];
#pragma unroll
        for (int bj = 0; bj < 2; ++bj) { const f32x4 b0 = *(const LAS f32x4*)(bp + bj * 8), b1 = *(const LAS f32x4*)(bp + bj * 8 + 4);
            bg[bj] = (f32x4){b0.x, b0.z, b1.x, b1.z}; bu[bj] = (f32x4){b0.y, b0.w, b1.y, b1.w}; }
#pragma unroll
        for (int ai = 0; ai < 2; ++ai)
#pragma unroll
            for (int m = 0; m < 4; ++m) { uchar* rowp = ACT + (size_t)(row0 + ai * 128 + m * 16) * DFF + (col0 >> 1);
                u32x2 w;
#pragma unroll
                for (int bj = 0; bj < 2; ++bj) { f32x4 g = acc[ai][bj][m][0] * W8_INV + bg[bj], up = acc[ai][bj][m][1] * W8_INV + bu[bj];
#pragma unroll
                    for (int j = 0; j < 4; ++j) { g[j] = fminf(g[j], 7.f); up[j] = fminf(fmaxf(up[j], -7.f), 7.f); }
                    const f32x4 a = g * (-1.702f * 1.44269504f);
                    f32x4 d;
#pragma unroll
                    for (int j = 0; j < 4; ++j) d[j] = __builtin_amdgcn_exp2f(a[j]);
                    d = d + 1.f;
#pragma unroll
                    for (int j = 0; j < 4; ++j) d[j] = __builtin_amdgcn_rcpf(d[j]);
                    const f32x4 o = (up + 1.f) * (g * d);
                    const unsigned p = pk_fp8x4_nc(o[0], o[1], o[2], o[3]);
                    if (bj == 0) w.x = p; else w.y = p; }
                *(u32x2*)rowp = w; }
    }
};
struct EpiDown {
    static constexpr int PERM = 16, NST = 8, NPF = 1;
    uchar* YR; const float* bias;
    __device__ __forceinline__ void prefetch(const pg8::Unit& u, LAS uchar* buf, int wid, int lane) const {
        const int w4 = wid & 3; __builtin_amdgcn_global_load_lds((const unsigned*)(bias + (size_t)u.aux * D + u.col0 + 64 * w4 + lane), (LAS unsigned*)(buf + w4 * 256), 4, 0, 0); }
    __device__ __forceinline__ void operator()(const f32x4 (&acc)[2][2][4][2], const pg8::Unit& u, int wr, int wc, int fr_, int fq_, const LAS uchar* bl) const {
        EPI_LANE();
        const int row0 = u.row0 + wr * 64 + fr, col0 = u.col0 + wc * 64 + 16 * fq;
        const LAS float* bp = (const LAS float*)bl + wc * 64 + 16 * fq;
        f32x4 bv[2][2];
#pragma unroll
        for (int bj = 0; bj < 2; ++bj)
#pragma unroll
            for (int n = 0; n < 2; ++n) bv[bj][n] = *(const LAS f32x4*)(bp + bj * 8 + 4 * n);
#pragma unroll
        for (int ai = 0; ai < 2; ++ai)
#pragma unroll
            for (int m = 0; m < 4; ++m) { uchar* rowp = YR + (size_t)(row0 + ai * 128 + m * 16) * D + col0;
                const f32x4 v0 = acc[ai][0][m][0] * W8_INV + bv[0][0], v1 = acc[ai][0][m][1] * W8_INV + bv[0][1], v2 = acc[ai][1][m][0] * W8_INV + bv[1][0], v3 = acc[ai][1][m][1] * W8_INV + bv[1][1];
                u32x4 w; w.x = pk_fp8x4(v0[0], v0[1], v0[2], v0[3]); w.y = pk_fp8x4(v1[0], v1[1], v1[2], v1[3]); w.z = pk_fp8x4(v2[0], v2[1], v2[2], v2[3]); w.w = pk_fp8x4(v3[0], v3[1], v3[2], v3[3]);
                *(u32x4*)rowp = w; }
    }
};

#define XB_TMO      128
#define XB_XCNT(j)  (256  + 64 * (j))
#define XB_XSUB(j)  (1280 + 64 * (j))
#define XB_XGEN(j)  (2304 + 64 * (j))
#define XB_TOP      3328
#define XB_TOPGEN   3392
#define XCD_BAR_WORDS 3456
#define XB_SPIN_CAP (1u << 18)
__device__ __forceinline__ unsigned xb_ld(unsigned* p)              { return __hip_atomic_load(p, __ATOMIC_RELAXED, __HIP_MEMORY_SCOPE_AGENT); }
__device__ __forceinline__ unsigned xb_add(unsigned* p, unsigned v) { return __hip_atomic_fetch_add(p, v, __ATOMIC_RELAXED, __HIP_MEMORY_SCOPE_AGENT); }
__device__ __forceinline__ unsigned xb_xcc_id() { return (unsigned)__builtin_amdgcn_s_getreg((3 << 11) | 20) & 0xFu; }
#define XB_SPIN(cond, bar) do { unsigned _sp = 0; while (cond) { __builtin_amdgcn_s_sleep(1); \
    if ((++_sp & 255u) == 0u) { if (xb_ld(&(bar)[XB_TMO])) break; if (_sp > XB_SPIN_CAP) { atomicAdd(&(bar)[XB_TMO], 1u); break; } } } } while (0)
struct XcdBarrier { unsigned* bar; unsigned x; volatile LAS unsigned* st; };
__device__ __forceinline__ XcdBarrier xcd_barrier_post(unsigned* bar, volatile LAS unsigned* st) {
    XcdBarrier b; b.bar = bar; b.x = xb_xcc_id(); b.st = st;
    if (threadIdx.x == 0) (void)xb_add(&bar[XB_XCNT(b.x)], 1u);
    return b;
}
__device__ __forceinline__ void xcd_barrier_complete(unsigned* bar, unsigned x, unsigned& nloc, unsigned& nx) {
    const unsigned G = gridDim.x * gridDim.y * gridDim.z;
    unsigned sum, cnt, mine, sp = 0u;
    for (;;) {
        sum = 0u; cnt = 0u; mine = 0u;
#pragma unroll
        for (unsigned j = 0; j < 16; ++j) { const unsigned c = xb_ld(&bar[XB_XCNT(j)]); sum += c; cnt += (c > 0u) ? 1u : 0u; mine = (j == x) ? c : mine; }
        if (sum == G) break;
        __builtin_amdgcn_s_sleep(1);
        if ((++sp & 255u) == 0u) { if (xb_ld(&bar[XB_TMO])) break; if (sp > XB_SPIN_CAP) { atomicAdd(&bar[XB_TMO], 1u); break; } }
    }
    nloc = mine > 0u ? mine : 1u; nx = cnt > 0u ? cnt : 1u;
}
__device__ __forceinline__ void xcd_barrier(const XcdBarrier& b) {
    asm volatile("s_waitcnt vmcnt(0)" ::: "memory");
    __syncthreads();
    if (threadIdx.x == 0) {
        unsigned* bar = b.bar;
        __builtin_amdgcn_s_waitcnt(0);
        unsigned nloc = b.st[0], nx = b.st[1];
        if (nloc == 0u) { xcd_barrier_complete(bar, b.x, nloc, nx); b.st[0] = nloc; b.st[1] = nx; }
        const unsigned old = xb_add(&bar[XB_XSUB(b.x)], 1u);
        const unsigned gen = old / nloc;
        if (old + 1u == (gen + 1u) * nloc) {
            __builtin_amdgcn_fence(__ATOMIC_RELEASE, "agent");
            asm volatile("s_waitcnt vmcnt(0)" ::: "memory");
            const unsigned og = xb_add(&bar[XB_TOP], 1u);
            const unsigned tg = og / nx;
            if (og + 1u == (tg + 1u) * nx) xb_add(&bar[XB_TOPGEN], 1u);
            else XB_SPIN(xb_ld(&bar[XB_TOPGEN]) == tg, bar);
            __builtin_amdgcn_fence(__ATOMIC_ACQUIRE, "agent");
            xb_add(&bar[XB_XGEN(b.x)], 1u);
            asm volatile("s_waitcnt vmcnt(0)" ::: "memory");
        } else {
            XB_SPIN(xb_ld(&bar[XB_XGEN(b.x)]) == gen, bar);
            __builtin_amdgcn_fence(__ATOMIC_ACQUIRE, "agent");
            asm volatile("s_waitcnt vmcnt(0)" ::: "memory");
        }
    }
    __syncthreads();
}

struct Ctx { LAS uchar* lds; int tid, lane, wave, G, bid; uchar* ws; const void* const* in; float* out; };
#define XP_x(X) ((const float*)(X).in[0])
#define XP_pos(X) ((const int*)(X).in[1])
#define XP_ln_mix_w(X) ((const float*)(X).in[2])
#define XP_w_in(X) ((const float*)(X).in[3])
#define XP_conv_w(X) ((const float*)(X).in[4])
#define XP_conv_b(X) ((const float*)(X).in[5])
#define XP_dt_bias(X) ((const float*)(X).in[6])
#define XP_a_log(X) ((const float*)(X).in[7])
#define XP_d_skip(X) ((const float*)(X).in[8])
#define XP_ssm_norm_w(X) ((const float*)(X).in[9])
#define XP_w_out(X) ((const float*)(X).in[10])
#define XP_ln_ffn_w(X) ((const float*)(X).in[11])
#define XP_w_router(X) ((const float*)(X).in[12])
#define XP_b_router(X) ((const float*)(X).in[13])
#define XP_w_gu(X) ((const float*)(X).in[14])
#define XP_b_gu(X) ((const float*)(X).in[15])
#define XP_w_d(X) ((const float*)(X).in[16])
#define XP_b_d(X) ((const float*)(X).in[17])
#define XP_ln_final_w(X) ((const float*)(X).in[18])
#define XP_WinT(X) ((bf16*)((X).ws + WS_WINT))
#define XP_WoutT(X) ((bf16*)((X).ws + WS_WOUTT))
#define XP_WguT(X) ((uchar*)((X).ws + WS_WGUT))
#define XP_WdT(X) ((uchar*)((X).ws + WS_WDT))
#define XP_U(X) ((bf16*)((X).ws + WS_U))
#define XP_U2(X) ((uchar*)((X).ws + WS_U2))
#define XP_MIX(X) ((bf16*)((X).ws + WS_MIX))
#define XP_XBC(X) ((bf16*)((X).ws + WS_XBC))
#define XP_KV(X) ((bf16*)((X).ws + WS_KV))
#define XP_SST(X) ((bf16*)((X).ws + WS_SST))
#define XP_PROJ(X) ((bf16*)((X).ws + WS_PROJ))
#define XP_ACT(X) ((uchar*)((X).ws + WS_ACT))
#define XP_YR(X) ((uchar*)((X).ws + WS_YR))
#define XP_COS(X) ((float*)((X).ws + WS_COS))
#define XP_SIN(X) ((float*)((X).ws + WS_SIN))
#define XP_Hh(X) ((bf16*)((X).ws + WS_H))
#define XP_ADEC(X) ((float*)((X).ws + WS_ADEC))
#define XP_TOPW(X) ((float*)((X).ws + WS_TOPW))
#define XP_TOPI(X) ((int*)((X).ws + WS_TOPI))
#define XP_TOPR(X) ((int*)((X).ws + WS_TOPR))
#define XP_LIST(X) ((int*)((X).ws + WS_LIST))
#define XP_ctl(X) ((unsigned*)((X).ws + WS_CTL))
#define XP_WRH(X) ((bf16*)((X).ws + WS_WRH))
#define XP_WRL(X) ((bf16*)((X).ws + WS_WRL))


__device__ __forceinline__ bf16x8 tr_frag(LAS uchar* p, int rstep) {
    const s16x4 a = __builtin_amdgcn_ds_read_tr16_b64_v4i16((LAS s16x4*)p);
    const s16x4 b = __builtin_amdgcn_ds_read_tr16_b64_v4i16((LAS s16x4*)(p + rstep));
    return (bf16x8){a[0], a[1], a[2], a[3], b[0], b[1], b[2], b[3]};
}
__device__ __forceinline__ f32x4 mma16(bf16x8 xrow, bf16x8 ycol, f32x4 c) { return __builtin_amdgcn_mfma_f32_16x16x32_bf16(xrow, ycol, c, 0, 0, 0); }
__device__ __forceinline__ float wave_incl_scan(float v, int lane) {
#pragma unroll
    for (int o = 1; o < 64; o <<= 1) { const float t = __shfl_up(v, o); if (lane >= o) v += t; }
    return v;
}
__device__ __forceinline__ void rope8(const u32x4 k1, const u32x4 k2, const f32x4 c0, const f32x4 c1, const f32x4 s0, const f32x4 s1, const float sc, u32x4& o1, u32x4& o2) {
    float r1[8], r2[8];
#pragma unroll
    for (int m = 0; m < 4; ++m) {
        const float a0 = bf_lo(k1[m]), a1 = bf_hi(k1[m]), b0 = bf_lo(k2[m]), b1 = bf_hi(k2[m]);
        const float cs0 = (m < 2) ? c0[2 * m] : c1[2 * m - 4], cs1 = (m < 2) ? c0[2 * m + 1] : c1[2 * m - 3];
        const float sn0 = (m < 2) ? s0[2 * m] : s1[2 * m - 4], sn1 = (m < 2) ? s0[2 * m + 1] : s1[2 * m - 3];
        r1[2 * m] = (a0 * cs0 - b0 * sn0) * sc; r1[2 * m + 1] = (a1 * cs1 - b1 * sn1) * sc;
        r2[2 * m] = (b0 * cs0 + a0 * sn0) * sc; r2[2 * m + 1] = (b1 * cs1 + a1 * sn1) * sc;
    }
    o1.x = pk_bf16(r1[0], r1[1]); o1.y = pk_bf16(r1[2], r1[3]); o1.z = pk_bf16(r1[4], r1[5]); o1.w = pk_bf16(r1[6], r1[7]);
    o2.x = pk_bf16(r2[0], r2[1]); o2.y = pk_bf16(r2[2], r2[3]); o2.z = pk_bf16(r2[4], r2[5]); o2.w = pk_bf16(r2[6], r2[7]);
}

__device__ __forceinline__ void tr_decode(const Ctx& X, int r, const float*& W, bf16*& WT, int& N, int& kb, int& nb) {
    constexpr int I_IN = 32 * 209;
    if (r < I_IN) { W = XP_w_in(X); WT = XP_WinT(X); N = NPROJ; }
    else { r -= I_IN; W = XP_w_out(X); WT = XP_WoutT(X); N = D; }
    const int nbn = (N + 31) >> 5; kb = r / nbn; nb = r - kb * nbn;
}
__device__ __forceinline__ void tr8_item(const float* W, int N, uchar* WT, int kb, int nb, int lane) {
    const int k0 = kb * 128 + 16 * (lane & 7), n0 = nb * 32 + 4 * (lane >> 3);
    f32x4 v[16];
#pragma unroll
    for (int i = 0; i < 16; ++i) v[i] = __builtin_nontemporal_load((const f32x4*)(W + (size_t)(k0 + i) * N + n0));
#pragma unroll
    for (int j = 0; j < 4; ++j) { u32x4 o;
        o.x = pk_fp8x4(v[0][j] * W8_SCALE, v[1][j] * W8_SCALE, v[2][j] * W8_SCALE, v[3][j] * W8_SCALE); o.y = pk_fp8x4(v[4][j] * W8_SCALE, v[5][j] * W8_SCALE, v[6][j] * W8_SCALE, v[7][j] * W8_SCALE);
        o.z = pk_fp8x4(v[8][j] * W8_SCALE, v[9][j] * W8_SCALE, v[10][j] * W8_SCALE, v[11][j] * W8_SCALE); o.w = pk_fp8x4(v[12][j] * W8_SCALE, v[13][j] * W8_SCALE, v[14][j] * W8_SCALE, v[15][j] * W8_SCALE);
        __builtin_nontemporal_store(o, (u32x4*)(WT + (size_t)(n0 + j) * 2048 + k0)); }
}
__device__ __forceinline__ void tr_load(const float* W, int N, int kb, int nb, int lane, f32x4 (&v)[8]) {
    const int k0 = kb * 64 + 8 * (lane & 7), n0 = nb * 32 + 4 * (lane >> 3);
    if (n0 < N) {
#pragma unroll
        for (int i = 0; i < 8; ++i) v[i] = __builtin_nontemporal_load((const f32x4*)(W + (size_t)(k0 + i) * N + n0));
    }
}
__device__ __forceinline__ void tr_store(bf16* WT, int N, int kb, int nb, int lane, const f32x4 (&v)[8]) {
    const int k0 = kb * 64 + 8 * (lane & 7), n0 = nb * 32 + 4 * (lane >> 3);
    if (n0 < N) {
#pragma unroll
        for (int j = 0; j < 4; ++j) { u32x4 o; o.x = pk_bf16(v[0][j], v[1][j]); o.y = pk_bf16(v[2][j], v[3][j]); o.z = pk_bf16(v[4][j], v[5][j]); o.w = pk_bf16(v[6][j], v[7][j]);
            *(u32x4*)(WT + (size_t)(n0 + j) * 2048 + k0) = o; }
    }
}
constexpr int I_GU8 = 32 * 16 * 128, I_D8 = 32 * 16 * 64, I_ALL8 = I_GU8 + I_D8;
__device__ __forceinline__ void conv8_id(const Ctx& X, int it, int lane) {
    if (it < I_GU8) { const int e = it >> 11, r = it & 2047; tr8_item(XP_w_gu(X) + (size_t)e * D * (2 * DFF), 2 * DFF, XP_WguT(X) + (size_t)e * (2 * DFF) * D, r >> 7, r & 127, lane); }
    else { const int i2 = it - I_GU8, e = i2 >> 10, r = i2 & 1023; tr8_item(XP_w_d(X) + (size_t)e * DFF * D, D, XP_WdT(X) + (size_t)e * D * DFF, r >> 6, r & 63, lane); }
}
constexpr int FILL_N1 = 0, FILL_W1 = 160 * 8, FILL_N3 = 3, FILL_W3 = 64 * 8, FILL_N4 = 11, FILL_W4 = 128 * 8;
constexpr int P1_GEMM_BLOCKS = 144, WQ_CHUNK = 8;
constexpr int P5_GEMM_BLOCKS = 128, Q5_N = 28, Q5_W = 128 * 8;
constexpr int FILL_B1 = I_ALL8 - FILL_N1 * FILL_W1 - FILL_N3 * FILL_W3 - FILL_N4 * FILL_W4, FILL_B3 = FILL_B1 + FILL_N1 * FILL_W1, FILL_B4 = FILL_B3 + FILL_N3 * FILL_W3;
constexpr int Q5_BASE = FILL_B3 - Q5_N * Q5_W;
constexpr int CVT_STRIDE = 144, CVT_BUF = 256 * CVT_STRIDE, CQ_CHUNK = 4;
struct Cvb { const float* W; uchar* WT; int N; };
__device__ __forceinline__ Cvb conv8b_dec(const Ctx& X, int bit) { Cvb c; int kb, nb;
    if (bit < I_GU8 / 8) { const int e = bit >> 8, r = bit & 255; kb = r >> 4; nb = r & 15; c.N = 2 * DFF; c.W = XP_w_gu(X) + (size_t)e * D * (2 * DFF); c.WT = XP_WguT(X) + (size_t)e * (2 * DFF) * D; }
    else { const int b2 = bit - I_GU8 / 8, e = b2 >> 7, r = b2 & 127; kb = r >> 3; nb = r & 7; c.N = D; c.W = XP_w_d(X) + (size_t)e * DFF * D; c.WT = XP_WdT(X) + (size_t)e * D * DFF; }
    c.W += (size_t)(kb * 128 + 16 * X.wave) * c.N + nb * 256 + 4 * X.lane;
    c.WT += (size_t)(nb * 256 + 32 * X.wave + (X.lane >> 3)) * 2048 + kb * 128 + 16 * (X.lane & 7);
    return c; }
__device__ __forceinline__ void conv8b_ld(const Cvb& c, f32x4 (&v)[16]) {
#pragma unroll
    for (int i = 0; i < 16; ++i) v[i] = __builtin_nontemporal_load((const f32x4*)(c.W + (size_t)i * c.N)); }
__device__ __forceinline__ void conv8b_put(const Ctx& X, LAS uchar* buf, const f32x4 (&v)[16]) {
#pragma unroll
    for (int q = 0; q < 4; ++q) { u32x4 o;
        o.x = pk_fp8x4(v[0][q] * W8_SCALE, v[1][q] * W8_SCALE, v[2][q] * W8_SCALE, v[3][q] * W8_SCALE); o.y = pk_fp8x4(v[4][q] * W8_SCALE, v[5][q] * W8_SCALE, v[6][q] * W8_SCALE, v[7][q] * W8_SCALE);
        o.z = pk_fp8x4(v[8][q] * W8_SCALE, v[9][q] * W8_SCALE, v[10][q] * W8_SCALE, v[11][q] * W8_SCALE); o.w = pk_fp8x4(v[12][q] * W8_SCALE, v[13][q] * W8_SCALE, v[14][q] * W8_SCALE, v[15][q] * W8_SCALE);
        *(LAS u32x4*)(buf + (4 * X.lane + q) * CVT_STRIDE + 16 * X.wave) = o; } }
__device__ __forceinline__ void conv8b_get(const Ctx& X, const LAS uchar* buf, const Cvb& c) {
    asm volatile("s_waitcnt lgkmcnt(0)" ::: "memory"); __builtin_amdgcn_s_barrier();
#pragma unroll
    for (int it = 0; it < 4; ++it) { const u32x4 r = *(const LAS u32x4*)(buf + (32 * X.wave + 8 * it + (X.lane >> 3)) * CVT_STRIDE + 16 * (X.lane & 7));
        __builtin_nontemporal_store(r, (u32x4*)(c.WT + (size_t)it * 8 * 2048)); } }
__device__ __forceinline__ void conv8b_run(const Ctx& X, int first, int step, int count) {
    if (count <= 0) return;
    f32x4 va[16], vb[16];
    Cvb ca = conv8b_dec(X, first), cb = ca;
    conv8b_ld(ca, va);
    int j = 0;
    for (;;) {
        const bool hb = j + 1 < count;
        if (hb) { cb = conv8b_dec(X, first + (j + 1) * step); conv8b_ld(cb, vb); }
        conv8b_put(X, X.lds, va); conv8b_get(X, X.lds, ca);
        if (!hb) break;
        const bool ha = j + 2 < count;
        if (ha) { ca = conv8b_dec(X, first + (j + 2) * step); conv8b_ld(ca, va); }
        conv8b_put(X, X.lds + CVT_BUF, vb); conv8b_get(X, X.lds + CVT_BUF, cb);
        if (!ha) break;
        j += 2;
    }
    asm volatile("s_waitcnt lgkmcnt(0)" ::: "memory"); __builtin_amdgcn_s_barrier();
}
__device__ __forceinline__ void conv8_fill(const Ctx& X, int base, int rank, int nblk, int n) { conv8b_run(X, (base >> 3) + rank, nblk, n); }
__device__ __forceinline__ void conv8_queue(const Ctx& X, int n) {
    LAS int* qw = (LAS int*)(X.lds + LDS_MISC + 64);
    unsigned zo = 0; asm volatile("" : "+v"(zo));
    int nb_ = 0;
    if (X.tid == 0) nb_ = (int)__hip_atomic_fetch_add(XP_ctl(X) + CW_WQ + zo, (unsigned)(8 * CQ_CHUNK), __ATOMIC_RELAXED, __HIP_MEMORY_SCOPE_AGENT);
    for (;;) {
        if (X.tid == 0) *qw = nb_;
        __syncthreads();
        const int base = __builtin_amdgcn_readfirstlane(*qw);
        if (base >= n) break;
        if (X.tid == 0) nb_ = (int)__hip_atomic_fetch_add(XP_ctl(X) + CW_WQ + zo, (unsigned)(8 * CQ_CHUNK), __ATOMIC_RELAXED, __HIP_MEMORY_SCOPE_AGENT);
        const int left = (n - base) >> 3;
        conv8b_run(X, base >> 3, 1, left < CQ_CHUNK ? left : CQ_CHUNK);
    }
}
__device__ __forceinline__ void p0_prologue(Ctx& X) {
    const int gw = X.bid * NWAVES + X.wave, NGW = X.G * NWAVES, lane = X.lane;
    const int gt = X.bid * NTHR + X.tid, NGT = X.G * NTHR;
    for (int m = gw; m < T; m += NGW) {
        const f32x4* xr = (const f32x4*)(XP_x(X) + (size_t)m * D) + lane; const f32x4* wr_ = (const f32x4*)XP_ln_mix_w(X) + lane;
        f32x4 v[8]; float s = 0.f;
#pragma unroll
        for (int j = 0; j < 8; ++j) { v[j] = xr[64 * j]; s += (v[j].x * v[j].x + v[j].y * v[j].y) + (v[j].z * v[j].z + v[j].w * v[j].w); }
        const float rstd = rsqrtf(wave_sum(s) * (1.f / D) + EPS);
        u32x2* o8 = (u32x2*)(XP_U(X) + (size_t)m * D) + lane;
#pragma unroll
        for (int j = 0; j < 8; ++j) { const f32x4 w = wr_[64 * j]; u32x2 o; o.x = pk_bf16(v[j].x * rstd * w.x, v[j].y * rstd * w.y); o.y = pk_bf16(v[j].z * rstd * w.z, v[j].w * rstd * w.w); o8[64 * j] = o; }
    }
    for (int idx = gt; idx < T * 128; idx += NGT) {
        const int t = idx >> 7, i = idx & 127;
        const double ang = (double)XP_pos(X)[t] * INV_FREQ[i];
        double rev = ang * 0.15915494309189533577; rev -= floor(rev);
        const float f = (float)rev;
        XP_COS(X)[idx] = __builtin_amdgcn_cosf(f); XP_SIN(X)[idx] = __builtin_amdgcn_sinf(f);
    }
    { u32x4* p = (u32x4*)(XP_WinT(X) + (size_t)NPROJ * D); const int n16 = (LDP - NPROJ) * D * 2 / 16; const u32x4 z = {0u, 0u, 0u, 0u};
      for (int i = gt; i < n16; i += NGT) p[i] = z; }
    for (int idx = gt; idx < NE * D; idx += NGT) { const int e = idx >> 11, d = idx & 2047;
        const float wv = XP_ln_ffn_w(X)[d] * XP_w_router(X)[d * NE + e]; const unsigned hb = pk_bf16(wv, 0.f) & 0xffffu; const float lo = wv - __uint_as_float(hb << 16);
        XP_WRH(X)[idx] = (bf16)hb; XP_WRL(X)[idx] = (bf16)(pk_bf16(lo, 0.f) & 0xffffu); }
    constexpr int NIT = 32 * 209 + 32 * 64;
    for (int it = gw; it < NIT; it += 2 * NGW) {
        const float *W0, *W1 = nullptr; bf16 *T0, *T1 = nullptr; int N0, N1 = 0, kb0, kb1 = 0, nb0, nb1 = 0;
        f32x4 v0[8], v1[8];
        tr_decode(X, it, W0, T0, N0, kb0, nb0);
        const bool two = (it + NGW) < NIT;
        if (two) tr_decode(X, it + NGW, W1, T1, N1, kb1, nb1);
        tr_load(W0, N0, kb0, nb0, lane, v0);
        if (two) tr_load(W1, N1, kb1, nb1, lane, v1);
        tr_store(T0, N0, kb0, nb0, lane, v0);
        if (two) tr_store(T1, N1, kb1, nb1, lane, v1);
    }
}

__device__ __forceinline__ bf16x8 scale_frag(const bf16x8 f, const float base, const float (&rr)[8]) {
    u32x4 u = __builtin_bit_cast(u32x4, f);
    u.x = pk_bf16(bf_lo(u.x) * (base * rr[0]), bf_hi(u.x) * (base * rr[1])); u.y = pk_bf16(bf_lo(u.y) * (base * rr[2]), bf_hi(u.y) * (base * rr[3]));
    u.z = pk_bf16(bf_lo(u.z) * (base * rr[4]), bf_hi(u.z) * (base * rr[5])); u.w = pk_bf16(bf_lo(u.w) * (base * rr[6]), bf_hi(u.w) * (base * rr[7]));
    return __builtin_bit_cast(bf16x8, u);
}
__device__ __forceinline__ void p2_ret(Ctx& X, int unit) {
    const int c = unit >> 2, h = unit & 3, t0 = c * CH, tid = X.tid, lane = X.lane, w = X.wave;
    LAS uchar* Vt = X.lds; LAS uchar* Kt = X.lds + 69632;
    { u32x4 vv[8], kk[8];
#pragma unroll
      for (int i = 0; i < 8; ++i) { const int q = tid + 512 * i, l = q >> 5, vc = q & 31; const bf16* rp = XP_PROJ(X) + (size_t)(t0 + l) * LDP + h * 256 + vc * 8;
          vv[i] = *(const u32x4*)(rp + C_V); kk[i] = *(const u32x4*)(rp + C_K); }
#pragma unroll
      for (int i = 0; i < 8; ++i) { const int q = tid + 512 * i, l = q >> 5, vc = q & 31; *(LAS u32x4*)(Vt + l * 544 + vc * 16) = vv[i]; *(LAS u32x4*)(Kt + l * 544 + vc * 16) = kk[i]; } }
    __syncthreads();
    const float lg = LG2_GAMMA[h];
    float rr[8];
#pragma unroll
    for (int e = 0; e < 8; ++e) rr[e] = exp2f(-lg * (float)e);
    const int fr = lane & 15, fq = lane >> 4, trs = (8 * fq + ((lane & 15) >> 2)) * 544 + 8 * (lane & 3);
    f32x4 acc[2][16];
#pragma unroll
    for (int a = 0; a < 2; ++a)
#pragma unroll
        for (int n = 0; n < 16; ++n) acc[a][n] = (f32x4){0.f, 0.f, 0.f, 0.f};
#pragma unroll 1
    for (int ks = 0; ks < 4; ++ks) {
        const float base = exp2f(lg * (float)(127 - 32 * ks - 8 * fq));
        const bf16x8 af0 = scale_frag(tr_frag(Vt + (32 * ks) * 544 + (16 * w) * 2 + trs, 4 * 544), base, rr);
        const bf16x8 af1 = scale_frag(tr_frag(Vt + (32 * ks) * 544 + (128 + 16 * w) * 2 + trs, 4 * 544), base, rr);
#pragma unroll
        for (int n = 0; n < 16; ++n) { const bf16x8 bf = tr_frag(Kt + (32 * ks) * 544 + (16 * n) * 2 + trs, 4 * 544);
            acc[0][n] = mma16(bf, af0, acc[0][n]); acc[1][n] = mma16(bf, af1, acc[1][n]); }
    }
    bf16* outp = XP_KV(X) + (size_t)(c * 4 + h) * 65536;
#pragma unroll
    for (int a = 0; a < 2; ++a)
#pragma unroll
        for (int n = 0; n < 16; ++n) { u32x2 o; o.x = pk_bf16(acc[a][n][0], acc[a][n][1]); o.y = pk_bf16(acc[a][n][2], acc[a][n][3]);
            *(u32x2*)(outp + (size_t)(128 * a + 16 * w + fr) * 256 + 16 * n + 4 * fq) = o; }
    __syncthreads();
}
__device__ __forceinline__ void conv8(const Ctx& X, int t, int cx, float (&o)[8]) {
    const f32x4 b0 = *(const f32x4*)(XP_conv_b(X) + cx), b1 = *(const f32x4*)(XP_conv_b(X) + cx + 4);
    o[0] = b0.x; o[1] = b0.y; o[2] = b0.z; o[3] = b0.w; o[4] = b1.x; o[5] = b1.y; o[6] = b1.z; o[7] = b1.w;
#pragma unroll
    for (int j = 0; j < 4; ++j) { const int tt = t - 3 + j;
        if (tt >= 0) { const u32x4 v = *(const u32x4*)(XP_PROJ(X) + (size_t)tt * LDP + C_X + cx);
            const f32x4 w0 = *(const f32x4*)(XP_conv_w(X) + j * XBCW + cx), w1 = *(const f32x4*)(XP_conv_w(X) + j * XBCW + cx + 4);
            o[0] += w0.x * bf_lo(v.x); o[1] += w0.y * bf_hi(v.x); o[2] += w0.z * bf_lo(v.y); o[3] += w0.w * bf_hi(v.y);
            o[4] += w1.x * bf_lo(v.z); o[5] += w1.y * bf_hi(v.z); o[6] += w1.z * bf_lo(v.w); o[7] += w1.w * bf_hi(v.w); } }
#pragma unroll
    for (int i = 0; i < 8; ++i) o[i] = silu_f(o[i]);
}
__device__ __forceinline__ void p2_ssd(Ctx& X, int unit) {
    const int c = unit >> 2, g = (unit >> 1) & 1, hh = unit & 1, t0 = c * CH, tid = X.tid, lane = X.lane, w = X.wave;
    LAS uchar* Xd = X.lds; LAS uchar* Bc = X.lds + 69632;
    LAS float* dtS = (LAS float*)(X.lds + 106496); LAS float* acS = (LAS float*)(X.lds + 108544);
    if (w < 4) { const int h = 8 * g + 4 * hh + w, l0 = 2 * lane;
        const float dtb = XP_dt_bias(X)[h], A = -expf(XP_a_log(X)[h]);
        const float d0 = softplus_f(bf2f(XP_PROJ(X)[(size_t)(t0 + l0) * LDP + C_DT + h]) + dtb), d1 = softplus_f(bf2f(XP_PROJ(X)[(size_t)(t0 + l0 + 1) * LDP + C_DT + h]) + dtb);
        const float a0 = d0 * A, a1 = d1 * A, s = a0 + a1, incl = wave_incl_scan(s, lane);
        dtS[w * 128 + l0] = d0; dtS[w * 128 + l0 + 1] = d1; acS[w * 128 + l0] = incl - a1; acS[w * 128 + l0 + 1] = incl;
        if (lane == 63) XP_ADEC(X)[c * 16 + h] = expf(incl); }
    __syncthreads();
    if (tid < 504) { const int rg = tid / 56, j = tid - rg * 56, l0 = 15 * rg;
        int cx; if (j < 32) cx = 512 * g + 256 * hh + 8 * j; else if (j < 48) cx = 1024 + 128 * g + 8 * (j - 32); else cx = 1280 + 128 * g + 64 * hh + 8 * (j - 48);
        u32x4 rw[18];
#pragma unroll
        for (int r = 0; r < 18; ++r) { const int l = l0 - 3 + r, tt = t0 + l; rw[r] = (tt >= 0 && l < 128) ? *(const u32x4*)(XP_PROJ(X) + (size_t)tt * LDP + C_X + cx) : (u32x4){0u, 0u, 0u, 0u}; }
        f32x4 wa[4], wb[4];
#pragma unroll
        for (int k = 0; k < 4; ++k) { wa[k] = *(const f32x4*)(XP_conv_w(X) + k * XBCW + cx); wb[k] = *(const f32x4*)(XP_conv_w(X) + k * XBCW + cx + 4); }
        const f32x4 ba = *(const f32x4*)(XP_conv_b(X) + cx), bb = *(const f32x4*)(XP_conv_b(X) + cx + 4);
#pragma unroll
        for (int r = 0; r < 15; ++r) { const int l = l0 + r;
            if (l < 128) { float o[8] = {ba.x, ba.y, ba.z, ba.w, bb.x, bb.y, bb.z, bb.w};
#pragma unroll
                for (int k = 0; k < 4; ++k) { const u32x4 v = rw[r + k];
                    o[0] += wa[k].x * bf_lo(v.x); o[1] += wa[k].y * bf_hi(v.x); o[2] += wa[k].z * bf_lo(v.y); o[3] += wa[k].w * bf_hi(v.y);
                    o[4] += wb[k].x * bf_lo(v.z); o[5] += wb[k].y * bf_hi(v.z); o[6] += wb[k].z * bf_lo(v.w); o[7] += wb[k].w * bf_hi(v.w); }
#pragma unroll
                for (int i = 0; i < 8; ++i) o[i] = silu_f(o[i]);
                u32x4 ov; ov.x = pk_bf16(o[0], o[1]); ov.y = pk_bf16(o[2], o[3]); ov.z = pk_bf16(o[4], o[5]); ov.w = pk_bf16(o[6], o[7]);
                if (j < 32) { const int e = j >> 3; const float sc = dtS[e * 128 + l] * __expf(acS[e * 128 + 127] - acS[e * 128 + l]);
                    u32x4 os; os.x = pk_bf16(o[0] * sc, o[1] * sc); os.y = pk_bf16(o[2] * sc, o[3] * sc); os.z = pk_bf16(o[4] * sc, o[5] * sc); os.w = pk_bf16(o[6] * sc, o[7] * sc);
                    *(LAS u32x4*)(Xd + l * 544 + j * 16) = os; *(u32x4*)(XP_XBC(X) + (size_t)(t0 + l) * XBCW + cx) = ov; }
                else if (j < 48) { *(LAS u32x4*)(Bc + l * 288 + (j - 32) * 16) = ov; if (hh == 0) *(u32x4*)(XP_XBC(X) + (size_t)(t0 + l) * XBCW + cx) = ov; }
                else *(u32x4*)(XP_XBC(X) + (size_t)(t0 + l) * XBCW + cx) = ov; } } }
    __syncthreads();
    const int fr = lane & 15, fq = lane >> 4, q4 = (lane & 15) >> 2, p4 = lane & 3;
    const int trx = (8 * fq + q4) * 544 + 8 * p4, trb = (8 * fq + q4) * 288 + 8 * p4;
    f32x4 acc[2][8];
#pragma unroll
    for (int a = 0; a < 2; ++a)
#pragma unroll
        for (int n = 0; n < 8; ++n) acc[a][n] = (f32x4){0.f, 0.f, 0.f, 0.f};
#pragma unroll 1
    for (int ks = 0; ks < 4; ++ks) {
        const bf16x8 af0 = tr_frag(Xd + (32 * ks) * 544 + (16 * w) * 2 + trx, 4 * 544);
        const bf16x8 af1 = tr_frag(Xd + (32 * ks) * 544 + (128 + 16 * w) * 2 + trx, 4 * 544);
#pragma unroll
        for (int n = 0; n < 8; ++n) { const bf16x8 bf = tr_frag(Bc + (32 * ks) * 288 + (16 * n) * 2 + trb, 4 * 288);
            acc[0][n] = mma16(bf, af0, acc[0][n]); acc[1][n] = mma16(bf, af1, acc[1][n]); }
    }
#pragma unroll
    for (int a = 0; a < 2; ++a) { const int m = 128 * a + 16 * w + fr, h = 8 * g + 4 * hh + (m >> 6), p = m & 63;
        bf16* outp = XP_SST(X) + ((size_t)(c * 16 + h) * 64 + p) * 128;
#pragma unroll
        for (int n = 0; n < 8; ++n) { u32x2 o; o.x = pk_bf16(acc[a][n][0], acc[a][n][1]); o.y = pk_bf16(acc[a][n][2], acc[a][n][3]); *(u32x2*)(outp + 16 * n + 4 * fq) = o; } }
    __syncthreads();
}

__device__ __forceinline__ void p3_scan(Ctx& X) {
    const int gt = X.bid * NTHR + X.tid, NGT = X.G * NTHR;
    for (int item = gt; item < 65536 + 32768; item += NGT) {
        const bool ret = item < 65536; const int it2 = ret ? item : item - 65536;
        bf16* p = ret ? (XP_KV(X) + (size_t)it2 * 4) : (XP_SST(X) + (size_t)it2 * 4);
        const size_t stride = ret ? 262144 : 131072;
        const int head = ret ? (it2 >> 14) : (it2 >> 11);
        const float gdec = ret ? GAMMA_CHUNK[head & 3] : 0.f;
        float s0 = 0.f, s1 = 0.f, s2 = 0.f, s3 = 0.f;
        for (int c0 = 0; c0 < NCHUNK; c0 += 16) {
            u32x2 v[16]; float dec[16];
#pragma unroll
            for (int j = 0; j < 16; ++j) { v[j] = *(const u32x2*)(p + (size_t)(c0 + j) * stride); dec[j] = ret ? gdec : XP_ADEC(X)[(c0 + j) * 16 + head]; }
#pragma unroll
            for (int j = 0; j < 16; ++j) { u32x2 o; o.x = pk_bf16(s0, s1); o.y = pk_bf16(s2, s3); *(u32x2*)(p + (size_t)(c0 + j) * stride) = o;
                s0 = dec[j] * s0 + bf_lo(v[j].x); s1 = dec[j] * s1 + bf_hi(v[j].x); s2 = dec[j] * s2 + bf_lo(v[j].y); s3 = dec[j] * s3 + bf_hi(v[j].y); }
        }
    }
}

__device__ __forceinline__ void p4_ret(Ctx& X, int unit) {
    const int c = unit >> 2, h = unit & 3, t0 = c * CH, tid = X.tid, lane = X.lane, w = X.wave;
    LAS uchar* R1 = X.lds; LAS uchar* R2 = X.lds + 69632;
    const float lg = LG2_GAMMA[h];
    u32x4 P[8];
    { u32x4 qq[8];
#pragma unroll
      for (int i = 0; i < 8; ++i) { const int q = tid + 512 * i, l = q >> 5, dc = q & 31; const bf16* rp = XP_PROJ(X) + (size_t)(t0 + l) * LDP + h * 256 + dc * 8;
          qq[i] = *(const u32x4*)(rp + C_Q); P[i] = *(const u32x4*)(rp + C_K); }
#pragma unroll
      for (int i = 0; i < 8; ++i) { const int q = tid + 512 * i, l = q >> 5, dc = q & 31; *(LAS u32x4*)(R1 + l * 544 + dc * 16) = qq[i]; *(LAS u32x4*)(R2 + l * 544 + dc * 16) = P[i]; } }
    __syncthreads();
    const bf16* prev = XP_KV(X) + (size_t)(c * 4 + h) * 65536;
#pragma unroll
    for (int i = 0; i < 8; ++i) { const int q = tid + 512 * i, v = q >> 4, dc = q & 15; P[i] = *(const u32x4*)(prev + (size_t)v * 256 + dc * 8); }
    const int fr = lane & 15, fq = lane >> 4, q4 = (lane & 15) >> 2, p4 = lane & 3, l = 16 * w + fr;
    f32x4 sc[8];
#pragma unroll
    for (int n = 0; n < 8; ++n) sc[n] = (f32x4){0.f, 0.f, 0.f, 0.f};
#pragma unroll 2
    for (int ks = 0; ks < 8; ++ks) {
        const bf16x8 af = *(const LAS bf16x8*)(R1 + l * 544 + (32 * ks + 8 * fq) * 2);
#pragma unroll
        for (int n = 0; n < 8; ++n) if (n <= w) { const bf16x8 bf = *(const LAS bf16x8*)(R2 + (16 * n + fr) * 544 + (32 * ks + 8 * fq) * 2); sc[n] = mma16(bf, af, sc[n]); }
    }
    bf16x8 scf[4];
#pragma unroll
    for (int k2 = 0; k2 < 4; ++k2) { float v[8];
#pragma unroll
        for (int tq = 0; tq < 2; ++tq)
#pragma unroll
            for (int j = 0; j < 4; ++j) { const int s = 16 * (2 * k2 + tq) + 4 * fq + j; v[4 * tq + j] = (s <= l) ? sc[2 * k2 + tq][j] * exp2f(lg * (float)(l - s)) : 0.f; }
        u32x4 pk; pk.x = pk_bf16(v[0], v[1]); pk.y = pk_bf16(v[2], v[3]); pk.z = pk_bf16(v[4], v[5]); pk.w = pk_bf16(v[6], v[7]);
        scf[k2] = __builtin_bit_cast(bf16x8, pk); }
    __syncthreads();
    f32x4 acc[16];
#pragma unroll
    for (int n = 0; n < 16; ++n) acc[n] = (f32x4){0.f, 0.f, 0.f, 0.f};
#pragma unroll
    for (int dh = 0; dh < 2; ++dh) {
#pragma unroll
        for (int i = 0; i < 8; ++i) { const int q = tid + 512 * i, v = q >> 4, dc = q & 15; *(LAS u32x4*)(R2 + v * 272 + dc * 16) = P[i]; }
        __syncthreads();
        if (dh == 0) {
#pragma unroll
            for (int i = 0; i < 8; ++i) { const int q = tid + 512 * i, v = q >> 4, dc = q & 15; P[i] = *(const u32x4*)(prev + (size_t)v * 256 + 128 + dc * 8); }
        } else {
#pragma unroll
            for (int i = 0; i < 8; ++i) { const int q = tid + 512 * i, s_ = q >> 5, vc = q & 31; P[i] = *(const u32x4*)(XP_PROJ(X) + (size_t)(t0 + s_) * LDP + C_V + h * 256 + vc * 8); }
        }
#pragma unroll 2
        for (int ks = 0; ks < 4; ++ks) {
            const bf16x8 af = *(const LAS bf16x8*)(R1 + l * 544 + (128 * dh + 32 * ks + 8 * fq) * 2);
#pragma unroll
            for (int n = 0; n < 16; ++n) { const bf16x8 bf = *(const LAS bf16x8*)(R2 + (16 * n + fr) * 272 + (32 * ks + 8 * fq) * 2); acc[n] = mma16(bf, af, acc[n]); }
        }
        __syncthreads();
    }
    { const float qd = exp2f(lg * (float)(l + 1));
#pragma unroll
      for (int n = 0; n < 16; ++n) acc[n] = acc[n] * qd; }
#pragma unroll
    for (int i = 0; i < 8; ++i) { const int q = tid + 512 * i, s_ = q >> 5, vc = q & 31; *(LAS u32x4*)(R2 + s_ * 544 + vc * 16) = P[i]; }
    __syncthreads();
    const bf16* gp = XP_PROJ(X) + (size_t)(t0 + l) * LDP + C_G + h * 256 + 4 * fq; bf16* op = XP_MIX(X) + (size_t)(t0 + l) * D + h * 256 + 4 * fq;
    u32x2 gv[16];
#pragma unroll
    for (int n = 0; n < 16; ++n) gv[n] = *(const u32x2*)(gp + 16 * n);
    const int trp = (4 * fq + q4) * 544 + 8 * p4;
#pragma unroll
    for (int k2 = 0; k2 < 4; ++k2) if (2 * k2 <= w) {
#pragma unroll
        for (int n = 0; n < 16; ++n) { const bf16x8 bf = tr_frag(R2 + (32 * k2) * 544 + (16 * n) * 2 + trp, 16 * 544); acc[n] = mma16(bf, scf[k2], acc[n]); }
    }
    float ss = 0.f;
#pragma unroll
    for (int n = 0; n < 16; ++n) ss += (acc[n][0] * acc[n][0] + acc[n][1] * acc[n][1]) + (acc[n][2] * acc[n][2] + acc[n][3] * acc[n][3]);
    ss += __shfl_xor(ss, 16); ss += __shfl_xor(ss, 32);
    const float rstd = rsqrtf(ss * (1.f / 256.f) + EPS);
#pragma unroll
    for (int n = 0; n < 16; ++n) {
        u32x2 o; o.x = pk_bf16(acc[n][0] * rstd * silu_f(bf_lo(gv[n].x)), acc[n][1] * rstd * silu_f(bf_hi(gv[n].x))); o.y = pk_bf16(acc[n][2] * rstd * silu_f(bf_lo(gv[n].y)), acc[n][3] * rstd * silu_f(bf_hi(gv[n].y)));
        *(u32x2*)(op + 16 * n) = o; }
    __syncthreads();
}

__device__ __forceinline__ void p4_ssd(Ctx& X, int unit) {
    const int c = unit >> 1, g = unit & 1, t0 = c * CH, tid = X.tid, lane = X.lane, w = X.wave;
    LAS uchar* Cc = X.lds; LAS uchar* Bc = X.lds + 34816;
    LAS uchar* HP = X.lds + 34816;
    LAS float* dtS = (LAS float*)(X.lds + 110592); LAS float* acS = (LAS float*)(X.lds + 114688);
    const int fr = lane & 15, fq = lane >> 4, q4 = (lane & 15) >> 2, p4 = lane & 3, l = 16 * w + fr;
    const bf16* zp = XP_PROJ(X) + (size_t)(t0 + l) * LDP + C_Z + 512 * g + 4 * fq;
    const int hd = 8 * g + w, l0 = 2 * lane;
    const bf16 dr0 = XP_PROJ(X)[(size_t)(t0 + l0) * LDP + C_DT + hd], dr1 = XP_PROJ(X)[(size_t)(t0 + l0 + 1) * LDP + C_DT + hd];
    u32x4 bcv[8];
#pragma unroll
    for (int i = 0; i < 4; ++i) { const int q = tid + 512 * i, l_ = q >> 4, nc = q & 15;
        bcv[2 * i] = *(const u32x4*)(XP_XBC(X) + (size_t)(t0 + l_) * XBCW + 1024 + 128 * g + nc * 8);
        bcv[2 * i + 1] = *(const u32x4*)(XP_XBC(X) + (size_t)(t0 + l_) * XBCW + 1280 + 128 * g + nc * 8); }
    u32x4 px[4], ps[4];
#pragma unroll
    for (int i = 0; i < 4; ++i) { const int q = tid + 512 * i; { const int e2 = q >> 10, s_ = (q >> 3) & 127, pc = q & 7; px[i] = *(const u32x4*)(XP_XBC(X) + (size_t)(t0 + s_) * XBCW + 512 * g + 64 * e2 + pc * 8); }
        { const int e2 = q >> 10, p = (q >> 4) & 63, nc = q & 15; ps[i] = *(const u32x4*)(XP_SST(X) + ((size_t)(c * 16 + 8 * g + e2) * 64 + p) * 128 + nc * 8); } }
    u32x2 zq[2][4];
#pragma unroll
    for (int e2 = 0; e2 < 2; ++e2)
#pragma unroll
        for (int n = 0; n < 4; ++n) zq[e2][n] = *(const u32x2*)(zp + 64 * e2 + 16 * n);
    { const float dtb = XP_dt_bias(X)[hd], A = -expf(XP_a_log(X)[hd]);
      const float d0 = softplus_f(bf2f(dr0) + dtb), d1 = softplus_f(bf2f(dr1) + dtb);
      const float a0 = d0 * A, a1 = d1 * A, incl = wave_incl_scan(a0 + a1, lane);
      dtS[w * 128 + l0] = d0; dtS[w * 128 + l0 + 1] = d1; acS[w * 128 + l0] = incl - a1; acS[w * 128 + l0 + 1] = incl; }
#pragma unroll
    for (int i = 0; i < 4; ++i) { const int q = tid + 512 * i, l_ = q >> 4, nc = q & 15;
        *(LAS u32x4*)(Bc + l_ * 272 + nc * 16) = bcv[2 * i];
        *(LAS u32x4*)(Cc + l_ * 272 + nc * 16) = bcv[2 * i + 1]; }
    __syncthreads();
    f32x4 cb[8]; bf16x8 cfr[4];
#pragma unroll
    for (int n = 0; n < 8; ++n) cb[n] = (f32x4){0.f, 0.f, 0.f, 0.f};
#pragma unroll
    for (int ks = 0; ks < 4; ++ks) {
        cfr[ks] = *(const LAS bf16x8*)(Cc + l * 272 + (32 * ks + 8 * fq) * 2);
#pragma unroll
        for (int n = 0; n < 8; ++n) if (n <= w) { const bf16x8 bf = *(const LAS bf16x8*)(Bc + (16 * n + fr) * 272 + (32 * ks + 8 * fq) * 2); cb[n] = mma16(bf, cfr[ks], cb[n]); }
    }
    __syncthreads();
    float ss = 0.f;
    const int trp = (4 * fq + q4) * 144 + 8 * p4;
    bf16* op = XP_MIX(X) + (size_t)(t0 + l) * D + 1024 + 512 * g + 4 * fq;
#pragma unroll 1
    for (int hp = 0; hp < 4; ++hp) {
#pragma unroll
        for (int i = 0; i < 4; ++i) { const int q = tid + 512 * i; { const int e2 = q >> 10, s_ = (q >> 3) & 127, pc = q & 7; *(LAS u32x4*)(HP + e2 * 18432 + s_ * 144 + pc * 16) = px[i]; }
            { const int e2 = q >> 10, p = (q >> 4) & 63, nc = q & 15; *(LAS u32x4*)(HP + 36864 + e2 * 17408 + p * 272 + nc * 16) = ps[i]; } }
        __syncthreads();
        if (hp < 3) {
#pragma unroll
            for (int i = 0; i < 4; ++i) { const int q = tid + 512 * i; { const int e2 = q >> 10, s_ = (q >> 3) & 127, pc = q & 7, e = 2 * hp + 2 + e2; px[i] = *(const u32x4*)(XP_XBC(X) + (size_t)(t0 + s_) * XBCW + 512 * g + 64 * e + pc * 8); }
                { const int e2 = q >> 10, p = (q >> 4) & 63, nc = q & 15, e = 2 * hp + 2 + e2; ps[i] = *(const u32x4*)(XP_SST(X) + ((size_t)(c * 16 + 8 * g + e) * 64 + p) * 128 + nc * 8); } }
        }
        u32x2 zqn[2][4];
#pragma unroll
        for (int e2 = 0; e2 < 2; ++e2)
#pragma unroll
            for (int n = 0; n < 4; ++n) zqn[e2][n] = zq[e2][n];
        if (hp < 3) {
#pragma unroll
            for (int e2 = 0; e2 < 2; ++e2)
#pragma unroll
                for (int n = 0; n < 4; ++n) zqn[e2][n] = *(const u32x2*)(zp + 64 * (2 * hp + 2 + e2) + 16 * n);
        }
#pragma unroll
        for (int e2 = 0; e2 < 2; ++e2) { const int e = 2 * hp + e2;
            LAS uchar* Xh = HP + e2 * 18432; LAS uchar* Ph = HP + 36864 + e2 * 17408;
            f32x4 y[4];
#pragma unroll
            for (int n = 0; n < 4; ++n) y[n] = (f32x4){0.f, 0.f, 0.f, 0.f};
#pragma unroll
            for (int ks = 0; ks < 4; ++ks)
#pragma unroll
                for (int n = 0; n < 4; ++n) { const bf16x8 bf = *(const LAS bf16x8*)(Ph + (16 * n + fr) * 272 + (32 * ks + 8 * fq) * 2); y[n] = mma16(bf, cfr[ks], y[n]); }
            const float al = acS[e * 128 + l], el = __expf(al);
#pragma unroll
            for (int n = 0; n < 4; ++n) y[n] = y[n] * el;
#pragma unroll
            for (int k2 = 0; k2 < 4; ++k2) if (2 * k2 <= w) { float v[8];
#pragma unroll
                for (int tq = 0; tq < 2; ++tq) { const int s0 = 16 * (2 * k2 + tq) + 4 * fq; const f32x4 as = *(const LAS f32x4*)(acS + e * 128 + s0), ds = *(const LAS f32x4*)(dtS + e * 128 + s0);
#pragma unroll
                    for (int j = 0; j < 4; ++j) v[4 * tq + j] = (s0 + j <= l) ? cb[2 * k2 + tq][j] * ds[j] * __expf(al - as[j]) : 0.f; }
                u32x4 pk; pk.x = pk_bf16(v[0], v[1]); pk.y = pk_bf16(v[2], v[3]); pk.z = pk_bf16(v[4], v[5]); pk.w = pk_bf16(v[6], v[7]);
                const bf16x8 gf = __builtin_bit_cast(bf16x8, pk);
#pragma unroll
                for (int n = 0; n < 4; ++n) { const bf16x8 bf = tr_frag(Xh + (32 * k2) * 144 + (16 * n) * 2 + trp, 16 * 144); y[n] = mma16(bf, gf, y[n]); }
            }
            const float dsk = XP_d_skip(X)[8 * g + e];
#pragma unroll
            for (int n = 0; n < 4; ++n) { const u32x2 xv = *(const LAS u32x2*)(Xh + l * 144 + (16 * n + 4 * fq) * 2), zv = zq[e2][n];
                const float t0_ = (y[n][0] + dsk * bf_lo(xv.x)) * silu_f(bf_lo(zv.x)), t1_ = (y[n][1] + dsk * bf_hi(xv.x)) * silu_f(bf_hi(zv.x));
                const float t2_ = (y[n][2] + dsk * bf_lo(xv.y)) * silu_f(bf_lo(zv.y)), t3_ = (y[n][3] + dsk * bf_hi(xv.y)) * silu_f(bf_hi(zv.y));
                ss += (t0_ * t0_ + t1_ * t1_) + (t2_ * t2_ + t3_ * t3_);
                u32x2 o; o.x = pk_bf16(t0_, t1_); o.y = pk_bf16(t2_, t3_); *(u32x2*)(op + 64 * e + 16 * n) = o; }
        }
#pragma unroll
        for (int e2 = 0; e2 < 2; ++e2)
#pragma unroll
            for (int n = 0; n < 4; ++n) zq[e2][n] = zqn[e2][n];
        __syncthreads();
    }
    ss += __shfl_xor(ss, 16); ss += __shfl_xor(ss, 32);
    const float rstd = rsqrtf(ss * (1.f / 512.f) + EPS);
    const float* nw = XP_ssm_norm_w(X) + 512 * g + 4 * fq;
    u32x2 tv[32];
#pragma unroll
    for (int i = 0; i < 32; ++i) tv[i] = *(const u32x2*)(op + 16 * i);
#pragma unroll
    for (int i = 0; i < 32; ++i) { const f32x4 wv = *(const f32x4*)(nw + 16 * i); const u32x2 t = tv[i];
        u32x2 o; o.x = pk_bf16(bf_lo(t.x) * rstd * wv.x, bf_hi(t.x) * rstd * wv.y); o.y = pk_bf16(bf_lo(t.y) * rstd * wv.z, bf_hi(t.y) * rstd * wv.w);
        *(u32x2*)(op + 16 * i) = o; }
    __syncthreads();
}

__device__ __forceinline__ void p6_router(Ctx& X) {
    const int tid = X.tid, lane = X.lane, w = X.wave, fr = lane & 15, fq = lane >> 4;
    LAS float* part = (LAS float*)X.lds;
    LAS float* ssq = (LAS float*)(X.lds + 32768);
    LAS float* lgt = (LAS float*)(X.lds + 32768 + 1024);
    LAS float* rs = (LAS float*)(X.lds + 32768 + 1024 + 4096);
    for (int item = X.bid; item < T / 32; item += X.G) {
        const int tb = item * 32;
        f32x4 acc[2][2]; float ss[2] = {0.f, 0.f};
#pragma unroll
        for (int a = 0; a < 2; ++a)
#pragma unroll
            for (int n = 0; n < 2; ++n) acc[a][n] = (f32x4){0.f, 0.f, 0.f, 0.f};
#pragma unroll 2
        for (int ks = 0; ks < 8; ++ks) { const int kb = 256 * w + 32 * ks + 8 * fq;
            bf16x8 ah[2], bh[2], bl[2];
#pragma unroll
            for (int mt = 0; mt < 2; ++mt) { const u32x4 hv = *(const u32x4*)(XP_Hh(X) + (size_t)(tb + 16 * mt + fr) * D + kb);
                const float f0 = bf_lo(hv.x), f1 = bf_hi(hv.x), f2 = bf_lo(hv.y), f3 = bf_hi(hv.y), f4 = bf_lo(hv.z), f5 = bf_hi(hv.z), f6 = bf_lo(hv.w), f7 = bf_hi(hv.w);
                ss[mt] += (f0 * f0 + f1 * f1) + (f2 * f2 + f3 * f3) + (f4 * f4 + f5 * f5) + (f6 * f6 + f7 * f7);
                ah[mt] = __builtin_bit_cast(bf16x8, hv); }
#pragma unroll
            for (int nt = 0; nt < 2; ++nt) { bh[nt] = *(const bf16x8*)(XP_WRH(X) + (size_t)(16 * nt + fr) * D + kb); bl[nt] = *(const bf16x8*)(XP_WRL(X) + (size_t)(16 * nt + fr) * D + kb); }
#pragma unroll
            for (int mt = 0; mt < 2; ++mt)
#pragma unroll
                for (int nt = 0; nt < 2; ++nt) { acc[mt][nt] = mma16(bh[nt], ah[mt], acc[mt][nt]); acc[mt][nt] = mma16(bl[nt], ah[mt], acc[mt][nt]); }
        }
#pragma unroll
        for (int mt = 0; mt < 2; ++mt) { float q = ss[mt]; q += __shfl_xor(q, 16); q += __shfl_xor(q, 32); if (fq == 0) ssq[w * 32 + 16 * mt + fr] = q;
#pragma unroll
            for (int nt = 0; nt < 2; ++nt) *(LAS f32x4*)(part + (w * 32 + 16 * mt + fr) * 32 + 16 * nt + 4 * fq) = acc[mt][nt]; }
        __syncthreads();
        { const int tk = tid >> 4, e0 = 2 * (tid & 15); float q = 0.f, a0 = 0.f, a1 = 0.f;
#pragma unroll
          for (int ww = 0; ww < 8; ++ww) { q += ssq[ww * 32 + tk]; const f32x2 p = *(const LAS f32x2*)(part + (ww * 32 + tk) * 32 + e0); a0 += p.x; a1 += p.y; }
          const float rstd = rsqrtf(q * (1.f / D) + EPS);
          lgt[tk * 32 + e0] = a0 * rstd + XP_b_router(X)[e0]; lgt[tk * 32 + e0 + 1] = a1 * rstd + XP_b_router(X)[e0 + 1];
          if ((tid & 15) == 0) rs[tk] = rstd; }
        __syncthreads();
        if (tid < 32) { const int t = tb + tid; unsigned used = 0u; int idx[4]; float val[4];
#pragma unroll
            for (int k = 0; k < 4; ++k) { float best = -3.0e38f; int bi = 0;
#pragma unroll 8
                for (int j = 0; j < 32; ++j) { const float v = lgt[tid * 32 + j]; if (!((used >> j) & 1u) && v > best) { best = v; bi = j; } }
                used |= 1u << bi; idx[k] = bi; val[k] = best; }
            const float e1 = __expf(val[1] - val[0]), e2 = __expf(val[2] - val[0]), e3 = __expf(val[3] - val[0]), inv = 1.f / (1.f + e1 + e2 + e3);
            const float wv[4] = {inv, e1 * inv, e2 * inv, e3 * inv};
            int rk[4];
#pragma unroll
            for (int k = 0; k < 4; ++k) rk[k] = (int)__hip_atomic_fetch_add(XP_ctl(X) + CW_CNT + 64 * idx[k], 1u, __ATOMIC_RELAXED, __HIP_MEMORY_SCOPE_AGENT);
#pragma unroll
            for (int k = 0; k < 4; ++k) { XP_LIST(X)[idx[k] * T + rk[k]] = t; XP_TOPI(X)[t * 4 + k] = idx[k]; XP_TOPR(X)[t * 4 + k] = rk[k]; XP_TOPW(X)[t * 4 + k] = wv[k]; } }
#pragma unroll 2
        for (int r = 0; r < 4; ++r) { const int tk = 4 * w + r, t = tb + tk; const float rstd = rs[tk];
            const u32x2* hr = (const u32x2*)(XP_Hh(X) + (size_t)t * D) + lane; const f32x4* wr_ = (const f32x4*)XP_ln_ffn_w(X) + lane;
            unsigned* o8 = (unsigned*)(XP_U2(X) + (size_t)t * D) + lane;
#pragma unroll
            for (int j = 0; j < 8; ++j) { const u32x2 v = hr[64 * j]; const f32x4 wv = wr_[64 * j]; o8[64 * j] = pk_fp8x4(bf_lo(v.x) * rstd * wv.x, bf_hi(v.x) * rstd * wv.y, bf_lo(v.y) * rstd * wv.z, bf_hi(v.y) * rstd * wv.w); } }
        __syncthreads();
    }
}

__device__ __forceinline__ void moe_tables(Ctx& X) {
    LAS int* tab = (LAS int*)(X.lds + LDS_TAB);
    if (X.tid < 64) { const int e = X.tid;
        const int cnt = (e < NE) ? (int)__hip_atomic_load(XP_ctl(X) + CW_CNT + 64 * e, __ATOMIC_RELAXED, __HIP_MEMORY_SCOPE_AGENT) : 0; const int k = (cnt + 255) >> 8;
        int incl = k;
#pragma unroll
        for (int o = 1; o < 64; o <<= 1) { const int t = __shfl_up(incl, o); if (e >= o) incl += t; }
        const int first = incl - k;
        if (e < NE) { tab[8 + e] = first; for (int b = 0; b < k; ++b) { if (first + b < MAXBLK) { tab[64 + first + b] = e; tab[256 + first + b] = (cnt - 256 * b) < 256 ? (cnt - 256 * b) : 256; } } }
        if (e == NE - 1) { tab[8 + NE] = incl; tab[0] = incl < MAXBLK ? incl : MAXBLK; } }
    __syncthreads();
}

__device__ __forceinline__ void p9_final(Ctx& X) {
    const LAS int* tab = (const LAS int*)(X.lds + LDS_TAB);
    const int gw = X.bid * NWAVES + X.wave, NGW = X.G * NWAVES, lane = X.lane;
    for (int t = gw; t < T; t += NGW) {
        const u32x2* hr = (const u32x2*)(XP_Hh(X) + (size_t)t * D) + lane;
        f32x4 v[8];
#pragma unroll
        for (int j = 0; j < 8; ++j) { const u32x2 hv = hr[64 * j]; v[j] = (f32x4){bf_lo(hv.x), bf_hi(hv.x), bf_lo(hv.y), bf_hi(hv.y)}; }
#pragma unroll
        for (int k = 0; k < 4; ++k) { const int e = XP_TOPI(X)[t * 4 + k], r = XP_TOPR(X)[t * 4 + k]; const float wk = XP_TOPW(X)[t * 4 + k];
            const unsigned* yr = (const unsigned*)(XP_YR(X) + ((size_t)tab[8 + e] * 256 + r) * D) + lane;
#pragma unroll
            for (int j = 0; j < 8; ++j) { const int y = (int)yr[64 * j]; const f32x2 lo = __builtin_amdgcn_cvt_pk_f32_fp8(y, false), hi = __builtin_amdgcn_cvt_pk_f32_fp8(y, true);
                v[j].x += wk * lo.x; v[j].y += wk * lo.y; v[j].z += wk * hi.x; v[j].w += wk * hi.y; } }
        float s = 0.f;
#pragma unroll
        for (int j = 0; j < 8; ++j) s += (v[j].x * v[j].x + v[j].y * v[j].y) + (v[j].z * v[j].z + v[j].w * v[j].w);
        const float rstd = rsqrtf(wave_sum(s) * (1.f / D) + EPS);
        f32x4* o = (f32x4*)(X.out + (size_t)t * D) + lane; const f32x4* wr_ = (const f32x4*)XP_ln_final_w(X) + lane;
#pragma unroll
        for (int j = 0; j < 8; ++j) { const f32x4 wv = wr_[64 * j]; f32x4 r; r.x = v[j].x * rstd * wv.x; r.y = v[j].y * rstd * wv.y; r.z = v[j].z * rstd * wv.z; r.w = v[j].w * rstd * wv.w; o[64 * j] = r; }
    }
}

#ifdef NO_P4R
#define P4R(X,u)
#else
#define P4R(X,u) p4_ret(X,u)
#endif
#ifdef NO_P4S
#define P4S(X,u)
#else
#define P4S(X,u) p4_ssd(X,u)
#endif
struct Args { const void* in[19]; float* out; uchar* ws; int ph_lo, ph_hi; };
__global__ void __launch_bounds__(NTHR, 2) fwd(Args args) {
    extern __shared__ __attribute__((aligned(16))) uchar lds_raw[];
    Ctx X;
    X.lds = (LAS uchar*)lds_raw; X.tid = threadIdx.x; X.lane = X.tid & 63; X.wave = __builtin_amdgcn_readfirstlane(X.tid >> 6); X.G = gridDim.x; X.bid = blockIdx.x;
    X.in = (const void* const*)__builtin_amdgcn_kernarg_segment_ptr(); X.out = args.out; X.ws = args.ws;
    for (int u = X.tid; u < (LDS_BYTES - LDS_PHASE_END) / 4; u += NTHR) ((LAS unsigned*)(X.lds + LDS_PHASE_END))[u] = 0u;
    __syncthreads();
    const int lo = args.ph_lo, hi = args.ph_hi;
    const bool multi = (hi - lo) > 1;
    XcdBarrier bar; bar.bar = XP_ctl(X) + CW_BAR; bar.x = 0; bar.st = nullptr;
    if (multi) bar = xcd_barrier_post(XP_ctl(X) + CW_BAR, (volatile LAS unsigned*)(X.lds + LDS_MISC + 32));
#ifdef ONLY_PHASE
#define IN(k) ((k) == ONLY_PHASE && lo <= (k) && (k) < hi)
#else
#define IN(k) (lo <= (k) && (k) < hi)
#endif
#define SEAM(k) do { if (IN(k) && IN((k) + 1)) xcd_barrier(bar); } while (0)
    if (IN(0)) { p0_prologue(X); } SEAM(0);
    if (IN(1)) {
        const int gb = (X.G == 256) ? P1_GEMM_BLOCKS : X.G;
        if (X.bid < gb) { DenseSched S{(const char*)XP_U(X), (const char*)XP_WinT(X), D, T / 256, LDP / 256, (T / 256) * (LDP / 256), gb, X.bid}; EpiProj E{XP_PROJ(X), LDP, XP_COS(X), XP_SIN(X)};
            pg8::gemm_phase<EpiProj, DenseSched, false, false>(X.lds, D, S, E); }
        conv8_queue(X, (X.G == 256) ? Q5_BASE : I_ALL8); } SEAM(1);
    if (IN(2)) { for (int u = X.bid; u < 256; u += X.G) p2_ret(X, u);
        for (int u = X.bid; u < 256; u += X.G) p2_ssd(X, u); } SEAM(2);
    if (IN(3)) { p3_scan(X); if (X.G == 256 && X.bid >= 192) conv8_fill(X, FILL_B3, X.bid - 192, FILL_W3 / NWAVES, FILL_N3); } SEAM(3);
    if (IN(4)) { for (int u = X.bid; u < 256; u += X.G) { P4R(X, u); }
        for (int u = X.bid; u < 128; u += X.G) { P4S(X, u); }
        if (X.G == 256 && X.bid >= 128) conv8_fill(X, FILL_B4, X.bid - 128, FILL_W4 / NWAVES, FILL_N4); } SEAM(4);
    if (IN(5)) {
        const int gb = (X.G == 256) ? P5_GEMM_BLOCKS : X.G;
        if (X.bid < gb) { DenseSched S{(const char*)XP_MIX(X), (const char*)XP_WoutT(X), D, T / 256, D / 256, (T / 256) * (D / 256), gb, X.bid}; EpiOut E{XP_x(X), XP_Hh(X)};
            pg8::gemm_phase<EpiOut, DenseSched, false, false>(X.lds, D, S, E); }
        else conv8_fill(X, Q5_BASE, X.bid - gb, Q5_W / NWAVES, Q5_N); } SEAM(5);
    if (IN(6)) { p6_router(X); } SEAM(6);
    if (IN(7)) { moe_tables(X); MoeSched S{(const LAS int*)(X.lds + LDS_TAB), (const char*)XP_U2(X), (const char*)XP_WguT(X), (size_t)(2 * DFF) * D, XP_LIST(X), D / 2, (2 * DFF) / 256, X.G, X.bid}; EpiGateUp E{XP_ACT(X), XP_b_gu(X)};
        pg8::gemm_phase<EpiGateUp, MoeSched, true, true>(X.lds, D / 2, S, E); } SEAM(7);
    if (IN(8)) { moe_tables(X); MoeSchedDirect S{(const LAS int*)(X.lds + LDS_TAB), (const char*)XP_ACT(X), (const char*)XP_WdT(X), (size_t)D * DFF, DFF / 2, D / 256, X.G, X.bid}; EpiDown E{XP_YR(X), XP_b_d(X)};
        pg8::gemm_phase<EpiDown, MoeSchedDirect, true, true>(X.lds, DFF / 2, S, E); } SEAM(8);
    if (IN(9)) { moe_tables(X); p9_final(X); }
#undef IN
#undef SEAM
}

extern "C" void kernel_launch(void* const* d_in, const int* in_sizes, int n_in, void* d_out, int out_size, void* d_ws, size_t ws_size, hipStream_t stream) {
    static int grid = 0;
    if (grid == 0) {
        if (n_in != 19 || out_size != T * D || ws_size < WS_END) { fprintf(stderr, "kernel_launch: unexpected shapes (n_in %d, out %d, ws %zu)\n", n_in, out_size, ws_size); grid = -1; return; }
        int dev = 0, cus = 0, per_cu = 0;
        if (hipGetDevice(&dev) != hipSuccess || hipDeviceGetAttribute(&cus, hipDeviceAttributeMultiprocessorCount, dev) != hipSuccess) { grid = -1; return; }
        if (hipFuncSetAttribute((const void*)fwd, hipFuncAttributeMaxDynamicSharedMemorySize, LDS_BYTES) != hipSuccess) { fprintf(stderr, "kernel_launch: hipFuncSetAttribute failed\n"); grid = -1; return; }
        if (hipOccupancyMaxActiveBlocksPerMultiprocessor(&per_cu, (const void*)fwd, NTHR, LDS_BYTES) != hipSuccess || per_cu < 1) { fprintf(stderr, "kernel_launch: occupancy query reports %d\n", per_cu); }
        (void)hipGetLastError();
        grid = cus;
    }
    if (grid < 0) return;
    (void)hipMemsetAsync((char*)d_ws + WS_CTL, 0, CTL_ZERO_BYTES, stream);
    Args a{};
    for (int i = 0; i < 19; ++i) a.in[i] = d_in[i];
    a.out = (float*)d_out; a.ws = (uchar*)d_ws;
    constexpr int NL = MK_N_LAUNCHES;
    for (int li = 0; li < NL; ++li) {
        a.ph_lo = (NL == 1) ? 0 : li; a.ph_hi = (NL == 1) ? NPHASE : li + 1;
        hipLaunchKernelGGL(fwd, dim3(grid), dim3(NTHR), LDS_BYTES, stream, a);
    }
}
```

```cpp
#include <hip/hip_runtime.h>
#include <cstdio>
#include <cstdint>

#ifndef MK_N_LAUNCHES
#define MK_N_LAUNCHES 1
#endif

#define LAS __attribute__((address_space(3)))
typedef unsigned short bf16;
typedef short bf16x8 __attribute__((ext_vector_type(8)));
typedef short s16x4 __attribute__((ext_vector_type(4)));
typedef float f32x4 __attribute__((ext_vector_type(4)));
typedef float f32x2 __attribute__((ext_vector_type(2)));
typedef unsigned u32x4 __attribute__((ext_vector_type(4)));
typedef unsigned u32x2 __attribute__((ext_vector_type(2)));
typedef unsigned char uchar;
typedef int i32x8 __attribute__((ext_vector_type(8)));
typedef int i32x4 __attribute__((ext_vector_type(4)));
constexpr int W8LD = 2048 + 128;
constexpr float W8_SCALE = 64.f, W8_INV = 1.f / 64.f;

constexpr int T = 8192, D = 2048, NPROJ = 6672, LDP = 6912;
constexpr int C_Q = 0, C_K = 1024, C_V = 2048, C_G = 3072, C_Z = 4096, C_X = 5120, C_DT = 6656;
constexpr int XBCW = 1536, NCHUNK = 64, CH = 128;
constexpr int NE = 32, DFF = 2048, MAXBLK = 160;
constexpr float EPS = 1e-6f;
constexpr int NPHASE = 10;
constexpr int NWAVES = 8, NTHR = 512;

constexpr size_t MiB = 1ull << 20;
constexpr size_t WS_CTL = 0, CTL_ZERO_BYTES = 128 * 1024;
constexpr size_t WS_WINT = 2 * MiB, WS_WOUTT = 30 * MiB, WS_COS = 38 * MiB, WS_SIN = 42 * MiB;
constexpr size_t WS_TOPI = 46 * MiB, WS_TOPR = 46 * MiB + 128 * 1024, WS_TOPW = 46 * MiB + 256 * 1024, WS_LIST = 47 * MiB, WS_ADEC = 48 * MiB;
constexpr size_t WS_WRH = 49 * MiB, WS_WRL = 49 * MiB + 128 * 1024;
constexpr size_t WS_U = 64 * MiB, WS_U2 = 96 * MiB, WS_MIX = 128 * MiB, WS_XBC = 160 * MiB, WS_KV = 192 * MiB, WS_SST = 224 * MiB;
constexpr size_t WS_H = 256 * MiB, WS_PROJ = 320 * MiB, WS_ACT = 448 * MiB, WS_YR = 608 * MiB, WS_WGUT = 768 * MiB, WS_WDT = 1280 * MiB, WS_END = 1536 * MiB;
constexpr int CW_TMO = 0, CW_BAR = 4096, CW_CNT = 16384, CW_WQ = 20480;

constexpr int RING_BYTES = 131072;
constexpr int LDS_PHASE_END = 139264;
constexpr int LDS_TAB = LDS_PHASE_END;
constexpr int LDS_IDX = LDS_PHASE_END + 2048;
constexpr int LDS_MISC = LDS_PHASE_END + 4096;
constexpr int LDS_BIAS = LDS_PHASE_END + 5120;
constexpr int LDS_BYTES = 147456;

__device__ __forceinline__ unsigned pk_bf16(float lo, float hi) { unsigned r; asm("v_cvt_pk_bf16_f32 %0, %1, %2" : "=v"(r) : "v"(lo), "v"(hi)); return r; }
__device__ __forceinline__ float clamp448(float x) { return fminf(fmaxf(x, -448.f), 448.f); }
__device__ __forceinline__ unsigned pk_fp8x4(float a, float b, float c, float d) {
    int p = 0; p = __builtin_amdgcn_cvt_pk_fp8_f32(clamp448(a), clamp448(b), p, false); p = __builtin_amdgcn_cvt_pk_fp8_f32(clamp448(c), clamp448(d), p, true); return (unsigned)p; }
__device__ __forceinline__ unsigned pk_fp8x4_nc(float a, float b, float c, float d) {
    int p = 0; p = __builtin_amdgcn_cvt_pk_fp8_f32(a, b, p, false); p = __builtin_amdgcn_cvt_pk_fp8_f32(c, d, p, true); return (unsigned)p; }
__device__ __forceinline__ float bf_lo(unsigned u) { return __uint_as_float(u << 16); }
__device__ __forceinline__ float bf_hi(unsigned u) { return __uint_as_float(u & 0xffff0000u); }
__device__ __forceinline__ float bf2f(bf16 b) { return __uint_as_float(((unsigned)b) << 16); }
__device__ __forceinline__ float wave_sum(float v) {
#pragma unroll
    for (int o = 1; o < 64; o <<= 1) v += __shfl_xor(v, o);
    return v;
}
__device__ __forceinline__ float silu_f(float x) { return x * __builtin_amdgcn_rcpf(1.0f + __expf(-x)); }
__device__ __forceinline__ float softplus_f(float x) { return x > 20.f ? x : log1pf(__expf(x)); }

__constant__ double INV_FREQ[128] = {1,0.93057204092969903,0.86596432336006535,0.80584218776148187,0.74989420933245587,0.69783058485986638,0.64938163157621132,0.60429639023813286,0.56234132519034907,0.5232991146814947,0.48696752516586311,0.45315836376008178,0.42169650342858223,0.39241897584845359,0.36517412725483772,0.33982083289425596,0.31622776601683794,0.29427271762092816,0.27384196342643613,0.25482967479793467,0.23713737056616552,0.22067340690845899,0.20535250264571461,0.19109529749704404,0.17782794100389229,0.16548170999431813,0.15399265260594919,0.14330125702369628,0.1333521432163324,0.12409377607517195,0.11547819846894582,0.10746078283213174,0.10000000000000001,0.0930572040929699,0.086596432336006529,0.080584218776148187,0.074989420933245579,0.069783058485986635,0.064938163157621132,0.060429639023813285,0.056234132519034911,0.05232991146814947,0.048696752516586311,0.045315836376008181,0.042169650342858224,0.039241897584845357,0.036517412725483769,0.033982083289425591,0.031622776601683791,0.029427271762092817,0.027384196342643614,0.025482967479793464,0.023713737056616554,0.022067340690845899,0.02053525026457146,0.019109529749704406,0.017782794100389229,0.016548170999431813,0.015399265260594919,0.014330125702369627,0.013335214321633241,0.012409377607517195,0.011547819846894581,0.010746078283213174,0.01,0.0093057204092969904,0.0086596432336006543,0.008058421877614819,0.0074989420933245579,0.0069783058485986633,0.006493816315762113,0.0060429639023813278,0.005623413251903491,0.0052329911468149467,0.004869675251658631,0.0045315836376008181,0.0042169650342858229,0.0039241897584845363,0.0036517412725483771,0.0033982083289425592,0.0031622776601683794,0.002942727176209282,0.0027384196342643613,0.0025482967479793467,0.0023713737056616554,0.0022067340690845897,0.002053525026457146,0.0019109529749704406,0.0017782794100389228,0.0016548170999431814,0.001539926526059492,0.0014330125702369627,0.0013335214321633241,0.0012409377607517195,0.0011547819846894581,0.0010746078283213176,0.001,0.00093057204092969893,0.00086596432336006539,0.00080584218776148179,0.00074989420933245586,0.00069783058485986635,0.00064938163157621134,0.00060429639023813287,0.0005623413251903491,0.00052329911468149473,0.0004869675251658631,0.00045315836376008179,0.00042169650342858224,0.00039241897584845359,0.0003651741272548377,0.00033982083289425596,0.00031622776601683794,0.00029427271762092817,0.00027384196342643611,0.00025482967479793463,0.00023713737056616554,0.00022067340690845897,0.00020535250264571461,0.00019109529749704405,0.00017782794100389227,0.00016548170999431815,0.00015399265260594919,0.00014330125702369627,0.0001333521432163324,0.00012409377607517196,0.00011547819846894582,0.00010746078283213175};
__constant__ float LG2_GAMMA[4] = {-0.045803689613124789f, -0.022720076500083529f, -0.011315313227834146f, -0.0056465631411420627f};
__constant__ float GAMMA_CHUNK[4] = {0.017183023570817902f, 0.13321516287964841f, 0.36643771592203728f, 0.60593708822908032f};

namespace pg8 {
constexpr int BM = 256, BK = 64, HALF = 128, HTB = HALF * BK * 2, STAGE_BYTES = 8 * HTB, NXCD = 8, WGM = 8;
__host__ __device__ __forceinline__ int lds_byte(int r, int c) { const int st = (r >> 4) * 2 + (c >> 5), rr = r & 15, cc = c & 31, ob = rr * 64 + cc * 2; return st * 1024 + (ob ^ (((ob >> 9) & 1) << 5)); }
__host__ __device__ __forceinline__ void stage_rc(int b, int& R, int& C) { const int st = b / 1024, sb = b % 1024, swz = sb ^ (((sb >> 9) & 1) << 5); R = (st >> 1) * 16 + swz / 64; C = (st & 1) * 32 + (swz % 64) / 2; }
__host__ __device__ __forceinline__ int perm32(int rho) { const int n = rho >> 4, i = rho & 15; return 8 * (i >> 2) + 4 * n + (i & 3); }

struct Unit { const char* pa; const char* pb; int row0, col0, aux, blk; };

template <class Epi, class Sched, bool GATHER, bool FP8>
__device__ __forceinline__ void gemm_phase(LAS uchar* lds, const int K, const int LDB, const Sched& S, const Epi& E) {
    const int tid = threadIdx.x, wid = __builtin_amdgcn_readfirstlane(tid >> 6), lane = tid & 63, wr = wid >> 2, wc = wid & 3, fr = lane & 15, fq = lane >> 4;
    const int nt = K / BK;
    unsigned voA[2][2], voffB[2];
#pragma unroll
    for (int i = 0; i < 2; ++i) { int R, C; stage_rc(tid * 16 + i * 8192, R, C); const int Rb = Epi::PERM == 17 ? 64 * (R >> 5) + 16 * ((R >> 2) & 3) + 2 * (R & 3) + ((R >> 4) & 1) : Epi::PERM == 16 ? 64 * (R >> 5) + 16 * ((R >> 2) & 3) + 4 * ((R >> 4) & 1) + (R & 3) : (Epi::PERM == 8 ? ((R & ~31) + perm32(R & 31)) : R);
        voA[0][i] = (unsigned)(R * K + C) * 2u; voA[1][i] = voA[0][i] + (unsigned)(HALF * K * 2); voffB[i] = (unsigned)(Rb * LDB + C) * 2u; }
    const size_t kstep = (size_t)(BK * 2);
    const size_t hstep = (size_t)(Epi::PERM >= 16 ? 8 : HALF) * LDB * 2;
    const unsigned ldsw = (unsigned)wid * 1024u;
    const int aoff = lds_byte(wr * 64 + fr, fq * 8), boff = lds_byte(wc * 32 + fr, fq * 8);
#define PG8_SA(b, h) (((b) * 2 + (h)) * HTB)
#define PG8_SB(b, h) ((4 + (b) * 2 + (h)) * HTB)
#define PG8_STAGE(bufoff, gbase, voff) do { _Pragma("unroll") for (int _i = 0; _i < 2; ++_i) \
        __builtin_amdgcn_global_load_lds((const unsigned*)((const char*)(gbase) + (voff)[_i]), (LAS unsigned*)(lds + (bufoff) + ldsw + _i * 8192), 16, 0, 0); } while (0)
#define PG8_LDA(dst, b, h) do { _Pragma("unroll") for (int m = 0; m < 4; ++m) _Pragma("unroll") for (int k = 0; k < 2; ++k) dst[m][k] = *(const LAS bf16x8*)(lds + PG8_SA(b, h) + aoff + m * 2048 + k * 1024); } while (0)
#define PG8_LDB(dst, b, h) do { _Pragma("unroll") for (int n = 0; n < 2; ++n) _Pragma("unroll") for (int k = 0; k < 2; ++k) dst[n][k] = *(const LAS bf16x8*)(lds + PG8_SB(b, h) + boff + n * 2048 + k * 1024); } while (0)
#define PG8_CAT(x) __builtin_shufflevector(__builtin_bit_cast(i32x4, (x)[0]), __builtin_bit_cast(i32x4, (x)[1]), 0, 1, 2, 3, 4, 5, 6, 7)
#define PG8_MMA(ai, bj, At, Bt) do { __builtin_amdgcn_s_setprio(1); \
        if constexpr (FP8) { _Pragma("unroll") for (int m = 0; m < 4; ++m) _Pragma("unroll") for (int n = 0; n < 2; ++n) \
            acc[ai][bj][m][n] = __builtin_amdgcn_mfma_scale_f32_16x16x128_f8f6f4(PG8_CAT(Bt[n]), PG8_CAT(At[m]), acc[ai][bj][m][n], 0, 0, 0, 0x7f7f7f7f, 0, 0x7f7f7f7f); } \
        else { _Pragma("unroll") for (int m = 0; m < 4; ++m) _Pragma("unroll") for (int n = 0; n < 2; ++n) _Pragma("unroll") for (int k = 0; k < 2; ++k) \
            acc[ai][bj][m][n] = __builtin_amdgcn_mfma_f32_16x16x32_bf16(Bt[n][k], At[m][k], acc[ai][bj][m][n], 0, 0, 0); } \
        __builtin_amdgcn_s_setprio(0); } while (0)
#define PG8_WAIT_V(n) asm volatile("s_waitcnt vmcnt(" #n ")" ::: "memory")
#define PG8_WAIT_V8F(fresh) asm volatile("s_cmp_eq_u32 %0, 0\n\ts_cbranch_scc1 .Lw8_%=\n\ts_waitcnt vmcnt(%1)\n\ts_branch .Lwe_%=\n.Lw8_%=:\n\ts_waitcnt vmcnt(8)\n.Lwe_%=:" :: "s"(fresh), "n"(8 + Epi::NST + Epi::NPF) : "memory", "scc")
#define PG8_WAIT_L(n) asm volatile("s_waitcnt lgkmcnt(" #n ")" ::: "memory")
#define PG8_BAR __builtin_amdgcn_s_barrier()
#define PG8_SCHED __builtin_amdgcn_sched_barrier(0)
    Unit cur, nxt; int ui = 0;
    if (!S.next(0, cur)) return;
    f32x4 acc[2][2][4][2];
#pragma unroll
    for (int a = 0; a < 2; ++a)
#pragma unroll
        for (int b = 0; b < 2; ++b)
#pragma unroll
            for (int m = 0; m < 4; ++m)
#pragma unroll
                for (int n = 0; n < 2; ++n) acc[a][b][m][n] = (f32x4){0.f, 0.f, 0.f, 0.f};
    bf16x8 At[4][2], B0[2][2], B1[2][2];
    const char* cA = cur.pa; const char* cB = cur.pb;
    if constexpr (GATHER) S.gather(cur, voA, (const LAS int*)nullptr);
    PG8_STAGE(PG8_SB(0, 0), cB, voffB); PG8_STAGE(PG8_SB(0, 1), cB + hstep, voffB); PG8_STAGE(PG8_SA(0, 0), cA, voA[0]); PG8_STAGE(PG8_SA(0, 1), cA, voA[1]);
    if (wr == 1) PG8_BAR;
    PG8_WAIT_V(2); PG8_BAR;
    PG8_STAGE(PG8_SB(1, 0), cB + kstep, voffB); PG8_STAGE(PG8_SA(1, 0), cA + kstep, voA[0]); PG8_STAGE(PG8_SB(1, 1), cB + hstep + kstep, voffB);
    PG8_WAIT_V(6); PG8_BAR;
    for (;;) {
        const bool has_next = S.next(ui + 1, nxt);
        if constexpr (GATHER) { if (has_next) S.prefetch(nxt, lds + LDS_IDX + ((ui + 1) & 1) * 1024, wid, lane); }
        E.prefetch(cur, lds + LDS_BIAS + (ui & 1) * 1024, wid, lane);
        const char* nA = has_next ? nxt.pa : cA; const char* nB = has_next ? nxt.pb : cB;
        for (int t = 0; t < nt; t += 2) {
            const bool last = (t == nt - 2);
            const char* a1 = cA + (size_t)(t + 1) * kstep;
            const char* a2 = last ? nA : cA + (size_t)(t + 2) * kstep; const char* b2 = last ? nB : cB + (size_t)(t + 2) * kstep;
            const char* a3 = a2 + kstep; const char* b3 = b2 + kstep;
            int fresh; { const int fv = (t == 0 && ui > 0) ? 1 : 0; asm volatile("s_nop 0\n\tv_readfirstlane_b32 %0, %1" : "=s"(fresh) : "v"(fv)); }
            PG8_LDB(B0, 0, 0); PG8_LDB(B1, 0, 1); PG8_SCHED; PG8_LDA(At, 0, 0); PG8_STAGE(PG8_SA(1, 1), a1, voA[1]);
            if constexpr (GATHER) { if (last && has_next) S.gather(nxt, voA, (const LAS int*)(lds + LDS_IDX + ((ui + 1) & 1) * 1024)); }
            PG8_WAIT_V8F(fresh); PG8_WAIT_L(0); PG8_BAR; PG8_MMA(0, 0, At, B0); PG8_MMA(0, 1, At, B1); PG8_BAR; PG8_SCHED;
            PG8_LDA(At, 0, 1); PG8_STAGE(PG8_SB(0, 0), b2, voffB); PG8_STAGE(PG8_SB(0, 1), b2 + hstep, voffB); PG8_STAGE(PG8_SA(0, 0), a2, voA[0]);
            PG8_WAIT_V8F(fresh); PG8_WAIT_L(0); PG8_BAR; PG8_MMA(1, 0, At, B0); PG8_MMA(1, 1, At, B1); PG8_BAR; PG8_SCHED;
            PG8_LDB(B0, 1, 0); PG8_LDB(B1, 1, 1); PG8_SCHED; PG8_LDA(At, 1, 0); PG8_STAGE(PG8_SA(0, 1), a2, voA[1]);
            PG8_WAIT_V(8); PG8_WAIT_L(0); PG8_BAR; PG8_MMA(0, 0, At, B0); PG8_MMA(0, 1, At, B1); PG8_BAR; PG8_SCHED;
            PG8_LDA(At, 1, 1); PG8_STAGE(PG8_SB(1, 0), b3, voffB); PG8_STAGE(PG8_SB(1, 1), b3 + hstep, voffB); PG8_STAGE(PG8_SA(1, 0), a3, voA[0]);
            PG8_WAIT_V(8); PG8_WAIT_L(0); PG8_BAR; PG8_MMA(1, 0, At, B0); PG8_MMA(1, 1, At, B1); PG8_BAR; PG8_SCHED;
        }
        if (wr == 0) PG8_BAR;
        E(acc, cur, wr, wc, fr, fq, lds + LDS_BIAS + (ui & 1) * 1024);
        if (!has_next) break;
#pragma unroll
        for (int a = 0; a < 2; ++a)
#pragma unroll
            for (int b = 0; b < 2; ++b)
#pragma unroll
                for (int m = 0; m < 4; ++m)
#pragma unroll
                    for (int n = 0; n < 2; ++n) acc[a][b][m][n] = (f32x4){0.f, 0.f, 0.f, 0.f};
        cur = nxt; cA = nA; cB = nB; ++ui;
        if (wr == 1) PG8_BAR;
    }
    PG8_WAIT_V(0);
    PG8_BAR;
#undef PG8_SA
#undef PG8_SB
#undef PG8_STAGE
#undef PG8_LDA
#undef PG8_LDB
#undef PG8_MMA
#undef PG8_CAT
#undef PG8_WAIT_V
#undef PG8_WAIT_V8F
#undef PG8_WAIT_L
#undef PG8_BAR
#undef PG8_SCHED
}
}

struct DenseSched {
    const char* A; const char* B; int K, nM, nN, nwg, G, c;
    __device__ __forceinline__ bool next(int i, pg8::Unit& u) const {
        const long L = (long)i * G + c; if (L >= nwg) return false;
        int wgid = (int)L; { const int q = nwg / pg8::NXCD, r = nwg % pg8::NXCD, xcd = wgid % pg8::NXCD, off = wgid / pg8::NXCD; wgid = (xcd < r ? xcd * (q + 1) : r * (q + 1) + (xcd - r) * q) + off; }
        const int nig = pg8::WGM * nN, gid = wgid / nig, fm = gid * pg8::WGM, gsz = (nM - fm) < pg8::WGM ? (nM - fm) : pg8::WGM;
        const int pm = fm + ((wgid % nig) % gsz), pn = (wgid % nig) / gsz;
        u.pa = A + (size_t)pm * 256 * K * 2; u.pb = B + (size_t)pn * 256 * K * 2; u.row0 = pm * 256; u.col0 = pn * 256; u.aux = 0; u.blk = 0; return true;
    }
    __device__ __forceinline__ void gather(const pg8::Unit&, unsigned (&)[2][2], const LAS int*) const {}
    __device__ __forceinline__ void prefetch(const pg8::Unit&, LAS uchar*, int, int) const {}
};
struct MoeSched {
    const LAS int* tab; const char* A; const char* B; size_t bexp; const int* list; int K, nN, G, c;
    __device__ __forceinline__ bool next(int i, pg8::Unit& u) const {
        const int NB = __builtin_amdgcn_readfirstlane(tab[0]); const int L = i * G + c; if (L >= NB * nN) return false;
        const int b = L / nN, pn = L - b * nN, e = __builtin_amdgcn_readfirstlane(tab[64 + b]);
        u.pa = A; u.pb = B + (size_t)e * bexp + (size_t)pn * 256 * W8LD; u.row0 = b * 256; u.col0 = pn * 256; u.aux = e; u.blk = b; return true;
    }
    __device__ __forceinline__ void prefetch(const pg8::Unit& u, LAS uchar* buf, int wid, int lane) const {
        { const int e = u.aux, lb = (u.blk - __builtin_amdgcn_readfirstlane(tab[8 + e])) * 256, w4 = wid & 3;
            __builtin_amdgcn_global_load_lds((const unsigned*)(list + e * T + lb + 64 * w4 + lane), (LAS unsigned*)(buf + w4 * 256), 4, 0, 0); }
    }
    __device__ __forceinline__ void gather(const pg8::Unit& u, unsigned (&vo)[2][2], const LAS int* idx) const {
        const int e = u.aux, lb = (u.blk - __builtin_amdgcn_readfirstlane(tab[8 + e])) * 256, cnt = __builtin_amdgcn_readfirstlane(tab[256 + u.blk]);
#pragma unroll
        for (int i = 0; i < 2; ++i) { int R, C; pg8::stage_rc((int)threadIdx.x * 16 + i * 8192, R, C);
#pragma unroll
            for (int h = 0; h < 2; ++h) { const int r = h * 128 + R; const int raw = idx ? idx[r] : list[e * T + lb + r]; const int tok = (r < cnt) ? raw : 0; vo[h][i] = ((unsigned)tok * (unsigned)K + (unsigned)C) * 2u; } }
    }
};
struct MoeSchedDirect {
    const LAS int* tab; const char* A; const char* B; size_t bexp; int K, nN, G, c;
    __device__ __forceinline__ bool next(int i, pg8::Unit& u) const {
        const int NB = __builtin_amdgcn_readfirstlane(tab[0]); const int L = i * G + c; if (L >= NB * nN) return false;
        const int b = L / nN, pn = L - b * nN, e = __builtin_amdgcn_readfirstlane(tab[64 + b]);
        u.pa = A; u.pb = B + (size_t)e * bexp + (size_t)pn * 256 * W8LD; u.row0 = b * 256; u.col0 = pn * 256; u.aux = e; u.blk = b; return true;
    }
    __device__ __forceinline__ void prefetch(const pg8::Unit&, LAS uchar*, int, int) const {}
    __device__ __forceinline__ void gather(const pg8::Unit& u, unsigned (&vo)[2][2], const LAS int*) const {
#pragma unroll
        for (int i = 0; i < 2; ++i) { int R, C; pg8::stage_rc((int)threadIdx.x * 16 + i * 8192, R, C);
#pragma unroll
            for (int h = 0; h < 2; ++h) vo[h][i] = ((unsigned)(u.row0 + h * 128 + R) * (unsigned)K + (unsigned)C) * 2u; }
    }
};

#define EPI_LANE() int tz = threadIdx.x; asm volatile("" : "+v"(tz)); const int fr = tz & 15, fq = (tz >> 4) & 3; (void)fr_; (void)fq_
struct EpiProj {
    static constexpr int NST = 16, NPF = 0;
    static constexpr int PERM = 8;
    bf16* O; int ldc; const float* COS; const float* SIN;
    __device__ __forceinline__ void prefetch(const pg8::Unit&, LAS uchar*, int, int) const {}
    __device__ __forceinline__ void operator()(const f32x4 (&acc)[2][2][4][2], const pg8::Unit& u, int wr, int wc, int fr_, int fq_, const LAS uchar* bl) const {
        EPI_LANE();
        const int row0 = u.row0 + wr * 64 + fr, col0 = u.col0 + wc * 32 + 8 * fq;
        if (u.col0 < 2048) {
            const float sc = (u.col0 >= 1024) ? 0.0625f : 1.0f; const int i0 = wc * 32 + 8 * fq;
#pragma unroll
            for (int ai = 0; ai < 2; ++ai)
#pragma unroll
                for (int m = 0; m < 4; ++m) { const int t = row0 + ai * 128 + m * 16; bf16* rowp = O + (size_t)t * ldc + col0;
                    const f32x4 c0 = *(const f32x4*)(COS + (size_t)t * 128 + i0), c1 = *(const f32x4*)(COS + (size_t)t * 128 + i0 + 4), s0 = *(const f32x4*)(SIN + (size_t)t * 128 + i0), s1 = *(const f32x4*)(SIN + (size_t)t * 128 + i0 + 4);
                    const f32x4 a0 = acc[ai][0][m][0], a1 = acc[ai][0][m][1], b0 = acc[ai][1][m][0], b1 = acc[ai][1][m][1];
                    const f32x4 p0 = (a0 * c0 - b0 * s0) * sc, p1 = (a1 * c1 - b1 * s1) * sc, q0 = (b0 * c0 + a0 * s0) * sc, q1 = (b1 * c1 + a1 * s1) * sc;
                    u32x4 w; w.x = pk_bf16(p0[0], p0[1]); w.y = pk_bf16(p0[2], p0[3]); w.z = pk_bf16(p1[0], p1[1]); w.w = pk_bf16(p1[2], p1[3]); *(u32x4*)rowp = w;
                    w.x = pk_bf16(q0[0], q0[1]); w.y = pk_bf16(q0[2], q0[3]); w.z = pk_bf16(q1[0], q1[1]); w.w = pk_bf16(q1[2], q1[3]); *(u32x4*)(rowp + 128) = w; }
        } else {
#pragma unroll
            for (int ai = 0; ai < 2; ++ai)
#pragma unroll
                for (int m = 0; m < 4; ++m) { bf16* rowp = O + (size_t)(row0 + ai * 128 + m * 16) * ldc + col0;
#pragma unroll
                    for (int bj = 0; bj < 2; ++bj) { const f32x4 v0 = acc[ai][bj][m][0], v1 = acc[ai][bj][m][1];
                        u32x4 w; w.x = pk_bf16(v0[0], v0[1]); w.y = pk_bf16(v0[2], v0[3]); w.z = pk_bf16(v1[0], v1[1]); w.w = pk_bf16(v1[2], v1[3]);
                        *(u32x4*)(rowp + bj * 128) = w; } }
        }
    }
};
struct EpiOut {
    static constexpr int PERM = 8, NST = 16, NPF = 0;
    const float* X; bf16* Hh;
    __device__ __forceinline__ void prefetch(const pg8::Unit&, LAS uchar*, int, int) const {}
    __device__ __forceinline__ void operator()(const f32x4 (&acc)[2][2][4][2], const pg8::Unit& u, int wr, int wc, int fr_, int fq_, const LAS uchar* bl) const {
        EPI_LANE();
        const int row0 = u.row0 + wr * 64 + fr, col0 = u.col0 + wc * 32 + 8 * fq;
#pragma unroll
        for (int ai = 0; ai < 2; ++ai)
#pragma unroll
            for (int m = 0; m < 4; ++m) { const size_t off = (size_t)(row0 + ai * 128 + m * 16) * D + col0;
#pragma unroll
                for (int bj = 0; bj < 2; ++bj) { const f32x4 x0 = *(const f32x4*)(X + off + bj * 128), x1 = *(const f32x4*)(X + off + bj * 128 + 4);
                    const f32x4 v0 = x0 + acc[ai][bj][m][0], v1 = x1 + acc[ai][bj][m][1];
                    u32x4 w; w.x = pk_bf16(v0[0], v0[1]); w.y = pk_bf16(v0[2], v0[3]); w.z = pk_bf16(v1[0], v1[1]); w.w = pk_bf16(v1[2], v1[3]);
                    *(u32x4*)(Hh + off + bj * 128) = w; } }
    }
};
__device__ __forceinline__ float swiglu_f(float gate, float up) { const float g = fminf(gate, 7.f), u = fminf(fmaxf(up, -7.f), 7.f); return (u + 1.f) * g * __builtin_amdgcn_rcpf(1.f + __builtin_amdgcn_exp2f(-1.702f * 1.44269504f * g)); }
struct EpiGateUp {
    static constexpr int PERM = 17, NST = 8, NPF = 1;
    uchar* ACT; const float* bias;
    __device__ __forceinline__ void prefetch(const pg8::Unit& u, LAS uchar* buf, int wid, int lane) const {
        const int w4 = wid & 3; __builtin_amdgcn_global_load_lds((const unsigned*)(bias + (size_t)u.aux * (2 * DFF) + u.col0 + 64 * w4 + lane), (LAS unsigned*)(buf + w4 * 256), 4, 0, 0); }
    __device__ __forceinline__ void operator()(const f32x4 (&acc)[2][2][4][2], const pg8::Unit& u, int wr, int wc, int fr_, int fq_, const LAS uchar* bl) const {
        EPI_LANE();
        const int row0 = u.row0 + wr * 64 + fr, col0 = u.col0 + wc * 64 + 16 * fq;
        const LAS float* bp = (const LAS float*)bl + wc * 64 + 16 * fq;
        f32x4 bg[2], bu[2];
#pragma unroll
        for (int bj = 0; bj < 2; ++bj) { const f32x4 b0 = *(const LAS f32x4*)(bp + bj * 8), b1 = *(const LAS f32x4*)(bp + bj * 8 + 4);
            bg[bj] = (f32x4){b0.x, b0.z, b1.x, b1.z}; bu[bj] = (f32x4){b0.y, b0.w, b1.y, b1.w}; }
#pragma unroll
        for (int ai = 0; ai < 2; ++ai)
#pragma unroll
            for (int m = 0; m < 4; ++m) { uchar* rowp = ACT + (size_t)(row0 + ai * 128 + m * 16) * DFF + (col0 >> 1);
                u32x2 w;
#pragma unroll
                for (int bj = 0; bj < 2; ++bj) { f32x4 g = acc[ai][bj][m][0] * W8_INV + bg[bj], up = acc[ai][bj][m][1] * W8_INV + bu[bj];
#pragma unroll
                    for (int j = 0; j < 4; ++j) { g[j] = fminf(g[j], 7.f); up[j] = fminf(fmaxf(up[j], -7.f), 7.f); }
                    const f32x4 a = g * (-1.702f * 1.44269504f);
                    f32x4 d;
#pragma unroll
                    for (int j = 0; j < 4; ++j) d[j] = __builtin_amdgcn_exp2f(a[j]);
                    d = d + 1.f;
#pragma unroll
                    for (int j = 0; j < 4; ++j) d[j] = __builtin_amdgcn_rcpf(d[j]);
                    const f32x4 o = (up + 1.f) * (g * d);
                    const unsigned p = pk_fp8x4_nc(o[0], o[1], o[2], o[3]);
                    if (bj == 0) w.x = p; else w.y = p; }
                *(u32x2*)rowp = w; }
    }
};
struct EpiDown {
    static constexpr int PERM = 16, NST = 8, NPF = 1;
    uchar* YR; const float* bias;
    __device__ __forceinline__ void prefetch(const pg8::Unit& u, LAS uchar* buf, int wid, int lane) const {
        const int w4 = wid & 3; __builtin_amdgcn_global_load_lds((const unsigned*)(bias + (size_t)u.aux * D + u.col0 + 64 * w4 + lane), (LAS unsigned*)(buf + w4 * 256), 4, 0, 0); }
    __device__ __forceinline__ void operator()(const f32x4 (&acc)[2][2][4][2], const pg8::Unit& u, int wr, int wc, int fr_, int fq_, const LAS uchar* bl) const {
        EPI_LANE();
        const int row0 = u.row0 + wr * 64 + fr, col0 = u.col0 + wc * 64 + 16 * fq;
        const LAS float* bp = (const LAS float*)bl + wc * 64 + 16 * fq;
        f32x4 bv[2][2];
#pragma unroll
        for (int bj = 0; bj < 2; ++bj)
#pragma unroll
            for (int n = 0; n < 2; ++n) bv[bj][n] = *(const LAS f32x4*)(bp + bj * 8 + 4 * n);
#pragma unroll
        for (int ai = 0; ai < 2; ++ai)
#pragma unroll
            for (int m = 0; m < 4; ++m) { uchar* rowp = YR + (size_t)(row0 + ai * 128 + m * 16) * D + col0;
                const f32x4 v0 = acc[ai][0][m][0] * W8_INV + bv[0][0], v1 = acc[ai][0][m][1] * W8_INV + bv[0][1], v2 = acc[ai][1][m][0] * W8_INV + bv[1][0], v3 = acc[ai][1][m][1] * W8_INV + bv[1][1];
                u32x4 w; w.x = pk_fp8x4(v0[0], v0[1], v0[2], v0[3]); w.y = pk_fp8x4(v1[0], v1[1], v1[2], v1[3]); w.z = pk_fp8x4(v2[0], v2[1], v2[2], v2[3]); w.w = pk_fp8x4(v3[0], v3[1], v3[2], v3[3]);
                *(u32x4*)rowp = w; }
    }
};

#define XB_TMO      128
#define XB_XCNT(j)  (256  + 64 * (j))
#define XB_XSUB(j)  (1280 + 64 * (j))
#define XB_XGEN(j)  (2304 + 64 * (j))
#define XB_TOP      3328
#define XB_TOPGEN   3392
#define XCD_BAR_WORDS 3456
#define XB_SPIN_CAP (1u << 18)
__device__ __forceinline__ unsigned xb_ld(unsigned* p)              { return __hip_atomic_load(p, __ATOMIC_RELAXED, __HIP_MEMORY_SCOPE_AGENT); }
__device__ __forceinline__ unsigned xb_add(unsigned* p, unsigned v) { return __hip_atomic_fetch_add(p, v, __ATOMIC_RELAXED, __HIP_MEMORY_SCOPE_AGENT); }
__device__ __forceinline__ unsigned xb_xcc_id() { return (unsigned)__builtin_amdgcn_s_getreg((3 << 11) | 20) & 0xFu; }
#define XB_SPIN(cond, bar) do { unsigned _sp = 0; while (cond) { __builtin_amdgcn_s_sleep(1); \
    if ((++_sp & 255u) == 0u) { if (xb_ld(&(bar)[XB_TMO])) break; if (_sp > XB_SPIN_CAP) { atomicAdd(&(bar)[XB_TMO], 1u); break; } } } } while (0)
struct XcdBarrier { unsigned* bar; unsigned x; volatile LAS unsigned* st; };
__device__ __forceinline__ XcdBarrier xcd_barrier_post(unsigned* bar, volatile LAS unsigned* st) {
    XcdBarrier b; b.bar = bar; b.x = xb_xcc_id(); b.st = st;
    if (threadIdx.x == 0) (void)xb_add(&bar[XB_XCNT(b.x)], 1u);
    return b;
}
__device__ __forceinline__ void xcd_barrier_complete(unsigned* bar, unsigned x, unsigned& nloc, unsigned& nx) {
    const unsigned G = gridDim.x * gridDim.y * gridDim.z;
    unsigned sum, cnt, mine, sp = 0u;
    for (;;) {
        sum = 0u; cnt = 0u; mine = 0u;
#pragma unroll
        for (unsigned j = 0; j < 16; ++j) { const unsigned c = xb_ld(&bar[XB_XCNT(j)]); sum += c; cnt += (c > 0u) ? 1u : 0u; mine = (j == x) ? c : mine; }
        if (sum == G) break;
        __builtin_amdgcn_s_sleep(1);
        if ((++sp & 255u) == 0u) { if (xb_ld(&bar[XB_TMO])) break; if (sp > XB_SPIN_CAP) { atomicAdd(&bar[XB_TMO], 1u); break; } }
    }
    nloc = mine > 0u ? mine : 1u; nx = cnt > 0u ? cnt : 1u;
}
__device__ __forceinline__ void xcd_barrier(const XcdBarrier& b) {
    asm volatile("s_waitcnt vmcnt(0)" ::: "memory");
    __syncthreads();
    if (threadIdx.x == 0) {
        unsigned* bar = b.bar;
        __builtin_amdgcn_s_waitcnt(0);
        unsigned nloc = b.st[0], nx = b.st[1];
        if (nloc == 0u) { xcd_barrier_complete(bar, b.x, nloc, nx); b.st[0] = nloc; b.st[1] = nx; }
        const unsigned old = xb_add(&bar[XB_XSUB(b.x)], 1u);
        const unsigned gen = old / nloc;
        if (old + 1u == (gen + 1u) * nloc) {
            __builtin_amdgcn_fence(__ATOMIC_RELEASE, "agent");
            asm volatile("s_waitcnt vmcnt(0)" ::: "memory");
            const unsigned og = xb_add(&bar[XB_TOP], 1u);
            const unsigned tg = og / nx;
            if (og + 1u == (tg + 1u) * nx) xb_add(&bar[XB_TOPGEN], 1u);
            else XB_SPIN(xb_ld(&bar[XB_TOPGEN]) == tg, bar);
            __builtin_amdgcn_fence(__ATOMIC_ACQUIRE, "agent");
            xb_add(&bar[XB_XGEN(b.x)], 1u);
            asm volatile("s_waitcnt vmcnt(0)" ::: "memory");
        } else {
            XB_SPIN(xb_ld(&bar[XB_XGEN(b.x)]) == gen, bar);
            __builtin_amdgcn_fence(__ATOMIC_ACQUIRE, "agent");
            asm volatile("s_waitcnt vmcnt(0)" ::: "memory");
        }
    }
    __syncthreads();
}

struct Ctx { LAS uchar* lds; int tid, lane, wave, G, bid; uchar* ws; const void* const* in; float* out; };
#define XP_x(X) ((const float*)(X).in[0])
#define XP_pos(X) ((const int*)(X).in[1])
#define XP_ln_mix_w(X) ((const float*)(X).in[2])
#define XP_w_in(X) ((const float*)(X).in[3])
#define XP_conv_w(X) ((const float*)(X).in[4])
#define XP_conv_b(X) ((const float*)(X).in[5])
#define XP_dt_bias(X) ((const float*)(X).in[6])
#define XP_a_log(X) ((const float*)(X).in[7])
#define XP_d_skip(X) ((const float*)(X).in[8])
#define XP_ssm_norm_w(X) ((const float*)(X).in[9])
#define XP_w_out(X) ((const float*)(X).in[10])
#define XP_ln_ffn_w(X) ((const float*)(X).in[11])
#define XP_w_router(X) ((const float*)(X).in[12])
#define XP_b_router(X) ((const float*)(X).in[13])
#define XP_w_gu(X) ((const float*)(X).in[14])
#define XP_b_gu(X) ((const float*)(X).in[15])
#define XP_w_d(X) ((const float*)(X).in[16])
#define XP_b_d(X) ((const float*)(X).in[17])
#define XP_ln_final_w(X) ((const float*)(X).in[18])
#define XP_WinT(X) ((bf16*)((X).ws + WS_WINT))
#define XP_WoutT(X) ((bf16*)((X).ws + WS_WOUTT))
#define XP_WguT(X) ((uchar*)((X).ws + WS_WGUT))
#define XP_WdT(X) ((uchar*)((X).ws + WS_WDT))
#define XP_U(X) ((bf16*)((X).ws + WS_U))
#define XP_U2(X) ((uchar*)((X).ws + WS_U2))
#define XP_MIX(X) ((bf16*)((X).ws + WS_MIX))
#define XP_XBC(X) ((bf16*)((X).ws + WS_XBC))
#define XP_KV(X) ((bf16*)((X).ws + WS_KV))
#define XP_SST(X) ((bf16*)((X).ws + WS_SST))
#define XP_PROJ(X) ((bf16*)((X).ws + WS_PROJ))
#define XP_ACT(X) ((uchar*)((X).ws + WS_ACT))
#define XP_YR(X) ((uchar*)((X).ws + WS_YR))
#define XP_COS(X) ((float*)((X).ws + WS_COS))
#define XP_SIN(X) ((float*)((X).ws + WS_SIN))
#define XP_Hh(X) ((bf16*)((X).ws + WS_H))
#define XP_ADEC(X) ((float*)((X).ws + WS_ADEC))
#define XP_TOPW(X) ((float*)((X).ws + WS_TOPW))
#define XP_TOPI(X) ((int*)((X).ws + WS_TOPI))
#define XP_TOPR(X) ((int*)((X).ws + WS_TOPR))
#define XP_LIST(X) ((int*)((X).ws + WS_LIST))
#define XP_ctl(X) ((unsigned*)((X).ws + WS_CTL))
#define XP_WRH(X) ((bf16*)((X).ws + WS_WRH))
#define XP_WRL(X) ((bf16*)((X).ws + WS_WRL))


__device__ __forceinline__ bf16x8 tr_frag(LAS uchar* p, int rstep) {
    const s16x4 a = __builtin_amdgcn_ds_read_tr16_b64_v4i16((LAS s16x4*)p);
    const s16x4 b = __builtin_amdgcn_ds_read_tr16_b64_v4i16((LAS s16x4*)(p + rstep));
    return (bf16x8){a[0], a[1], a[2], a[3], b[0], b[1], b[2], b[3]};
}
__device__ __forceinline__ f32x4 mma16(bf16x8 xrow, bf16x8 ycol, f32x4 c) { return __builtin_amdgcn_mfma_f32_16x16x32_bf16(xrow, ycol, c, 0, 0, 0); }
__device__ __forceinline__ float wave_incl_scan(float v, int lane) {
#pragma unroll
    for (int o = 1; o < 64; o <<= 1) { const float t = __shfl_up(v, o); if (lane >= o) v += t; }
    return v;
}
__device__ __forceinline__ void rope8(const u32x4 k1, const u32x4 k2, const f32x4 c0, const f32x4 c1, const f32x4 s0, const f32x4 s1, const float sc, u32x4& o1, u32x4& o2) {
    float r1[8], r2[8];
#pragma unroll
    for (int m = 0; m < 4; ++m) {
        const float a0 = bf_lo(k1[m]), a1 = bf_hi(k1[m]), b0 = bf_lo(k2[m]), b1 = bf_hi(k2[m]);
        const float cs0 = (m < 2) ? c0[2 * m] : c1[2 * m - 4], cs1 = (m < 2) ? c0[2 * m + 1] : c1[2 * m - 3];
        const float sn0 = (m < 2) ? s0[2 * m] : s1[2 * m - 4], sn1 = (m < 2) ? s0[2 * m + 1] : s1[2 * m - 3];
        r1[2 * m] = (a0 * cs0 - b0 * sn0) * sc; r1[2 * m + 1] = (a1 * cs1 - b1 * sn1) * sc;
        r2[2 * m] = (b0 * cs0 + a0 * sn0) * sc; r2[2 * m + 1] = (b1 * cs1 + a1 * sn1) * sc;
    }
    o1.x = pk_bf16(r1[0], r1[1]); o1.y = pk_bf16(r1[2], r1[3]); o1.z = pk_bf16(r1[4], r1[5]); o1.w = pk_bf16(r1[6], r1[7]);
    o2.x = pk_bf16(r2[0], r2[1]); o2.y = pk_bf16(r2[2], r2[3]); o2.z = pk_bf16(r2[4], r2[5]); o2.w = pk_bf16(r2[6], r2[7]);
}

__device__ __forceinline__ void tr_decode(const Ctx& X, int r, const float*& W, bf16*& WT, int& N, int& kb, int& nb) {
    constexpr int I_IN = 32 * 209;
    if (r < I_IN) { W = XP_w_in(X); WT = XP_WinT(X); N = NPROJ; }
    else { r -= I_IN; W = XP_w_out(X); WT = XP_WoutT(X); N = D; }
    const int nbn = (N + 31) >> 5; kb = r / nbn; nb = r - kb * nbn;
}
__device__ __forceinline__ void tr8_item(const float* W, int N, uchar* WT, int kb, int nb, int lane) {
    const int k0 = kb * 128 + 16 * (lane & 7), n0 = nb * 32 + 4 * (lane >> 3);
    f32x4 v[16];
#pragma unroll
    for (int i = 0; i < 16; ++i) v[i] = __builtin_nontemporal_load((const f32x4*)(W + (size_t)(k0 + i) * N + n0));
#pragma unroll
    for (int j = 0; j < 4; ++j) { u32x4 o;
        o.x = pk_fp8x4(v[0][j] * W8_SCALE, v[1][j] * W8_SCALE, v[2][j] * W8_SCALE, v[3][j] * W8_SCALE); o.y = pk_fp8x4(v[4][j] * W8_SCALE, v[5][j] * W8_SCALE, v[6][j] * W8_SCALE, v[7][j] * W8_SCALE);
        o.z = pk_fp8x4(v[8][j] * W8_SCALE, v[9][j] * W8_SCALE, v[10][j] * W8_SCALE, v[11][j] * W8_SCALE); o.w = pk_fp8x4(v[12][j] * W8_SCALE, v[13][j] * W8_SCALE, v[14][j] * W8_SCALE, v[15][j] * W8_SCALE);
        __builtin_nontemporal_store(o, (u32x4*)(WT + (size_t)(n0 + j) * 2048 + k0)); }
}
__device__ __forceinline__ void tr_load(const float* W, int N, int kb, int nb, int lane, f32x4 (&v)[8]) {
    const int k0 = kb * 64 + 8 * (lane & 7), n0 = nb * 32 + 4 * (lane >> 3);
    if (n0 < N) {
#pragma unroll
        for (int i = 0; i < 8; ++i) v[i] = __builtin_nontemporal_load((const f32x4*)(W + (size_t)(k0 + i) * N + n0));
    }
}
__device__ __forceinline__ void tr_store(bf16* WT, int N, int kb, int nb, int lane, const f32x4 (&v)[8]) {
    const int k0 = kb * 64 + 8 * (lane & 7), n0 = nb * 32 + 4 * (lane >> 3);
    if (n0 < N) {
#pragma unroll
        for (int j = 0; j < 4; ++j) { u32x4 o; o.x = pk_bf16(v[0][j], v[1][j]); o.y = pk_bf16(v[2][j], v[3][j]); o.z = pk_bf16(v[4][j], v[5][j]); o.w = pk_bf16(v[6][j], v[7][j]);
            *(u32x4*)(WT + (size_t)(n0 + j) * 2048 + k0) = o; }
    }
}
constexpr int I_GU8 = 32 * 16 * 128, I_D8 = 32 * 16 * 64, I_ALL8 = I_GU8 + I_D8;
constexpr int FILL_N1 = 0, FILL_W1 = 160 * 8, FILL_N3 = 3, FILL_W3 = 64 * 8, FILL_N4 = 11, FILL_W4 = 128 * 8;
constexpr int P1_GEMM_BLOCKS = 144, WQ_CHUNK = 8;
constexpr int P5_GEMM_BLOCKS = 128, Q5_N = 24, Q5_W = 128 * 8;
constexpr int FILL_B1 = I_ALL8 - FILL_N1 * FILL_W1 - FILL_N3 * FILL_W3 - FILL_N4 * FILL_W4, FILL_B3 = FILL_B1 + FILL_N1 * FILL_W1, FILL_B4 = FILL_B3 + FILL_N3 * FILL_W3;
constexpr int Q5_BASE = FILL_B3 - Q5_N * Q5_W;
constexpr int CVT_STRIDE = 144, CVT_BUF = 256 * CVT_STRIDE, CQ_CHUNK = 4;
struct Cvb { const float* W; uchar* WT; int N; };
__device__ __forceinline__ Cvb conv8b_dec(const Ctx& X, int bit) { Cvb c; int kb, nb;
    if (bit < I_GU8 / 8) { const int e = bit >> 8, r = bit & 255; kb = r >> 4; nb = r & 15; c.N = 2 * DFF; c.W = XP_w_gu(X) + (size_t)e * D * (2 * DFF); c.WT = XP_WguT(X) + (size_t)e * (2 * DFF) * W8LD; }
    else { const int b2 = bit - I_GU8 / 8, e = b2 >> 7, r = b2 & 127; kb = r >> 3; nb = r & 7; c.N = D; c.W = XP_w_d(X) + (size_t)e * DFF * D; c.WT = XP_WdT(X) + (size_t)e * D * W8LD; }
    c.W += (size_t)(kb * 128 + 16 * X.wave) * c.N + nb * 256 + 4 * X.lane;
    c.WT += (size_t)(nb * 256 + 32 * X.wave + (X.lane >> 3)) * W8LD + kb * 128 + 16 * (X.lane & 7);
    return c; }
__device__ __forceinline__ void conv8b_run(const Ctx& X, int first, int step, int count) {
    if (count <= 0) return;
    f32x4 v[16];
    Cvb c = conv8b_dec(X, first), cn = c;
#pragma unroll
    for (int i = 0; i < 16; ++i) v[i] = __builtin_nontemporal_load((const f32x4*)(c.W + (size_t)i * c.N));
#pragma unroll 1
    for (int j = 0; j < count; ++j) {
        LAS uchar* buf = X.lds + (j & 1) * CVT_BUF;
#pragma unroll
        for (int q = 0; q < 4; ++q) { u32x4 o;
            o.x = pk_fp8x4(v[0][q] * W8_SCALE, v[1][q] * W8_SCALE, v[2][q] * W8_SCALE, v[3][q] * W8_SCALE); o.y = pk_fp8x4(v[4][q] * W8_SCALE, v[5][q] * W8_SCALE, v[6][q] * W8_SCALE, v[7][q] * W8_SCALE);
            o.z = pk_fp8x4(v[8][q] * W8_SCALE, v[9][q] * W8_SCALE, v[10][q] * W8_SCALE, v[11][q] * W8_SCALE); o.w = pk_fp8x4(v[12][q] * W8_SCALE, v[13][q] * W8_SCALE, v[14][q] * W8_SCALE, v[15][q] * W8_SCALE);
            *(LAS u32x4*)(buf + (4 * X.lane + q) * CVT_STRIDE + 16 * X.wave) = o; }
        if (j + 1 < count) { cn = conv8b_dec(X, first + (j + 1) * step);
#pragma unroll
            for (int i = 0; i < 16; ++i) v[i] = __builtin_nontemporal_load((const f32x4*)(cn.W + (size_t)i * cn.N)); }
        asm volatile("s_waitcnt lgkmcnt(0)" ::: "memory"); __builtin_amdgcn_s_barrier();
#pragma unroll
        for (int it = 0; it < 4; ++it) { const u32x4 r = *(const LAS u32x4*)(buf + (32 * X.wave + 8 * it + (X.lane >> 3)) * CVT_STRIDE + 16 * (X.lane & 7));
            __builtin_nontemporal_store(r, (u32x4*)(c.WT + (size_t)it * 8 * W8LD)); }
        c = cn;
    }
    asm volatile("s_waitcnt lgkmcnt(0)" ::: "memory"); __builtin_amdgcn_s_barrier();
}
__device__ __forceinline__ void conv8_fill(const Ctx& X, int base, int rank, int nblk, int n) { conv8b_run(X, (base >> 3) + rank, nblk, n); }
__device__ __forceinline__ void conv8_queue(const Ctx& X, int n) {
    LAS int* qw = (LAS int*)(X.lds + LDS_MISC + 64);
    unsigned zo = 0; asm volatile("" : "+v"(zo));
    int nb_ = 0;
    if (X.tid == 0) nb_ = (int)__hip_atomic_fetch_add(XP_ctl(X) + CW_WQ + zo, (unsigned)(8 * CQ_CHUNK), __ATOMIC_RELAXED, __HIP_MEMORY_SCOPE_AGENT);
    for (;;) {
        if (X.tid == 0) *qw = nb_;
        __syncthreads();
        const int base = __builtin_amdgcn_readfirstlane(*qw);
        if (base >= n) break;
        if (X.tid == 0) nb_ = (int)__hip_atomic_fetch_add(XP_ctl(X) + CW_WQ + zo, (unsigned)(8 * CQ_CHUNK), __ATOMIC_RELAXED, __HIP_MEMORY_SCOPE_AGENT);
        const int left = (n - base) >> 3;
        conv8b_run(X, base >> 3, 1, left < CQ_CHUNK ? left : CQ_CHUNK);
    }
}
__device__ __forceinline__ void p0_prologue(Ctx& X) {
    const int gw = X.bid * NWAVES + X.wave, NGW = X.G * NWAVES, lane = X.lane;
    const int gt = X.bid * NTHR + X.tid, NGT = X.G * NTHR;
    for (int m = gw; m < T; m += NGW) {
        const f32x4* xr = (const f32x4*)(XP_x(X) + (size_t)m * D) + lane; const f32x4* wr_ = (const f32x4*)XP_ln_mix_w(X) + lane;
        f32x4 v[8]; float s = 0.f;
#pragma unroll
        for (int j = 0; j < 8; ++j) { v[j] = xr[64 * j]; s += (v[j].x * v[j].x + v[j].y * v[j].y) + (v[j].z * v[j].z + v[j].w * v[j].w); }
        const float rstd = rsqrtf(wave_sum(s) * (1.f / D) + EPS);
        u32x2* o8 = (u32x2*)(XP_U(X) + (size_t)m * D) + lane;
#pragma unroll
        for (int j = 0; j < 8; ++j) { const f32x4 w = wr_[64 * j]; u32x2 o; o.x = pk_bf16(v[j].x * rstd * w.x, v[j].y * rstd * w.y); o.y = pk_bf16(v[j].z * rstd * w.z, v[j].w * rstd * w.w); o8[64 * j] = o; }
    }
    for (int idx = gt; idx < T * 128; idx += NGT) {
        const int t = idx >> 7, i = idx & 127;
        const double ang = (double)XP_pos(X)[t] * INV_FREQ[i];
        double rev = ang * 0.15915494309189533577; rev -= floor(rev);
        const float f = (float)rev;
        XP_COS(X)[idx] = __builtin_amdgcn_cosf(f); XP_SIN(X)[idx] = __builtin_amdgcn_sinf(f);
    }
    { u32x4* p = (u32x4*)(XP_WinT(X) + (size_t)NPROJ * D); const int n16 = (LDP - NPROJ) * D * 2 / 16; const u32x4 z = {0u, 0u, 0u, 0u};
      for (int i = gt; i < n16; i += NGT) p[i] = z; }
    for (int idx = gt; idx < NE * D; idx += NGT) { const int e = idx >> 11, d = idx & 2047;
        const float wv = XP_ln_ffn_w(X)[d] * XP_w_router(X)[d * NE + e]; const unsigned hb = pk_bf16(wv, 0.f) & 0xffffu; const float lo = wv - __uint_as_float(hb << 16);
        XP_WRH(X)[idx] = (bf16)hb; XP_WRL(X)[idx] = (bf16)(pk_bf16(lo, 0.f) & 0xffffu); }
    constexpr int NIT = 32 * 209 + 32 * 64;
    for (int it = gw; it < NIT; it += 2 * NGW) {
        const float *W0, *W1 = nullptr; bf16 *T0, *T1 = nullptr; int N0, N1 = 0, kb0, kb1 = 0, nb0, nb1 = 0;
        f32x4 v0[8], v1[8];
        tr_decode(X, it, W0, T0, N0, kb0, nb0);
        const bool two = (it + NGW) < NIT;
        if (two) tr_decode(X, it + NGW, W1, T1, N1, kb1, nb1);
        tr_load(W0, N0, kb0, nb0, lane, v0);
        if (two) tr_load(W1, N1, kb1, nb1, lane, v1);
        tr_store(T0, N0, kb0, nb0, lane, v0);
        if (two) tr_store(T1, N1, kb1, nb1, lane, v1);
    }
}

__device__ __forceinline__ bf16x8 scale_frag(const bf16x8 f, const float base, const float (&rr)[8]) {
    u32x4 u = __builtin_bit_cast(u32x4, f);
    u.x = pk_bf16(bf_lo(u.x) * (base * rr[0]), bf_hi(u.x) * (base * rr[1])); u.y = pk_bf16(bf_lo(u.y) * (base * rr[2]), bf_hi(u.y) * (base * rr[3]));
    u.z = pk_bf16(bf_lo(u.z) * (base * rr[4]), bf_hi(u.z) * (base * rr[5])); u.w = pk_bf16(bf_lo(u.w) * (base * rr[6]), bf_hi(u.w) * (base * rr[7]));
    return __builtin_bit_cast(bf16x8, u);
}
__device__ __forceinline__ void p2_ret(Ctx& X, int unit) {
    const int c = unit >> 2, h = unit & 3, t0 = c * CH, tid = X.tid, lane = X.lane, w = X.wave;
    LAS uchar* Vt = X.lds; LAS uchar* Kt = X.lds + 69632;
    { u32x4 vv[8], kk[8];
#pragma unroll
      for (int i = 0; i < 8; ++i) { const int q = tid + 512 * i, l = q >> 5, vc = q & 31; const bf16* rp = XP_PROJ(X) + (size_t)(t0 + l) * LDP + h * 256 + vc * 8;
          vv[i] = *(const u32x4*)(rp + C_V); kk[i] = *(const u32x4*)(rp + C_K); }
#pragma unroll
      for (int i = 0; i < 8; ++i) { const int q = tid + 512 * i, l = q >> 5, vc = q & 31; *(LAS u32x4*)(Vt + l * 544 + vc * 16) = vv[i]; *(LAS u32x4*)(Kt + l * 544 + vc * 16) = kk[i]; } }
    __syncthreads();
    const float lg = LG2_GAMMA[h];
    float rr[8];
#pragma unroll
    for (int e = 0; e < 8; ++e) rr[e] = exp2f(-lg * (float)e);
    const int fr = lane & 15, fq = lane >> 4, trs = (8 * fq + ((lane & 15) >> 2)) * 544 + 8 * (lane & 3);
    f32x4 acc[2][16];
#pragma unroll
    for (int a = 0; a < 2; ++a)
#pragma unroll
        for (int n = 0; n < 16; ++n) acc[a][n] = (f32x4){0.f, 0.f, 0.f, 0.f};
#pragma unroll 1
    for (int ks = 0; ks < 4; ++ks) {
        const float base = exp2f(lg * (float)(127 - 32 * ks - 8 * fq));
        const bf16x8 af0 = scale_frag(tr_frag(Vt + (32 * ks) * 544 + (16 * w) * 2 + trs, 4 * 544), base, rr);
        const bf16x8 af1 = scale_frag(tr_frag(Vt + (32 * ks) * 544 + (128 + 16 * w) * 2 + trs, 4 * 544), base, rr);
#pragma unroll
        for (int n = 0; n < 16; ++n) { const bf16x8 bf = tr_frag(Kt + (32 * ks) * 544 + (16 * n) * 2 + trs, 4 * 544);
            acc[0][n] = mma16(bf, af0, acc[0][n]); acc[1][n] = mma16(bf, af1, acc[1][n]); }
    }
    bf16* outp = XP_KV(X) + (size_t)(c * 4 + h) * 65536;
#pragma unroll
    for (int a = 0; a < 2; ++a)
#pragma unroll
        for (int n = 0; n < 16; ++n) { u32x2 o; o.x = pk_bf16(acc[a][n][0], acc[a][n][1]); o.y = pk_bf16(acc[a][n][2], acc[a][n][3]);
            *(u32x2*)(outp + (size_t)(128 * a + 16 * w + fr) * 256 + 16 * n + 4 * fq) = o; }
    __syncthreads();
}
__device__ __forceinline__ void conv8(const Ctx& X, int t, int cx, float (&o)[8]) {
    const f32x4 b0 = *(const f32x4*)(XP_conv_b(X) + cx), b1 = *(const f32x4*)(XP_conv_b(X) + cx + 4);
    o[0] = b0.x; o[1] = b0.y; o[2] = b0.z; o[3] = b0.w; o[4] = b1.x; o[5] = b1.y; o[6] = b1.z; o[7] = b1.w;
#pragma unroll
    for (int j = 0; j < 4; ++j) { const int tt = t - 3 + j;
        if (tt >= 0) { const u32x4 v = *(const u32x4*)(XP_PROJ(X) + (size_t)tt * LDP + C_X + cx);
            const f32x4 w0 = *(const f32x4*)(XP_conv_w(X) + j * XBCW + cx), w1 = *(const f32x4*)(XP_conv_w(X) + j * XBCW + cx + 4);
            o[0] += w0.x * bf_lo(v.x); o[1] += w0.y * bf_hi(v.x); o[2] += w0.z * bf_lo(v.y); o[3] += w0.w * bf_hi(v.y);
            o[4] += w1.x * bf_lo(v.z); o[5] += w1.y * bf_hi(v.z); o[6] += w1.z * bf_lo(v.w); o[7] += w1.w * bf_hi(v.w); } }
#pragma unroll
    for (int i = 0; i < 8; ++i) o[i] = silu_f(o[i]);
}
__device__ __forceinline__ void p2_ssd(Ctx& X, int unit) {
    const int c = unit >> 2, g = (unit >> 1) & 1, hh = unit & 1, t0 = c * CH, tid = X.tid, lane = X.lane, w = X.wave;
    LAS uchar* Xd = X.lds; LAS uchar* Bc = X.lds + 69632;
    LAS float* dtS = (LAS float*)(X.lds + 106496); LAS float* acS = (LAS float*)(X.lds + 108544);
    if (w < 4) { const int h = 8 * g + 4 * hh + w, l0 = 2 * lane;
        const float dtb = XP_dt_bias(X)[h], A = -expf(XP_a_log(X)[h]);
        const float d0 = softplus_f(bf2f(XP_PROJ(X)[(size_t)(t0 + l0) * LDP + C_DT + h]) + dtb), d1 = softplus_f(bf2f(XP_PROJ(X)[(size_t)(t0 + l0 + 1) * LDP + C_DT + h]) + dtb);
        const float a0 = d0 * A, a1 = d1 * A, s = a0 + a1, incl = wave_incl_scan(s, lane);
        dtS[w * 128 + l0] = d0; dtS[w * 128 + l0 + 1] = d1; acS[w * 128 + l0] = incl - a1; acS[w * 128 + l0 + 1] = incl;
        if (lane == 63) XP_ADEC(X)[c * 16 + h] = expf(incl); }
    __syncthreads();
    if (tid < 504) { const int rg = tid / 56, j = tid - rg * 56, l0 = 15 * rg;
        int cx; if (j < 32) cx = 512 * g + 256 * hh + 8 * j; else if (j < 48) cx = 1024 + 128 * g + 8 * (j - 32); else cx = 1280 + 128 * g + 64 * hh + 8 * (j - 48);
        u32x4 rw[18];
#pragma unroll
        for (int r = 0; r < 18; ++r) { const int l = l0 - 3 + r, tt = t0 + l; rw[r] = (tt >= 0 && l < 128) ? *(const u32x4*)(XP_PROJ(X) + (size_t)tt * LDP + C_X + cx) : (u32x4){0u, 0u, 0u, 0u}; }
        f32x4 wa[4], wb[4];
#pragma unroll
        for (int k = 0; k < 4; ++k) { wa[k] = *(const f32x4*)(XP_conv_w(X) + k * XBCW + cx); wb[k] = *(const f32x4*)(XP_conv_w(X) + k * XBCW + cx + 4); }
        const f32x4 ba = *(const f32x4*)(XP_conv_b(X) + cx), bb = *(const f32x4*)(XP_conv_b(X) + cx + 4);
#pragma unroll
        for (int r = 0; r < 15; ++r) { const int l = l0 + r;
            if (l < 128) { float o[8] = {ba.x, ba.y, ba.z, ba.w, bb.x, bb.y, bb.z, bb.w};
#pragma unroll
                for (int k = 0; k < 4; ++k) { const u32x4 v = rw[r + k];
                    o[0] += wa[k].x * bf_lo(v.x); o[1] += wa[k].y * bf_hi(v.x); o[2] += wa[k].z * bf_lo(v.y); o[3] += wa[k].w * bf_hi(v.y);
                    o[4] += wb[k].x * bf_lo(v.z); o[5] += wb[k].y * bf_hi(v.z); o[6] += wb[k].z * bf_lo(v.w); o[7] += wb[k].w * bf_hi(v.w); }
#pragma unroll
                for (int i = 0; i < 8; ++i) o[i] = silu_f(o[i]);
                u32x4 ov; ov.x = pk_bf16(o[0], o[1]); ov.y = pk_bf16(o[2], o[3]); ov.z = pk_bf16(o[4], o[5]); ov.w = pk_bf16(o[6], o[7]);
                if (j < 32) { const int e = j >> 3; const float sc = dtS[e * 128 + l] * __expf(acS[e * 128 + 127] - acS[e * 128 + l]);
                    u32x4 os; os.x = pk_bf16(o[0] * sc, o[1] * sc); os.y = pk_bf16(o[2] * sc, o[3] * sc); os.z = pk_bf16(o[4] * sc, o[5] * sc); os.w = pk_bf16(o[6] * sc, o[7] * sc);
                    *(LAS u32x4*)(Xd + l * 544 + j * 16) = os; *(u32x4*)(XP_XBC(X) + (size_t)(t0 + l) * XBCW + cx) = ov; }
                else if (j < 48) { *(LAS u32x4*)(Bc + l * 288 + (j - 32) * 16) = ov; if (hh == 0) *(u32x4*)(XP_XBC(X) + (size_t)(t0 + l) * XBCW + cx) = ov; }
                else *(u32x4*)(XP_XBC(X) + (size_t)(t0 + l) * XBCW + cx) = ov; } } }
    __syncthreads();
    const int fr = lane & 15, fq = lane >> 4, q4 = (lane & 15) >> 2, p4 = lane & 3;
    const int trx = (8 * fq + q4) * 544 + 8 * p4, trb = (8 * fq + q4) * 288 + 8 * p4;
    f32x4 acc[2][8];
#pragma unroll
    for (int a = 0; a < 2; ++a)
#pragma unroll
        for (int n = 0; n < 8; ++n) acc[a][n] = (f32x4){0.f, 0.f, 0.f, 0.f};
#pragma unroll 1
    for (int ks = 0; ks < 4; ++ks) {
        const bf16x8 af0 = tr_frag(Xd + (32 * ks) * 544 + (16 * w) * 2 + trx, 4 * 544);
        const bf16x8 af1 = tr_frag(Xd + (32 * ks) * 544 + (128 + 16 * w) * 2 + trx, 4 * 544);
#pragma unroll
        for (int n = 0; n < 8; ++n) { const bf16x8 bf = tr_frag(Bc + (32 * ks) * 288 + (16 * n) * 2 + trb, 4 * 288);
            acc[0][n] = mma16(bf, af0, acc[0][n]); acc[1][n] = mma16(bf, af1, acc[1][n]); }
    }
#pragma unroll
    for (int a = 0; a < 2; ++a) { const int m = 128 * a + 16 * w + fr, h = 8 * g + 4 * hh + (m >> 6), p = m & 63;
        bf16* outp = XP_SST(X) + ((size_t)(c * 16 + h) * 64 + p) * 128;
#pragma unroll
        for (int n = 0; n < 8; ++n) { u32x2 o; o.x = pk_bf16(acc[a][n][0], acc[a][n][1]); o.y = pk_bf16(acc[a][n][2], acc[a][n][3]); *(u32x2*)(outp + 16 * n + 4 * fq) = o; } }
    __syncthreads();
}

__device__ __forceinline__ void p3_scan(Ctx& X) {
    const int gt = X.bid * NTHR + X.tid, NGT = X.G * NTHR;
    for (int item = gt; item < 65536 + 32768; item += NGT) {
        const bool ret = item < 65536; const int it2 = ret ? item : item - 65536;
        bf16* p = ret ? (XP_KV(X) + (size_t)it2 * 4) : (XP_SST(X) + (size_t)it2 * 4);
        const size_t stride = ret ? 262144 : 131072;
        const int head = ret ? (it2 >> 14) : (it2 >> 11);
        const float gdec = ret ? GAMMA_CHUNK[head & 3] : 0.f;
        float s0 = 0.f, s1 = 0.f, s2 = 0.f, s3 = 0.f;
        for (int c0 = 0; c0 < NCHUNK; c0 += 16) {
            u32x2 v[16]; float dec[16];
#pragma unroll
            for (int j = 0; j < 16; ++j) { v[j] = *(const u32x2*)(p + (size_t)(c0 + j) * stride); dec[j] = ret ? gdec : XP_ADEC(X)[(c0 + j) * 16 + head]; }
#pragma unroll
            for (int j = 0; j < 16; ++j) { u32x2 o; o.x = pk_bf16(s0, s1); o.y = pk_bf16(s2, s3); *(u32x2*)(p + (size_t)(c0 + j) * stride) = o;
                s0 = dec[j] * s0 + bf_lo(v[j].x); s1 = dec[j] * s1 + bf_hi(v[j].x); s2 = dec[j] * s2 + bf_lo(v[j].y); s3 = dec[j] * s3 + bf_hi(v[j].y); }
        }
    }
}

__device__ __forceinline__ void p4_ret(Ctx& X, int unit) {
    const int c = unit >> 2, h = unit & 3, t0 = c * CH, tid = X.tid, lane = X.lane, w = X.wave;
    LAS uchar* R1 = X.lds; LAS uchar* R2 = X.lds + 69632;
    const float lg = LG2_GAMMA[h];
    u32x4 P[8];
    { u32x4 qq[8];
#pragma unroll
      for (int i = 0; i < 8; ++i) { const int q = tid + 512 * i, l = q >> 5, dc = q & 31; const bf16* rp = XP_PROJ(X) + (size_t)(t0 + l) * LDP + h * 256 + dc * 8;
          qq[i] = *(const u32x4*)(rp + C_Q); P[i] = *(const u32x4*)(rp + C_K); }
#pragma unroll
      for (int i = 0; i < 8; ++i) { const int q = tid + 512 * i, l = q >> 5, dc = q & 31; *(LAS u32x4*)(R1 + l * 544 + dc * 16) = qq[i]; *(LAS u32x4*)(R2 + l * 544 + dc * 16) = P[i]; } }
    __syncthreads();
    const bf16* prev = XP_KV(X) + (size_t)(c * 4 + h) * 65536;
#pragma unroll
    for (int i = 0; i < 8; ++i) { const int q = tid + 512 * i, v = q >> 4, dc = q & 15; P[i] = *(const u32x4*)(prev + (size_t)v * 256 + dc * 8); }
    const int fr = lane & 15, fq = lane >> 4, q4 = (lane & 15) >> 2, p4 = lane & 3, l = 16 * w + fr;
    f32x4 sc[8];
#pragma unroll
    for (int n = 0; n < 8; ++n) sc[n] = (f32x4){0.f, 0.f, 0.f, 0.f};
#pragma unroll 2
    for (int ks = 0; ks < 8; ++ks) {
        const bf16x8 af = *(const LAS bf16x8*)(R1 + l * 544 + (32 * ks + 8 * fq) * 2);
#pragma unroll
        for (int n = 0; n < 8; ++n) if (n <= w) { const bf16x8 bf = *(const LAS bf16x8*)(R2 + (16 * n + fr) * 544 + (32 * ks + 8 * fq) * 2); sc[n] = mma16(bf, af, sc[n]); }
    }
    bf16x8 scf[4];
#pragma unroll
    for (int k2 = 0; k2 < 4; ++k2) { float v[8];
#pragma unroll
        for (int tq = 0; tq < 2; ++tq)
#pragma unroll
            for (int j = 0; j < 4; ++j) { const int s = 16 * (2 * k2 + tq) + 4 * fq + j; v[4 * tq + j] = (s <= l) ? sc[2 * k2 + tq][j] * exp2f(lg * (float)(l - s)) : 0.f; }
        u32x4 pk; pk.x = pk_bf16(v[0], v[1]); pk.y = pk_bf16(v[2], v[3]); pk.z = pk_bf16(v[4], v[5]); pk.w = pk_bf16(v[6], v[7]);
        scf[k2] = __builtin_bit_cast(bf16x8, pk); }
    __syncthreads();
    f32x4 acc[16];
#pragma unroll
    for (int n = 0; n < 16; ++n) acc[n] = (f32x4){0.f, 0.f, 0.f, 0.f};
#pragma unroll
    for (int dh = 0; dh < 2; ++dh) {
#pragma unroll
        for (int i = 0; i < 8; ++i) { const int q = tid + 512 * i, v = q >> 4, dc = q & 15; *(LAS u32x4*)(R2 + v * 272 + dc * 16) = P[i]; }
        __syncthreads();
        if (dh == 0) {
#pragma unroll
            for (int i = 0; i < 8; ++i) { const int q = tid + 512 * i, v = q >> 4, dc = q & 15; P[i] = *(const u32x4*)(prev + (size_t)v * 256 + 128 + dc * 8); }
        } else {
#pragma unroll
            for (int i = 0; i < 8; ++i) { const int q = tid + 512 * i, s_ = q >> 5, vc = q & 31; P[i] = *(const u32x4*)(XP_PROJ(X) + (size_t)(t0 + s_) * LDP + C_V + h * 256 + vc * 8); }
        }
#pragma unroll 2
        for (int ks = 0; ks < 4; ++ks) {
            const bf16x8 af = *(const LAS bf16x8*)(R1 + l * 544 + (128 * dh + 32 * ks + 8 * fq) * 2);
#pragma unroll
            for (int n = 0; n < 16; ++n) { const bf16x8 bf = *(const LAS bf16x8*)(R2 + (16 * n + fr) * 272 + (32 * ks + 8 * fq) * 2); acc[n] = mma16(bf, af, acc[n]); }
        }
        __syncthreads();
    }
    { const float qd = exp2f(lg * (float)(l + 1));
#pragma unroll
      for (int n = 0; n < 16; ++n) acc[n] = acc[n] * qd; }
#pragma unroll
    for (int i = 0; i < 8; ++i) { const int q = tid + 512 * i, s_ = q >> 5, vc = q & 31; *(LAS u32x4*)(R2 + s_ * 544 + vc * 16) = P[i]; }
    __syncthreads();
    const bf16* gp = XP_PROJ(X) + (size_t)(t0 + l) * LDP + C_G + h * 256 + 4 * fq; bf16* op = XP_MIX(X) + (size_t)(t0 + l) * D + h * 256 + 4 * fq;
    u32x2 gv[16];
#pragma unroll
    for (int n = 0; n < 16; ++n) gv[n] = *(const u32x2*)(gp + 16 * n);
    const int trp = (4 * fq + q4) * 544 + 8 * p4;
#pragma unroll
    for (int k2 = 0; k2 < 4; ++k2) if (2 * k2 <= w) {
#pragma unroll
        for (int n = 0; n < 16; ++n) { const bf16x8 bf = tr_frag(R2 + (32 * k2) * 544 + (16 * n) * 2 + trp, 16 * 544); acc[n] = mma16(bf, scf[k2], acc[n]); }
    }
    float ss = 0.f;
#pragma unroll
    for (int n = 0; n < 16; ++n) ss += (acc[n][0] * acc[n][0] + acc[n][1] * acc[n][1]) + (acc[n][2] * acc[n][2] + acc[n][3] * acc[n][3]);
    ss += __shfl_xor(ss, 16); ss += __shfl_xor(ss, 32);
    const float rstd = rsqrtf(ss * (1.f / 256.f) + EPS);
#pragma unroll
    for (int n = 0; n < 16; ++n) {
        u32x2 o; o.x = pk_bf16(acc[n][0] * rstd * silu_f(bf_lo(gv[n].x)), acc[n][1] * rstd * silu_f(bf_hi(gv[n].x))); o.y = pk_bf16(acc[n][2] * rstd * silu_f(bf_lo(gv[n].y)), acc[n][3] * rstd * silu_f(bf_hi(gv[n].y)));
        *(u32x2*)(op + 16 * n) = o; }
    __syncthreads();
}

__device__ __forceinline__ void p4_ssd(Ctx& X, int unit) {
    const int c = unit >> 1, g = unit & 1, t0 = c * CH, tid = X.tid, lane = X.lane, w = X.wave;
    LAS uchar* Cc = X.lds; LAS uchar* Bc = X.lds + 34816;
    LAS uchar* HP = X.lds + 34816;
    LAS float* dtS = (LAS float*)(X.lds + 110592); LAS float* acS = (LAS float*)(X.lds + 114688);
    const int fr = lane & 15, fq = lane >> 4, q4 = (lane & 15) >> 2, p4 = lane & 3, l = 16 * w + fr;
    const bf16* zp = XP_PROJ(X) + (size_t)(t0 + l) * LDP + C_Z + 512 * g + 4 * fq;
    const int hd = 8 * g + w, l0 = 2 * lane;
    const bf16 dr0 = XP_PROJ(X)[(size_t)(t0 + l0) * LDP + C_DT + hd], dr1 = XP_PROJ(X)[(size_t)(t0 + l0 + 1) * LDP + C_DT + hd];
    u32x4 bcv[8];
#pragma unroll
    for (int i = 0; i < 4; ++i) { const int q = tid + 512 * i, l_ = q >> 4, nc = q & 15;
        bcv[2 * i] = *(const u32x4*)(XP_XBC(X) + (size_t)(t0 + l_) * XBCW + 1024 + 128 * g + nc * 8);
        bcv[2 * i + 1] = *(const u32x4*)(XP_XBC(X) + (size_t)(t0 + l_) * XBCW + 1280 + 128 * g + nc * 8); }
    u32x4 px[4], ps[4];
#pragma unroll
    for (int i = 0; i < 4; ++i) { const int q = tid + 512 * i; { const int e2 = q >> 10, s_ = (q >> 3) & 127, pc = q & 7; px[i] = *(const u32x4*)(XP_XBC(X) + (size_t)(t0 + s_) * XBCW + 512 * g + 64 * e2 + pc * 8); }
        { const int e2 = q >> 10, p = (q >> 4) & 63, nc = q & 15; ps[i] = *(const u32x4*)(XP_SST(X) + ((size_t)(c * 16 + 8 * g + e2) * 64 + p) * 128 + nc * 8); } }
    u32x2 zq[2][4];
#pragma unroll
    for (int e2 = 0; e2 < 2; ++e2)
#pragma unroll
        for (int n = 0; n < 4; ++n) zq[e2][n] = *(const u32x2*)(zp + 64 * e2 + 16 * n);
    { const float dtb = XP_dt_bias(X)[hd], A = -expf(XP_a_log(X)[hd]);
      const float d0 = softplus_f(bf2f(dr0) + dtb), d1 = softplus_f(bf2f(dr1) + dtb);
      const float a0 = d0 * A, a1 = d1 * A, incl = wave_incl_scan(a0 + a1, lane);
      dtS[w * 128 + l0] = d0; dtS[w * 128 + l0 + 1] = d1; acS[w * 128 + l0] = incl - a1; acS[w * 128 + l0 + 1] = incl; }
#pragma unroll
    for (int i = 0; i < 4; ++i) { const int q = tid + 512 * i, l_ = q >> 4, nc = q & 15;
        *(LAS u32x4*)(Bc + l_ * 272 + nc * 16) = bcv[2 * i];
        *(LAS u32x4*)(Cc + l_ * 272 + nc * 16) = bcv[2 * i + 1]; }
    __syncthreads();
    f32x4 cb[8]; bf16x8 cfr[4];
#pragma unroll
    for (int n = 0; n < 8; ++n) cb[n] = (f32x4){0.f, 0.f, 0.f, 0.f};
#pragma unroll
    for (int ks = 0; ks < 4; ++ks) {
        cfr[ks] = *(const LAS bf16x8*)(Cc + l * 272 + (32 * ks + 8 * fq) * 2);
#pragma unroll
        for (int n = 0; n < 8; ++n) if (n <= w) { const bf16x8 bf = *(const LAS bf16x8*)(Bc + (16 * n + fr) * 272 + (32 * ks + 8 * fq) * 2); cb[n] = mma16(bf, cfr[ks], cb[n]); }
    }
    __syncthreads();
    float ss = 0.f;
    const int trp = (4 * fq + q4) * 144 + 8 * p4;
    bf16* op = XP_MIX(X) + (size_t)(t0 + l) * D + 1024 + 512 * g + 4 * fq;
#pragma unroll 1
    for (int hp = 0; hp < 4; ++hp) {
#pragma unroll
        for (int i = 0; i < 4; ++i) { const int q = tid + 512 * i; { const int e2 = q >> 10, s_ = (q >> 3) & 127, pc = q & 7; *(LAS u32x4*)(HP + e2 * 18432 + s_ * 144 + pc * 16) = px[i]; }
            { const int e2 = q >> 10, p = (q >> 4) & 63, nc = q & 15; *(LAS u32x4*)(HP + 36864 + e2 * 17408 + p * 272 + nc * 16) = ps[i]; } }
        __syncthreads();
        if (hp < 3) {
#pragma unroll
            for (int i = 0; i < 4; ++i) { const int q = tid + 512 * i; { const int e2 = q >> 10, s_ = (q >> 3) & 127, pc = q & 7, e = 2 * hp + 2 + e2; px[i] = *(const u32x4*)(XP_XBC(X) + (size_t)(t0 + s_) * XBCW + 512 * g + 64 * e + pc * 8); }
                { const int e2 = q >> 10, p = (q >> 4) & 63, nc = q & 15, e = 2 * hp + 2 + e2; ps[i] = *(const u32x4*)(XP_SST(X) + ((size_t)(c * 16 + 8 * g + e) * 64 + p) * 128 + nc * 8); } }
        }
        u32x2 zqn[2][4];
#pragma unroll
        for (int e2 = 0; e2 < 2; ++e2)
#pragma unroll
            for (int n = 0; n < 4; ++n) zqn[e2][n] = zq[e2][n];
        if (hp < 3) {
#pragma unroll
            for (int e2 = 0; e2 < 2; ++e2)
#pragma unroll
                for (int n = 0; n < 4; ++n) zqn[e2][n] = *(const u32x2*)(zp + 64 * (2 * hp + 2 + e2) + 16 * n);
        }
#pragma unroll
        for (int e2 = 0; e2 < 2; ++e2) { const int e = 2 * hp + e2;
            LAS uchar* Xh = HP + e2 * 18432; LAS uchar* Ph = HP + 36864 + e2 * 17408;
            f32x4 y[4];
#pragma unroll
            for (int n = 0; n < 4; ++n) y[n] = (f32x4){0.f, 0.f, 0.f, 0.f};
#pragma unroll
            for (int ks = 0; ks < 4; ++ks)
#pragma unroll
                for (int n = 0; n < 4; ++n) { const bf16x8 bf = *(const LAS bf16x8*)(Ph + (16 * n + fr) * 272 + (32 * ks + 8 * fq) * 2); y[n] = mma16(bf, cfr[ks], y[n]); }
            const float al = acS[e * 128 + l], el = __expf(al);
#pragma unroll
            for (int n = 0; n < 4; ++n) y[n] = y[n] * el;
#pragma unroll
            for (int k2 = 0; k2 < 4; ++k2) if (2 * k2 <= w) { float v[8];
#pragma unroll
                for (int tq = 0; tq < 2; ++tq) { const int s0 = 16 * (2 * k2 + tq) + 4 * fq; const f32x4 as = *(const LAS f32x4*)(acS + e * 128 + s0), ds = *(const LAS f32x4*)(dtS + e * 128 + s0);
#pragma unroll
                    for (int j = 0; j < 4; ++j) v[4 * tq + j] = (s0 + j <= l) ? cb[2 * k2 + tq][j] * ds[j] * __expf(al - as[j]) : 0.f; }
                u32x4 pk; pk.x = pk_bf16(v[0], v[1]); pk.y = pk_bf16(v[2], v[3]); pk.z = pk_bf16(v[4], v[5]); pk.w = pk_bf16(v[6], v[7]);
                const bf16x8 gf = __builtin_bit_cast(bf16x8, pk);
#pragma unroll
                for (int n = 0; n < 4; ++n) { const bf16x8 bf = tr_frag(Xh + (32 * k2) * 144 + (16 * n) * 2 + trp, 16 * 144); y[n] = mma16(bf, gf, y[n]); }
            }
            const float dsk = XP_d_skip(X)[8 * g + e];
#pragma unroll
            for (int n = 0; n < 4; ++n) { const u32x2 xv = *(const LAS u32x2*)(Xh + l * 144 + (16 * n + 4 * fq) * 2), zv = zq[e2][n];
                const float t0_ = (y[n][0] + dsk * bf_lo(xv.x)) * silu_f(bf_lo(zv.x)), t1_ = (y[n][1] + dsk * bf_hi(xv.x)) * silu_f(bf_hi(zv.x));
                const float t2_ = (y[n][2] + dsk * bf_lo(xv.y)) * silu_f(bf_lo(zv.y)), t3_ = (y[n][3] + dsk * bf_hi(xv.y)) * silu_f(bf_hi(zv.y));
                ss += (t0_ * t0_ + t1_ * t1_) + (t2_ * t2_ + t3_ * t3_);
                u32x2 o; o.x = pk_bf16(t0_, t1_); o.y = pk_bf16(t2_, t3_); *(u32x2*)(op + 64 * e + 16 * n) = o; }
        }
#pragma unroll
        for (int e2 = 0; e2 < 2; ++e2)
#pragma unroll
            for (int n = 0; n < 4; ++n) zq[e2][n] = zqn[e2][n];
        __syncthreads();
    }
    ss += __shfl_xor(ss, 16); ss += __shfl_xor(ss, 32);
    const float rstd = rsqrtf(ss * (1.f / 512.f) + EPS);
    const float* nw = XP_ssm_norm_w(X) + 512 * g + 4 * fq;
    u32x2 tv[32];
#pragma unroll
    for (int i = 0; i < 32; ++i) tv[i] = *(const u32x2*)(op + 16 * i);
#pragma unroll
    for (int i = 0; i < 32; ++i) { const f32x4 wv = *(const f32x4*)(nw + 16 * i); const u32x2 t = tv[i];
        u32x2 o; o.x = pk_bf16(bf_lo(t.x) * rstd * wv.x, bf_hi(t.x) * rstd * wv.y); o.y = pk_bf16(bf_lo(t.y) * rstd * wv.z, bf_hi(t.y) * rstd * wv.w);
        *(u32x2*)(op + 16 * i) = o; }
    __syncthreads();
}

__device__ __forceinline__ void p6_router(Ctx& X) {
    const int tid = X.tid, lane = X.lane, w = X.wave, fr = lane & 15, fq = lane >> 4;
    LAS float* part = (LAS float*)X.lds;
    LAS float* ssq = (LAS float*)(X.lds + 32768);
    LAS float* lgt = (LAS float*)(X.lds + 32768 + 1024);
    LAS float* rs = (LAS float*)(X.lds + 32768 + 1024 + 4096);
    for (int item = X.bid; item < T / 32; item += X.G) {
        const int tb = item * 32;
        f32x4 acc[2][2]; float ss[2] = {0.f, 0.f};
#pragma unroll
        for (int a = 0; a < 2; ++a)
#pragma unroll
            for (int n = 0; n < 2; ++n) acc[a][n] = (f32x4){0.f, 0.f, 0.f, 0.f};
#pragma unroll 2
        for (int ks = 0; ks < 8; ++ks) { const int kb = 256 * w + 32 * ks + 8 * fq;
            bf16x8 ah[2], bh[2], bl[2];
#pragma unroll
            for (int mt = 0; mt < 2; ++mt) { const u32x4 hv = *(const u32x4*)(XP_Hh(X) + (size_t)(tb + 16 * mt + fr) * D + kb);
                const float f0 = bf_lo(hv.x), f1 = bf_hi(hv.x), f2 = bf_lo(hv.y), f3 = bf_hi(hv.y), f4 = bf_lo(hv.z), f5 = bf_hi(hv.z), f6 = bf_lo(hv.w), f7 = bf_hi(hv.w);
                ss[mt] += (f0 * f0 + f1 * f1) + (f2 * f2 + f3 * f3) + (f4 * f4 + f5 * f5) + (f6 * f6 + f7 * f7);
                ah[mt] = __builtin_bit_cast(bf16x8, hv); }
#pragma unroll
            for (int nt = 0; nt < 2; ++nt) { bh[nt] = *(const bf16x8*)(XP_WRH(X) + (size_t)(16 * nt + fr) * D + kb); bl[nt] = *(const bf16x8*)(XP_WRL(X) + (size_t)(16 * nt + fr) * D + kb); }
#pragma unroll
            for (int mt = 0; mt < 2; ++mt)
#pragma unroll
                for (int nt = 0; nt < 2; ++nt) { acc[mt][nt] = mma16(bh[nt], ah[mt], acc[mt][nt]); acc[mt][nt] = mma16(bl[nt], ah[mt], acc[mt][nt]); }
        }
#pragma unroll
        for (int mt = 0; mt < 2; ++mt) { float q = ss[mt]; q += __shfl_xor(q, 16); q += __shfl_xor(q, 32); if (fq == 0) ssq[w * 32 + 16 * mt + fr] = q;
#pragma unroll
            for (int nt = 0; nt < 2; ++nt) *(LAS f32x4*)(part + (w * 32 + 16 * mt + fr) * 32 + 16 * nt + 4 * fq) = acc[mt][nt]; }
        __syncthreads();
        { const int tk = tid >> 4, e0 = 2 * (tid & 15); float q = 0.f, a0 = 0.f, a1 = 0.f;
#pragma unroll
          for (int ww = 0; ww < 8; ++ww) { q += ssq[ww * 32 + tk]; const f32x2 p = *(const LAS f32x2*)(part + (ww * 32 + tk) * 32 + e0); a0 += p.x; a1 += p.y; }
          const float rstd = rsqrtf(q * (1.f / D) + EPS);
          lgt[tk * 32 + e0] = a0 * rstd + XP_b_router(X)[e0]; lgt[tk * 32 + e0 + 1] = a1 * rstd + XP_b_router(X)[e0 + 1];
          if ((tid & 15) == 0) rs[tk] = rstd; }
        __syncthreads();
        if (tid < 32) { const int t = tb + tid; unsigned used = 0u; int idx[4]; float val[4];
#pragma unroll
            for (int k = 0; k < 4; ++k) { float best = -3.0e38f; int bi = 0;
#pragma unroll 8
                for (int j = 0; j < 32; ++j) { const float v = lgt[tid * 32 + j]; if (!((used >> j) & 1u) && v > best) { best = v; bi = j; } }
                used |= 1u << bi; idx[k] = bi; val[k] = best; }
            const float e1 = __expf(val[1] - val[0]), e2 = __expf(val[2] - val[0]), e3 = __expf(val[3] - val[0]), inv = 1.f / (1.f + e1 + e2 + e3);
            const float wv[4] = {inv, e1 * inv, e2 * inv, e3 * inv};
            int rk[4];
#pragma unroll
            for (int k = 0; k < 4; ++k) rk[k] = (int)__hip_atomic_fetch_add(XP_ctl(X) + CW_CNT + 64 * idx[k], 1u, __ATOMIC_RELAXED, __HIP_MEMORY_SCOPE_AGENT);
#pragma unroll
            for (int k = 0; k < 4; ++k) { XP_LIST(X)[idx[k] * T + rk[k]] = t; XP_TOPI(X)[t * 4 + k] = idx[k]; XP_TOPR(X)[t * 4 + k] = rk[k]; XP_TOPW(X)[t * 4 + k] = wv[k]; } }
#pragma unroll 2
        for (int r = 0; r < 4; ++r) { const int tk = 4 * w + r, t = tb + tk; const float rstd = rs[tk];
            const u32x2* hr = (const u32x2*)(XP_Hh(X) + (size_t)t * D) + lane; const f32x4* wr_ = (const f32x4*)XP_ln_ffn_w(X) + lane;
            unsigned* o8 = (unsigned*)(XP_U2(X) + (size_t)t * D) + lane;
#pragma unroll
            for (int j = 0; j < 8; ++j) { const u32x2 v = hr[64 * j]; const f32x4 wv = wr_[64 * j]; o8[64 * j] = pk_fp8x4(bf_lo(v.x) * rstd * wv.x, bf_hi(v.x) * rstd * wv.y, bf_lo(v.y) * rstd * wv.z, bf_hi(v.y) * rstd * wv.w); } }
        __syncthreads();
    }
}

__device__ __forceinline__ void moe_tables(Ctx& X) {
    LAS int* tab = (LAS int*)(X.lds + LDS_TAB);
    if (X.tid < 64) { const int e = X.tid;
        const int cnt = (e < NE) ? (int)__hip_atomic_load(XP_ctl(X) + CW_CNT + 64 * e, __ATOMIC_RELAXED, __HIP_MEMORY_SCOPE_AGENT) : 0; const int k = (cnt + 255) >> 8;
        int incl = k;
#pragma unroll
        for (int o = 1; o < 64; o <<= 1) { const int t = __shfl_up(incl, o); if (e >= o) incl += t; }
        const int first = incl - k;
        if (e < NE) { tab[8 + e] = first; for (int b = 0; b < k; ++b) { if (first + b < MAXBLK) { tab[64 + first + b] = e; tab[256 + first + b] = (cnt - 256 * b) < 256 ? (cnt - 256 * b) : 256; } } }
        if (e == NE - 1) { tab[8 + NE] = incl; tab[0] = incl < MAXBLK ? incl : MAXBLK; } }
    __syncthreads();
}

__device__ __forceinline__ void p9_final(Ctx& X) {
    const LAS int* tab = (const LAS int*)(X.lds + LDS_TAB);
    const int gw = X.bid * NWAVES + X.wave, NGW = X.G * NWAVES, lane = X.lane;
    for (int t = gw; t < T; t += NGW) {
        const u32x2* hr = (const u32x2*)(XP_Hh(X) + (size_t)t * D) + lane;
        f32x4 v[8];
#pragma unroll
        for (int j = 0; j < 8; ++j) { const u32x2 hv = hr[64 * j]; v[j] = (f32x4){bf_lo(hv.x), bf_hi(hv.x), bf_lo(hv.y), bf_hi(hv.y)}; }
#pragma unroll
        for (int k = 0; k < 4; ++k) { const int e = XP_TOPI(X)[t * 4 + k], r = XP_TOPR(X)[t * 4 + k]; const float wk = XP_TOPW(X)[t * 4 + k];
            const unsigned* yr = (const unsigned*)(XP_YR(X) + ((size_t)tab[8 + e] * 256 + r) * D) + lane;
#pragma unroll
            for (int j = 0; j < 8; ++j) { const int y = (int)yr[64 * j]; const f32x2 lo = __builtin_amdgcn_cvt_pk_f32_fp8(y, false), hi = __builtin_amdgcn_cvt_pk_f32_fp8(y, true);
                v[j].x += wk * lo.x; v[j].y += wk * lo.y; v[j].z += wk * hi.x; v[j].w += wk * hi.y; } }
        float s = 0.f;
#pragma unroll
        for (int j = 0; j < 8; ++j) s += (v[j].x * v[j].x + v[j].y * v[j].y) + (v[j].z * v[j].z + v[j].w * v[j].w);
        const float rstd = rsqrtf(wave_sum(s) * (1.f / D) + EPS);
        f32x4* o = (f32x4*)(X.out + (size_t)t * D) + lane; const f32x4* wr_ = (const f32x4*)XP_ln_final_w(X) + lane;
#pragma unroll
        for (int j = 0; j < 8; ++j) { const f32x4 wv = wr_[64 * j]; f32x4 r; r.x = v[j].x * rstd * wv.x; r.y = v[j].y * rstd * wv.y; r.z = v[j].z * rstd * wv.z; r.w = v[j].w * rstd * wv.w; o[64 * j] = r; }
    }
}

#ifdef NO_P4R
#define P4R(X,u)
#else
#define P4R(X,u) p4_ret(X,u)
#endif
#ifdef NO_P4S
#define P4S(X,u)
#else
#define P4S(X,u) p4_ssd(X,u)
#endif
struct Args { const void* in[19]; float* out; uchar* ws; int ph_lo, ph_hi; };
__global__ void __launch_bounds__(NTHR, 2) fwd(Args args) {
    extern __shared__ __attribute__((aligned(16))) uchar lds_raw[];
    Ctx X;
    X.lds = (LAS uchar*)lds_raw; X.tid = threadIdx.x; X.lane = X.tid & 63; X.wave = __builtin_amdgcn_readfirstlane(X.tid >> 6); X.G = gridDim.x; X.bid = blockIdx.x;
    X.in = (const void* const*)__builtin_amdgcn_kernarg_segment_ptr(); X.out = args.out; X.ws = args.ws;
    for (int u = X.tid; u < (LDS_BYTES - LDS_PHASE_END) / 4; u += NTHR) ((LAS unsigned*)(X.lds + LDS_PHASE_END))[u] = 0u;
    __syncthreads();
    const int lo = args.ph_lo, hi = args.ph_hi;
    const bool multi = (hi - lo) > 1;
    XcdBarrier bar; bar.bar = XP_ctl(X) + CW_BAR; bar.x = 0; bar.st = nullptr;
    if (multi) bar = xcd_barrier_post(XP_ctl(X) + CW_BAR, (volatile LAS unsigned*)(X.lds + LDS_MISC + 32));
#ifdef ONLY_PHASE
#define IN(k) ((k) == ONLY_PHASE && lo <= (k) && (k) < hi)
#else
#define IN(k) (lo <= (k) && (k) < hi)
#endif
#define SEAM(k) do { if (IN(k) && IN((k) + 1)) xcd_barrier(bar); } while (0)
    if (IN(0)) { p0_prologue(X); } SEAM(0);
    if (IN(1)) {
        const int gb = (X.G == 256) ? P1_GEMM_BLOCKS : X.G;
        if (X.bid < gb) { DenseSched S{(const char*)XP_U(X), (const char*)XP_WinT(X), D, T / 256, LDP / 256, (T / 256) * (LDP / 256), gb, X.bid}; EpiProj E{XP_PROJ(X), LDP, XP_COS(X), XP_SIN(X)};
            pg8::gemm_phase<EpiProj, DenseSched, false, false>(X.lds, D, D, S, E); }
        conv8_queue(X, (X.G == 256) ? Q5_BASE : I_ALL8); } SEAM(1);
    if (IN(2)) { for (int u = X.bid; u < 256; u += X.G) p2_ret(X, u);
        for (int u = X.bid; u < 256; u += X.G) p2_ssd(X, u); } SEAM(2);
    if (IN(3)) { p3_scan(X); if (X.G == 256 && X.bid >= 192) conv8_fill(X, FILL_B3, X.bid - 192, FILL_W3 / NWAVES, FILL_N3); } SEAM(3);
    if (IN(4)) { for (int u = X.bid; u < 256; u += X.G) { P4R(X, u); }
        for (int u = X.bid; u < 128; u += X.G) { P4S(X, u); }
        if (X.G == 256 && X.bid >= 128) conv8_fill(X, FILL_B4, X.bid - 128, FILL_W4 / NWAVES, FILL_N4); } SEAM(4);
    if (IN(5)) {
        const int gb = (X.G == 256) ? P5_GEMM_BLOCKS : X.G;
        if (X.bid < gb) { DenseSched S{(const char*)XP_MIX(X), (const char*)XP_WoutT(X), D, T / 256, D / 256, (T / 256) * (D / 256), gb, X.bid}; EpiOut E{XP_x(X), XP_Hh(X)};
            pg8::gemm_phase<EpiOut, DenseSched, false, false>(X.lds, D, D, S, E); }
        else conv8_fill(X, Q5_BASE, X.bid - gb, Q5_W / NWAVES, Q5_N); } SEAM(5);
    if (IN(6)) { p6_router(X); } SEAM(6);
    if (IN(7)) { moe_tables(X); MoeSched S{(const LAS int*)(X.lds + LDS_TAB), (const char*)XP_U2(X), (const char*)XP_WguT(X), (size_t)(2 * DFF) * W8LD, XP_LIST(X), D / 2, (2 * DFF) / 256, X.G, X.bid}; EpiGateUp E{XP_ACT(X), XP_b_gu(X)};
        pg8::gemm_phase<EpiGateUp, MoeSched, true, true>(X.lds, D / 2, W8LD / 2, S, E); } SEAM(7);
    if (IN(8)) { moe_tables(X); MoeSchedDirect S{(const LAS int*)(X.lds + LDS_TAB), (const char*)XP_ACT(X), (const char*)XP_WdT(X), (size_t)D * W8LD, DFF / 2, D / 256, X.G, X.bid}; EpiDown E{XP_YR(X), XP_b_d(X)};
        pg8::gemm_phase<EpiDown, MoeSchedDirect, true, true>(X.lds, DFF / 2, W8LD / 2, S, E); } SEAM(8);
    if (IN(9)) { moe_tables(X); p9_final(X); }
#undef IN
#undef SEAM
}

extern "C" void kernel_launch(void* const* d_in, const int* in_sizes, int n_in, void* d_out, int out_size, void* d_ws, size_t ws_size, hipStream_t stream) {
    static int grid = 0;
    if (grid == 0) {
        if (n_in != 19 || out_size != T * D || ws_size < WS_END) { fprintf(stderr, "kernel_launch: unexpected shapes (n_in %d, out %d, ws %zu)\n", n_in, out_size, ws_size); grid = -1; return; }
        int dev = 0, cus = 0, per_cu = 0;
        if (hipGetDevice(&dev) != hipSuccess || hipDeviceGetAttribute(&cus, hipDeviceAttributeMultiprocessorCount, dev) != hipSuccess) { grid = -1; return; }
        if (hipFuncSetAttribute((const void*)fwd, hipFuncAttributeMaxDynamicSharedMemorySize, LDS_BYTES) != hipSuccess) { fprintf(stderr, "kernel_launch: hipFuncSetAttribute failed\n"); grid = -1; return; }
        if (hipOccupancyMaxActiveBlocksPerMultiprocessor(&per_cu, (const void*)fwd, NTHR, LDS_BYTES) != hipSuccess || per_cu < 1) { fprintf(stderr, "kernel_launch: occupancy query reports %d\n", per_cu); }
        (void)hipGetLastError();
        grid = cus;
    }
    if (grid < 0) return;
    (void)hipMemsetAsync((char*)d_ws + WS_CTL, 0, CTL_ZERO_BYTES, stream);
    Args a{};
    for (int i = 0; i < 19; ++i) a.in[i] = d_in[i];
    a.out = (float*)d_out; a.ws = (uchar*)d_ws;
    constexpr int NL = MK_N_LAUNCHES;
    for (int li = 0; li < NL; ++li) {
        a.ph_lo = (NL == 1) ? 0 : li; a.ph_hi = (NL == 1) ? NPHASE : li + 1;
        hipLaunchKernelGGL(fwd, dim3(grid), dim3(NTHR), LDS_BYTES, stream, a);
    }
}
```

```cpp
#include <hip/hip_runtime.h>
#include <cstdio>
#include <cstdint>

#ifndef MK_N_LAUNCHES
#define MK_N_LAUNCHES 1
#endif

#define LAS __attribute__((address_space(3)))
typedef unsigned short bf16;
typedef short bf16x8 __attribute__((ext_vector_type(8)));
typedef short s16x4 __attribute__((ext_vector_type(4)));
typedef float f32x4 __attribute__((ext_vector_type(4)));
typedef float f32x2 __attribute__((ext_vector_type(2)));
typedef unsigned u32x4 __attribute__((ext_vector_type(4)));
typedef unsigned u32x2 __attribute__((ext_vector_type(2)));
typedef unsigned char uchar;
typedef int i32x8 __attribute__((ext_vector_type(8)));
typedef int i32x4 __attribute__((ext_vector_type(4)));
constexpr int W8LD = 2048 + 128;
constexpr float W8_SCALE = 64.f, W8_INV = 1.f / 64.f;

constexpr int T = 8192, D = 2048, NPROJ = 6672, LDP = 6912;
constexpr int C_Q = 0, C_K = 1024, C_V = 2048, C_G = 3072, C_Z = 4096, C_X = 5120, C_DT = 6656;
constexpr int XBCW = 1536, NCHUNK = 64, CH = 128;
constexpr int NE = 32, DFF = 2048, MAXBLK = 160;
constexpr float EPS = 1e-6f;
constexpr int NPHASE = 10;
constexpr int NWAVES = 8, NTHR = 512;

constexpr size_t MiB = 1ull << 20;
constexpr size_t WS_CTL = 0, CTL_ZERO_BYTES = 128 * 1024;
constexpr size_t WS_WINT = 2 * MiB, WS_WOUTT = 30 * MiB, WS_COS = 38 * MiB, WS_SIN = 42 * MiB;
constexpr size_t WS_TOPI = 46 * MiB, WS_TOPR = 46 * MiB + 128 * 1024, WS_TOPW = 46 * MiB + 256 * 1024, WS_LIST = 47 * MiB, WS_ADEC = 48 * MiB;
constexpr size_t WS_WRH = 49 * MiB, WS_WRL = 49 * MiB + 128 * 1024;
constexpr size_t WS_U = 64 * MiB, WS_U2 = 96 * MiB, WS_MIX = 128 * MiB, WS_XBC = 160 * MiB, WS_KV = 192 * MiB, WS_SST = 224 * MiB;
constexpr size_t WS_H = 256 * MiB, WS_PROJ = 320 * MiB, WS_ACT = 448 * MiB, WS_YR = 608 * MiB, WS_WGUT = 768 * MiB, WS_WDT = 1280 * MiB, WS_END = 1536 * MiB;
constexpr int CW_TMO = 0, CW_BAR = 4096, CW_CNT = 16384, CW_WQ = 20480;

constexpr int RING_BYTES = 131072;
constexpr int LDS_PHASE_END = 139264;
constexpr int LDS_TAB = LDS_PHASE_END;
constexpr int LDS_IDX = LDS_PHASE_END + 2048;
constexpr int LDS_MISC = LDS_PHASE_END + 4096;
constexpr int LDS_BIAS = LDS_PHASE_END + 5120;
constexpr int LDS_BYTES = 147456;

__device__ __forceinline__ unsigned pk_bf16(float lo, float hi) { unsigned r; asm("v_cvt_pk_bf16_f32 %0, %1, %2" : "=v"(r) : "v"(lo), "v"(hi)); return r; }
__device__ __forceinline__ float clamp448(float x) { return fminf(fmaxf(x, -448.f), 448.f); }
__device__ __forceinline__ unsigned pk_fp8x4(float a, float b, float c, float d) {
    int p = 0; p = __builtin_amdgcn_cvt_pk_fp8_f32(clamp448(a), clamp448(b), p, false); p = __builtin_amdgcn_cvt_pk_fp8_f32(clamp448(c), clamp448(d), p, true); return (unsigned)p; }
__device__ __forceinline__ unsigned pk_fp8x4_nc(float a, float b, float c, float d) {
    int p = 0; p = __builtin_amdgcn_cvt_pk_fp8_f32(a, b, p, false); p = __builtin_amdgcn_cvt_pk_fp8_f32(c, d, p, true); return (unsigned)p; }
__device__ __forceinline__ float bf_lo(unsigned u) { return __uint_as_float(u << 16); }
__device__ __forceinline__ float bf_hi(unsigned u) { return __uint_as_float(u & 0xffff0000u); }
__device__ __forceinline__ float bf2f(bf16 b) { return __uint_as_float(((unsigned)b) << 16); }
__device__ __forceinline__ float wave_sum(float v) {
#pragma unroll
    for (int o = 1; o < 64; o <<= 1) v += __shfl_xor(v, o);
    return v;
}
__device__ __forceinline__ float silu_f(float x) { return x * __builtin_amdgcn_rcpf(1.0f + __expf(-x)); }
__device__ __forceinline__ float softplus_f(float x) { return x > 20.f ? x : log1pf(__expf(x)); }

__constant__ double INV_FREQ[128] = {1,0.93057204092969903,0.86596432336006535,0.80584218776148187,0.74989420933245587,0.69783058485986638,0.64938163157621132,0.60429639023813286,0.56234132519034907,0.5232991146814947,0.48696752516586311,0.45315836376008178,0.42169650342858223,0.39241897584845359,0.36517412725483772,0.33982083289425596,0.31622776601683794,0.29427271762092816,0.27384196342643613,0.25482967479793467,0.23713737056616552,0.22067340690845899,0.20535250264571461,0.19109529749704404,0.17782794100389229,0.16548170999431813,0.15399265260594919,0.14330125702369628,0.1333521432163324,0.12409377607517195,0.11547819846894582,0.10746078283213174,0.10000000000000001,0.0930572040929699,0.086596432336006529,0.080584218776148187,0.074989420933245579,0.069783058485986635,0.064938163157621132,0.060429639023813285,0.056234132519034911,0.05232991146814947,0.048696752516586311,0.045315836376008181,0.042169650342858224,0.039241897584845357,0.036517412725483769,0.033982083289425591,0.031622776601683791,0.029427271762092817,0.027384196342643614,0.025482967479793464,0.023713737056616554,0.022067340690845899,0.02053525026457146,0.019109529749704406,0.017782794100389229,0.016548170999431813,0.015399265260594919,0.014330125702369627,0.013335214321633241,0.012409377607517195,0.011547819846894581,0.010746078283213174,0.01,0.0093057204092969904,0.0086596432336006543,0.008058421877614819,0.0074989420933245579,0.0069783058485986633,0.006493816315762113,0.0060429639023813278,0.005623413251903491,0.0052329911468149467,0.004869675251658631,0.0045315836376008181,0.0042169650342858229,0.0039241897584845363,0.0036517412725483771,0.0033982083289425592,0.0031622776601683794,0.002942727176209282,0.0027384196342643613,0.0025482967479793467,0.0023713737056616554,0.0022067340690845897,0.002053525026457146,0.0019109529749704406,0.0017782794100389228,0.0016548170999431814,0.001539926526059492,0.0014330125702369627,0.0013335214321633241,0.0012409377607517195,0.0011547819846894581,0.0010746078283213176,0.001,0.00093057204092969893,0.00086596432336006539,0.00080584218776148179,0.00074989420933245586,0.00069783058485986635,0.00064938163157621134,0.00060429639023813287,0.0005623413251903491,0.00052329911468149473,0.0004869675251658631,0.00045315836376008179,0.00042169650342858224,0.00039241897584845359,0.0003651741272548377,0.00033982083289425596,0.00031622776601683794,0.00029427271762092817,0.00027384196342643611,0.00025482967479793463,0.00023713737056616554,0.00022067340690845897,0.00020535250264571461,0.00019109529749704405,0.00017782794100389227,0.00016548170999431815,0.00015399265260594919,0.00014330125702369627,0.0001333521432163324,0.00012409377607517196,0.00011547819846894582,0.00010746078283213175};
__constant__ float LG2_GAMMA[4] = {-0.045803689613124789f, -0.022720076500083529f, -0.011315313227834146f, -0.0056465631411420627f};
__constant__ float GAMMA_CHUNK[4] = {0.017183023570817902f, 0.13321516287964841f, 0.36643771592203728f, 0.60593708822908032f};

namespace pg8 {
constexpr int BM = 256, BK = 64, HALF = 128, HTB = HALF * BK * 2, STAGE_BYTES = 8 * HTB, NXCD = 8, WGM = 8;
__host__ __device__ __forceinline__ int lds_byte(int r, int c) { const int st = (r >> 4) * 2 + (c >> 5), rr = r & 15, cc = c & 31, ob = rr * 64 + cc * 2; return st * 1024 + (ob ^ (((ob >> 9) & 1) << 5)); }
__host__ __device__ __forceinline__ void stage_rc(int b, int& R, int& C) { const int st = b / 1024, sb = b % 1024, swz = sb ^ (((sb >> 9) & 1) << 5); R = (st >> 1) * 16 + swz / 64; C = (st & 1) * 32 + (swz % 64) / 2; }
__host__ __device__ __forceinline__ int perm32(int rho) { const int n = rho >> 4, i = rho & 15; return 8 * (i >> 2) + 4 * n + (i & 3); }

struct Unit { const char* pa; const char* pb; int row0, col0, aux, blk; };

template <class Epi, class Sched, bool GATHER, bool FP8>
__device__ __forceinline__ void gemm_phase(LAS uchar* lds, const int K, const int LDB, const Sched& S, const Epi& E) {
    const int tid = threadIdx.x, wid = __builtin_amdgcn_readfirstlane(tid >> 6), lane = tid & 63, wr = wid >> 2, wc = wid & 3, fr = lane & 15, fq = lane >> 4;
    const int nt = K / BK;
    unsigned voA[2][2], voffB[2];
#pragma unroll
    for (int i = 0; i < 2; ++i) { int R, C; stage_rc(tid * 16 + i * 8192, R, C); const int Rb = Epi::PERM == 17 ? 64 * (R >> 5) + 16 * ((R >> 2) & 3) + 2 * (R & 3) + ((R >> 4) & 1) : Epi::PERM == 16 ? 64 * (R >> 5) + 16 * ((R >> 2) & 3) + 4 * ((R >> 4) & 1) + (R & 3) : (Epi::PERM == 8 ? ((R & ~31) + perm32(R & 31)) : R);
        voA[0][i] = (unsigned)(R * K + C) * 2u; voA[1][i] = voA[0][i] + (unsigned)(HALF * K * 2); voffB[i] = (unsigned)(Rb * LDB + C) * 2u; }
    const size_t kstep = (size_t)(BK * 2);
    const size_t hstep = (size_t)(Epi::PERM >= 16 ? 8 : HALF) * LDB * 2;
    const unsigned ldsw = (unsigned)wid * 1024u;
    const int aoff = lds_byte(wr * 64 + fr, fq * 8), boff = lds_byte(wc * 32 + fr, fq * 8);
#define PG8_SA(b, h) (((b) * 2 + (h)) * HTB)
#define PG8_SB(b, h) ((4 + (b) * 2 + (h)) * HTB)
#define PG8_STAGE(bufoff, gbase, voff) do { _Pragma("unroll") for (int _i = 0; _i < 2; ++_i) \
        __builtin_amdgcn_global_load_lds((const unsigned*)((const char*)(gbase) + (voff)[_i]), (LAS unsigned*)(lds + (bufoff) + ldsw + _i * 8192), 16, 0, 0); } while (0)
#define PG8_LDA(dst, b, h) do { _Pragma("unroll") for (int m = 0; m < 4; ++m) _Pragma("unroll") for (int k = 0; k < 2; ++k) dst[m][k] = *(const LAS bf16x8*)(lds + PG8_SA(b, h) + aoff + m * 2048 + k * 1024); } while (0)
#define PG8_LDB(dst, b, h) do { _Pragma("unroll") for (int n = 0; n < 2; ++n) _Pragma("unroll") for (int k = 0; k < 2; ++k) dst[n][k] = *(const LAS bf16x8*)(lds + PG8_SB(b, h) + boff + n * 2048 + k * 1024); } while (0)
#define PG8_CAT(x) __builtin_shufflevector(__builtin_bit_cast(i32x4, (x)[0]), __builtin_bit_cast(i32x4, (x)[1]), 0, 1, 2, 3, 4, 5, 6, 7)
#define PG8_MMA(ai, bj, At, Bt) do { __builtin_amdgcn_s_setprio(1); \
        if constexpr (FP8) { _Pragma("unroll") for (int m = 0; m < 4; ++m) _Pragma("unroll") for (int n = 0; n < 2; ++n) \
            acc[ai][bj][m][n] = __builtin_amdgcn_mfma_scale_f32_16x16x128_f8f6f4(PG8_CAT(Bt[n]), PG8_CAT(At[m]), acc[ai][bj][m][n], 0, 0, 0, 0x7f7f7f7f, 0, 0x7f7f7f7f); } \
        else { _Pragma("unroll") for (int m = 0; m < 4; ++m) _Pragma("unroll") for (int n = 0; n < 2; ++n) _Pragma("unroll") for (int k = 0; k < 2; ++k) \
            acc[ai][bj][m][n] = __builtin_amdgcn_mfma_f32_16x16x32_bf16(Bt[n][k], At[m][k], acc[ai][bj][m][n], 0, 0, 0); } \
        __builtin_amdgcn_s_setprio(0); } while (0)
#define PG8_WAIT_V(n) asm volatile("s_waitcnt vmcnt(" #n ")" ::: "memory")
#define PG8_WAIT_V8F(fresh) asm volatile("s_cmp_eq_u32 %0, 0\n\ts_cbranch_scc1 .Lw8_%=\n\ts_waitcnt vmcnt(%1)\n\ts_branch .Lwe_%=\n.Lw8_%=:\n\ts_waitcnt vmcnt(8)\n.Lwe_%=:" :: "s"(fresh), "n"(8 + Epi::NST + Epi::NPF) : "memory", "scc")
#define PG8_WAIT_L(n) asm volatile("s_waitcnt lgkmcnt(" #n ")" ::: "memory")
#define PG8_BAR __builtin_amdgcn_s_barrier()
#define PG8_SCHED __builtin_amdgcn_sched_barrier(0)
    Unit cur, nxt; int ui = 0;
    if (!S.next(0, cur)) return;
    f32x4 acc[2][2][4][2];
#pragma unroll
    for (int a = 0; a < 2; ++a)
#pragma unroll
        for (int b = 0; b < 2; ++b)
#pragma unroll
            for (int m = 0; m < 4; ++m)
#pragma unroll
                for (int n = 0; n < 2; ++n) acc[a][b][m][n] = (f32x4){0.f, 0.f, 0.f, 0.f};
    bf16x8 At[4][2], B0[2][2], B1[2][2];
    const char* cA = cur.pa; const char* cB = cur.pb;
    if constexpr (GATHER) S.gather(cur, voA, (const LAS int*)nullptr);
    PG8_STAGE(PG8_SB(0, 0), cB, voffB); PG8_STAGE(PG8_SB(0, 1), cB + hstep, voffB); PG8_STAGE(PG8_SA(0, 0), cA, voA[0]); PG8_STAGE(PG8_SA(0, 1), cA, voA[1]);
    if (wr == 1) PG8_BAR;
    PG8_WAIT_V(2); PG8_BAR;
    PG8_STAGE(PG8_SB(1, 0), cB + kstep, voffB); PG8_STAGE(PG8_SA(1, 0), cA + kstep, voA[0]); PG8_STAGE(PG8_SB(1, 1), cB + hstep + kstep, voffB);
    PG8_WAIT_V(6); PG8_BAR;
    for (;;) {
        const bool has_next = S.next(ui + 1, nxt);
        if constexpr (GATHER) { if (has_next) S.prefetch(nxt, lds + LDS_IDX + ((ui + 1) & 1) * 1024, wid, lane); }
        E.prefetch(cur, lds + LDS_BIAS + (ui & 1) * 1024, wid, lane);
        const char* nA = has_next ? nxt.pa : cA; const char* nB = has_next ? nxt.pb : cB;
        for (int t = 0; t < nt; t += 2) {
            const bool last = (t == nt - 2);
            const char* a1 = cA + (size_t)(t + 1) * kstep;
            const char* a2 = last ? nA : cA + (size_t)(t + 2) * kstep; const char* b2 = last ? nB : cB + (size_t)(t + 2) * kstep;
            const char* a3 = a2 + kstep; const char* b3 = b2 + kstep;
            int fresh; { const int fv = (t == 0 && ui > 0) ? 1 : 0; asm volatile("s_nop 0\n\tv_readfirstlane_b32 %0, %1" : "=s"(fresh) : "v"(fv)); }
            PG8_LDB(B0, 0, 0); PG8_LDB(B1, 0, 1); PG8_SCHED; PG8_LDA(At, 0, 0); PG8_STAGE(PG8_SA(1, 1), a1, voA[1]);
            if constexpr (GATHER) { if (last && has_next) S.gather(nxt, voA, (const LAS int*)(lds + LDS_IDX + ((ui + 1) & 1) * 1024)); }
            PG8_WAIT_V8F(fresh); PG8_WAIT_L(0); PG8_BAR; PG8_MMA(0, 0, At, B0); PG8_MMA(0, 1, At, B1); PG8_BAR; PG8_SCHED;
            PG8_LDA(At, 0, 1); PG8_STAGE(PG8_SB(0, 0), b2, voffB); PG8_STAGE(PG8_SB(0, 1), b2 + hstep, voffB); PG8_STAGE(PG8_SA(0, 0), a2, voA[0]);
            PG8_WAIT_V8F(fresh); PG8_WAIT_L(0); PG8_BAR; PG8_MMA(1, 0, At, B0); PG8_MMA(1, 1, At, B1); PG8_BAR; PG8_SCHED;
            PG8_LDB(B0, 1, 0); PG8_LDB(B1, 1, 1); PG8_SCHED; PG8_LDA(At, 1, 0); PG8_STAGE(PG8_SA(0, 1), a2, voA[1]);
            PG8_WAIT_V(8); PG8_WAIT_L(0); PG8_BAR; PG8_MMA(0, 0, At, B0); PG8_MMA(0, 1, At, B1); PG8_BAR; PG8_SCHED;
            PG8_LDA(At, 1, 1); PG8_STAGE(PG8_SB(1, 0), b3, voffB); PG8_STAGE(PG8_SB(1, 1), b3 + hstep, voffB); PG8_STAGE(PG8_SA(1, 0), a3, voA[0]);
            PG8_WAIT_V(8); PG8_WAIT_L(0); PG8_BAR; PG8_MMA(1, 0, At, B0); PG8_MMA(1, 1, At, B1); PG8_BAR; PG8_SCHED;
        }
        if (wr == 0) PG8_BAR;
        E(acc, cur, wr, wc, fr, fq, lds + LDS_BIAS + (ui & 1) * 1024);
        if (!has_next) break;
#pragma unroll
        for (int a = 0; a < 2; ++a)
#pragma unroll
            for (int b = 0; b < 2; ++b)
#pragma unroll
                for (int m = 0; m < 4; ++m)
#pragma unroll
                    for (int n = 0; n < 2; ++n) acc[a][b][m][n] = (f32x4){0.f, 0.f, 0.f, 0.f};
        cur = nxt; cA = nA; cB = nB; ++ui;
        if (wr == 1) PG8_BAR;
    }
    PG8_WAIT_V(0);
    PG8_BAR;
#undef PG8_SA
#undef PG8_SB
#undef PG8_STAGE
#undef PG8_LDA
#undef PG8_LDB
#undef PG8_MMA
#undef PG8_CAT
#undef PG8_WAIT_V
#undef PG8_WAIT_V8F
#undef PG8_WAIT_L
#undef PG8_BAR
#undef PG8_SCHED
}
}

struct DenseSched {
    const char* A; const char* B; int K, nM, nN, nwg, G, c;
    __device__ __forceinline__ bool next(int i, pg8::Unit& u) const {
        const long L = (long)i * G + c; if (L >= nwg) return false;
        int wgid = (int)L; { const int q = nwg / pg8::NXCD, r = nwg % pg8::NXCD, xcd = wgid % pg8::NXCD, off = wgid / pg8::NXCD; wgid = (xcd < r ? xcd * (q + 1) : r * (q + 1) + (xcd - r) * q) + off; }
        const int nig = pg8::WGM * nN, gid = wgid / nig, fm = gid * pg8::WGM, gsz = (nM - fm) < pg8::WGM ? (nM - fm) : pg8::WGM;
        const int pm = fm + ((wgid % nig) % gsz), pn = (wgid % nig) / gsz;
        u.pa = A + (size_t)pm * 256 * K * 2; u.pb = B + (size_t)pn * 256 * K * 2; u.row0 = pm * 256; u.col0 = pn * 256; u.aux = 0; u.blk = 0; return true;
    }
    __device__ __forceinline__ void gather(const pg8::Unit&, unsigned (&)[2][2], const LAS int*) const {}
    __device__ __forceinline__ void prefetch(const pg8::Unit&, LAS uchar*, int, int) const {}
};
struct MoeSched {
    const LAS int* tab; const char* A; const char* B; size_t bexp; const int* list; int K, nN, G, c;
    __device__ __forceinline__ bool next(int i, pg8::Unit& u) const {
        const int NB = __builtin_amdgcn_readfirstlane(tab[0]); const int L = i * G + c; if (L >= NB * nN) return false;
        const int b = L / nN, pn = L - b * nN, e = __builtin_amdgcn_readfirstlane(tab[64 + b]);
        u.pa = A; u.pb = B + (size_t)e * bexp + (size_t)pn * 256 * W8LD; u.row0 = b * 256; u.col0 = pn * 256; u.aux = e; u.blk = b; return true;
    }
    __device__ __forceinline__ void prefetch(const pg8::Unit& u, LAS uchar* buf, int wid, int lane) const {
        { const int e = u.aux, lb = (u.blk - __builtin_amdgcn_readfirstlane(tab[8 + e])) * 256, w4 = wid & 3;
            __builtin_amdgcn_global_load_lds((const unsigned*)(list + e * T + lb + 64 * w4 + lane), (LAS unsigned*)(buf + w4 * 256), 4, 0, 0); }
    }
    __device__ __forceinline__ void gather(const pg8::Unit& u, unsigned (&vo)[2][2], const LAS int* idx) const {
        const int e = u.aux, lb = (u.blk - __builtin_amdgcn_readfirstlane(tab[8 + e])) * 256, cnt = __builtin_amdgcn_readfirstlane(tab[256 + u.blk]);
#pragma unroll
        for (int i = 0; i < 2; ++i) { int R, C; pg8::stage_rc((int)threadIdx.x * 16 + i * 8192, R, C);
#pragma unroll
            for (int h = 0; h < 2; ++h) { const int r = h * 128 + R; const int raw = idx ? idx[r] : list[e * T + lb + r]; const int tok = (r < cnt) ? raw : 0; vo[h][i] = ((unsigned)tok * (unsigned)K + (unsigned)C) * 2u; } }
    }
};
struct MoeSchedDirect {
    const LAS int* tab; const char* A; const char* B; size_t bexp; int K, nN, G, c;
    __device__ __forceinline__ bool next(int i, pg8::Unit& u) const {
        const int NB = __builtin_amdgcn_readfirstlane(tab[0]); const int L = i * G + c; if (L >= NB * nN) return false;
        const int b = L / nN, pn = L - b * nN, e = __builtin_amdgcn_readfirstlane(tab[64 + b]);
        u.pa = A; u.pb = B + (size_t)e * bexp + (size_t)pn * 256 * W8LD; u.row0 = b * 256; u.col0 = pn * 256; u.aux = e; u.blk = b; return true;
    }
    __device__ __forceinline__ void prefetch(const pg8::Unit&, LAS uchar*, int, int) const {}
    __device__ __forceinline__ void gather(const pg8::Unit& u, unsigned (&vo)[2][2], const LAS int*) const {
#pragma unroll
        for (int i = 0; i < 2; ++i) { int R, C; pg8::stage_rc((int)threadIdx.x * 16 + i * 8192, R, C);
#pragma unroll
            for (int h = 0; h < 2; ++h) vo[h][i] = (unsigned)(u.row0 + h * 128 + R) * (unsigned)W8LD + (unsigned)C * 2u; }
    }
};

#define EPI_LANE() int tz = threadIdx.x; asm volatile("" : "+v"(tz)); const int fr = tz & 15, fq = (tz >> 4) & 3; (void)fr_; (void)fq_
struct EpiProj {
    static constexpr int NST = 16, NPF = 0;
    static constexpr int PERM = 8;
    bf16* O; int ldc; const float* COS; const float* SIN;
    __device__ __forceinline__ void prefetch(const pg8::Unit&, LAS uchar*, int, int) const {}
    __device__ __forceinline__ void operator()(const f32x4 (&acc)[2][2][4][2], const pg8::Unit& u, int wr, int wc, int fr_, int fq_, const LAS uchar* bl) const {
        EPI_LANE();
        const int row0 = u.row0 + wr * 64 + fr, col0 = u.col0 + wc * 32 + 8 * fq;
        if (u.col0 < 2048) {
            const float sc = (u.col0 >= 1024) ? 0.0625f : 1.0f; const int i0 = wc * 32 + 8 * fq;
#pragma unroll
            for (int ai = 0; ai < 2; ++ai)
#pragma unroll
                for (int m = 0; m < 4; ++m) { const int t = row0 + ai * 128 + m * 16; bf16* rowp = O + (size_t)t * ldc + col0;
                    const f32x4 c0 = *(const f32x4*)(COS + (size_t)t * 128 + i0), c1 = *(const f32x4*)(COS + (size_t)t * 128 + i0 + 4), s0 = *(const f32x4*)(SIN + (size_t)t * 128 + i0), s1 = *(const f32x4*)(SIN + (size_t)t * 128 + i0 + 4);
                    const f32x4 a0 = acc[ai][0][m][0], a1 = acc[ai][0][m][1], b0 = acc[ai][1][m][0], b1 = acc[ai][1][m][1];
                    const f32x4 p0 = (a0 * c0 - b0 * s0) * sc, p1 = (a1 * c1 - b1 * s1) * sc, q0 = (b0 * c0 + a0 * s0) * sc, q1 = (b1 * c1 + a1 * s1) * sc;
                    u32x4 w; w.x = pk_bf16(p0[0], p0[1]); w.y = pk_bf16(p0[2], p0[3]); w.z = pk_bf16(p1[0], p1[1]); w.w = pk_bf16(p1[2], p1[3]); *(u32x4*)rowp = w;
                    w.x = pk_bf16(q0[0], q0[1]); w.y = pk_bf16(q0[2], q0[3]); w.z = pk_bf16(q1[0], q1[1]); w.w = pk_bf16(q1[2], q1[3]); *(u32x4*)(rowp + 128) = w; }
        } else {
#pragma unroll
            for (int ai = 0; ai < 2; ++ai)
#pragma unroll
                for (int m = 0; m < 4; ++m) { bf16* rowp = O + (size_t)(row0 + ai * 128 + m * 16) * ldc + col0;
#pragma unroll
                    for (int bj = 0; bj < 2; ++bj) { const f32x4 v0 = acc[ai][bj][m][0], v1 = acc[ai][bj][m][1];
                        u32x4 w; w.x = pk_bf16(v0[0], v0[1]); w.y = pk_bf16(v0[2], v0[3]); w.z = pk_bf16(v1[0], v1[1]); w.w = pk_bf16(v1[2], v1[3]);
                        *(u32x4*)(rowp + bj * 128) = w; } }
        }
    }
};
struct EpiOut {
    static constexpr int PERM = 8, NST = 16, NPF = 0;
    const float* X; bf16* Hh;
    __device__ __forceinline__ void prefetch(const pg8::Unit&, LAS uchar*, int, int) const {}
    __device__ __forceinline__ void operator()(const f32x4 (&acc)[2][2][4][2], const pg8::Unit& u, int wr, int wc, int fr_, int fq_, const LAS uchar* bl) const {
        EPI_LANE();
        const int row0 = u.row0 + wr * 64 + fr, col0 = u.col0 + wc * 32 + 8 * fq;
#pragma unroll
        for (int ai = 0; ai < 2; ++ai)
#pragma unroll
            for (int m = 0; m < 4; ++m) { const size_t off = (size_t)(row0 + ai * 128 + m * 16) * D + col0;
#pragma unroll
                for (int bj = 0; bj < 2; ++bj) { const f32x4 x0 = *(const f32x4*)(X + off + bj * 128), x1 = *(const f32x4*)(X + off + bj * 128 + 4);
                    const f32x4 v0 = x0 + acc[ai][bj][m][0], v1 = x1 + acc[ai][bj][m][1];
                    u32x4 w; w.x = pk_bf16(v0[0], v0[1]); w.y = pk_bf16(v0[2], v0[3]); w.z = pk_bf16(v1[0], v1[1]); w.w = pk_bf16(v1[2], v1[3]);
                    *(u32x4*)(Hh + off + bj * 128) = w; } }
    }
};
__device__ __forceinline__ float swiglu_f(float gate, float up) { const float g = fminf(gate, 7.f), u = fminf(fmaxf(up, -7.f), 7.f); return (u + 1.f) * g * __builtin_amdgcn_rcpf(1.f + __builtin_amdgcn_exp2f(-1.702f * 1.44269504f * g)); }
struct EpiGateUp {
    static constexpr int PERM = 17, NST = 8, NPF = 1;
    uchar* ACT; const float* bias;
    __device__ __forceinline__ void prefetch(const pg8::Unit& u, LAS uchar* buf, int wid, int lane) const {
        const int w4 = wid & 3; __builtin_amdgcn_global_load_lds((const unsigned*)(bias + (size_t)u.aux * (2 * DFF) + u.col0 + 64 * w4 + lane), (LAS unsigned*)(buf + w4 * 256), 4, 0, 0); }
    __device__ __forceinline__ void operator()(const f32x4 (&acc)[2][2][4][2], const pg8::Unit& u, int wr, int wc, int fr_, int fq_, const LAS uchar* bl) const {
        EPI_LANE();
        const int row0 = u.row0 + wr * 64 + fr, col0 = u.col0 + wc * 64 + 16 * fq;
        const LAS float* bp = (const LAS float*)bl + wc * 64 + 16 * fq;
        f32x4 bg[2], bu[2];
#pragma unroll
        for (int bj = 0; bj < 2; ++bj) { const f32x4 b0 = *(const LAS f32x4*)(bp + bj * 8), b1 = *(const LAS f32x4*)(bp + bj * 8 + 4);
            bg[bj] = (f32x4){b0.x, b0.z, b1.x, b1.z}; bu[bj] = (f32x4){b0.y, b0.w, b1.y, b1.w}; }
#pragma unroll
        for (int ai = 0; ai < 2; ++ai)
#pragma unroll
            for (int m = 0; m < 4; ++m) { uchar* rowp = ACT + (size_t)(row0 + ai * 128 + m * 16) * W8LD + (col0 >> 1);
                u32x2 w;
#pragma unroll
                for (int bj = 0; bj < 2; ++bj) { f32x4 g = acc[ai][bj][m][0] * W8_INV + bg[bj], up = acc[ai][bj][m][1] * W8_INV + bu[bj];
#pragma unroll
                    for (int j = 0; j < 4; ++j) { g[j] = fminf(g[j], 7.f); up[j] = fminf(fmaxf(up[j], -7.f), 7.f); }
                    const f32x4 a = g * (-1.702f * 1.44269504f);
                    f32x4 d;
#pragma unroll
                    for (int j = 0; j < 4; ++j) d[j] = __builtin_amdgcn_exp2f(a[j]);
                    d = d + 1.f;
#pragma unroll
                    for (int j = 0; j < 4; ++j) d[j] = __builtin_amdgcn_rcpf(d[j]);
                    const f32x4 o = (up + 1.f) * (g * d);
                    const unsigned p = pk_fp8x4_nc(o[0], o[1], o[2], o[3]);
                    if (bj == 0) w.x = p; else w.y = p; }
                *(u32x2*)rowp = w; }
    }
};
struct EpiDown {
    static constexpr int PERM = 16, NST = 8, NPF = 1;
    uchar* YR; const float* bias;
    __device__ __forceinline__ void prefetch(const pg8::Unit& u, LAS uchar* buf, int wid, int lane) const {
        const int w4 = wid & 3; __builtin_amdgcn_global_load_lds((const unsigned*)(bias + (size_t)u.aux * D + u.col0 + 64 * w4 + lane), (LAS unsigned*)(buf + w4 * 256), 4, 0, 0); }
    __device__ __forceinline__ void operator()(const f32x4 (&acc)[2][2][4][2], const pg8::Unit& u, int wr, int wc, int fr_, int fq_, const LAS uchar* bl) const {
        EPI_LANE();
        const int row0 = u.row0 + wr * 64 + fr, col0 = u.col0 + wc * 64 + 16 * fq;
        const LAS float* bp = (const LAS float*)bl + wc * 64 + 16 * fq;
        f32x4 bv[2][2];
#pragma unroll
        for (int bj = 0; bj < 2; ++bj)
#pragma unroll
            for (int n = 0; n < 2; ++n) bv[bj][n] = *(const LAS f32x4*)(bp + bj * 8 + 4 * n);
#pragma unroll
        for (int ai = 0; ai < 2; ++ai)
#pragma unroll
            for (int m = 0; m < 4; ++m) { uchar* rowp = YR + (size_t)(row0 + ai * 128 + m * 16) * D + col0;
                const f32x4 v0 = acc[ai][0][m][0] * W8_INV + bv[0][0], v1 = acc[ai][0][m][1] * W8_INV + bv[0][1], v2 = acc[ai][1][m][0] * W8_INV + bv[1][0], v3 = acc[ai][1][m][1] * W8_INV + bv[1][1];
                u32x4 w; w.x = pk_fp8x4(v0[0], v0[1], v0[2], v0[3]); w.y = pk_fp8x4(v1[0], v1[1], v1[2], v1[3]); w.z = pk_fp8x4(v2[0], v2[1], v2[2], v2[3]); w.w = pk_fp8x4(v3[0], v3[1], v3[2], v3[3]);
                *(u32x4*)rowp = w; }
    }
};

#define XB_TMO      128
#define XB_XCNT(j)  (256  + 64 * (j))
#define XB_XSUB(j)  (1280 + 64 * (j))
#define XB_XGEN(j)  (2304 + 64 * (j))
#define XB_TOP      3328
#define XB_TOPGEN   3392
#define XCD_BAR_WORDS 3456
#define XB_SPIN_CAP (1u << 18)
__device__ __forceinline__ unsigned xb_ld(unsigned* p)              { return __hip_atomic_load(p, __ATOMIC_RELAXED, __HIP_MEMORY_SCOPE_AGENT); }
__device__ __forceinline__ unsigned xb_add(unsigned* p, unsigned v) { return __hip_atomic_fetch_add(p, v, __ATOMIC_RELAXED, __HIP_MEMORY_SCOPE_AGENT); }
__device__ __forceinline__ unsigned xb_xcc_id() { return (unsigned)__builtin_amdgcn_s_getreg((3 << 11) | 20) & 0xFu; }
#define XB_SPIN(cond, bar) do { unsigned _sp = 0; while (cond) { __builtin_amdgcn_s_sleep(1); \
    if ((++_sp & 255u) == 0u) { if (xb_ld(&(bar)[XB_TMO])) break; if (_sp > XB_SPIN_CAP) { atomicAdd(&(bar)[XB_TMO], 1u); break; } } } } while (0)
struct XcdBarrier { unsigned* bar; unsigned x; volatile LAS unsigned* st; };
__device__ __forceinline__ XcdBarrier xcd_barrier_post(unsigned* bar, volatile LAS unsigned* st) {
    XcdBarrier b; b.bar = bar; b.x = xb_xcc_id(); b.st = st;
    if (threadIdx.x == 0) (void)xb_add(&bar[XB_XCNT(b.x)], 1u);
    return b;
}
__device__ __forceinline__ void xcd_barrier_complete(unsigned* bar, unsigned x, unsigned& nloc, unsigned& nx) {
    const unsigned G = gridDim.x * gridDim.y * gridDim.z;
    unsigned sum, cnt, mine, sp = 0u;
    for (;;) {
        sum = 0u; cnt = 0u; mine = 0u;
#pragma unroll
        for (unsigned j = 0; j < 16; ++j) { const unsigned c = xb_ld(&bar[XB_XCNT(j)]); sum += c; cnt += (c > 0u) ? 1u : 0u; mine = (j == x) ? c : mine; }
        if (sum == G) break;
        __builtin_amdgcn_s_sleep(1);
        if ((++sp & 255u) == 0u) { if (xb_ld(&bar[XB_TMO])) break; if (sp > XB_SPIN_CAP) { atomicAdd(&bar[XB_TMO], 1u); break; } }
    }
    nloc = mine > 0u ? mine : 1u; nx = cnt > 0u ? cnt : 1u;
}
__device__ __forceinline__ void xcd_barrier(const XcdBarrier& b) {
    asm volatile("s_waitcnt vmcnt(0)" ::: "memory");
    __syncthreads();
    if (threadIdx.x == 0) {
        unsigned* bar = b.bar;
        __builtin_amdgcn_s_waitcnt(0);
        unsigned nloc = b.st[0], nx = b.st[1];
        if (nloc == 0u) { xcd_barrier_complete(bar, b.x, nloc, nx); b.st[0] = nloc; b.st[1] = nx; }
        const unsigned old = xb_add(&bar[XB_XSUB(b.x)], 1u);
        const unsigned gen = old / nloc;
        if (old + 1u == (gen + 1u) * nloc) {
            __builtin_amdgcn_fence(__ATOMIC_RELEASE, "agent");
            asm volatile("s_waitcnt vmcnt(0)" ::: "memory");
            const unsigned og = xb_add(&bar[XB_TOP], 1u);
            const unsigned tg = og / nx;
            if (og + 1u == (tg + 1u) * nx) xb_add(&bar[XB_TOPGEN], 1u);
            else XB_SPIN(xb_ld(&bar[XB_TOPGEN]) == tg, bar);
            __builtin_amdgcn_fence(__ATOMIC_ACQUIRE, "agent");
            xb_add(&bar[XB_XGEN(b.x)], 1u);
            asm volatile("s_waitcnt vmcnt(0)" ::: "memory");
        } else {
            XB_SPIN(xb_ld(&bar[XB_XGEN(b.x)]) == gen, bar);
            __builtin_amdgcn_fence(__ATOMIC_ACQUIRE, "agent");
            asm volatile("s_waitcnt vmcnt(0)" ::: "memory");
        }
    }
    __syncthreads();
}

struct Ctx { LAS uchar* lds; int tid, lane, wave, G, bid; uchar* ws; const void* const* in; float* out; };
#define XP_x(X) ((const float*)(X).in[0])
#define XP_pos(X) ((const int*)(X).in[1])
#define XP_ln_mix_w(X) ((const float*)(X).in[2])
#define XP_w_in(X) ((const float*)(X).in[3])
#define XP_conv_w(X) ((const float*)(X).in[4])
#define XP_conv_b(X) ((const float*)(X).in[5])
#define XP_dt_bias(X) ((const float*)(X).in[6])
#define XP_a_log(X) ((const float*)(X).in[7])
#define XP_d_skip(X) ((const float*)(X).in[8])
#define XP_ssm_norm_w(X) ((const float*)(X).in[9])
#define XP_w_out(X) ((const float*)(X).in[10])
#define XP_ln_ffn_w(X) ((const float*)(X).in[11])
#define XP_w_router(X) ((const float*)(X).in[12])
#define XP_b_router(X) ((const float*)(X).in[13])
#define XP_w_gu(X) ((const float*)(X).in[14])
#define XP_b_gu(X) ((const float*)(X).in[15])
#define XP_w_d(X) ((const float*)(X).in[16])
#define XP_b_d(X) ((const float*)(X).in[17])
#define XP_ln_final_w(X) ((const float*)(X).in[18])
#define XP_WinT(X) ((bf16*)((X).ws + WS_WINT))
#define XP_WoutT(X) ((bf16*)((X).ws + WS_WOUTT))
#define XP_WguT(X) ((uchar*)((X).ws + WS_WGUT))
#define XP_WdT(X) ((uchar*)((X).ws + WS_WDT))
#define XP_U(X) ((bf16*)((X).ws + WS_U))
#define XP_U2(X) ((uchar*)((X).ws + WS_U2))
#define XP_MIX(X) ((bf16*)((X).ws + WS_MIX))
#define XP_XBC(X) ((bf16*)((X).ws + WS_XBC))
#define XP_KV(X) ((bf16*)((X).ws + WS_KV))
#define XP_SST(X) ((bf16*)((X).ws + WS_SST))
#define XP_PROJ(X) ((bf16*)((X).ws + WS_PROJ))
#define XP_ACT(X) ((uchar*)((X).ws + WS_ACT))
#define XP_YR(X) ((uchar*)((X).ws + WS_YR))
#define XP_COS(X) ((float*)((X).ws + WS_COS))
#define XP_SIN(X) ((float*)((X).ws + WS_SIN))
#define XP_Hh(X) ((bf16*)((X).ws + WS_H))
#define XP_ADEC(X) ((float*)((X).ws + WS_ADEC))
#define XP_TOPW(X) ((float*)((X).ws + WS_TOPW))
#define XP_TOPI(X) ((int*)((X).ws + WS_TOPI))
#define XP_TOPR(X) ((int*)((X).ws + WS_TOPR))
#define XP_LIST(X) ((int*)((X).ws + WS_LIST))
#define XP_ctl(X) ((unsigned*)((X).ws + WS_CTL))
#define XP_WRH(X) ((bf16*)((X).ws + WS_WRH))
#define XP_WRL(X) ((bf16*)((X).ws + WS_WRL))


__device__ __forceinline__ bf16x8 tr_frag(LAS uchar* p, int rstep) {
    const s16x4 a = __builtin_amdgcn_ds_read_tr16_b64_v4i16((LAS s16x4*)p);
    const s16x4 b = __builtin_amdgcn_ds_read_tr16_b64_v4i16((LAS s16x4*)(p + rstep));
    return (bf16x8){a[0], a[1], a[2], a[3], b[0], b[1], b[2], b[3]};
}
__device__ __forceinline__ f32x4 mma16(bf16x8 xrow, bf16x8 ycol, f32x4 c) { return __builtin_amdgcn_mfma_f32_16x16x32_bf16(xrow, ycol, c, 0, 0, 0); }
__device__ __forceinline__ float wave_incl_scan(float v, int lane) {
#pragma unroll
    for (int o = 1; o < 64; o <<= 1) { const float t = __shfl_up(v, o); if (lane >= o) v += t; }
    return v;
}
__device__ __forceinline__ void rope8(const u32x4 k1, const u32x4 k2, const f32x4 c0, const f32x4 c1, const f32x4 s0, const f32x4 s1, const float sc, u32x4& o1, u32x4& o2) {
    float r1[8], r2[8];
#pragma unroll
    for (int m = 0; m < 4; ++m) {
        const float a0 = bf_lo(k1[m]), a1 = bf_hi(k1[m]), b0 = bf_lo(k2[m]), b1 = bf_hi(k2[m]);
        const float cs0 = (m < 2) ? c0[2 * m] : c1[2 * m - 4], cs1 = (m < 2) ? c0[2 * m + 1] : c1[2 * m - 3];
        const float sn0 = (m < 2) ? s0[2 * m] : s1[2 * m - 4], sn1 = (m < 2) ? s0[2 * m + 1] : s1[2 * m - 3];
        r1[2 * m] = (a0 * cs0 - b0 * sn0) * sc; r1[2 * m + 1] = (a1 * cs1 - b1 * sn1) * sc;
        r2[2 * m] = (b0 * cs0 + a0 * sn0) * sc; r2[2 * m + 1] = (b1 * cs1 + a1 * sn1) * sc;
    }
    o1.x = pk_bf16(r1[0], r1[1]); o1.y = pk_bf16(r1[2], r1[3]); o1.z = pk_bf16(r1[4], r1[5]); o1.w = pk_bf16(r1[6], r1[7]);
    o2.x = pk_bf16(r2[0], r2[1]); o2.y = pk_bf16(r2[2], r2[3]); o2.z = pk_bf16(r2[4], r2[5]); o2.w = pk_bf16(r2[6], r2[7]);
}

__device__ __forceinline__ void tr_decode(const Ctx& X, int r, const float*& W, bf16*& WT, int& N, int& kb, int& nb) {
    constexpr int I_IN = 32 * 209;
    if (r < I_IN) { W = XP_w_in(X); WT = XP_WinT(X); N = NPROJ; }
    else { r -= I_IN; W = XP_w_out(X); WT = XP_WoutT(X); N = D; }
    const int nbn = (N + 31) >> 5; kb = r / nbn; nb = r - kb * nbn;
}
__device__ __forceinline__ void tr8_item(const float* W, int N, uchar* WT, int kb, int nb, int lane) {
    const int k0 = kb * 128 + 16 * (lane & 7), n0 = nb * 32 + 4 * (lane >> 3);
    f32x4 v[16];
#pragma unroll
    for (int i = 0; i < 16; ++i) v[i] = __builtin_nontemporal_load((const f32x4*)(W + (size_t)(k0 + i) * N + n0));
#pragma unroll
    for (int j = 0; j < 4; ++j) { u32x4 o;
        o.x = pk_fp8x4(v[0][j] * W8_SCALE, v[1][j] * W8_SCALE, v[2][j] * W8_SCALE, v[3][j] * W8_SCALE); o.y = pk_fp8x4(v[4][j] * W8_SCALE, v[5][j] * W8_SCALE, v[6][j] * W8_SCALE, v[7][j] * W8_SCALE);
        o.z = pk_fp8x4(v[8][j] * W8_SCALE, v[9][j] * W8_SCALE, v[10][j] * W8_SCALE, v[11][j] * W8_SCALE); o.w = pk_fp8x4(v[12][j] * W8_SCALE, v[13][j] * W8_SCALE, v[14][j] * W8_SCALE, v[15][j] * W8_SCALE);
        __builtin_nontemporal_store(o, (u32x4*)(WT + (size_t)(n0 + j) * 2048 + k0)); }
}
__device__ __forceinline__ void tr_load(const float* W, int N, int kb, int nb, int lane, f32x4 (&v)[8]) {
    const int k0 = kb * 64 + 8 * (lane & 7), n0 = nb * 32 + 4 * (lane >> 3);
    if (n0 < N) {
#pragma unroll
        for (int i = 0; i < 8; ++i) v[i] = __builtin_nontemporal_load((const f32x4*)(W + (size_t)(k0 + i) * N + n0));
    }
}
__device__ __forceinline__ void tr_store(bf16* WT, int N, int kb, int nb, int lane, const f32x4 (&v)[8]) {
    const int k0 = kb * 64 + 8 * (lane & 7), n0 = nb * 32 + 4 * (lane >> 3);
    if (n0 < N) {
#pragma unroll
        for (int j = 0; j < 4; ++j) { u32x4 o; o.x = pk_bf16(v[0][j], v[1][j]); o.y = pk_bf16(v[2][j], v[3][j]); o.z = pk_bf16(v[4][j], v[5][j]); o.w = pk_bf16(v[6][j], v[7][j]);
            *(u32x4*)(WT + (size_t)(n0 + j) * 2048 + k0) = o; }
    }
}
constexpr int I_GU8 = 32 * 16 * 128, I_D8 = 32 * 16 * 64, I_ALL8 = I_GU8 + I_D8;
constexpr int FILL_N1 = 0, FILL_W1 = 160 * 8, FILL_N3 = 3, FILL_W3 = 64 * 8, FILL_N4 = 11, FILL_W4 = 128 * 8;
constexpr int P1_GEMM_BLOCKS = 144, WQ_CHUNK = 8;
constexpr int P5_GEMM_BLOCKS = 128, Q5_N = 24, Q5_W = 128 * 8;
constexpr int FILL_B1 = I_ALL8 - FILL_N1 * FILL_W1 - FILL_N3 * FILL_W3 - FILL_N4 * FILL_W4, FILL_B3 = FILL_B1 + FILL_N1 * FILL_W1, FILL_B4 = FILL_B3 + FILL_N3 * FILL_W3;
constexpr int Q5_BASE = FILL_B3 - Q5_N * Q5_W;
constexpr int CVT_STRIDE = 144, CVT_BUF = 256 * CVT_STRIDE, CQ_CHUNK = 4;
struct Cvb { const float* W; uchar* WT; int N; };
__device__ __forceinline__ Cvb conv8b_dec(const Ctx& X, int bit) { Cvb c; int kb, nb;
    if (bit < I_GU8 / 8) { const int e = bit >> 8, r = bit & 255; kb = r >> 4; nb = r & 15; c.N = 2 * DFF; c.W = XP_w_gu(X) + (size_t)e * D * (2 * DFF); c.WT = XP_WguT(X) + (size_t)e * (2 * DFF) * W8LD; }
    else { const int b2 = bit - I_GU8 / 8, e = b2 >> 7, r = b2 & 127; kb = r >> 3; nb = r & 7; c.N = D; c.W = XP_w_d(X) + (size_t)e * DFF * D; c.WT = XP_WdT(X) + (size_t)e * D * W8LD; }
    c.W += (size_t)(kb * 128 + 16 * X.wave) * c.N + nb * 256 + 4 * X.lane;
    c.WT += (size_t)(nb * 256 + 32 * X.wave + (X.lane >> 3)) * W8LD + kb * 128 + 16 * (X.lane & 7);
    return c; }
__device__ __forceinline__ void conv8b_run(const Ctx& X, int first, int step, int count) {
    if (count <= 0) return;
    f32x4 v[16];
    Cvb c = conv8b_dec(X, first), cn = c;
#pragma unroll
    for (int i = 0; i < 16; ++i) v[i] = __builtin_nontemporal_load((const f32x4*)(c.W + (size_t)i * c.N));
#pragma unroll 1
    for (int j = 0; j < count; ++j) {
        LAS uchar* buf = X.lds + (j & 1) * CVT_BUF;
#pragma unroll
        for (int q = 0; q < 4; ++q) { u32x4 o;
            o.x = pk_fp8x4(v[0][q] * W8_SCALE, v[1][q] * W8_SCALE, v[2][q] * W8_SCALE, v[3][q] * W8_SCALE); o.y = pk_fp8x4(v[4][q] * W8_SCALE, v[5][q] * W8_SCALE, v[6][q] * W8_SCALE, v[7][q] * W8_SCALE);
            o.z = pk_fp8x4(v[8][q] * W8_SCALE, v[9][q] * W8_SCALE, v[10][q] * W8_SCALE, v[11][q] * W8_SCALE); o.w = pk_fp8x4(v[12][q] * W8_SCALE, v[13][q] * W8_SCALE, v[14][q] * W8_SCALE, v[15][q] * W8_SCALE);
            *(LAS u32x4*)(buf + (4 * X.lane + q) * CVT_STRIDE + 16 * X.wave) = o; }
        if (j + 1 < count) { cn = conv8b_dec(X, first + (j + 1) * step);
#pragma unroll
            for (int i = 0; i < 16; ++i) v[i] = __builtin_nontemporal_load((const f32x4*)(cn.W + (size_t)i * cn.N)); }
        asm volatile("s_waitcnt lgkmcnt(0)" ::: "memory"); __builtin_amdgcn_s_barrier();
#pragma unroll
        for (int it = 0; it < 4; ++it) { const u32x4 r = *(const LAS u32x4*)(buf + (32 * X.wave + 8 * it + (X.lane >> 3)) * CVT_STRIDE + 16 * (X.lane & 7));
            __builtin_nontemporal_store(r, (u32x4*)(c.WT + (size_t)it * 8 * W8LD)); }
        c = cn;
    }
    asm volatile("s_waitcnt lgkmcnt(0)" ::: "memory"); __builtin_amdgcn_s_barrier();
}
__device__ __forceinline__ void conv8_fill(const Ctx& X, int base, int rank, int nblk, int n) { conv8b_run(X, (base >> 3) + rank, nblk, n); }
__device__ __forceinline__ void conv8_queue(const Ctx& X, int n) {
    LAS int* qw = (LAS int*)(X.lds + LDS_MISC + 64);
    unsigned zo = 0; asm volatile("" : "+v"(zo));
    int nb_ = 0;
    if (X.tid == 0) nb_ = (int)__hip_atomic_fetch_add(XP_ctl(X) + CW_WQ + zo, (unsigned)(8 * CQ_CHUNK), __ATOMIC_RELAXED, __HIP_MEMORY_SCOPE_AGENT);
    for (;;) {
        if (X.tid == 0) *qw = nb_;
        __syncthreads();
        const int base = __builtin_amdgcn_readfirstlane(*qw);
        if (base >= n) break;
        if (X.tid == 0) nb_ = (int)__hip_atomic_fetch_add(XP_ctl(X) + CW_WQ + zo, (unsigned)(8 * CQ_CHUNK), __ATOMIC_RELAXED, __HIP_MEMORY_SCOPE_AGENT);
        const int left = (n - base) >> 3;
        conv8b_run(X, base >> 3, 1, left < CQ_CHUNK ? left : CQ_CHUNK);
    }
}
__device__ __forceinline__ void p0_prologue(Ctx& X) {
    const int gw = X.bid * NWAVES + X.wave, NGW = X.G * NWAVES, lane = X.lane;
    const int gt = X.bid * NTHR + X.tid, NGT = X.G * NTHR;
    for (int m = gw; m < T; m += NGW) {
        const f32x4* xr = (const f32x4*)(XP_x(X) + (size_t)m * D) + lane; const f32x4* wr_ = (const f32x4*)XP_ln_mix_w(X) + lane;
        f32x4 v[8]; float s = 0.f;
#pragma unroll
        for (int j = 0; j < 8; ++j) { v[j] = xr[64 * j]; s += (v[j].x * v[j].x + v[j].y * v[j].y) + (v[j].z * v[j].z + v[j].w * v[j].w); }
        const float rstd = rsqrtf(wave_sum(s) * (1.f / D) + EPS);
        u32x2* o8 = (u32x2*)(XP_U(X) + (size_t)m * D) + lane;
#pragma unroll
        for (int j = 0; j < 8; ++j) { const f32x4 w = wr_[64 * j]; u32x2 o; o.x = pk_bf16(v[j].x * rstd * w.x, v[j].y * rstd * w.y); o.y = pk_bf16(v[j].z * rstd * w.z, v[j].w * rstd * w.w); o8[64 * j] = o; }
    }
    for (int idx = gt; idx < T * 128; idx += NGT) {
        const int t = idx >> 7, i = idx & 127;
        const double ang = (double)XP_pos(X)[t] * INV_FREQ[i];
        double rev = ang * 0.15915494309189533577; rev -= floor(rev);
        const float f = (float)rev;
        XP_COS(X)[idx] = __builtin_amdgcn_cosf(f); XP_SIN(X)[idx] = __builtin_amdgcn_sinf(f);
    }
    { u32x4* p = (u32x4*)(XP_WinT(X) + (size_t)NPROJ * D); const int n16 = (LDP - NPROJ) * D * 2 / 16; const u32x4 z = {0u, 0u, 0u, 0u};
      for (int i = gt; i < n16; i += NGT) p[i] = z; }
    for (int idx = gt; idx < NE * D; idx += NGT) { const int e = idx >> 11, d = idx & 2047;
        const float wv = XP_ln_ffn_w(X)[d] * XP_w_router(X)[d * NE + e]; const unsigned hb = pk_bf16(wv, 0.f) & 0xffffu; const float lo = wv - __uint_as_float(hb << 16);
        XP_WRH(X)[idx] = (bf16)hb; XP_WRL(X)[idx] = (bf16)(pk_bf16(lo, 0.f) & 0xffffu); }
    constexpr int NIT = 32 * 209 + 32 * 64;
    for (int it = gw; it < NIT; it += 2 * NGW) {
        const float *W0, *W1 = nullptr; bf16 *T0, *T1 = nullptr; int N0, N1 = 0, kb0, kb1 = 0, nb0, nb1 = 0;
        f32x4 v0[8], v1[8];
        tr_decode(X, it, W0, T0, N0, kb0, nb0);
        const bool two = (it + NGW) < NIT;
        if (two) tr_decode(X, it + NGW, W1, T1, N1, kb1, nb1);
        tr_load(W0, N0, kb0, nb0, lane, v0);
        if (two) tr_load(W1, N1, kb1, nb1, lane, v1);
        tr_store(T0, N0, kb0, nb0, lane, v0);
        if (two) tr_store(T1, N1, kb1, nb1, lane, v1);
    }
}

__device__ __forceinline__ bf16x8 scale_frag(const bf16x8 f, const float base, const float (&rr)[8]) {
    u32x4 u = __builtin_bit_cast(u32x4, f);
    u.x = pk_bf16(bf_lo(u.x) * (base * rr[0]), bf_hi(u.x) * (base * rr[1])); u.y = pk_bf16(bf_lo(u.y) * (base * rr[2]), bf_hi(u.y) * (base * rr[3]));
    u.z = pk_bf16(bf_lo(u.z) * (base * rr[4]), bf_hi(u.z) * (base * rr[5])); u.w = pk_bf16(bf_lo(u.w) * (base * rr[6]), bf_hi(u.w) * (base * rr[7]));
    return __builtin_bit_cast(bf16x8, u);
}
__device__ __forceinline__ void p2_ret(Ctx& X, int unit) {
    const int c = unit >> 2, h = unit & 3, t0 = c * CH, tid = X.tid, lane = X.lane, w = X.wave;
    LAS uchar* Vt = X.lds; LAS uchar* Kt = X.lds + 69632;
    { u32x4 vv[8], kk[8];
#pragma unroll
      for (int i = 0; i < 8; ++i) { const int q = tid + 512 * i, l = q >> 5, vc = q & 31; const bf16* rp = XP_PROJ(X) + (size_t)(t0 + l) * LDP + h * 256 + vc * 8;
          vv[i] = *(const u32x4*)(rp + C_V); kk[i] = *(const u32x4*)(rp + C_K); }
#pragma unroll
      for (int i = 0; i < 8; ++i) { const int q = tid + 512 * i, l = q >> 5, vc = q & 31; *(LAS u32x4*)(Vt + l * 544 + vc * 16) = vv[i]; *(LAS u32x4*)(Kt + l * 544 + vc * 16) = kk[i]; } }
    __syncthreads();
    const float lg = LG2_GAMMA[h];
    float rr[8];
#pragma unroll
    for (int e = 0; e < 8; ++e) rr[e] = exp2f(-lg * (float)e);
    const int fr = lane & 15, fq = lane >> 4, trs = (8 * fq + ((lane & 15) >> 2)) * 544 + 8 * (lane & 3);
    f32x4 acc[2][16];
#pragma unroll
    for (int a = 0; a < 2; ++a)
#pragma unroll
        for (int n = 0; n < 16; ++n) acc[a][n] = (f32x4){0.f, 0.f, 0.f, 0.f};
#pragma unroll 1
    for (int ks = 0; ks < 4; ++ks) {
        const float base = exp2f(lg * (float)(127 - 32 * ks - 8 * fq));
        const bf16x8 af0 = scale_frag(tr_frag(Vt + (32 * ks) * 544 + (16 * w) * 2 + trs, 4 * 544), base, rr);
        const bf16x8 af1 = scale_frag(tr_frag(Vt + (32 * ks) * 544 + (128 + 16 * w) * 2 + trs, 4 * 544), base, rr);
#pragma unroll
        for (int n = 0; n < 16; ++n) { const bf16x8 bf = tr_frag(Kt + (32 * ks) * 544 + (16 * n) * 2 + trs, 4 * 544);
            acc[0][n] = mma16(bf, af0, acc[0][n]); acc[1][n] = mma16(bf, af1, acc[1][n]); }
    }
    bf16* outp = XP_KV(X) + (size_t)(c * 4 + h) * 65536;
#pragma unroll
    for (int a = 0; a < 2; ++a)
#pragma unroll
        for (int n = 0; n < 16; ++n) { u32x2 o; o.x = pk_bf16(acc[a][n][0], acc[a][n][1]); o.y = pk_bf16(acc[a][n][2], acc[a][n][3]);
            *(u32x2*)(outp + (size_t)(128 * a + 16 * w + fr) * 256 + 16 * n + 4 * fq) = o; }
    __syncthreads();
}
__device__ __forceinline__ void conv8(const Ctx& X, int t, int cx, float (&o)[8]) {
    const f32x4 b0 = *(const f32x4*)(XP_conv_b(X) + cx), b1 = *(const f32x4*)(XP_conv_b(X) + cx + 4);
    o[0] = b0.x; o[1] = b0.y; o[2] = b0.z; o[3] = b0.w; o[4] = b1.x; o[5] = b1.y; o[6] = b1.z; o[7] = b1.w;
#pragma unroll
    for (int j = 0; j < 4; ++j) { const int tt = t - 3 + j;
        if (tt >= 0) { const u32x4 v = *(const u32x4*)(XP_PROJ(X) + (size_t)tt * LDP + C_X + cx);
            const f32x4 w0 = *(const f32x4*)(XP_conv_w(X) + j * XBCW + cx), w1 = *(const f32x4*)(XP_conv_w(X) + j * XBCW + cx + 4);
            o[0] += w0.x * bf_lo(v.x); o[1] += w0.y * bf_hi(v.x); o[2] += w0.z * bf_lo(v.y); o[3] += w0.w * bf_hi(v.y);
            o[4] += w1.x * bf_lo(v.z); o[5] += w1.y * bf_hi(v.z); o[6] += w1.z * bf_lo(v.w); o[7] += w1.w * bf_hi(v.w); } }
#pragma unroll
    for (int i = 0; i < 8; ++i) o[i] = silu_f(o[i]);
}
__device__ __forceinline__ void p2_ssd(Ctx& X, int unit) {
    const int c = unit >> 2, g = (unit >> 1) & 1, hh = unit & 1, t0 = c * CH, tid = X.tid, lane = X.lane, w = X.wave;
    LAS uchar* Xd = X.lds; LAS uchar* Bc = X.lds + 69632;
    LAS float* dtS = (LAS float*)(X.lds + 106496); LAS float* acS = (LAS float*)(X.lds + 108544);
    if (w < 4) { const int h = 8 * g + 4 * hh + w, l0 = 2 * lane;
        const float dtb = XP_dt_bias(X)[h], A = -expf(XP_a_log(X)[h]);
        const float d0 = softplus_f(bf2f(XP_PROJ(X)[(size_t)(t0 + l0) * LDP + C_DT + h]) + dtb), d1 = softplus_f(bf2f(XP_PROJ(X)[(size_t)(t0 + l0 + 1) * LDP + C_DT + h]) + dtb);
        const float a0 = d0 * A, a1 = d1 * A, s = a0 + a1, incl = wave_incl_scan(s, lane);
        dtS[w * 128 + l0] = d0; dtS[w * 128 + l0 + 1] = d1; acS[w * 128 + l0] = incl - a1; acS[w * 128 + l0 + 1] = incl;
        if (lane == 63) XP_ADEC(X)[c * 16 + h] = expf(incl); }
    __syncthreads();
    if (tid < 504) { const int rg = tid / 56, j = tid - rg * 56, l0 = 15 * rg;
        int cx; if (j < 32) cx = 512 * g + 256 * hh + 8 * j; else if (j < 48) cx = 1024 + 128 * g + 8 * (j - 32); else cx = 1280 + 128 * g + 64 * hh + 8 * (j - 48);
        u32x4 rw[18];
#pragma unroll
        for (int r = 0; r < 18; ++r) { const int l = l0 - 3 + r, tt = t0 + l; rw[r] = (tt >= 0 && l < 128) ? *(const u32x4*)(XP_PROJ(X) + (size_t)tt * LDP + C_X + cx) : (u32x4){0u, 0u, 0u, 0u}; }
        f32x4 wa[4], wb[4];
#pragma unroll
        for (int k = 0; k < 4; ++k) { wa[k] = *(const f32x4*)(XP_conv_w(X) + k * XBCW + cx); wb[k] = *(const f32x4*)(XP_conv_w(X) + k * XBCW + cx + 4); }
        const f32x4 ba = *(const f32x4*)(XP_conv_b(X) + cx), bb = *(const f32x4*)(XP_conv_b(X) + cx + 4);
#pragma unroll
        for (int r = 0; r < 15; ++r) { const int l = l0 + r;
            if (l < 128) { float o[8] = {ba.x, ba.y, ba.z, ba.w, bb.x, bb.y, bb.z, bb.w};
#pragma unroll
                for (int k = 0; k < 4; ++k) { const u32x4 v = rw[r + k];
                    o[0] += wa[k].x * bf_lo(v.x); o[1] += wa[k].y * bf_hi(v.x); o[2] += wa[k].z * bf_lo(v.y); o[3] += wa[k].w * bf_hi(v.y);
                    o[4] += wb[k].x * bf_lo(v.z); o[5] += wb[k].y * bf_hi(v.z); o[6] += wb[k].z * bf_lo(v.w); o[7] += wb[k].w * bf_hi(v.w); }
#pragma unroll
                for (int i = 0; i < 8; ++i) o[i] = silu_f(o[i]);
                u32x4 ov; ov.x = pk_bf16(o[0], o[1]); ov.y = pk_bf16(o[2], o[3]); ov.z = pk_bf16(o[4], o[5]); ov.w = pk_bf16(o[6], o[7]);
                if (j < 32) { const int e = j >> 3; const float sc = dtS[e * 128 + l] * __expf(acS[e * 128 + 127] - acS[e * 128 + l]);
                    u32x4 os; os.x = pk_bf16(o[0] * sc, o[1] * sc); os.y = pk_bf16(o[2] * sc, o[3] * sc); os.z = pk_bf16(o[4] * sc, o[5] * sc); os.w = pk_bf16(o[6] * sc, o[7] * sc);
                    *(LAS u32x4*)(Xd + l * 544 + j * 16) = os; *(u32x4*)(XP_XBC(X) + (size_t)(t0 + l) * XBCW + cx) = ov; }
                else if (j < 48) { *(LAS u32x4*)(Bc + l * 288 + (j - 32) * 16) = ov; if (hh == 0) *(u32x4*)(XP_XBC(X) + (size_t)(t0 + l) * XBCW + cx) = ov; }
                else *(u32x4*)(XP_XBC(X) + (size_t)(t0 + l) * XBCW + cx) = ov; } } }
    __syncthreads();
    const int fr = lane & 15, fq = lane >> 4, q4 = (lane & 15) >> 2, p4 = lane & 3;
    const int trx = (8 * fq + q4) * 544 + 8 * p4, trb = (8 * fq + q4) * 288 + 8 * p4;
    f32x4 acc[2][8];
#pragma unroll
    for (int a = 0; a < 2; ++a)
#pragma unroll
        for (int n = 0; n < 8; ++n) acc[a][n] = (f32x4){0.f, 0.f, 0.f, 0.f};
#pragma unroll 1
    for (int ks = 0; ks < 4; ++ks) {
        const bf16x8 af0 = tr_frag(Xd + (32 * ks) * 544 + (16 * w) * 2 + trx, 4 * 544);
        const bf16x8 af1 = tr_frag(Xd + (32 * ks) * 544 + (128 + 16 * w) * 2 + trx, 4 * 544);
#pragma unroll
        for (int n = 0; n < 8; ++n) { const bf16x8 bf = tr_frag(Bc + (32 * ks) * 288 + (16 * n) * 2 + trb, 4 * 288);
            acc[0][n] = mma16(bf, af0, acc[0][n]); acc[1][n] = mma16(bf, af1, acc[1][n]); }
    }
#pragma unroll
    for (int a = 0; a < 2; ++a) { const int m = 128 * a + 16 * w + fr, h = 8 * g + 4 * hh + (m >> 6), p = m & 63;
        bf16* outp = XP_SST(X) + ((size_t)(c * 16 + h) * 64 + p) * 128;
#pragma unroll
        for (int n = 0; n < 8; ++n) { u32x2 o; o.x = pk_bf16(acc[a][n][0], acc[a][n][1]); o.y = pk_bf16(acc[a][n][2], acc[a][n][3]); *(u32x2*)(outp + 16 * n + 4 * fq) = o; } }
    __syncthreads();
}

__device__ __forceinline__ void p3_scan(Ctx& X) {
    const int gt = X.bid * NTHR + X.tid, NGT = X.G * NTHR;
    for (int item = gt; item < 65536 + 32768; item += NGT) {
        const bool ret = item < 65536; const int it2 = ret ? item : item - 65536;
        bf16* p = ret ? (XP_KV(X) + (size_t)it2 * 4) : (XP_SST(X) + (size_t)it2 * 4);
        const size_t stride = ret ? 262144 : 131072;
        const int head = ret ? (it2 >> 14) : (it2 >> 11);
        const float gdec = ret ? GAMMA_CHUNK[head & 3] : 0.f;
        float s0 = 0.f, s1 = 0.f, s2 = 0.f, s3 = 0.f;
        for (int c0 = 0; c0 < NCHUNK; c0 += 16) {
            u32x2 v[16]; float dec[16];
#pragma unroll
            for (int j = 0; j < 16; ++j) { v[j] = *(const u32x2*)(p + (size_t)(c0 + j) * stride); dec[j] = ret ? gdec : XP_ADEC(X)[(c0 + j) * 16 + head]; }
#pragma unroll
            for (int j = 0; j < 16; ++j) { u32x2 o; o.x = pk_bf16(s0, s1); o.y = pk_bf16(s2, s3); *(u32x2*)(p + (size_t)(c0 + j) * stride) = o;
                s0 = dec[j] * s0 + bf_lo(v[j].x); s1 = dec[j] * s1 + bf_hi(v[j].x); s2 = dec[j] * s2 + bf_lo(v[j].y); s3 = dec[j] * s3 + bf_hi(v[j].y); }
        }
    }
}

__device__ __forceinline__ void p4_ret(Ctx& X, int unit) {
    const int c = unit >> 2, h = unit & 3, t0 = c * CH, tid = X.tid, lane = X.lane, w = X.wave;
    LAS uchar* R1 = X.lds; LAS uchar* R2 = X.lds + 69632;
    const float lg = LG2_GAMMA[h];
    u32x4 P[8];
    { u32x4 qq[8];
#pragma unroll
      for (int i = 0; i < 8; ++i) { const int q = tid + 512 * i, l = q >> 5, dc = q & 31; const bf16* rp = XP_PROJ(X) + (size_t)(t0 + l) * LDP + h * 256 + dc * 8;
          qq[i] = *(const u32x4*)(rp + C_Q); P[i] = *(const u32x4*)(rp + C_K); }
#pragma unroll
      for (int i = 0; i < 8; ++i) { const int q = tid + 512 * i, l = q >> 5, dc = q & 31; *(LAS u32x4*)(R1 + l * 544 + dc * 16) = qq[i]; *(LAS u32x4*)(R2 + l * 544 + dc * 16) = P[i]; } }
    __syncthreads();
    const bf16* prev = XP_KV(X) + (size_t)(c * 4 + h) * 65536;
#pragma unroll
    for (int i = 0; i < 8; ++i) { const int q = tid + 512 * i, v = q >> 4, dc = q & 15; P[i] = *(const u32x4*)(prev + (size_t)v * 256 + dc * 8); }
    const int fr = lane & 15, fq = lane >> 4, q4 = (lane & 15) >> 2, p4 = lane & 3, l = 16 * w + fr;
    f32x4 sc[8];
#pragma unroll
    for (int n = 0; n < 8; ++n) sc[n] = (f32x4){0.f, 0.f, 0.f, 0.f};
#pragma unroll 2
    for (int ks = 0; ks < 8; ++ks) {
        const bf16x8 af = *(const LAS bf16x8*)(R1 + l * 544 + (32 * ks + 8 * fq) * 2);
#pragma unroll
        for (int n = 0; n < 8; ++n) if (n <= w) { const bf16x8 bf = *(const LAS bf16x8*)(R2 + (16 * n + fr) * 544 + (32 * ks + 8 * fq) * 2); sc[n] = mma16(bf, af, sc[n]); }
    }
    bf16x8 scf[4];
#pragma unroll
    for (int k2 = 0; k2 < 4; ++k2) { float v[8];
#pragma unroll
        for (int tq = 0; tq < 2; ++tq)
#pragma unroll
            for (int j = 0; j < 4; ++j) { const int s = 16 * (2 * k2 + tq) + 4 * fq + j; v[4 * tq + j] = (s <= l) ? sc[2 * k2 + tq][j] * exp2f(lg * (float)(l - s)) : 0.f; }
        u32x4 pk; pk.x = pk_bf16(v[0], v[1]); pk.y = pk_bf16(v[2], v[3]); pk.z = pk_bf16(v[4], v[5]); pk.w = pk_bf16(v[6], v[7]);
        scf[k2] = __builtin_bit_cast(bf16x8, pk); }
    __syncthreads();
    f32x4 acc[16];
#pragma unroll
    for (int n = 0; n < 16; ++n) acc[n] = (f32x4){0.f, 0.f, 0.f, 0.f};
#pragma unroll
    for (int dh = 0; dh < 2; ++dh) {
#pragma unroll
        for (int i = 0; i < 8; ++i) { const int q = tid + 512 * i, v = q >> 4, dc = q & 15; *(LAS u32x4*)(R2 + v * 272 + dc * 16) = P[i]; }
        __syncthreads();
        if (dh == 0) {
#pragma unroll
            for (int i = 0; i < 8; ++i) { const int q = tid + 512 * i, v = q >> 4, dc = q & 15; P[i] = *(const u32x4*)(prev + (size_t)v * 256 + 128 + dc * 8); }
        } else {
#pragma unroll
            for (int i = 0; i < 8; ++i) { const int q = tid + 512 * i, s_ = q >> 5, vc = q & 31; P[i] = *(const u32x4*)(XP_PROJ(X) + (size_t)(t0 + s_) * LDP + C_V + h * 256 + vc * 8); }
        }
#pragma unroll 2
        for (int ks = 0; ks < 4; ++ks) {
            const bf16x8 af = *(const LAS bf16x8*)(R1 + l * 544 + (128 * dh + 32 * ks + 8 * fq) * 2);
#pragma unroll
            for (int n = 0; n < 16; ++n) { const bf16x8 bf = *(const LAS bf16x8*)(R2 + (16 * n + fr) * 272 + (32 * ks + 8 * fq) * 2); acc[n] = mma16(bf, af, acc[n]); }
        }
        __syncthreads();
    }
    { const float qd = exp2f(lg * (float)(l + 1));
#pragma unroll
      for (int n = 0; n < 16; ++n) acc[n] = acc[n] * qd; }
#pragma unroll
    for (int i = 0; i < 8; ++i) { const int q = tid + 512 * i, s_ = q >> 5, vc = q & 31; *(LAS u32x4*)(R2 + s_ * 544 + vc * 16) = P[i]; }
    __syncthreads();
    const bf16* gp = XP_PROJ(X) + (size_t)(t0 + l) * LDP + C_G + h * 256 + 4 * fq; bf16* op = XP_MIX(X) + (size_t)(t0 + l) * D + h * 256 + 4 * fq;
    u32x2 gv[16];
#pragma unroll
    for (int n = 0; n < 16; ++n) gv[n] = *(const u32x2*)(gp + 16 * n);
    const int trp = (4 * fq + q4) * 544 + 8 * p4;
#pragma unroll
    for (int k2 = 0; k2 < 4; ++k2) if (2 * k2 <= w) {
#pragma unroll
        for (int n = 0; n < 16; ++n) { const bf16x8 bf = tr_frag(R2 + (32 * k2) * 544 + (16 * n) * 2 + trp, 16 * 544); acc[n] = mma16(bf, scf[k2], acc[n]); }
    }
    float ss = 0.f;
#pragma unroll
    for (int n = 0; n < 16; ++n) ss += (acc[n][0] * acc[n][0] + acc[n][1] * acc[n][1]) + (acc[n][2] * acc[n][2] + acc[n][3] * acc[n][3]);
    ss += __shfl_xor(ss, 16); ss += __shfl_xor(ss, 32);
    const float rstd = rsqrtf(ss * (1.f / 256.f) + EPS);
#pragma unroll
    for (int n = 0; n < 16; ++n) {
        u32x2 o; o.x = pk_bf16(acc[n][0] * rstd * silu_f(bf_lo(gv[n].x)), acc[n][1] * rstd * silu_f(bf_hi(gv[n].x))); o.y = pk_bf16(acc[n][2] * rstd * silu_f(bf_lo(gv[n].y)), acc[n][3] * rstd * silu_f(bf_hi(gv[n].y)));
        *(u32x2*)(op + 16 * n) = o; }
    __syncthreads();
}

__device__ __forceinline__ void p4_ssd(Ctx& X, int unit) {
    const int c = unit >> 1, g = unit & 1, t0 = c * CH, tid = X.tid, lane = X.lane, w = X.wave;
    LAS uchar* Cc = X.lds; LAS uchar* Bc = X.lds + 34816;
    LAS uchar* HP = X.lds + 34816;
    LAS float* dtS = (LAS float*)(X.lds + 110592); LAS float* acS = (LAS float*)(X.lds + 114688);
    const int fr = lane & 15, fq = lane >> 4, q4 = (lane & 15) >> 2, p4 = lane & 3, l = 16 * w + fr;
    const bf16* zp = XP_PROJ(X) + (size_t)(t0 + l) * LDP + C_Z + 512 * g + 4 * fq;
    const int hd = 8 * g + w, l0 = 2 * lane;
    const bf16 dr0 = XP_PROJ(X)[(size_t)(t0 + l0) * LDP + C_DT + hd], dr1 = XP_PROJ(X)[(size_t)(t0 + l0 + 1) * LDP + C_DT + hd];
    u32x4 bcv[8];
#pragma unroll
    for (int i = 0; i < 4; ++i) { const int q = tid + 512 * i, l_ = q >> 4, nc = q & 15;
        bcv[2 * i] = *(const u32x4*)(XP_XBC(X) + (size_t)(t0 + l_) * XBCW + 1024 + 128 * g + nc * 8);
        bcv[2 * i + 1] = *(const u32x4*)(XP_XBC(X) + (size_t)(t0 + l_) * XBCW + 1280 + 128 * g + nc * 8); }
    u32x4 px[4], ps[4];
#pragma unroll
    for (int i = 0; i < 4; ++i) { const int q = tid + 512 * i; { const int e2 = q >> 10, s_ = (q >> 3) & 127, pc = q & 7; px[i] = *(const u32x4*)(XP_XBC(X) + (size_t)(t0 + s_) * XBCW + 512 * g + 64 * e2 + pc * 8); }
        { const int e2 = q >> 10, p = (q >> 4) & 63, nc = q & 15; ps[i] = *(const u32x4*)(XP_SST(X) + ((size_t)(c * 16 + 8 * g + e2) * 64 + p) * 128 + nc * 8); } }
    u32x2 zq[2][4];
#pragma unroll
    for (int e2 = 0; e2 < 2; ++e2)
#pragma unroll
        for (int n = 0; n < 4; ++n) zq[e2][n] = *(const u32x2*)(zp + 64 * e2 + 16 * n);
    { const float dtb = XP_dt_bias(X)[hd], A = -expf(XP_a_log(X)[hd]);
      const float d0 = softplus_f(bf2f(dr0) + dtb), d1 = softplus_f(bf2f(dr1) + dtb);
      const float a0 = d0 * A, a1 = d1 * A, incl = wave_incl_scan(a0 + a1, lane);
      dtS[w * 128 + l0] = d0; dtS[w * 128 + l0 + 1] = d1; acS[w * 128 + l0] = incl - a1; acS[w * 128 + l0 + 1] = incl; }
#pragma unroll
    for (int i = 0; i < 4; ++i) { const int q = tid + 512 * i, l_ = q >> 4, nc = q & 15;
        *(LAS u32x4*)(Bc + l_ * 272 + nc * 16) = bcv[2 * i];
        *(LAS u32x4*)(Cc + l_ * 272 + nc * 16) = bcv[2 * i + 1]; }
    __syncthreads();
    f32x4 cb[8]; bf16x8 cfr[4];
#pragma unroll
    for (int n = 0; n < 8; ++n) cb[n] = (f32x4){0.f, 0.f, 0.f, 0.f};
#pragma unroll
    for (int ks = 0; ks < 4; ++ks) {
        cfr[ks] = *(const LAS bf16x8*)(Cc + l * 272 + (32 * ks + 8 * fq) * 2);
#pragma unroll
        for (int n = 0; n < 8; ++n) if (n <= w) { const bf16x8 bf = *(const LAS bf16x8*)(Bc + (16 * n + fr) * 272 + (32 * ks + 8 * fq) * 2); cb[n] = mma16(bf, cfr[ks], cb[n]); }
    }
    __syncthreads();
    float ss = 0.f;
    const int trp = (4 * fq + q4) * 144 + 8 * p4;
    bf16* op = XP_MIX(X) + (size_t)(t0 + l) * D + 1024 + 512 * g + 4 * fq;
#pragma unroll 1
    for (int hp = 0; hp < 4; ++hp) {
#pragma unroll
        for (int i = 0; i < 4; ++i) { const int q = tid + 512 * i; { const int e2 = q >> 10, s_ = (q >> 3) & 127, pc = q & 7; *(LAS u32x4*)(HP + e2 * 18432 + s_ * 144 + pc * 16) = px[i]; }
            { const int e2 = q >> 10, p = (q >> 4) & 63, nc = q & 15; *(LAS u32x4*)(HP + 36864 + e2 * 17408 + p * 272 + nc * 16) = ps[i]; } }
        __syncthreads();
        if (hp < 3) {
#pragma unroll
            for (int i = 0; i < 4; ++i) { const int q = tid + 512 * i; { const int e2 = q >> 10, s_ = (q >> 3) & 127, pc = q & 7, e = 2 * hp + 2 + e2; px[i] = *(const u32x4*)(XP_XBC(X) + (size_t)(t0 + s_) * XBCW + 512 * g + 64 * e + pc * 8); }
                { const int e2 = q >> 10, p = (q >> 4) & 63, nc = q & 15, e = 2 * hp + 2 + e2; ps[i] = *(const u32x4*)(XP_SST(X) + ((size_t)(c * 16 + 8 * g + e) * 64 + p) * 128 + nc * 8); } }
        }
        u32x2 zqn[2][4];
#pragma unroll
        for (int e2 = 0; e2 < 2; ++e2)
#pragma unroll
            for (int n = 0; n < 4; ++n) zqn[e2][n] = zq[e2][n];
        if (hp < 3) {
#pragma unroll
            for (int e2 = 0; e2 < 2; ++e2)
#pragma unroll
                for (int n = 0; n < 4; ++n) zqn[e2][n] = *(const u32x2*)(zp + 64 * (2 * hp + 2 + e2) + 16 * n);
        }
#pragma unroll
        for (int e2 = 0; e2 < 2; ++e2) { const int e = 2 * hp + e2;
            LAS uchar* Xh = HP + e2 * 18432; LAS uchar* Ph = HP + 36864 + e2 * 17408;
            f32x4 y[4];
#pragma unroll
            for (int n = 0; n < 4; ++n) y[n] = (f32x4){0.f, 0.f, 0.f, 0.f};
#pragma unroll
            for (int ks = 0; ks < 4; ++ks)
#pragma unroll
                for (int n = 0; n < 4; ++n) { const bf16x8 bf = *(const LAS bf16x8*)(Ph + (16 * n + fr) * 272 + (32 * ks + 8 * fq) * 2); y[n] = mma16(bf, cfr[ks], y[n]); }
            const float al = acS[e * 128 + l], el = __expf(al);
#pragma unroll
            for (int n = 0; n < 4; ++n) y[n] = y[n] * el;
#pragma unroll
            for (int k2 = 0; k2 < 4; ++k2) if (2 * k2 <= w) { float v[8];
#pragma unroll
                for (int tq = 0; tq < 2; ++tq) { const int s0 = 16 * (2 * k2 + tq) + 4 * fq; const f32x4 as = *(const LAS f32x4*)(acS + e * 128 + s0), ds = *(const LAS f32x4*)(dtS + e * 128 + s0);
#pragma unroll
                    for (int j = 0; j < 4; ++j) v[4 * tq + j] = (s0 + j <= l) ? cb[2 * k2 + tq][j] * ds[j] * __expf(al - as[j]) : 0.f; }
                u32x4 pk; pk.x = pk_bf16(v[0], v[1]); pk.y = pk_bf16(v[2], v[3]); pk.z = pk_bf16(v[4], v[5]); pk.w = pk_bf16(v[6], v[7]);
                const bf16x8 gf = __builtin_bit_cast(bf16x8, pk);
#pragma unroll
                for (int n = 0; n < 4; ++n) { const bf16x8 bf = tr_frag(Xh + (32 * k2) * 144 + (16 * n) * 2 + trp, 16 * 144); y[n] = mma16(bf, gf, y[n]); }
            }
            const float dsk = XP_d_skip(X)[8 * g + e];
#pragma unroll
            for (int n = 0; n < 4; ++n) { const u32x2 xv = *(const LAS u32x2*)(Xh + l * 144 + (16 * n + 4 * fq) * 2), zv = zq[e2][n];
                const float t0_ = (y[n][0] + dsk * bf_lo(xv.x)) * silu_f(bf_lo(zv.x)), t1_ = (y[n][1] + dsk * bf_hi(xv.x)) * silu_f(bf_hi(zv.x));
                const float t2_ = (y[n][2] + dsk * bf_lo(xv.y)) * silu_f(bf_lo(zv.y)), t3_ = (y[n][3] + dsk * bf_hi(xv.y)) * silu_f(bf_hi(zv.y));
                ss += (t0_ * t0_ + t1_ * t1_) + (t2_ * t2_ + t3_ * t3_);
                u32x2 o; o.x = pk_bf16(t0_, t1_); o.y = pk_bf16(t2_, t3_); *(u32x2*)(op + 64 * e + 16 * n) = o; }
        }
#pragma unroll
        for (int e2 = 0; e2 < 2; ++e2)
#pragma unroll
            for (int n = 0; n < 4; ++n) zq[e2][n] = zqn[e2][n];
        __syncthreads();
    }
    ss += __shfl_xor(ss, 16); ss += __shfl_xor(ss, 32);
    const float rstd = rsqrtf(ss * (1.f / 512.f) + EPS);
    const float* nw = XP_ssm_norm_w(X) + 512 * g + 4 * fq;
    u32x2 tv[32];
#pragma unroll
    for (int i = 0; i < 32; ++i) tv[i] = *(const u32x2*)(op + 16 * i);
#pragma unroll
    for (int i = 0; i < 32; ++i) { const f32x4 wv = *(const f32x4*)(nw + 16 * i); const u32x2 t = tv[i];
        u32x2 o; o.x = pk_bf16(bf_lo(t.x) * rstd * wv.x, bf_hi(t.x) * rstd * wv.y); o.y = pk_bf16(bf_lo(t.y) * rstd * wv.z, bf_hi(t.y) * rstd * wv.w);
        *(u32x2*)(op + 16 * i) = o; }
    __syncthreads();
}

__device__ __forceinline__ void p6_router(Ctx& X) {
    const int tid = X.tid, lane = X.lane, w = X.wave, fr = lane & 15, fq = lane >> 4;
    LAS float* part = (LAS float*)X.lds;
    LAS float* ssq = (LAS float*)(X.lds + 32768);
    LAS float* lgt = (LAS float*)(X.lds + 32768 + 1024);
    LAS float* rs = (LAS float*)(X.lds + 32768 + 1024 + 4096);
    for (int item = X.bid; item < T / 32; item += X.G) {
        const int tb = item * 32;
        f32x4 acc[2][2]; float ss[2] = {0.f, 0.f};
#pragma unroll
        for (int a = 0; a < 2; ++a)
#pragma unroll
            for (int n = 0; n < 2; ++n) acc[a][n] = (f32x4){0.f, 0.f, 0.f, 0.f};
#pragma unroll 2
        for (int ks = 0; ks < 8; ++ks) { const int kb = 256 * w + 32 * ks + 8 * fq;
            bf16x8 ah[2], bh[2], bl[2];
#pragma unroll
            for (int mt = 0; mt < 2; ++mt) { const u32x4 hv = *(const u32x4*)(XP_Hh(X) + (size_t)(tb + 16 * mt + fr) * D + kb);
                const float f0 = bf_lo(hv.x), f1 = bf_hi(hv.x), f2 = bf_lo(hv.y), f3 = bf_hi(hv.y), f4 = bf_lo(hv.z), f5 = bf_hi(hv.z), f6 = bf_lo(hv.w), f7 = bf_hi(hv.w);
                ss[mt] += (f0 * f0 + f1 * f1) + (f2 * f2 + f3 * f3) + (f4 * f4 + f5 * f5) + (f6 * f6 + f7 * f7);
                ah[mt] = __builtin_bit_cast(bf16x8, hv); }
#pragma unroll
            for (int nt = 0; nt < 2; ++nt) { bh[nt] = *(const bf16x8*)(XP_WRH(X) + (size_t)(16 * nt + fr) * D + kb); bl[nt] = *(const bf16x8*)(XP_WRL(X) + (size_t)(16 * nt + fr) * D + kb); }
#pragma unroll
            for (int mt = 0; mt < 2; ++mt)
#pragma unroll
                for (int nt = 0; nt < 2; ++nt) { acc[mt][nt] = mma16(bh[nt], ah[mt], acc[mt][nt]); acc[mt][nt] = mma16(bl[nt], ah[mt], acc[mt][nt]); }
        }
#pragma unroll
        for (int mt = 0; mt < 2; ++mt) { float q = ss[mt]; q += __shfl_xor(q, 16); q += __shfl_xor(q, 32); if (fq == 0) ssq[w * 32 + 16 * mt + fr] = q;
#pragma unroll
            for (int nt = 0; nt < 2; ++nt) *(LAS f32x4*)(part + (w * 32 + 16 * mt + fr) * 32 + 16 * nt + 4 * fq) = acc[mt][nt]; }
        __syncthreads();
        { const int tk = tid >> 4, e0 = 2 * (tid & 15); float q = 0.f, a0 = 0.f, a1 = 0.f;
#pragma unroll
          for (int ww = 0; ww < 8; ++ww) { q += ssq[ww * 32 + tk]; const f32x2 p = *(const LAS f32x2*)(part + (ww * 32 + tk) * 32 + e0); a0 += p.x; a1 += p.y; }
          const float rstd = rsqrtf(q * (1.f / D) + EPS);
          lgt[tk * 32 + e0] = a0 * rstd + XP_b_router(X)[e0]; lgt[tk * 32 + e0 + 1] = a1 * rstd + XP_b_router(X)[e0 + 1];
          if ((tid & 15) == 0) rs[tk] = rstd; }
        __syncthreads();
        if (tid < 32) { const int t = tb + tid; unsigned used = 0u; int idx[4]; float val[4];
#pragma unroll
            for (int k = 0; k < 4; ++k) { float best = -3.0e38f; int bi = 0;
#pragma unroll 8
                for (int j = 0; j < 32; ++j) { const float v = lgt[tid * 32 + j]; if (!((used >> j) & 1u) && v > best) { best = v; bi = j; } }
                used |= 1u << bi; idx[k] = bi; val[k] = best; }
            const float e1 = __expf(val[1] - val[0]), e2 = __expf(val[2] - val[0]), e3 = __expf(val[3] - val[0]), inv = 1.f / (1.f + e1 + e2 + e3);
            const float wv[4] = {inv, e1 * inv, e2 * inv, e3 * inv};
            int rk[4];
#pragma unroll
            for (int k = 0; k < 4; ++k) rk[k] = (int)__hip_atomic_fetch_add(XP_ctl(X) + CW_CNT + 64 * idx[k], 1u, __ATOMIC_RELAXED, __HIP_MEMORY_SCOPE_AGENT);
#pragma unroll
            for (int k = 0; k < 4; ++k) { XP_LIST(X)[idx[k] * T + rk[k]] = t; XP_TOPI(X)[t * 4 + k] = idx[k]; XP_TOPR(X)[t * 4 + k] = rk[k]; XP_TOPW(X)[t * 4 + k] = wv[k]; } }
#pragma unroll 2
        for (int r = 0; r < 4; ++r) { const int tk = 4 * w + r, t = tb + tk; const float rstd = rs[tk];
            const u32x2* hr = (const u32x2*)(XP_Hh(X) + (size_t)t * D) + lane; const f32x4* wr_ = (const f32x4*)XP_ln_ffn_w(X) + lane;
            unsigned* o8 = (unsigned*)(XP_U2(X) + (size_t)t * D) + lane;
#pragma unroll
            for (int j = 0; j < 8; ++j) { const u32x2 v = hr[64 * j]; const f32x4 wv = wr_[64 * j]; o8[64 * j] = pk_fp8x4(bf_lo(v.x) * rstd * wv.x, bf_hi(v.x) * rstd * wv.y, bf_lo(v.y) * rstd * wv.z, bf_hi(v.y) * rstd * wv.w); } }
        __syncthreads();
    }
}

__device__ __forceinline__ void moe_tables(Ctx& X) {
    LAS int* tab = (LAS int*)(X.lds + LDS_TAB);
    if (X.tid < 64) { const int e = X.tid;
        const int cnt = (e < NE) ? (int)__hip_atomic_load(XP_ctl(X) + CW_CNT + 64 * e, __ATOMIC_RELAXED, __HIP_MEMORY_SCOPE_AGENT) : 0; const int k = (cnt + 255) >> 8;
        int incl = k;
#pragma unroll
        for (int o = 1; o < 64; o <<= 1) { const int t = __shfl_up(incl, o); if (e >= o) incl += t; }
        const int first = incl - k;
        if (e < NE) { tab[8 + e] = first; for (int b = 0; b < k; ++b) { if (first + b < MAXBLK) { tab[64 + first + b] = e; tab[256 + first + b] = (cnt - 256 * b) < 256 ? (cnt - 256 * b) : 256; } } }
        if (e == NE - 1) { tab[8 + NE] = incl; tab[0] = incl < MAXBLK ? incl : MAXBLK; } }
    __syncthreads();
}

__device__ __forceinline__ void p9_final(Ctx& X) {
    const LAS int* tab = (const LAS int*)(X.lds + LDS_TAB);
    const int gw = X.bid * NWAVES + X.wave, NGW = X.G * NWAVES, lane = X.lane;
    for (int t = gw; t < T; t += NGW) {
        const u32x2* hr = (const u32x2*)(XP_Hh(X) + (size_t)t * D) + lane;
        f32x4 v[8];
#pragma unroll
        for (int j = 0; j < 8; ++j) { const u32x2 hv = hr[64 * j]; v[j] = (f32x4){bf_lo(hv.x), bf_hi(hv.x), bf_lo(hv.y), bf_hi(hv.y)}; }
#pragma unroll
        for (int k = 0; k < 4; ++k) { const int e = XP_TOPI(X)[t * 4 + k], r = XP_TOPR(X)[t * 4 + k]; const float wk = XP_TOPW(X)[t * 4 + k];
            const unsigned* yr = (const unsigned*)(XP_YR(X) + ((size_t)tab[8 + e] * 256 + r) * D) + lane;
#pragma unroll
            for (int j = 0; j < 8; ++j) { const int y = (int)yr[64 * j]; const f32x2 lo = __builtin_amdgcn_cvt_pk_f32_fp8(y, false), hi = __builtin_amdgcn_cvt_pk_f32_fp8(y, true);
                v[j].x += wk * lo.x; v[j].y += wk * lo.y; v[j].z += wk * hi.x; v[j].w += wk * hi.y; } }
        float s = 0.f;
#pragma unroll
        for (int j = 0; j < 8; ++j) s += (v[j].x * v[j].x + v[j].y * v[j].y) + (v[j].z * v[j].z + v[j].w * v[j].w);
        const float rstd = rsqrtf(wave_sum(s) * (1.f / D) + EPS);
        f32x4* o = (f32x4*)(X.out + (size_t)t * D) + lane; const f32x4* wr_ = (const f32x4*)XP_ln_final_w(X) + lane;
#pragma unroll
        for (int j = 0; j < 8; ++j) { const f32x4 wv = wr_[64 * j]; f32x4 r; r.x = v[j].x * rstd * wv.x; r.y = v[j].y * rstd * wv.y; r.z = v[j].z * rstd * wv.z; r.w = v[j].w * rstd * wv.w; o[64 * j] = r; }
    }
}

#ifdef NO_P4R
#define P4R(X,u)
#else
#define P4R(X,u) p4_ret(X,u)
#endif
#ifdef NO_P4S
#define P4S(X,u)
#else
#define P4S(X,u) p4_ssd(X,u)
#endif
struct Args { const void* in[19]; float* out; uchar* ws; int ph_lo, ph_hi; };
__global__ void __launch_bounds__(NTHR, 2) fwd(Args args) {
    extern __shared__ __attribute__((aligned(16))) uchar lds_raw[];
    Ctx X;
    X.lds = (LAS uchar*)lds_raw; X.tid = threadIdx.x; X.lane = X.tid & 63; X.wave = __builtin_amdgcn_readfirstlane(X.tid >> 6); X.G = gridDim.x; X.bid = blockIdx.x;
    X.in = (const void* const*)__builtin_amdgcn_kernarg_segment_ptr(); X.out = args.out; X.ws = args.ws;
    for (int u = X.tid; u < (LDS_BYTES - LDS_PHASE_END) / 4; u += NTHR) ((LAS unsigned*)(X.lds + LDS_PHASE_END))[u] = 0u;
    __syncthreads();
    const int lo = args.ph_lo, hi = args.ph_hi;
    const bool multi = (hi - lo) > 1;
    XcdBarrier bar; bar.bar = XP_ctl(X) + CW_BAR; bar.x = 0; bar.st = nullptr;
    if (multi) bar = xcd_barrier_post(XP_ctl(X) + CW_BAR, (volatile LAS unsigned*)(X.lds + LDS_MISC + 32));
#ifdef ONLY_PHASE
#define IN(k) ((k) == ONLY_PHASE && lo <= (k) && (k) < hi)
#else
#define IN(k) (lo <= (k) && (k) < hi)
#endif
#define SEAM(k) do { if (IN(k) && IN((k) + 1)) xcd_barrier(bar); } while (0)
    if (IN(0)) { p0_prologue(X); } SEAM(0);
    if (IN(1)) {
        const int gb = (X.G == 256) ? P1_GEMM_BLOCKS : X.G;
        if (X.bid < gb) { DenseSched S{(const char*)XP_U(X), (const char*)XP_WinT(X), D, T / 256, LDP / 256, (T / 256) * (LDP / 256), gb, X.bid}; EpiProj E{XP_PROJ(X), LDP, XP_COS(X), XP_SIN(X)};
            pg8::gemm_phase<EpiProj, DenseSched, false, false>(X.lds, D, D, S, E); }
        conv8_queue(X, (X.G == 256) ? Q5_BASE : I_ALL8); } SEAM(1);
    if (IN(2)) { for (int u = X.bid; u < 256; u += X.G) p2_ret(X, u);
        for (int u = X.bid; u < 256; u += X.G) p2_ssd(X, u); } SEAM(2);
    if (IN(3)) { p3_scan(X); if (X.G == 256 && X.bid >= 192) conv8_fill(X, FILL_B3, X.bid - 192, FILL_W3 / NWAVES, FILL_N3); } SEAM(3);
    if (IN(4)) { for (int u = X.bid; u < 256; u += X.G) { P4R(X, u); }
        for (int u = X.bid; u < 128; u += X.G) { P4S(X, u); }
        if (X.G == 256 && X.bid >= 128) conv8_fill(X, FILL_B4, X.bid - 128, FILL_W4 / NWAVES, FILL_N4); } SEAM(4);
    if (IN(5)) {
        const int gb = (X.G == 256) ? P5_GEMM_BLOCKS : X.G;
        if (X.bid < gb) { DenseSched S{(const char*)XP_MIX(X), (const char*)XP_WoutT(X), D, T / 256, D / 256, (T / 256) * (D / 256), gb, X.bid}; EpiOut E{XP_x(X), XP_Hh(X)};
            pg8::gemm_phase<EpiOut, DenseSched, false, false>(X.lds, D, D, S, E); }
        else conv8_fill(X, Q5_BASE, X.bid - gb, Q5_W / NWAVES, Q5_N); } SEAM(5);
    if (IN(6)) { p6_router(X); } SEAM(6);
    if (IN(7)) { moe_tables(X); MoeSched S{(const LAS int*)(X.lds + LDS_TAB), (const char*)XP_U2(X), (const char*)XP_WguT(X), (size_t)(2 * DFF) * W8LD, XP_LIST(X), D / 2, (2 * DFF) / 256, X.G, X.bid}; EpiGateUp E{XP_ACT(X), XP_b_gu(X)};
        pg8::gemm_phase<EpiGateUp, MoeSched, true, true>(X.lds, D / 2, W8LD / 2, S, E); } SEAM(7);
    if (IN(8)) { moe_tables(X); MoeSchedDirect S{(const LAS int*)(X.lds + LDS_TAB), (const char*)XP_ACT(X), (const char*)XP_WdT(X), (size_t)D * W8LD, DFF / 2, D / 256, X.G, X.bid}; EpiDown E{XP_YR(X), XP_b_d(X)};
        pg8::gemm_phase<EpiDown, MoeSchedDirect, true, true>(X.lds, DFF / 2, W8LD / 2, S, E); } SEAM(8);
    if (IN(9)) { moe_tables(X); p9_final(X); }
#undef IN
#undef SEAM
}

extern "C" void kernel_launch(void* const* d_in, const int* in_sizes, int n_in, void* d_out, int out_size, void* d_ws, size_t ws_size, hipStream_t stream) {
    static int grid = 0;
    if (grid == 0) {
        if (n_in != 19 || out_size != T * D || ws_size < WS_END) { fprintf(stderr, "kernel_launch: unexpected shapes (n_in %d, out %d, ws %zu)\n", n_in, out_size, ws_size); grid = -1; return; }
        int dev = 0, cus = 0, per_cu = 0;
        if (hipGetDevice(&dev) != hipSuccess || hipDeviceGetAttribute(&cus, hipDeviceAttributeMultiprocessorCount, dev) != hipSuccess) { grid = -1; return; }
        if (hipFuncSetAttribute((const void*)fwd, hipFuncAttributeMaxDynamicSharedMemorySize, LDS_BYTES) != hipSuccess) { fprintf(stderr, "kernel_launch: hipFuncSetAttribute failed\n"); grid = -1; return; }
        if (hipOccupancyMaxActiveBlocksPerMultiprocessor(&per_cu, (const void*)fwd, NTHR, LDS_BYTES) != hipSuccess || per_cu < 1) { fprintf(stderr, "kernel_launch: occupancy query reports %d\n", per_cu); }
        (void)hipGetLastError();
        grid = cus;
    }
    if (grid < 0) return;
    (void)hipMemsetAsync((char*)d_ws + WS_CTL, 0, CTL_ZERO_BYTES, stream);
    Args a{};
    for (int i = 0; i < 19; ++i) a.in[i] = d_in[i];
    a.out = (float*)d_out; a.ws = (uchar*)d_ws;
    constexpr int NL = MK_N_LAUNCHES;
    for (int li = 0; li < NL; ++li) {
        a.ph_lo = (NL == 1) ? 0 : li; a.ph_hi = (NL == 1) ? NPHASE : li + 1;
        hipLaunchKernelGGL(fwd, dim3(grid), dim3(NTHR), LDS_BYTES, stream, a);
    }
}
```
